# Optimizing an MI355X kernel written in HIP

```python
import math
import jax, jax.numpy as jnp
from jax import lax
import numpy as np

D_MODEL = 2048
BATCH = 1
SEQ = 16384
DEPTH = 2

GRID_W = 64
CTX_LEN = 256
Q_BLOCK = 128
ROPE_BASE = 10000.0
LN_EPS = 1e-5
RMS_EPS = 1e-6

DA_HEADS = 4
DA_HEAD_DIM = 64
DA_WIDTH = DA_HEADS * 2 * DA_HEAD_DIM

LRU_WIDTH = 512
LRU_BLOCKS = 4
LRU_BLOCK = LRU_WIDTH // LRU_BLOCKS
CONV_W = 4
CONV_LEFT = 2
LRU_C = 8.0

MLA_HEADS = 4
MLA_Q_RANK = 384
MLA_KV_RANK = 256
MLA_NOPE = 128
MLA_ROPE = 64
MLA_V = 128
MLA_WIDTH = MLA_HEADS * MLA_V

FFT_GROUPS = 4
FFT_GROUP = 128
FFT_WIDTH = FFT_GROUPS * FFT_GROUP

MIX_WIDTH = DA_WIDTH + LRU_WIDTH + MLA_WIDTH + FFT_WIDTH

IN_DA = 3 * DA_WIDTH
IN_LRU = 2 * LRU_WIDTH
IN_MLA = MLA_Q_RANK + MLA_KV_RANK + MLA_ROPE
IN_FFT = FFT_WIDTH
OFF_LRU = IN_DA
OFF_MLA = OFF_LRU + IN_LRU
OFF_FFT = OFF_MLA + IN_MLA
IN_WIDTH = OFF_FFT + IN_FFT

D_FF = ((8 * D_MODEL + 3 * 256 - 1) // (3 * 256)) * 256

DEEPNORM_ALPHA = (2 * DEPTH) ** 0.25
DEEPNORM_BETA = (8 * DEPTH) ** -0.25

kernel_name = "hymba_style_hybrid_dit_block"


def _layernorm(x, g, b):
    xf = x.astype(jnp.float32)
    mu = jnp.mean(xf, axis=-1, keepdims=True)
    var = jnp.mean(jnp.square(xf - mu), axis=-1, keepdims=True)
    return ((xf - mu) * lax.rsqrt(var + LN_EPS) * g + b).astype(x.dtype)


def _rmsnorm(x, g):
    xf = x.astype(jnp.float32)
    inv = lax.rsqrt(jnp.mean(jnp.square(xf), axis=-1, keepdims=True) + RMS_EPS)
    return (xf * inv * g).astype(x.dtype)


def _modulate(x, shift, scale):
    return x * (1.0 + scale) + shift


def _ada_mods(cvec, w, b):
    m = jax.nn.silu(cvec) @ w + b
    return jnp.split(m, 6, axis=-1)


def _axial_rope_tables(n, rot_dim):
    rows = n // GRID_W
    row = jnp.repeat(jnp.arange(rows, dtype=jnp.float32), GRID_W)
    col = jnp.tile(jnp.arange(GRID_W, dtype=jnp.float32), rows)
    axis_dim = rot_dim // 2
    inv = ROPE_BASE ** (-jnp.arange(0, axis_dim, 2, dtype=jnp.float32) / axis_dim)
    ang = jnp.concatenate([row[:, None] * inv, col[:, None] * inv], axis=-1)
    return jnp.cos(ang), jnp.sin(ang)


def _rope(x, cos, sin):
    half = x.shape[-1] // 2
    bshape = (1, x.shape[1]) + (1,) * (x.ndim - 3) + (half,)
    c = cos.reshape(bshape)
    s = sin.reshape(bshape)
    x1 = x[..., :half].astype(jnp.float32)
    x2 = x[..., half:].astype(jnp.float32)
    return jnp.concatenate([x1 * c - x2 * s, x1 * s + x2 * c], axis=-1).astype(x.dtype)


def _sweep_query_blocks(fn, qs):
    b, n = qs[0].shape[:2]
    nb = n // Q_BLOCK
    blk = tuple(jnp.moveaxis(q.reshape((b, nb, Q_BLOCK) + q.shape[2:]), 1, 0) for q in qs)
    out = lax.map(lambda a: fn(*a), blk)
    out = jnp.moveaxis(out, 0, 1)
    return out.reshape((b, n) + out.shape[3:])


def _probs(q, k, scale):
    s = jnp.einsum("bqhd,bkhd->bhqk", q, k, preferred_element_type=jnp.float32) * scale
    return jax.nn.softmax(s, axis=-1)


def _diff_attention(u_lat, u_ctx, cos, sin, lq1, lk1, lq2, lk2, subln_g, lambda_init, need_ctx):
    def split(u):
        b, n, _ = u.shape
        q = u[..., :DA_WIDTH].reshape(b, n, DA_HEADS, 2, DA_HEAD_DIM)
        k = u[..., DA_WIDTH:2 * DA_WIDTH].reshape(b, n, DA_HEADS, 2, DA_HEAD_DIM)
        v = u[..., 2 * DA_WIDTH:].reshape(b, n, DA_HEADS, 2 * DA_HEAD_DIM)
        return q, k, v

    q_l, k_l, v_l = split(u_lat)
    q_c, k_c, v_c = split(u_ctx)
    q_l = _rope(q_l, cos, sin)
    k_l = _rope(k_l, cos, sin)
    f32 = jnp.float32
    lam = (jnp.exp(jnp.sum(lq1.astype(f32) * lk1.astype(f32)))
           - jnp.exp(jnp.sum(lq2.astype(f32) * lk2.astype(f32))) + lambda_init)
    scale = DA_HEAD_DIM ** -0.5
    k_all = jnp.concatenate([k_c, k_l], axis=1)
    v_all = jnp.concatenate([v_c, v_l], axis=1)

    def core(q, k, v):
        p = _probs(q[..., 0, :], k[..., 0, :], scale) - lam * _probs(q[..., 1, :], k[..., 1, :], scale)
        return jnp.einsum("bhqk,bkhd->bqhd", p, v.astype(f32))

    def post(o):
        b, n = o.shape[:2]
        return (_rmsnorm(o, subln_g) * (1.0 - lambda_init)).reshape(b, n, DA_WIDTH)

    y_lat = post(_sweep_query_blocks(lambda qb: core(qb, k_all, v_all), (q_l,)))
    y_ctx = post(core(q_c, k_c, v_c)) if need_ctx else None
    return y_lat, y_ctx


def _depthwise_conv(x, w, b):
    rhs = w.reshape(CONV_W, 1, x.shape[-1]).astype(x.dtype)
    y = lax.conv_general_dilated(x, rhs, window_strides=(1,),
                                 padding=[(CONV_LEFT, CONV_W - 1 - CONV_LEFT)],
                                 dimension_numbers=("NWC", "WIO", "NWC"),
                                 feature_group_count=x.shape[-1])
    return y + b


def _linear_combine(e1, e2):
    return e1[0] * e2[0], e2[0] * e1[1] + e2[1]


def _rglru_scan(x, h0, w_r, b_r, w_i, b_i, lam, reverse):
    b, n, _ = x.shape
    xb = x.reshape(b, n, LRU_BLOCKS, LRU_BLOCK)

    def gate(w, bias):
        z = jnp.einsum("bnhi,hij->bnhj", xb, w, preferred_element_type=jnp.float32)
        return jax.nn.sigmoid(z.reshape(b, n, LRU_WIDTH) + bias)

    r = gate(w_r, b_r)
    i = gate(w_i, b_i)
    log_a = -LRU_C * r * jax.nn.softplus(-lam.astype(jnp.float32))
    a = jnp.exp(log_a)
    u = jnp.sqrt(-jnp.expm1(2.0 * log_a)) * (i * x.astype(jnp.float32))
    if reverse:
        a, u = jnp.flip(a, 1), jnp.flip(u, 1)
    u = u.at[:, 0].add(a[:, 0] * h0)
    _, h = lax.associative_scan(_linear_combine, (a, u), axis=1)
    h_last = h[:, -1]
    if reverse:
        h = jnp.flip(h, 1)
    return h, h_last


def _rglru_mixer(u_lat, u_ctx, conv_w, conv_b, wr, br, wi, bi, lam, need_ctx):
    x_l = _depthwise_conv(u_lat[..., :LRU_WIDTH], conv_w, conv_b)
    x_c = _depthwise_conv(u_ctx[..., :LRU_WIDTH], conv_w, conv_b)
    h0 = jnp.zeros((u_ctx.shape[0], LRU_WIDTH), jnp.float32)
    hc_f, s_f = _rglru_scan(x_c, h0, wr[0], br[0], wi[0], bi[0], lam[0], reverse=False)
    hc_b, s_b = _rglru_scan(x_c, h0, wr[1], br[1], wi[1], bi[1], lam[1], reverse=True)
    hl_f, _ = _rglru_scan(x_l, s_f, wr[0], br[0], wi[0], bi[0], lam[0], reverse=False)
    hl_b, _ = _rglru_scan(x_l, s_b, wr[1], br[1], wi[1], bi[1], lam[1], reverse=True)
    y_lat = (hl_f + hl_b) * jax.nn.gelu(u_lat[..., LRU_WIDTH:].astype(jnp.float32))
    y_ctx = ((hc_f + hc_b) * jax.nn.gelu(u_ctx[..., LRU_WIDTH:].astype(jnp.float32))) if need_ctx else None
    return y_lat, y_ctx


def _mla(u_lat, u_ctx, cos, sin, qn_g, w_uq, kvn_g, w_ukv, need_ctx):
    def qkv(u, rotate):
        b, n, _ = u.shape
        c_q = u[..., :MLA_Q_RANK]
        c_kv = u[..., MLA_Q_RANK:MLA_Q_RANK + MLA_KV_RANK]
        k_r = u[..., MLA_Q_RANK + MLA_KV_RANK:][:, :, None, :]
        q = (_rmsnorm(c_q, qn_g) @ w_uq).reshape(b, n, MLA_HEADS, MLA_NOPE + MLA_ROPE)
        kv = (_rmsnorm(c_kv, kvn_g) @ w_ukv).reshape(b, n, MLA_HEADS, MLA_NOPE + MLA_V)
        q_nope, q_rope = q[..., :MLA_NOPE], q[..., MLA_NOPE:]
        k_nope, v = kv[..., :MLA_NOPE], kv[..., MLA_NOPE:]
        if rotate:
            q_rope = _rope(q_rope, cos, sin)
            k_r = _rope(k_r, cos, sin)
        q = jnp.concatenate([q_nope, q_rope], axis=-1)
        k = jnp.concatenate([k_nope, jnp.broadcast_to(k_r, (b, n, MLA_HEADS, MLA_ROPE))], axis=-1)
        return q, k, v

    q_l, k_l, v_l = qkv(u_lat, True)
    q_c, k_c, v_c = qkv(u_ctx, False)
    scale = (MLA_NOPE + MLA_ROPE) ** -0.5
    k_all = jnp.concatenate([k_c, k_l], axis=1)
    v_all = jnp.concatenate([v_c, v_l], axis=1)

    def core(q, k, v):
        return jnp.einsum("bhqk,bkhd->bqhd", _probs(q, k, scale), v.astype(jnp.float32))

    b, n = u_lat.shape[:2]
    y_lat = _sweep_query_blocks(lambda qb: core(qb, k_all, v_all), (q_l,)).reshape(b, n, MLA_WIDTH)
    y_ctx = core(q_c, k_c, v_c).reshape(b, u_ctx.shape[1], MLA_WIDTH) if need_ctx else None
    return y_lat, y_ctx


def _fourier(u):
    b, n, _ = u.shape
    g = u.astype(jnp.float32).reshape(b, n, FFT_GROUPS, FFT_GROUP)
    return jnp.real(jnp.fft.fft2(g, axes=(1, 3), norm="ortho")).reshape(b, n, FFT_WIDTH)


def _swiglu(h, wg, wu, wd):
    return (jax.nn.silu(h @ wg) * (h @ wu)) @ wd


def setup_inputs(seed: int = 0) -> dict:
    key = jax.random.key(seed)
    ks = iter(jax.random.split(key, 32))

    def nrm(shape, s):
        return jax.random.normal(next(ks), shape, jnp.float32) * s

    L, D = DEPTH, D_MODEL
    inp = {}
    inp["x"] = nrm((BATCH, SEQ, D), 1.0)
    inp["c"] = nrm((BATCH, D), 1.0)
    inp["ctx"] = nrm((BATCH, CTX_LEN, D), 1.0)
    inp["c_ctx"] = nrm((D,), 1.0)
    inp["w_ada"] = nrm((L, D, 6 * D), 0.5 * D ** -0.5)
    inp["b_ada"] = nrm((L, 6 * D), 0.02)
    inp["w_in"] = nrm((L, D, IN_WIDTH), D ** -0.5)
    inp["w_out"] = nrm((L, MIX_WIDTH, D), DEEPNORM_BETA * MIX_WIDTH ** -0.5)
    inp["ln1_g"] = 1.0 + nrm((L, D), 0.02)
    inp["ln1_b"] = nrm((L, D), 0.02)
    inp["ln2_g"] = 1.0 + nrm((L, D), 0.02)
    inp["ln2_b"] = nrm((L, D), 0.02)
    inp["da_lq1"] = nrm((L, DA_HEAD_DIM), 0.1)
    inp["da_lk1"] = nrm((L, DA_HEAD_DIM), 0.1)
    inp["da_lq2"] = nrm((L, DA_HEAD_DIM), 0.1)
    inp["da_lk2"] = nrm((L, DA_HEAD_DIM), 0.1)
    inp["da_subln_g"] = 1.0 + nrm((L, 2 * DA_HEAD_DIM), 0.02)
    inp["lru_conv_w"] = nrm((L, CONV_W, LRU_WIDTH), CONV_W ** -0.5)
    inp["lru_conv_b"] = nrm((L, LRU_WIDTH), 0.02)
    inp["lru_wr"] = nrm((L, 2, LRU_BLOCKS, LRU_BLOCK, LRU_BLOCK), LRU_BLOCK ** -0.5)
    inp["lru_br"] = nrm((L, 2, LRU_WIDTH), 0.02)
    inp["lru_wi"] = nrm((L, 2, LRU_BLOCKS, LRU_BLOCK, LRU_BLOCK), LRU_BLOCK ** -0.5)
    inp["lru_bi"] = nrm((L, 2, LRU_WIDTH), 0.02)
    a_c = jax.random.uniform(next(ks), (L, 2, LRU_WIDTH), jnp.float32, 0.9, 0.999)
    a = a_c ** (1.0 / LRU_C)
    inp["lru_lam"] = jnp.log(a) - jnp.log1p(-a)
    inp["mla_qn_g"] = 1.0 + nrm((L, MLA_Q_RANK), 0.02)
    inp["mla_wuq"] = nrm((L, MLA_Q_RANK, MLA_HEADS * (MLA_NOPE + MLA_ROPE)), MLA_Q_RANK ** -0.5)
    inp["mla_kvn_g"] = 1.0 + nrm((L, MLA_KV_RANK), 0.02)
    inp["mla_wukv"] = nrm((L, MLA_KV_RANK, MLA_HEADS * (MLA_NOPE + MLA_V)), MLA_KV_RANK ** -0.5)
    inp["ffn_wg"] = nrm((L, D, D_FF), D ** -0.5)
    inp["ffn_wu"] = nrm((L, D, D_FF), D ** -0.5)
    inp["ffn_wd"] = nrm((L, D_FF, D), DEEPNORM_BETA * D_FF ** -0.5)
    return inp


def reference(x, c, ctx, c_ctx, w_ada, b_ada, w_in, w_out, ln1_g, ln1_b, ln2_g, ln2_b,
              da_lq1, da_lk1, da_lq2, da_lk2, da_subln_g,
              lru_conv_w, lru_conv_b, lru_wr, lru_br, lru_wi, lru_bi, lru_lam,
              mla_qn_g, mla_wuq, mla_kvn_g, mla_wukv,
              ffn_wg, ffn_wu, ffn_wd):
    n = x.shape[1]
    cos_da, sin_da = _axial_rope_tables(n, DA_HEAD_DIM)
    cos_mla, sin_mla = _axial_rope_tables(n, MLA_ROPE)
    x_lat, x_ctx = x, ctx
    for l in range(DEPTH):
        need_ctx = l < DEPTH - 1
        lambda_init = 0.8 - 0.6 * math.exp(-0.3 * l)
        sh1, sc1, g1, sh2, sc2, g2 = [m[:, None, :] for m in _ada_mods(c, w_ada[l], b_ada[l])]
        csh1, csc1, cg1, csh2, csc2, cg2 = _ada_mods(c_ctx, w_ada[l], b_ada[l])

        u_lat = _modulate(x_lat, sh1, sc1) @ w_in[l]
        u_ctx = _modulate(x_ctx, csh1, csc1) @ w_in[l]
        da_l, da_c = _diff_attention(u_lat[..., :OFF_LRU], u_ctx[..., :OFF_LRU], cos_da, sin_da,
                                     da_lq1[l], da_lk1[l], da_lq2[l], da_lk2[l], da_subln_g[l],
                                     lambda_init, need_ctx)
        lru_l, lru_c = _rglru_mixer(u_lat[..., OFF_LRU:OFF_MLA], u_ctx[..., OFF_LRU:OFF_MLA],
                                    lru_conv_w[l], lru_conv_b[l], lru_wr[l], lru_br[l],
                                    lru_wi[l], lru_bi[l], lru_lam[l], need_ctx)
        mla_l, mla_c = _mla(u_lat[..., OFF_MLA:OFF_FFT], u_ctx[..., OFF_MLA:OFF_FFT], cos_mla, sin_mla,
                            mla_qn_g[l], mla_wuq[l], mla_kvn_g[l], mla_wukv[l], need_ctx)
        fft_l = _fourier(u_lat[..., OFF_FFT:])
        mix_l = jnp.concatenate([da_l, lru_l, mla_l, fft_l], axis=-1).astype(x_lat.dtype)
        x_lat = _layernorm(DEEPNORM_ALPHA * x_lat + g1 * (mix_l @ w_out[l]), ln1_g[l], ln1_b[l])

        ff_l = _swiglu(_modulate(x_lat, sh2, sc2), ffn_wg[l], ffn_wu[l], ffn_wd[l])
        x_lat = _layernorm(DEEPNORM_ALPHA * x_lat + g2 * ff_l, ln2_g[l], ln2_b[l])

        if need_ctx:
            fft_c = _fourier(u_ctx[..., OFF_FFT:])
            mix_c = jnp.concatenate([da_c, lru_c, mla_c, fft_c], axis=-1).astype(x_ctx.dtype)
            x_ctx = _layernorm(DEEPNORM_ALPHA * x_ctx + cg1 * (mix_c @ w_out[l]), ln1_g[l], ln1_b[l])
            ff_c = _swiglu(_modulate(x_ctx, csh2, csc2), ffn_wg[l], ffn_wu[l], ffn_wd[l])
            x_ctx = _layernorm(DEEPNORM_ALPHA * x_ctx + cg2 * ff_c, ln2_g[l], ln2_b[l])
    return x_lat
```

```cpp
#include <hip/hip_runtime.h>
#include <hip/hip_cooperative_groups.h>
#include <cstdio>
#include <cstdint>
namespace cg = cooperative_groups;
#ifndef PH_MASK
#define PH_MASK 0xfffff
#endif
#define EN(k) (((MASK) >> (k)) & 1u)
#ifndef DUP_ATTN
#define DUP_ATTN 1
#endif
#ifndef DUP_S1
#define DUP_S1 1
#endif
#ifndef DUP_S2
#define DUP_S2 1
#endif
#ifndef DUP_S3
#define DUP_S3 1
#endif
#ifndef DUP_S4
#define DUP_S4 1
#endif
#ifndef DUP_GEMM
#define DUP_GEMM 1
#endif
#ifndef DUP_P0
#define DUP_P0 1
#endif
#ifndef MK_MULTI
#define MK_MULTI 0
#endif
namespace pg8 {
#define PG8_LAS __attribute__((address_space(3)))
typedef unsigned short bf16_t;
typedef short bf16x8 __attribute__((ext_vector_type(8)));
typedef float f32x4 __attribute__((ext_vector_type(4)));
typedef unsigned u32x4 __attribute__((ext_vector_type(4)));
constexpr int BM = 256, BK = 64, HALF = 128, HTB = HALF * BK * 2  , STAGE_BYTES = 8 * HTB, NXCD = 8, WGM = 8;

__host__ __device__ __forceinline__ int lds_byte(int r, int c) { const int st = (r >> 4) * 2 + (c >> 5), rr = r & 15, cc = c & 31, ob = rr * 64 + cc * 2; return st * 1024 + (ob ^ (((ob >> 9) & 1) << 5)); }
__host__ __device__ __forceinline__ void stage_rc(int b, int& R, int& C) { const int st = b / 1024, sb = b % 1024, swz = sb ^ (((sb >> 9) & 1) << 5); R = (st >> 1) * 16 + swz / 64; C = (st & 1) * 32 + (swz % 64) / 2; }
__host__ __device__ __forceinline__ int perm32(int rho) { const int n = rho >> 4, i = rho & 15; return 8 * (i >> 2) + 4 * n + (i & 3); }

struct Unit { int pm, pn; };
struct Gemm { const bf16_t* A; const bf16_t* Bt; int M, N, K; int ld; };

struct StaticOrder {
    int nM, nN, nwg, G, c;
    __host__ __device__ void init(int M, int N, int G_, int c_) { nM = M / BM; nN = N / BM; nwg = nM * nN; G = G_; c = c_; }
    __host__ __device__ bool next(int i, Unit& u) const {
        const long L = (long)i * G + c; if (L >= nwg) return false;
        int wgid = (int)L; { const int q = nwg / NXCD, r = nwg % NXCD, xcd = wgid % NXCD, off = wgid / NXCD; wgid = (xcd < r ? xcd * (q + 1) : r * (q + 1) + (xcd - r) * q) + off; }
        const int nig = WGM * nN, gid = wgid / nig, fm = gid * WGM, gsz = (nM - fm) < WGM ? (nM - fm) : WGM;
        u.pm = fm + ((wgid % nig) % gsz); u.pn = (wgid % nig) / gsz; return true;
    }
    __device__ __forceinline__ void a_ready(const Unit&) const {}
    __device__ __forceinline__ void done(const Unit&) const {}
};

template <class Epi, class Sched, bool ALIGN_EPI = false, bool SP2 = false>
__device__ __forceinline__ void gemm_phase(PG8_LAS unsigned char* lds, const Gemm g, const Sched& S, const Epi& E) {
    int tid_ = threadIdx.x; asm volatile("" : "+v"(tid_));
    const int tid = tid_, wid = __builtin_amdgcn_readfirstlane(tid >> 6), lane = tid & 63, wr = wid >> 2, wc = wid & 3, fr = lane & 15, fq = lane >> 4;
    int K_ = g.K; asm volatile("" : "+s"(K_));
    const int K = K_, nt = K / BK; int LD_ = g.ld ? g.ld : g.K; asm volatile("" : "+s"(LD_)); const int LD = LD_;
    unsigned voffA[2], voffB[2];
#pragma unroll
    for (int i = 0; i < 2; ++i) { int R, C; stage_rc(tid * 16 + i * 8192, R, C); const int Rb = Epi::PERM ? ((R & ~31) + perm32(R & 31)) : R;
        voffA[i] = (unsigned)(R * LD + C) * 2u; voffB[i] = (unsigned)(Rb * LD + C) * 2u; }
    const size_t kstep = (size_t)(BK * 2);
    const size_t hstep = (size_t)HALF * LD * 2;
    const size_t tstep = 2 * hstep;
    const unsigned ldsw = (unsigned)wid * 1024u;
    const int aoff = lds_byte(wr * 64 + fr, fq * 8), boff = lds_byte(wc * 32 + fr, fq * 8);
#define PG8_SA(b, h) (((b) * 2 + (h)) * HTB)
#define PG8_SB(b, h) ((4 + (b) * 2 + (h)) * HTB)
#define PG8_STAGE(bufoff, gbase, voff) do { _Pragma("unroll") for (int _i = 0; _i < 2; ++_i) \
        __builtin_amdgcn_global_load_lds((const unsigned*)((const char*)(gbase) + (voff)[_i]), (PG8_LAS unsigned*)(lds + (bufoff) + ldsw + _i * 8192), 16, 0, 0); } while (0)
#define PG8_LDA(dst, b, h) do { _Pragma("unroll") for (int m = 0; m < 4; ++m) _Pragma("unroll") for (int k = 0; k < 2; ++k) dst[m][k] = *(const PG8_LAS bf16x8*)(lds + PG8_SA(b, h) + aoff + m * 2048 + k * 1024); } while (0)
#define PG8_LDB(dst, b, h) do { _Pragma("unroll") for (int n = 0; n < 2; ++n) _Pragma("unroll") for (int k = 0; k < 2; ++k) dst[n][k] = *(const PG8_LAS bf16x8*)(lds + PG8_SB(b, h) + boff + n * 2048 + k * 1024); } while (0)
#define PG8_MMA(ai, bj, At, Bt) do { __builtin_amdgcn_s_setprio(1); _Pragma("unroll") for (int m = 0; m < 4; ++m) _Pragma("unroll") for (int n = 0; n < 2; ++n) _Pragma("unroll") for (int k = 0; k < 2; ++k) \
        acc[ai][bj][m][n] = __builtin_amdgcn_mfma_f32_16x16x32_bf16(Bt[n][k], At[m][k], acc[ai][bj][m][n], 0, 0, 0); __builtin_amdgcn_s_setprio(0); } while (0)
#define PG8_WAIT_V(n) asm volatile("s_waitcnt vmcnt(" #n ")" ::: "memory")
#define PG8_WAIT_L(n) asm volatile("s_waitcnt lgkmcnt(" #n ")" ::: "memory")
#define PG8_BAR __builtin_amdgcn_s_barrier()
#define PG8_SCHED __builtin_amdgcn_sched_barrier(0)
    Unit cur, nxt; int ui = 0;
    if (!S.next(0, cur)) return;
    f32x4 acc[2][2][4][2];
#pragma unroll
    for (int a = 0; a < 2; ++a)
#pragma unroll
        for (int b = 0; b < 2; ++b)
#pragma unroll
            for (int m = 0; m < 4; ++m)
#pragma unroll
                for (int n = 0; n < 2; ++n) acc[a][b][m][n] = (f32x4){0.f, 0.f, 0.f, 0.f};
    bf16x8 At[4][2], B0[2][2], B1[2][2];
    const char* cA = (const char*)g.A + (size_t)cur.pm * tstep; const char* cB = (const char*)g.Bt + (size_t)cur.pn * tstep;
    S.a_ready(cur);
    if constexpr (SP2) {
        PG8_STAGE(PG8_SB(0, 0), cB, voffB); PG8_STAGE(PG8_SB(0, 1), cB + hstep, voffB); PG8_STAGE(PG8_SA(0, 0), cA, voffA); PG8_STAGE(PG8_SA(0, 1), cA + hstep, voffA);
        if (wr == 1) PG8_BAR;
        PG8_WAIT_V(2); PG8_BAR;
        PG8_STAGE(PG8_SB(1, 0), cB + kstep, voffB); PG8_STAGE(PG8_SA(1, 0), cA + kstep, voffA); PG8_STAGE(PG8_SB(1, 1), cB + hstep + kstep, voffB);
        PG8_WAIT_V(6); PG8_BAR;
    } else {
        PG8_STAGE(PG8_SB(0, 0), cB, voffB); PG8_STAGE(PG8_SA(0, 0), cA, voffA); PG8_STAGE(PG8_SB(0, 1), cB + hstep, voffB); PG8_STAGE(PG8_SA(0, 1), cA + hstep, voffA);
        if (wr == 1) PG8_BAR;
        PG8_WAIT_V(4); PG8_BAR;
        PG8_STAGE(PG8_SB(1, 0), cB + kstep, voffB); PG8_STAGE(PG8_SA(1, 0), cA + kstep, voffA); PG8_STAGE(PG8_SB(1, 1), cB + hstep + kstep, voffB);
        PG8_WAIT_V(6); PG8_BAR;
    }
    for (;;) {
        const bool has_next = S.next(ui + 1, nxt);
        const char* nA = has_next ? (const char*)g.A + (size_t)nxt.pm * tstep : cA; const char* nB = has_next ? (const char*)g.Bt + (size_t)nxt.pn * tstep : cB;
        for (int t = 0; t < nt; t += 2) {
            const bool last = (t == nt - 2);
            const char* a1 = cA + (size_t)(t + 1) * kstep;
            const char* a2 = last ? nA : cA + (size_t)(t + 2) * kstep; const char* b2 = last ? nB : cB + (size_t)(t + 2) * kstep;
            const char* a3 = a2 + kstep; const char* b3 = b2 + kstep;
            if (last && has_next) S.a_ready(nxt);
            if constexpr (SP2) {
            PG8_LDB(B0, 0, 0); PG8_LDB(B1, 0, 1); PG8_SCHED; PG8_LDA(At, 0, 0); PG8_STAGE(PG8_SA(1, 1), a1 + hstep, voffA);
            PG8_WAIT_V(8); PG8_WAIT_L(0); PG8_BAR; PG8_MMA(0, 0, At, B0); PG8_MMA(0, 1, At, B1); PG8_BAR; PG8_SCHED;
            PG8_LDA(At, 0, 1); PG8_STAGE(PG8_SB(0, 0), b2, voffB); PG8_STAGE(PG8_SB(0, 1), b2 + hstep, voffB); PG8_STAGE(PG8_SA(0, 0), a2, voffA);
            PG8_WAIT_V(8); PG8_WAIT_L(0); PG8_BAR; PG8_MMA(1, 0, At, B0); PG8_MMA(1, 1, At, B1); PG8_BAR; PG8_SCHED;
            PG8_LDB(B0, 1, 0); PG8_LDB(B1, 1, 1); PG8_SCHED; PG8_LDA(At, 1, 0); PG8_STAGE(PG8_SA(0, 1), a2 + hstep, voffA);
            PG8_WAIT_V(8); PG8_WAIT_L(0); PG8_BAR; PG8_MMA(0, 0, At, B0); PG8_MMA(0, 1, At, B1); PG8_BAR; PG8_SCHED;
            PG8_LDA(At, 1, 1); PG8_STAGE(PG8_SB(1, 0), b3, voffB); PG8_STAGE(PG8_SB(1, 1), b3 + hstep, voffB); PG8_STAGE(PG8_SA(1, 0), a3, voffA);
            PG8_WAIT_V(8); PG8_WAIT_L(0); PG8_BAR; PG8_MMA(1, 0, At, B0); PG8_MMA(1, 1, At, B1); PG8_BAR; PG8_SCHED;
            } else {
            PG8_LDB(B0, 0, 0); PG8_SCHED; PG8_LDA(At, 0, 0); PG8_STAGE(PG8_SA(1, 1), a1 + hstep, voffA);
            PG8_WAIT_L(8); PG8_BAR; PG8_WAIT_L(0); PG8_MMA(0, 0, At, B0); PG8_BAR; PG8_SCHED;
            PG8_LDB(B1, 0, 1); PG8_STAGE(PG8_SB(0, 0), b2, voffB);
            PG8_BAR; PG8_WAIT_L(0); PG8_MMA(0, 1, At, B1); PG8_BAR;
            PG8_LDA(At, 0, 1); PG8_STAGE(PG8_SA(0, 0), a2, voffA);
            PG8_BAR; PG8_WAIT_L(0); PG8_MMA(1, 0, At, B0); PG8_BAR; PG8_SCHED;
            PG8_STAGE(PG8_SB(0, 1), b2 + hstep, voffB);
            PG8_WAIT_V(6); PG8_BAR; PG8_MMA(1, 1, At, B1); PG8_BAR;
            PG8_LDB(B0, 1, 0); PG8_SCHED; PG8_LDA(At, 1, 0); PG8_STAGE(PG8_SA(0, 1), a2 + hstep, voffA);
            PG8_WAIT_L(8); PG8_BAR; PG8_WAIT_L(0); PG8_MMA(0, 0, At, B0); PG8_BAR; PG8_SCHED;
            PG8_LDB(B1, 1, 1); PG8_STAGE(PG8_SB(1, 0), b3, voffB);
            PG8_BAR; PG8_WAIT_L(0); PG8_MMA(0, 1, At, B1); PG8_BAR;
            PG8_LDA(At, 1, 1); PG8_STAGE(PG8_SA(1, 0), a3, voffA);
            PG8_BAR; PG8_WAIT_L(0); PG8_MMA(1, 0, At, B0); PG8_BAR; PG8_SCHED;
            PG8_STAGE(PG8_SB(1, 1), b3 + hstep, voffB);
            PG8_WAIT_V(6); PG8_BAR; PG8_MMA(1, 1, At, B1); PG8_BAR;
            }
        }
        if constexpr (ALIGN_EPI) { if (wr == 0) PG8_BAR; }
        if constexpr (!Epi::AFTER_DRAIN) { E(acc, cur, wr, wc, fr, fq); S.done(cur); }
        if (!has_next) break;
#pragma unroll
        for (int a = 0; a < 2; ++a)
#pragma unroll
            for (int b = 0; b < 2; ++b)
#pragma unroll
                for (int m = 0; m < 4; ++m)
#pragma unroll
                    for (int n = 0; n < 2; ++n) acc[a][b][m][n] = (f32x4){0.f, 0.f, 0.f, 0.f};
        cur = nxt; cA = nA; cB = nB; ++ui;
        if constexpr (ALIGN_EPI) { if (wr == 1) PG8_BAR; }
    }
    PG8_WAIT_V(0);
    if constexpr (!ALIGN_EPI) { if (wr == 0) PG8_BAR; }
    PG8_BAR;
    if constexpr (Epi::AFTER_DRAIN) { E.fused(acc, cur, wr, wc, fr, fq, lds, wid, lane); S.done(cur); }
#undef PG8_SA
#undef PG8_SB
#undef PG8_STAGE
#undef PG8_LDA
#undef PG8_LDB
#undef PG8_MMA
#undef PG8_WAIT_V
#undef PG8_WAIT_L
#undef PG8_BAR
#undef PG8_SCHED
}
}

using pg8::bf16_t; using pg8::bf16x8; using pg8::f32x4; using pg8::u32x4;
typedef float f32x16 __attribute__((ext_vector_type(16)));
typedef unsigned u32x2 __attribute__((ext_vector_type(2)));
typedef float f32x2_t __attribute__((ext_vector_type(2)));
typedef __bf16 bf16x2_t __attribute__((ext_vector_type(2)));
#define LAS __attribute__((address_space(3)))

constexpr int T = 16640, NCTX = 256, DM = 2048, DFF = 5632, NIN = 4352, INW = 3776;
constexpr int NTHR = 512, NWV = 8;
constexpr float ALPHA = 1.4142135623730951f;
constexpr float LOG2E = 1.4426950408889634f;
constexpr float QS_DA = 0.125f * 1.4426950408889634f;
constexpr float QS_MLA = (float)(0.07216878364870323 * 1.4426950408889634);
constexpr float RSQ128 = 0.08838834764831845f;
constexpr int LDS_BYTES = 147456;

__device__ __forceinline__ unsigned pk2(float lo, float hi) { f32x2_t v = {lo, hi}; bf16x2_t b = __builtin_convertvector(v, bf16x2_t); return __builtin_bit_cast(unsigned, b); }
__device__ __forceinline__ bf16_t f2bf(float f) { return (bf16_t)(pk2(f, 0.f) & 0xffffu); }
__device__ __forceinline__ float bf2f(unsigned b) { return __uint_as_float(b << 16); }
__device__ __forceinline__ float ex2(float x) { return __builtin_amdgcn_exp2f(x); }
__device__ __forceinline__ int swap45(int o) { return (o & ~0x30) | ((o & 0x20) >> 1) | ((o & 0x10) << 1); }
__device__ __forceinline__ int swap23(int o) { return (o & ~0xC) | ((o & 0x4) << 1) | ((o & 0x8) >> 1); }
__device__ __forceinline__ float wave_sum(float v) {
#pragma unroll
    for (int o = 1; o < 64; o <<= 1) v += __shfl_xor(v, o);
    return v;
}
__device__ __forceinline__ float siluf(float x) { return x / (1.f + __expf(-x)); }
__device__ __forceinline__ float sigmf(float x) { return 1.f / (1.f + __expf(-x)); }
__device__ __forceinline__ float gelu_tanh(float x) { const float t = tanhf(0.7978845608028654f * (x + 0.044715f * x * x * x)); return 0.5f * x * (1.f + t); }

constexpr size_t al256(size_t x) { return (x + 255) & ~(size_t)255; }
constexpr size_t SZ_WIN = (size_t)NIN * DM * 2, SZ_WOUT = (size_t)DM * DM * 2, SZ_WGU = (size_t)2 * DFF * DM * 2, SZ_WD = (size_t)DM * DFF * 2;
constexpr size_t SZ_WUQ = (size_t)768 * 384 * 2, SZ_WUKV = (size_t)1024 * 256 * 2, SZ_WLRU = (size_t)8 * 256 * 128 * 2;
constexpr size_t O_WIN = 0, O_WOUT = O_WIN + SZ_WIN, O_WGU = O_WOUT + SZ_WOUT, O_WD = O_WGU + SZ_WGU, O_WUQ = O_WD + SZ_WD, O_WUKV = O_WUQ + SZ_WUQ, O_WLRU = O_WUKV + SZ_WUKV;
constexpr size_t SZ_WLAYER = O_WLRU + SZ_WLRU;
constexpr size_t O_F1T = 2 * SZ_WLAYER, O_F2T = O_F1T + 131072, O_ROPE = O_F2T + (size_t)128 * 131072, O_C8 = O_ROPE + 32768, O_MODS = O_C8 + 8192, O_BAR = al256(O_MODS + 2 * 2 * 12288 * 4), O_XMOD = al256(O_BAR + 16384);
constexpr size_t O_XRES = O_XMOD + (size_t)T * DM * 2, O_U = O_XRES + (size_t)T * DM * 4;
constexpr size_t O_QDA = O_U, O_KDA = O_QDA + (size_t)T * 512 * 2, O_VTDA = O_KDA + (size_t)T * 512 * 2, O_LRUX = O_VTDA + (size_t)T * 512 * 2, O_LRUG = O_LRUX + (size_t)T * 512 * 2;
constexpr size_t O_CQ = O_LRUG + (size_t)T * 512 * 2, O_CKV = O_CQ + (size_t)T * 384 * 2, O_PARTQ = O_CKV + (size_t)T * 256 * 2, O_PARTKV = O_PARTQ + (size_t)T * 8 * 4;
constexpr size_t O_QMLA = O_PARTKV + (size_t)T * 4 * 4, O_KMLA = O_QMLA + (size_t)T * 768 * 2, O_VTMLA = O_KMLA + (size_t)T * 768 * 2, O_FX = O_VTMLA + (size_t)T * 512 * 2;
constexpr size_t O_FT = O_FX + (size_t)65536 * 256 * 2, O_CTXW = O_FT + (size_t)65536 * 256 * 2, O_XC = O_CTXW + (size_t)256 * 1024 * 4, O_AU = O_XC + (size_t)4 * T * 128 * 2;
constexpr size_t O_SUMM = O_AU + (size_t)2 * T * 512 * 4, O_DAO = O_SUMM + (size_t)2 * 260 * 512 * 8, O_UEND = O_DAO + (size_t)T * 1024 * 2;
constexpr size_t O_H = O_U;
constexpr size_t WS_NEED = (O_UEND > O_H + (size_t)T * DFF * 2) ? O_UEND : (O_H + (size_t)T * DFF * 2);

struct Params { const float* in[31]; float* out; unsigned char* ws; int ph_lo, ph_hi; };
enum { I_X = 0, I_C, I_CTX, I_CCTX, I_WADA, I_BADA, I_WIN, I_WOUT, I_LN1G, I_LN1B, I_LN2G, I_LN2B, I_LQ1, I_LK1, I_LQ2, I_LK2, I_SUBLN, I_CONVW, I_CONVB, I_LWR, I_LBR, I_LWI, I_LBI, I_LLAM,
       I_QNG, I_WUQ, I_KVNG, I_WUKV, I_WG, I_WU, I_WD };

__device__ const float INVF[16] = {1.0f, 0.5623413324356079f, 0.3162277638912201f, 0.17782793939113617f, 0.10000000149011612f, 0.05623413249850273f, 0.03162277489900589f, 0.017782794311642647f,
                                   0.009999999776482582f, 0.005623413249850273f, 0.003162277629598975f, 0.0017782794311642647f, 0.0010000000474974513f, 0.000562341301701963f, 0.0003162277571391314f, 0.00017782794020604342f};

struct MapWin { const float* W; int stride;
    __device__ __forceinline__ const float* operator()(int d) const { const int tile = d >> 8, c = d & 255; int src;
        if (tile < 4) src = tile * 256 + swap45(c); else if (tile < 10) src = tile * 256 + c; else if (tile == 10) src = 2560 + c;
        else if (tile == 11) { if (c < 128) src = 2816 + c; else if (c < 192) src = 3200 + swap45(c - 128); else return nullptr; }
        else src = 2944 + c;
        return W + src; } };
struct MapPlain { const float* W; int stride; __device__ __forceinline__ const float* operator()(int d) const { return W + d; } };
struct MapGU { const float* Wg; const float* Wu; int stride;
    __device__ __forceinline__ const float* operator()(int d) const { const int tile = d >> 8, c = d & 255, n = (c >> 4) & 1, f = tile * 128 + 64 * (c >> 7) + 16 * ((c >> 5) & 3) + (c & 15); const long long dl = (const char*)Wu - (const char*)Wg; return (const float*)((const char*)Wg + (long long)n * dl) + f; } };
struct MapUq { const float* W; int stride;
    __device__ __forceinline__ const float* operator()(int d) const { if (d < 512) return W + (d >> 7) * 192 + (d & 127); const int c = d - 512; return W + (c >> 6) * 192 + 128 + swap45(c & 63); } };
struct MapUkv { const float* W; int stride;
    __device__ __forceinline__ const float* operator()(int d) const { if (d < 512) return W + (d >> 7) * 256 + (d & 127); const int e = d - 512; return W + (e >> 7) * 256 + 128 + (e & 127); } };
struct MapLru { const float* Wr; const float* Wi; int stride;
    __device__ __forceinline__ const float* operator()(int c) const { const int n = (c >> 4) & 1, j = 64 * (c >> 7) + 16 * ((c >> 5) & 3) + (c & 15); const long long dl = (const char*)Wi - (const char*)Wr; return (const float*)((const char*)Wr + (long long)n * dl) + j; } };

template <class Map>
__device__ __forceinline__ void tr_job(const Map mp, int Kd, int nrows, bf16_t* WT, const float* kscale, LAS float* scr, int gw, int NGW, int lane) {
    const int nblk = nrows / 32, items = (Kd / 64) * nblk, kr = lane >> 3, c4 = lane & 7;
    f32x4 cur[8], nxt[8];
#define TR_LOAD(dst, it_) do { const int kb_ = (it_) / nblk, nb_ = (it_) % nblk; const float* cp_ = mp(32 * nb_ + 4 * c4); const int st_ = mp.stride; \
        _Pragma("unroll") for (int i_ = 0; i_ < 8; ++i_) dst[i_] = cp_ ? *(const f32x4*)(cp_ + (size_t)(64 * kb_ + kr + 8 * i_) * st_) : (f32x4){0.f, 0.f, 0.f, 0.f}; } while (0)
    int it = gw;
    if (it < items) TR_LOAD(cur, it);
    for (; it < items; it += NGW) {
        const int kb = it / nblk, nb = it % nblk, k0 = 64 * kb, d0 = 32 * nb;
        if (it + NGW < items) TR_LOAD(nxt, it + NGW);
#pragma unroll
        for (int i = 0; i < 8; ++i) { const int kk = kr + 8 * i; f32x4 v = cur[i]; if (kscale) v = v * kscale[k0 + kk];
#pragma unroll
            for (int j = 0; j < 4; ++j) scr[kk * 33 + 4 * c4 + j] = v[j]; }
        asm volatile("s_waitcnt lgkmcnt(0)" ::: "memory");
        const int c = lane & 7;
#pragma unroll
        for (int j = 0; j < 4; ++j) { const int n = (lane >> 3) + 8 * j; const LAS float* sp = scr + (8 * c) * 33 + n;
            u32x4 o; o.x = pk2(sp[0 * 33], sp[1 * 33]); o.y = pk2(sp[2 * 33], sp[3 * 33]); o.z = pk2(sp[4 * 33], sp[5 * 33]); o.w = pk2(sp[6 * 33], sp[7 * 33]);
            *(u32x4*)(WT + (size_t)(d0 + n) * Kd + k0 + 8 * c) = o; }
        asm volatile("s_waitcnt lgkmcnt(0)" ::: "memory");
#pragma unroll
        for (int i = 0; i < 8; ++i) cur[i] = nxt[i];
    }
#undef TR_LOAD
}

#define EPI_ROWS_BEGIN _Pragma("unroll") for (int ai = 0; ai < 2; ++ai) _Pragma("unroll") for (int m = 0; m < 4; ++m) { const int row = u.pm * 256 + ai * 128 + wr * 64 + m * 16 + fr;
#define EPI_ROWS_END asm volatile("" ::: "memory"); __builtin_amdgcn_sched_barrier(0); }
__device__ __forceinline__ void st4bf(bf16_t* p, const f32x4 v) { u32x2 w; w.x = pk2(v[0], v[1]); w.y = pk2(v[2], v[3]); *(u32x2*)p = w; }

struct EpiInproj {
    static constexpr bool PERM = false, AFTER_DRAIN = false;
    bf16_t *QDA, *KDA, *VTDA, *LRUX, *LRUG, *CQ, *CKV, *KMLA, *FX; float *CTXW, *PARTQ, *PARTKV; const float* ROPE;
    __device__ __forceinline__ void rope_cs(int row, int wc, int fq, f32x4& c, f32x4& s) const {
        if (row < NCTX) { c = (f32x4){1.f, 1.f, 1.f, 1.f}; s = (f32x4){0.f, 0.f, 0.f, 0.f}; return; }
        const int nl = row - NCTX, pos = (wc & 1) ? (nl & 63) : (nl >> 6);
        const f32x4 a = *(const f32x4*)(ROPE + (pos * 16 + 4 * fq) * 2), b = *(const f32x4*)(ROPE + (pos * 16 + 4 * fq) * 2 + 4);
        c = (f32x4){a[0], a[2], b[0], b[2]}; s = (f32x4){a[1], a[3], b[1], b[3]};
    }
    __device__ __forceinline__ void operator()(const f32x4 (&acc)[2][2][4][2], const pg8::Unit& u, int wr, int wc, int fr, int fq) const {
        asm volatile("" : "+v"(fr), "+v"(fq));
        const int pn = u.pn;
        if (pn < 4) {
            bf16_t* dst = pn < 2 ? QDA : KDA; const float sc = pn < 2 ? QS_DA : 1.f; const int cb = (pn & 1) * 256 + 64 * (wc >> 1) + 16 * (wc & 1) + 4 * fq;
            EPI_ROWS_BEGIN  f32x4 c, s; rope_cs(row, wc, fq, c, s);
#pragma unroll
                for (int bj = 0; bj < 2; ++bj) { const f32x4 x1 = acc[ai][bj][m][0], x2 = acc[ai][bj][m][1];
                    st4bf(dst + (unsigned)row * 512 + cb + 128 * bj, (x1 * c - x2 * s) * sc); st4bf(dst + (unsigned)row * 512 + cb + 128 * bj + 32, (x1 * s + x2 * c) * sc); }  EPI_ROWS_END
        } else if (pn < 6) {
            EPI_ROWS_BEGIN
#pragma unroll
                for (int bj = 0; bj < 2; ++bj)
#pragma unroll
                    for (int n = 0; n < 2; ++n)
#pragma unroll
                        for (int j = 0; j < 4; ++j) VTDA[(unsigned)((pn - 4) * 256 + 128 * bj + 32 * wc + 16 * n + 4 * fq + j) * T + row] = f2bf(acc[ai][bj][m][n][j]);  EPI_ROWS_END
        } else if (pn < 10) {
            bf16_t* dst = pn < 8 ? LRUX : LRUG; const int cb = (pn & 1) * 256 + 32 * wc + 4 * fq;
            EPI_ROWS_BEGIN
#pragma unroll
                for (int bj = 0; bj < 2; ++bj)
#pragma unroll
                    for (int n = 0; n < 2; ++n) st4bf(dst + (unsigned)row * 512 + cb + 128 * bj + 16 * n, acc[ai][bj][m][n]);  EPI_ROWS_END
        } else if (pn == 10) {
            EPI_ROWS_BEGIN  float ss = 0.f;
#pragma unroll
                for (int bj = 0; bj < 2; ++bj)
#pragma unroll
                    for (int n = 0; n < 2; ++n) { const f32x4 v = acc[ai][bj][m][n]; st4bf(CQ + (unsigned)row * 384 + 128 * bj + 32 * wc + 16 * n + 4 * fq, v); ss += (v[0] * v[0] + v[1] * v[1]) + (v[2] * v[2] + v[3] * v[3]); }
                ss += __shfl_xor(ss, 16); ss += __shfl_xor(ss, 32); if (fq == 0) PARTQ[(unsigned)row * 8 + wc] = ss;  EPI_ROWS_END
        } else if (pn == 11) {
            EPI_ROWS_BEGIN  float ss = 0.f;
#pragma unroll
                for (int n = 0; n < 2; ++n) { const f32x4 v = acc[ai][0][m][n]; st4bf(CQ + (unsigned)row * 384 + 256 + 32 * wc + 16 * n + 4 * fq, v); ss += (v[0] * v[0] + v[1] * v[1]) + (v[2] * v[2] + v[3] * v[3]); }
                ss += __shfl_xor(ss, 16); ss += __shfl_xor(ss, 32); if (fq == 0) PARTQ[(unsigned)row * 8 + 4 + wc] = ss;
                if (wc < 2) { f32x4 c, s; rope_cs(row, wc, fq, c, s); const f32x4 x1 = acc[ai][1][m][0], x2 = acc[ai][1][m][1]; const f32x4 y1 = x1 * c - x2 * s, y2 = x1 * s + x2 * c;
#pragma unroll
                    for (int h = 0; h < 4; ++h) { bf16_t* kp = KMLA + (unsigned)row * 768 + h * 192 + 128 + 16 * (wc & 1) + 4 * fq; st4bf(kp, y1); st4bf(kp + 32, y2); } }  EPI_ROWS_END
        } else if (pn == 12) {
            EPI_ROWS_BEGIN  float ss = 0.f;
#pragma unroll
                for (int bj = 0; bj < 2; ++bj)
#pragma unroll
                    for (int n = 0; n < 2; ++n) { const f32x4 v = acc[ai][bj][m][n]; st4bf(CKV + (unsigned)row * 256 + 128 * bj + 32 * wc + 16 * n + 4 * fq, v); ss += (v[0] * v[0] + v[1] * v[1]) + (v[2] * v[2] + v[3] * v[3]); }
                ss += __shfl_xor(ss, 16); ss += __shfl_xor(ss, 32); if (fq == 0) PARTKV[(unsigned)row * 4 + wc] = ss;  EPI_ROWS_END
        } else {
            const int g = pn - 13;
            if (u.pm == 0) {
                EPI_ROWS_BEGIN
#pragma unroll
                    for (int bj = 0; bj < 2; ++bj)
#pragma unroll
                        for (int n = 0; n < 2; ++n) *(f32x4*)(CTXW + (unsigned)row * 1024 + g * 256 + 128 * bj + 32 * wc + 16 * n + 4 * fq) = acc[ai][bj][m][n];  EPI_ROWS_END
            } else {
                EPI_ROWS_BEGIN  const int nl = row - NCTX, n1 = nl >> 7, n2 = nl & 127;
#pragma unroll
                    for (int bj = 0; bj < 2; ++bj)
#pragma unroll
                        for (int n = 0; n < 2; ++n)
#pragma unroll
                            for (int j = 0; j < 4; ++j) FX[((unsigned)((n2 * 4 + g) * 128 + 32 * wc + 16 * n + 4 * fq + j)) * 256 + bj * 128 + n1] = f2bf(acc[ai][bj][m][n][j]);  EPI_ROWS_END
            }
        }
    }
};

struct EpiUpq {
    static constexpr bool PERM = false, AFTER_DRAIN = false;
    bf16_t* QMLA; const float* PARTQ; const float* ROPE;
    __device__ __forceinline__ void operator()(const f32x4 (&acc)[2][2][4][2], const pg8::Unit& u, int wr, int wc, int fr, int fq) const {
        asm volatile("" : "+v"(fr), "+v"(fq));
        const int pn = u.pn;
        EPI_ROWS_BEGIN  const f32x4 pa = *(const f32x4*)(PARTQ + (unsigned)row * 8), pb = *(const f32x4*)(PARTQ + (unsigned)row * 8 + 4);
            const float f = rsqrtf(((pa[0] + pa[1]) + (pa[2] + pa[3]) + (pb[0] + pb[1]) + (pb[2] + pb[3])) * (1.f / 384.f) + 1e-6f) * QS_MLA;
            if (pn < 2) {
#pragma unroll
                for (int bj = 0; bj < 2; ++bj)
#pragma unroll
                    for (int n = 0; n < 2; ++n) st4bf(QMLA + (unsigned)row * 768 + (2 * pn + bj) * 192 + 32 * wc + 16 * n + 4 * fq, acc[ai][bj][m][n] * f);
            } else {
                f32x4 c, s;
                if (row < NCTX) { c = (f32x4){1.f, 1.f, 1.f, 1.f}; s = (f32x4){0.f, 0.f, 0.f, 0.f}; }
                else { const int nl = row - NCTX, pos = (wc & 1) ? (nl & 63) : (nl >> 6);
                    const f32x4 a = *(const f32x4*)(ROPE + (pos * 16 + 4 * fq) * 2), b = *(const f32x4*)(ROPE + (pos * 16 + 4 * fq) * 2 + 4);
                    c = (f32x4){a[0], a[2], b[0], b[2]}; s = (f32x4){a[1], a[3], b[1], b[3]}; }
#pragma unroll
                for (int bj = 0; bj < 2; ++bj) { const f32x4 x1 = acc[ai][bj][m][0] * f, x2 = acc[ai][bj][m][1] * f; bf16_t* qp = QMLA + (unsigned)row * 768 + (2 * bj + (wc >> 1)) * 192 + 128 + 16 * (wc & 1) + 4 * fq;
                    st4bf(qp, x1 * c - x2 * s); st4bf(qp + 32, x1 * s + x2 * c); }
            }  EPI_ROWS_END
    }
};
struct EpiUpkv {
    static constexpr bool PERM = false, AFTER_DRAIN = false;
    bf16_t *KMLA, *VTMLA; const float* PARTKV;
    __device__ __forceinline__ void operator()(const f32x4 (&acc)[2][2][4][2], const pg8::Unit& u, int wr, int wc, int fr, int fq) const {
        asm volatile("" : "+v"(fr), "+v"(fq));
        const int pn = u.pn;
        EPI_ROWS_BEGIN  const f32x4 pa = *(const f32x4*)(PARTKV + (unsigned)row * 4);
            const float f = rsqrtf(((pa[0] + pa[1]) + (pa[2] + pa[3])) * (1.f / 256.f) + 1e-6f);
            if (pn < 2) {
#pragma unroll
                for (int bj = 0; bj < 2; ++bj)
#pragma unroll
                    for (int n = 0; n < 2; ++n) st4bf(KMLA + (unsigned)row * 768 + (2 * pn + bj) * 192 + 32 * wc + 16 * n + 4 * fq, acc[ai][bj][m][n] * f);
            } else {
#pragma unroll
                for (int bj = 0; bj < 2; ++bj)
#pragma unroll
                    for (int n = 0; n < 2; ++n)
#pragma unroll
                        for (int j = 0; j < 4; ++j) VTMLA[(unsigned)((pn - 2) * 256 + 128 * bj + 32 * wc + 16 * n + 4 * fq + j) * T + row] = f2bf(acc[ai][bj][m][n][j] * f);
            }  EPI_ROWS_END
    }
};
struct LruOrder {
    int G, c;
    __device__ bool next(int i, pg8::Unit& u) const { const long L = (long)i * G + c; if (L >= 520) return false; const int idx = (int)L, pmr = idx % 65, hd = idx / 65; u.pm = (hd >> 1) * 65 + pmr; u.pn = hd; return true; }
    __device__ __forceinline__ void a_ready(const pg8::Unit&) const {}
    __device__ __forceinline__ void done(const pg8::Unit&) const {}
};
__device__ __forceinline__ float neg_expm1(float x) {
    const float ser = -x * (1.f + x * (0.5f + x * (0.16666667f + x * 0.041666667f)));
    return x > -0.125f ? ser : 1.f - __expf(x);
}
struct EpiLru {
    static constexpr bool PERM = false, AFTER_DRAIN = false;
    unsigned* AU; const bf16_t* XC; const float *br, *bi, *c8;
    __device__ __forceinline__ void operator()(const f32x4 (&acc)[2][2][4][2], const pg8::Unit& u, int wr, int wc, int fr, int fq) const {
        asm volatile("" : "+v"(fr), "+v"(fq));
        const int h = u.pn >> 1, d = u.pn & 1, pmr = u.pm - h * 65;
#pragma unroll
        for (int bj = 0; bj < 2; ++bj) { const int chl = 64 * bj + 16 * wc + 4 * fq, ch = d * 512 + h * 128 + chl; const f32x4 vbr = *(const f32x4*)(br + ch), vbi = *(const f32x4*)(bi + ch), vc8 = *(const f32x4*)(c8 + ch);
#pragma unroll
            for (int ai = 0; ai < 2; ++ai)
#pragma unroll
                for (int m = 0; m < 4; ++m) { const int row = pmr * 256 + ai * 128 + wr * 64 + m * 16 + fr; const u32x2 xw = *(const u32x2*)(XC + ((unsigned)h * T + row) * 128 + chl); u32x4 o;
#pragma unroll
                    for (int j = 0; j < 4; ++j) { const float xv = bf2f(j & 1 ? (j < 2 ? xw.x : xw.y) >> 16 : (j < 2 ? xw.x : xw.y) & 0xffffu);
                        const float r = sigmf(acc[ai][bj][m][0][j] + vbr[j]), ig = sigmf(acc[ai][bj][m][1][j] + vbi[j]); const float la = vc8[j] * r;
                        const float uu = sqrtf(neg_expm1(2.f * la)) * (ig * xv); o[j] = pk2(uu, la * LOG2E); }
                    *(u32x4*)(AU + ((unsigned)d * T + row) * 512 + h * 128 + chl) = o; asm volatile("" ::: "memory"); __builtin_amdgcn_sched_barrier(0); } }
    }
};
struct EpiFftA {
    static constexpr bool PERM = false, AFTER_DRAIN = false;
    bf16_t* FT;
    __device__ __forceinline__ void operator()(const f32x4 (&acc)[2][2][4][2], const pg8::Unit& u, int wr, int wc, int fr, int fq) const {
        asm volatile("" : "+v"(fr), "+v"(fq));
        EPI_ROWS_BEGIN const int n2 = row >> 9, gj = row & 511; bf16_t* p0 = FT + ((unsigned)((16 * wc + 4 * fq) * 512 + gj)) * 256 + n2;
#pragma unroll
            for (int bj = 0; bj < 2; ++bj)
#pragma unroll
                for (int j = 0; j < 4; ++j) { bf16_t* p = p0 + (unsigned)(64 * bj + j) * 512 * 256; p[0] = f2bf(acc[ai][bj][m][0][j]); p[128] = f2bf(acc[ai][bj][m][1][j]); } EPI_ROWS_END
    }
};
struct FftCOrder {
    int G, c;
    __device__ bool next(int i, pg8::Unit& u) const { const long L = (long)i * G + c; if (L >= 256) return false; u.pm = (int)L; u.pn = (int)L >> 1; return true; }
    __device__ __forceinline__ void a_ready(const pg8::Unit&) const {}
    __device__ __forceinline__ void done(const pg8::Unit&) const {}
};
struct EpiFftC {
    static constexpr bool PERM = false, AFTER_DRAIN = false;
    bf16_t* MIX;
    __device__ __forceinline__ void operator()(const f32x4 (&acc)[2][2][4][2], const pg8::Unit& u, int wr, int wc, int fr, int fq) const {
        asm volatile("" : "+v"(fr), "+v"(fq));
        EPI_ROWS_BEGIN  const int k1 = row >> 9, gj = row & 511;
#pragma unroll
            for (int n = 0; n < 2; ++n)
#pragma unroll
                for (int j = 0; j < 4; ++j) { const int k2 = 32 * wc + 16 * n + 4 * fq + j; MIX[(unsigned)(NCTX + k1 + 128 * k2) * DM + 1536 + gj] = f2bf(acc[ai][0][m][n][j]); }  EPI_ROWS_END
    }
};
struct EpiRes {
    static constexpr bool PERM = false, AFTER_DRAIN = false;
    const float* xa; const float* xb; float* Y; const float* gate0; const float* gate1; int pm0;
    __device__ __forceinline__ void operator()(const f32x4 (&acc)[2][2][4][2], const pg8::Unit& u_, int wr, int wc, int fr, int fq) const {
        const pg8::Unit u{u_.pm + pm0, u_.pn};
        asm volatile("" : "+v"(fr), "+v"(fq));
        const float* gp = (u.pm == 0 ? gate0 : gate1) + u.pn * 256 + 32 * wc + 4 * fq;
        f32x4 gv[2][2];
#pragma unroll
        for (int bj = 0; bj < 2; ++bj)
#pragma unroll
            for (int n = 0; n < 2; ++n) gv[bj][n] = *(const f32x4*)(gp + 128 * bj + 16 * n);
        EPI_ROWS_BEGIN  const float* xo = (row < NCTX ? xa + (unsigned)row * DM : xb + (unsigned)(row - NCTX) * DM) + u.pn * 256 + 32 * wc + 4 * fq; float* yo = Y + (unsigned)row * DM + u.pn * 256 + 32 * wc + 4 * fq;
#pragma unroll
            for (int bj = 0; bj < 2; ++bj)
#pragma unroll
                for (int n = 0; n < 2; ++n) { const f32x4 xv = *(const f32x4*)(xo + 128 * bj + 16 * n); *(f32x4*)(yo + 128 * bj + 16 * n) = xv * ALPHA + gv[bj][n] * acc[ai][bj][m][n]; }  EPI_ROWS_END
    }
};
struct EpiResAtomic {
    static constexpr bool PERM = false, AFTER_DRAIN = false;
    float* Y; const float* gate;
    __device__ __forceinline__ void operator()(const f32x4 (&acc)[2][2][4][2], const pg8::Unit& u, int wr, int wc, int fr, int fq) const {
        asm volatile("" : "+v"(fr), "+v"(fq));
        const float* gp = gate + u.pn * 256 + 32 * wc + 4 * fq;
        EPI_ROWS_BEGIN float* yo = Y + (unsigned)row * DM + u.pn * 256 + 32 * wc + 4 * fq;
#pragma unroll
            for (int bj = 0; bj < 2; ++bj)
#pragma unroll
                for (int n = 0; n < 2; ++n) { const f32x4 gv = *(const f32x4*)(gp + 128 * bj + 16 * n);
#pragma unroll
                    for (int j = 0; j < 4; ++j) (void)unsafeAtomicAdd(yo + 128 * bj + 16 * n + j, gv[j] * acc[ai][bj][m][n][j]); } EPI_ROWS_END
    }
};
struct EpiGU {
    static constexpr bool PERM = false, AFTER_DRAIN = false;
    bf16_t* H; int pm0;
    __device__ __forceinline__ void operator()(const f32x4 (&acc)[2][2][4][2], const pg8::Unit& u_, int wr, int wc, int fr, int fq) const {
        const pg8::Unit u{u_.pm + pm0, u_.pn};
        asm volatile("" : "+v"(fr), "+v"(fq));
        EPI_ROWS_BEGIN
#pragma unroll
            for (int bj = 0; bj < 2; ++bj) { const f32x4 g = acc[ai][bj][m][0], v = acc[ai][bj][m][1]; f32x4 o;
#pragma unroll
                for (int j = 0; j < 4; ++j) o[j] = siluf(g[j]) * v[j];
                st4bf(H + (unsigned)row * DFF + u.pn * 128 + 64 * bj + 16 * wc + 4 * fq, o); }  EPI_ROWS_END
    }
};

template <int DQK>
__device__ __forceinline__ void attn_unit(const bf16_t* __restrict__ Q, int ldq, const bf16_t* __restrict__ K, int ldk, const bf16_t* __restrict__ Vt, bf16_t* O, int ldo, int q0, int nkeys, LAS unsigned char* lds) {
    constexpr int KS = DQK / 16, KROW = DQK + 8, KCH = DQK / 8, KLD = (64 * KCH) / NTHR, VROW = 72;
    LAS bf16_t* Ks = (LAS bf16_t*)lds; LAS bf16_t* Vs = (LAS bf16_t*)(lds + 2 * 64 * KROW * 2);
    int tid_ = threadIdx.x; asm volatile("" : "+v"(tid_));
    const int tid = tid_, lane = tid & 63, wid = tid >> 6, qi = lane & 31, hi = lane >> 5;
    bf16x8 qf[KS];
    { const bf16_t* qp = Q + (size_t)(q0 + wid * 32 + qi) * ldq + hi * 8;
#pragma unroll
      for (int ks = 0; ks < KS; ++ks) qf[ks] = *(const bf16x8*)(qp + ks * 16); }
    f32x16 o[4];
#pragma unroll
    for (int d0 = 0; d0 < 4; ++d0)
#pragma unroll
        for (int r = 0; r < 16; ++r) o[d0][r] = 0.f;
    float m_run = -1e30f, l_run = 0.f;
    const int NT = nkeys / 64;
    u32x4 kreg[KLD], vreg[2];
#define ATT_LOADK(t) do { _Pragma("unroll") for (int i_ = 0; i_ < KLD; ++i_) { const int c_ = tid + NTHR * i_, r_ = c_ / KCH, cc_ = c_ % KCH; kreg[i_] = *(const u32x4*)(K + (size_t)((t) * 64 + r_) * ldk + cc_ * 8); } } while (0)
#define ATT_LOADV(t) do { _Pragma("unroll") for (int i_ = 0; i_ < 2; ++i_) { const int c_ = tid + NTHR * i_, dv_ = c_ >> 3, k8_ = c_ & 7; vreg[i_] = *(const u32x4*)(Vt + (size_t)dv_ * T + (t) * 64 + k8_ * 8); } } while (0)
#define ATT_STOREK(b) do { _Pragma("unroll") for (int i_ = 0; i_ < KLD; ++i_) { const int c_ = tid + NTHR * i_, r_ = c_ / KCH, cc_ = c_ % KCH; *(LAS u32x4*)(Ks + (b) * 64 * KROW + r_ * KROW + cc_ * 8) = kreg[i_]; } } while (0)
#define ATT_STOREV(b) do { _Pragma("unroll") for (int i_ = 0; i_ < 2; ++i_) { const int c_ = tid + NTHR * i_, dv_ = c_ >> 3, k8_ = c_ & 7; *(LAS u32x4*)(Vs + (b) * 128 * VROW + dv_ * VROW + k8_ * 8) = vreg[i_]; } } while (0)
#define ATT_QK(S0, S1, b) do { const LAS bf16_t* kb_ = Ks + (b) * 64 * KROW + krow * KROW + hi * 8; \
        _Pragma("unroll") for (int r_ = 0; r_ < 16; ++r_) { S0[r_] = 0.f; S1[r_] = 0.f; } \
        _Pragma("unroll") for (int ks_ = 0; ks_ < KS; ++ks_) { const bf16x8 k0_ = *(const LAS bf16x8*)(kb_ + ks_ * 16), k1_ = *(const LAS bf16x8*)(kb_ + 32 * KROW + ks_ * 16); \
            S0 = __builtin_amdgcn_mfma_f32_32x32x16_bf16(k0_, qf[ks_], S0, 0, 0, 0); S1 = __builtin_amdgcn_mfma_f32_32x32x16_bf16(k1_, qf[ks_], S1, 0, 0, 0); } } while (0)
    const int krow = swap23(qi);
    ATT_LOADK(0); ATT_LOADV(0); ATT_STOREK(0); ATT_STOREV(0); ATT_LOADK(1); ATT_STOREK(1); __syncthreads();
    f32x16 s0, s1, n0, n1;
    ATT_QK(s0, s1, 0);
    for (int t = 0; t < NT; ++t) {
        const bool has1 = t + 1 < NT, has2 = t + 2 < NT;
        if (has2) ATT_LOADK(t + 2);
        if (has1) ATT_LOADV(t + 1);
        if (has1) ATT_QK(n0, n1, (t + 1) & 1);
        const LAS bf16_t* vb = Vs + (t & 1) * 128 * VROW + qi * VROW + hi * 8;
        float mx = fmaxf(s0[0], s1[0]);
#pragma unroll
        for (int r = 1; r < 16; ++r) mx = fmaxf(mx, fmaxf(s0[r], s1[r]));
        mx = fmaxf(mx, __shfl_xor(mx, 32));
        if (__any(mx > m_run + 8.f)) {
            const float m_new = fmaxf(m_run, mx), alpha = ex2(m_run - m_new); m_run = m_new; l_run *= alpha;
#pragma unroll
            for (int d0 = 0; d0 < 4; ++d0)
#pragma unroll
                for (int r = 0; r < 16; ++r) o[d0][r] *= alpha;
        }
        float ps = 0.f;
#pragma unroll
        for (int r = 0; r < 16; ++r) { s0[r] = ex2(s0[r] - m_run); s1[r] = ex2(s1[r] - m_run); ps += s0[r] + s1[r]; }
        l_run += ps;
        u32x4 pw[4];
#pragma unroll
        for (int i = 0; i < 4; ++i) { pw[0][i] = pk2(s0[2 * i], s0[2 * i + 1]); pw[1][i] = pk2(s0[8 + 2 * i], s0[8 + 2 * i + 1]); pw[2][i] = pk2(s1[2 * i], s1[2 * i + 1]); pw[3][i] = pk2(s1[8 + 2 * i], s1[8 + 2 * i + 1]); }
#pragma unroll
        for (int sp = 0; sp < 4; ++sp) { const bf16x8 pf = __builtin_bit_cast(bf16x8, pw[sp]);
#pragma unroll
            for (int d0 = 0; d0 < 4; ++d0) { const bf16x8 vf = *(const LAS bf16x8*)(vb + 32 * d0 * VROW + sp * 16); o[d0] = __builtin_amdgcn_mfma_f32_32x32x16_bf16(vf, pf, o[d0], 0, 0, 0); } }
        if (has2) ATT_STOREK(t & 1);
        if (has1) ATT_STOREV((t + 1) & 1);
        __syncthreads();
        s0 = n0; s1 = n1;
    }
#undef ATT_LOADK
#undef ATT_LOADV
#undef ATT_STOREK
#undef ATT_STOREV
#undef ATT_QK
    const float l = l_run + __shfl_xor(l_run, 32), inv = 1.f / l;
    bf16_t* op = O + (size_t)(q0 + wid * 32 + qi) * ldo + 4 * hi;
#pragma unroll
    for (int d0 = 0; d0 < 4; ++d0)
#pragma unroll
        for (int g = 0; g < 4; ++g) { u32x2 w; w.x = pk2(o[d0][4 * g] * inv, o[d0][4 * g + 1] * inv); w.y = pk2(o[d0][4 * g + 2] * inv, o[d0][4 * g + 3] * inv); *(u32x2*)(op + 32 * d0 + 8 * g) = w; }
}

__device__ __forceinline__ void attn_unit_da(const bf16_t* __restrict__ Q, const bf16_t* __restrict__ K, const bf16_t* __restrict__ Vt, bf16_t* O, int q0, int nkeys, LAS unsigned char* lds) {
    constexpr int KROW = 72, VROW = 72, LDQ = 512, LDO = 1024;
    LAS bf16_t* Ks = (LAS bf16_t*)lds; LAS bf16_t* Vs = (LAS bf16_t*)(lds + 2 * 64 * KROW * 2);
    int tid_ = threadIdx.x; asm volatile("" : "+v"(tid_));
    const int tid = tid_, lane = tid & 63, wid = tid >> 6, qi = lane & 31, hi = lane >> 5, qg = wid >> 1, kh = wid & 1;
    bf16x8 qf[2][4];
#pragma unroll
    for (int qs = 0; qs < 2; ++qs) { const bf16_t* qp = Q + (size_t)(q0 + qg * 64 + qs * 32 + qi) * LDQ + hi * 8;
#pragma unroll
        for (int ks = 0; ks < 4; ++ks) qf[qs][ks] = *(const bf16x8*)(qp + ks * 16); }
    f32x16 o[2][4];
#pragma unroll
    for (int qs = 0; qs < 2; ++qs)
#pragma unroll
        for (int d0 = 0; d0 < 4; ++d0)
#pragma unroll
            for (int r = 0; r < 16; ++r) o[qs][d0][r] = 0.f;
    float m_run[2] = {-1e30f, -1e30f}, l_run[2] = {0.f, 0.f};
    const int NT = nkeys / 64;
    u32x4 kreg, vreg[2];
#define DA_LOADG(t) do { { const int r_ = tid >> 3, cc_ = tid & 7; kreg = *(const u32x4*)(K + (size_t)((t) * 64 + r_) * 512 + cc_ * 8); } \
        _Pragma("unroll") for (int i_ = 0; i_ < 2; ++i_) { const int c_ = tid + NTHR * i_, dv_ = c_ >> 3, k8_ = c_ & 7; vreg[i_] = *(const u32x4*)(Vt + (size_t)dv_ * T + (t) * 64 + k8_ * 8); } } while (0)
#define DA_STOREL(b) do { { const int r_ = tid >> 3, cc_ = tid & 7; *(LAS u32x4*)(Ks + (b) * 64 * KROW + r_ * KROW + cc_ * 8) = kreg; } \
        _Pragma("unroll") for (int i_ = 0; i_ < 2; ++i_) { const int c_ = tid + NTHR * i_, dv_ = c_ >> 3, k8_ = c_ & 7; *(LAS u32x4*)(Vs + (b) * 128 * VROW + dv_ * VROW + k8_ * 8) = vreg[i_]; } } while (0)
    DA_LOADG(0); DA_STOREL(0); __syncthreads();
    const int krow = 32 * kh + swap23(qi);
    for (int t = 0; t < NT; ++t) {
        const int buf = t & 1;
        if (t + 1 < NT) DA_LOADG(t + 1);
        const LAS bf16_t* kb = Ks + buf * 64 * KROW + krow * KROW + hi * 8; const LAS bf16_t* vb = Vs + buf * 128 * VROW + qi * VROW + 32 * kh + hi * 8;
        f32x16 sc[2];
#pragma unroll
        for (int r = 0; r < 16; ++r) { sc[0][r] = 0.f; sc[1][r] = 0.f; }
#pragma unroll
        for (int ks = 0; ks < 4; ++ks) { const bf16x8 kf = *(const LAS bf16x8*)(kb + ks * 16);
            sc[0] = __builtin_amdgcn_mfma_f32_32x32x16_bf16(kf, qf[0][ks], sc[0], 0, 0, 0); sc[1] = __builtin_amdgcn_mfma_f32_32x32x16_bf16(kf, qf[1][ks], sc[1], 0, 0, 0); }
        u32x4 pw[2][2];
#pragma unroll
        for (int qs = 0; qs < 2; ++qs) {
            float mx = sc[qs][0];
#pragma unroll
            for (int r = 1; r < 16; ++r) mx = fmaxf(mx, sc[qs][r]);
            mx = fmaxf(mx, __shfl_xor(mx, 32));
            if (__any(mx > m_run[qs] + 8.f)) {
                const float m_new = fmaxf(m_run[qs], mx), alpha = ex2(m_run[qs] - m_new); m_run[qs] = m_new; l_run[qs] *= alpha;
#pragma unroll
                for (int d0 = 0; d0 < 4; ++d0)
#pragma unroll
                    for (int r = 0; r < 16; ++r) o[qs][d0][r] *= alpha;
            }
            float ps = 0.f;
#pragma unroll
            for (int r = 0; r < 16; ++r) { sc[qs][r] = ex2(sc[qs][r] - m_run[qs]); ps += sc[qs][r]; }
            l_run[qs] += ps;
#pragma unroll
            for (int i = 0; i < 4; ++i) { pw[qs][0][i] = pk2(sc[qs][2 * i], sc[qs][2 * i + 1]); pw[qs][1][i] = pk2(sc[qs][8 + 2 * i], sc[qs][8 + 2 * i + 1]); }
        }
#pragma unroll
        for (int sp = 0; sp < 2; ++sp)
#pragma unroll
            for (int d0 = 0; d0 < 4; ++d0) { const bf16x8 vf = *(const LAS bf16x8*)(vb + 32 * d0 * VROW + sp * 16);
                o[0][d0] = __builtin_amdgcn_mfma_f32_32x32x16_bf16(vf, __builtin_bit_cast(bf16x8, pw[0][sp]), o[0][d0], 0, 0, 0);
                o[1][d0] = __builtin_amdgcn_mfma_f32_32x32x16_bf16(vf, __builtin_bit_cast(bf16x8, pw[1][sp]), o[1][d0], 0, 0, 0); }
        if (t + 1 < NT) DA_STOREL(buf ^ 1);
        __syncthreads();
    }
#undef DA_LOADG
#undef DA_STOREL
    LAS float* xp = (LAS float*)lds + (size_t)qg * (130 * 64) + lane;
#pragma unroll
    for (int qs = 0; qs < 2; ++qs) {
        const float lt = l_run[qs] + __shfl_xor(l_run[qs], 32);
        if (kh == 1) { xp[128 * 64] = m_run[qs]; xp[129 * 64] = lt;
#pragma unroll
            for (int d0 = 0; d0 < 4; ++d0)
#pragma unroll
                for (int r = 0; r < 16; ++r) xp[(d0 * 16 + r) * 64] = o[qs][d0][r]; }
        __syncthreads();
        if (kh == 0) { const float mb = xp[128 * 64], lb = xp[129 * 64];
            const float m = fmaxf(m_run[qs], mb), fa = ex2(m_run[qs] - m), fb = ex2(mb - m), inv = 1.f / (lt * fa + lb * fb), ca = fa * inv, cb = fb * inv;
            bf16_t* op = O + (size_t)(q0 + qg * 64 + qs * 32 + qi) * LDO + 4 * hi;
#pragma unroll
            for (int d0 = 0; d0 < 4; ++d0)
#pragma unroll
                for (int g = 0; g < 4; ++g) { float v[4];
#pragma unroll
                    for (int j = 0; j < 4; ++j) v[j] = o[qs][d0][4 * g + j] * ca + xp[(d0 * 16 + 4 * g + j) * 64] * cb;
                    u32x2 w; w.x = pk2(v[0], v[1]); w.y = pk2(v[2], v[3]); *(u32x2*)(op + 32 * d0 + 8 * g) = w; } }
        __syncthreads();
    }
}

#define XB_TMO      128
#define XB_XCNT(j)  (256  + 64 * (j))
#define XB_XSUB(j)  (1280 + 64 * (j))
#define XB_XGEN(j)  (2304 + 64 * (j))
#define XB_TOP      3328
#define XB_TOPGEN   3392
#define XCD_BAR_WORDS 3456
#define XB_SPIN_CAP (1u << 18)

__device__ __forceinline__ unsigned xb_ld(unsigned* p)              { return __hip_atomic_load(p, __ATOMIC_RELAXED, __HIP_MEMORY_SCOPE_AGENT); }
__device__ __forceinline__ unsigned xb_add(unsigned* p, unsigned v) { return __hip_atomic_fetch_add(p, v, __ATOMIC_RELAXED, __HIP_MEMORY_SCOPE_AGENT); }
__device__ __forceinline__ unsigned xb_xcc_id() { return (unsigned)__builtin_amdgcn_s_getreg((3 << 11) | 20) & 0xFu; }
#define XB_SPIN(cond, bar) do { unsigned _sp = 0; while (cond) { __builtin_amdgcn_s_sleep(1); \
    if ((++_sp & 255u) == 0u) { if (xb_ld(&(bar)[XB_TMO])) break; if (_sp > XB_SPIN_CAP) { atomicAdd(&(bar)[XB_TMO], 1u); break; } } } } while (0)

struct XcdBarrier {
    unsigned* bar; unsigned x;
    volatile LAS unsigned* st;
};

__device__ __forceinline__ XcdBarrier xcd_barrier_post(unsigned* bar, volatile LAS unsigned* st) {
    XcdBarrier b; b.bar = bar; b.x = xb_xcc_id(); b.st = st;
    if (threadIdx.x == 0) (void)xb_add(&bar[XB_XCNT(b.x)], 1u);
    return b;
}
__device__ __forceinline__ void xcd_barrier_complete(unsigned* bar, unsigned x, unsigned& nloc, unsigned& nx) {
    const unsigned G = gridDim.x * gridDim.y * gridDim.z;
    unsigned sum, cnt, mine, sp = 0u;
    for (;;) {
        sum = 0u; cnt = 0u; mine = 0u;
#pragma unroll
        for (unsigned j = 0; j < 16; ++j) { const unsigned c = xb_ld(&bar[XB_XCNT(j)]); sum += c; cnt += (c > 0u) ? 1u : 0u; mine = (j == x) ? c : mine; }
        if (sum == G) break;
        __builtin_amdgcn_s_sleep(1);
        if ((++sp & 255u) == 0u) { if (xb_ld(&bar[XB_TMO])) break; if (sp > XB_SPIN_CAP) { atomicAdd(&bar[XB_TMO], 1u); break; } }
    }
    nloc = mine > 0u ? mine : 1u; nx = cnt > 0u ? cnt : 1u;
}

__device__ __forceinline__ void xcd_barrier(const XcdBarrier& b) {
    asm volatile("s_waitcnt vmcnt(0)" ::: "memory");
    __syncthreads();
    if (threadIdx.x == 0) {
        unsigned* bar = b.bar;
        __builtin_amdgcn_s_waitcnt(0);
        unsigned nloc = b.st[0], nx = b.st[1];
        if (nloc == 0u) { xcd_barrier_complete(bar, b.x, nloc, nx); b.st[0] = nloc; b.st[1] = nx; }
        const unsigned old = xb_add(&bar[XB_XSUB(b.x)], 1u);
        const unsigned gen = old / nloc;
        if (old + 1u == (gen + 1u) * nloc) {
            __builtin_amdgcn_fence(__ATOMIC_RELEASE, "agent");
            asm volatile("s_waitcnt vmcnt(0)" ::: "memory");
            const unsigned og = xb_add(&bar[XB_TOP], 1u);
            const unsigned tg = og / nx;
            if (og + 1u == (tg + 1u) * nx) xb_add(&bar[XB_TOPGEN], 1u);
            else XB_SPIN(xb_ld(&bar[XB_TOPGEN]) == tg, bar);
            __builtin_amdgcn_fence(__ATOMIC_ACQUIRE, "agent");
            xb_add(&bar[XB_XGEN(b.x)], 1u);
            asm volatile("s_waitcnt vmcnt(0)" ::: "memory");
        } else {
            XB_SPIN(xb_ld(&bar[XB_XGEN(b.x)]) == gen, bar);
            __builtin_amdgcn_fence(__ATOMIC_ACQUIRE, "agent");
            asm volatile("s_waitcnt vmcnt(0)" ::: "memory");
        }
    }
    __syncthreads();
}

#define GAS __attribute__((address_space(1)))
#define PIN(i) ((const float*)(const GAS float*)pp->in[i])
#define F1T ((bf16_t*)(ws + O_F1T))
#define F2T ((bf16_t*)(ws + O_F2T))
#define ROPE ((float*)(ws + O_ROPE))
#define C8T ((float*)(ws + O_C8))
#define MODS ((float*)(ws + O_MODS))
#define XMOD ((bf16_t*)(ws + O_XMOD))
#define XRES ((float*)(ws + O_XRES))
#define QDA ((bf16_t*)(ws + O_QDA))
#define KDA ((bf16_t*)(ws + O_KDA))
#define VTDA ((bf16_t*)(ws + O_VTDA))
#define LRUX ((bf16_t*)(ws + O_LRUX))
#define LRUG ((bf16_t*)(ws + O_LRUG))
#define CQ ((bf16_t*)(ws + O_CQ))
#define CKV ((bf16_t*)(ws + O_CKV))
#define PARTQ ((float*)(ws + O_PARTQ))
#define PARTKV ((float*)(ws + O_PARTKV))
#define QMLA ((bf16_t*)(ws + O_QMLA))
#define KMLA ((bf16_t*)(ws + O_KMLA))
#define VTMLA ((bf16_t*)(ws + O_VTMLA))
#define FX ((bf16_t*)(ws + O_FX))
#define FT ((bf16_t*)(ws + O_FT))
#define CTXW ((float*)(ws + O_CTXW))
#define XC ((bf16_t*)(ws + O_XC))
#define AU ((unsigned*)(ws + O_AU))
#define SUMM ((float*)(ws + O_SUMM))
#define DAO ((bf16_t*)(ws + O_DAO))
#define HB ((bf16_t*)(ws + O_H))
#define WIN ((bf16_t*)(wl + O_WIN))
#define WOUT ((bf16_t*)(wl + O_WOUT))
#define WGU ((bf16_t*)(wl + O_WGU))
#define WD ((bf16_t*)(wl + O_WD))
#define WUQ ((bf16_t*)(wl + O_WUQ))
#define WUKV ((bf16_t*)(wl + O_WUKV))
#define WLRU ((bf16_t*)(wl + O_WLRU))
#define MIX XMOD
#define mods_c (MODS + (size_t)(l * 2 + 0) * 12288)
#define mods_l (MODS + (size_t)(l * 2 + 1) * 12288)
__device__ __forceinline__ int chunk_start(int c) { if (c <= 4) return 64 * c; const int cl = c - 4; return NCTX + 65 * cl + (cl < 4 ? cl : 4); }
constexpr int N_PHASES = 22;
template <unsigned MASK>
__global__ void __launch_bounds__(NTHR, 2) mega_fwd(Params P) {
    extern __shared__ __attribute__((aligned(16))) unsigned char lds_raw[];
    LAS unsigned char* lds = (LAS unsigned char*)lds_raw;
    const int tid0 = threadIdx.x;
    const int G0 = gridDim.x, bid0 = blockIdx.x;
    cg::grid_group grid = cg::this_grid();
    volatile LAS unsigned* bst = (volatile LAS unsigned*)(lds + LDS_BYTES - 16);
    if (tid0 < 4) bst[tid0] = 0u;
    __syncthreads();
    XcdBarrier xbar = xcd_barrier_post((unsigned*)(P.ws + O_BAR), bst);

    for (int ph = P.ph_lo; ph < P.ph_hi; ++ph) {
        const __attribute__((address_space(4))) Params* pp = (const __attribute__((address_space(4))) Params*)__builtin_amdgcn_kernarg_segment_ptr(); asm volatile("" : "+s"(pp));
        int tid = tid0; asm volatile("" : "+v"(tid));
        int G = G0, bid = bid0; asm volatile("" : "+s"(G), "+s"(bid));
        const int NGW = G * NWV, NT_ALL = G * NTHR;
        const int lane = tid & 63, wid = __builtin_amdgcn_readfirstlane(tid >> 6), gw = bid * NWV + wid, gtid = bid * NTHR + tid;
        GAS unsigned char* ws = (GAS unsigned char*)pp->ws; asm volatile("" : "+s"(ws));
        const int l = ph >= 2 ? (ph - 2) / 10 : 0, sub = ph >= 2 ? (ph - 2) % 10 : -1;
        GAS unsigned char* wl = ws + (size_t)l * SZ_WLAYER;
        if (EN(0) && ph == 0) {
            for (int rp_ = 0; rp_ < DUP_P0; ++rp_) {
            for (int it = bid; it < 256; it += G) {
                const int ll = it >> 7, g = (it >> 5) & 3, kb = it & 31, k0 = 64 * kb;
                LAS float* wt = (LAS float*)lds; LAS float* tab = wt + 64 * 129;
                const float* wsrc = PIN(I_WIN) + (size_t)ll * DM * INW;
                for (int i = 0; i < 16; ++i) { const int e = tid + NTHR * i, kk = e >> 7, c = e & 127; wt[kk * 129 + c] = wsrc[(size_t)(k0 + kk) * INW + 3264 + 128 * g + c]; }
                if (tid < 128) tab[tid] = cospif((float)tid * (1.f / 64.f)) * RSQ128;
                __syncthreads();
                const int col = tid & 255, part = col >> 7, jj = col & 127, kh = tid >> 8; const int ph0 = part ? 96 : 0;
                bf16_t* dst = (bf16_t*)(ws + (size_t)ll * SZ_WLAYER + O_WIN) + (size_t)((13 + g) * 256 + col) * DM + k0 + 32 * kh;
                for (int q8 = 0; q8 < 4; ++q8) { float a[8];
#pragma unroll
                    for (int q = 0; q < 8; ++q) a[q] = 0.f;
                    const LAS float* wrow = wt + (32 * kh + 8 * q8) * 129;
                    for (int c = 0; c < 128; ++c) { const float tv = tab[(jj * c + ph0) & 127];
#pragma unroll
                        for (int q = 0; q < 8; ++q) a[q] += wrow[q * 129 + c] * tv; }
                    const float sg = part ? -1.f : 1.f; u32x4 o; o.x = pk2(a[0] * sg, a[1] * sg); o.y = pk2(a[2] * sg, a[3] * sg); o.z = pk2(a[4] * sg, a[5] * sg); o.w = pk2(a[6] * sg, a[7] * sg);
                    *(u32x4*)(dst + 8 * q8) = o; }
                __syncthreads();
            }
            for (int it = bid; it < 192; it += G) {
                const int ll = it / 96, nc = it % 96;
                LAS float* sv = (LAS float*)lds; LAS float* red = sv + 2 * DM;
                for (int i = tid; i < DM; i += NTHR) { sv[i] = siluf(PIN(I_CCTX)[i]); sv[DM + i] = siluf(PIN(I_C)[i]); }
                __syncthreads();
                const float* wp = PIN(I_WADA) + (size_t)ll * DM * 12288 + 128 * nc + 2 * lane;
                float a00 = 0.f, a01 = 0.f, a10 = 0.f, a11 = 0.f;
                for (int k0 = 256 * wid; k0 < 256 * wid + 256; k0 += 16) { f32x2_t w2[16];
#pragma unroll
                    for (int j = 0; j < 16; ++j) w2[j] = *(const f32x2_t*)(wp + (size_t)(k0 + j) * 12288);
#pragma unroll
                    for (int j = 0; j < 16; ++j) { const float s0 = sv[k0 + j], s1 = sv[DM + k0 + j]; a00 += s0 * w2[j][0]; a01 += s0 * w2[j][1]; a10 += s1 * w2[j][0]; a11 += s1 * w2[j][1]; } }
                red[(wid * 2 + 0) * 128 + 2 * lane] = a00; red[(wid * 2 + 0) * 128 + 2 * lane + 1] = a01; red[(wid * 2 + 1) * 128 + 2 * lane] = a10; red[(wid * 2 + 1) * 128 + 2 * lane + 1] = a11;
                __syncthreads();
                if (tid < 256) { const int v = tid >> 7, cc = tid & 127; float s = PIN(I_BADA)[(size_t)ll * 12288 + 128 * nc + cc];
                    for (int w = 0; w < 8; ++w) s += red[(w * 2 + v) * 128 + cc];
                    MODS[(size_t)(ll * 2 + v) * 12288 + 128 * nc + cc] = s; }
                __syncthreads();
            }
            for (int i = gtid; i < 4096; i += NT_ALL) { const int pos = i >> 4, f = i & 15; const float x = ((float)pos * INVF[f]) * 0.3183098861837907f; ROPE[2 * i] = cospif(x); ROPE[2 * i + 1] = sinpif(x); }
            for (int i = gtid; i < 65536; i += NT_ALL) { const int cp = i >> 8, kk = i & 255, part = kk >> 7, nn = kk & 127;
                const int n = (cp >> 4) & 1, k1 = 64 * (cp >> 7) + 16 * ((cp >> 5) & 3) + (cp & 15); const float ang = (float)((k1 * nn) & 127) * (1.f / 64.f); const float cv = cospif(ang) * RSQ128, sv = sinpif(ang) * RSQ128;
                F1T[i] = f2bf(n == 0 ? (part == 0 ? cv : sv) : (part == 0 ? -sv : cv)); }
            for (int i = gtid; i < 128 * 65536; i += NT_ALL) { const int k1 = i >> 16, cp = (i >> 8) & 255, kk = i & 255, part = kk >> 7, nn = kk & 127;
                float v = 0.f; if (cp < 128) { const float ang = (float)((nn * (k1 + 128 * cp)) & 16383) * (1.f / 8192.f); v = (part == 0 ? cospif(ang) : sinpif(ang)) * RSQ128; } F2T[i] = f2bf(v); }
            for (int i = gtid; i < 2048; i += NT_ALL) C8T[i] = -8.f * log1pf(__expf(-PIN(I_LLAM)[i]));
            LAS float* scr = (LAS float*)(lds + wid * 8704);
            for (int ll = 0; ll < 2; ++ll) {
                GAS unsigned char* wd = ws + (size_t)ll * SZ_WLAYER;
                tr_job(MapWin{PIN(I_WIN) + (size_t)ll * DM * INW, INW}, DM, 13 * 256, (bf16_t*)(wd + O_WIN), nullptr, scr, gw, NGW, lane);
                tr_job(MapPlain{PIN(I_WOUT) + (size_t)ll * DM * DM, DM}, DM, DM, (bf16_t*)(wd + O_WOUT), nullptr, scr, gw, NGW, lane);
                tr_job(MapGU{PIN(I_WG) + (size_t)ll * DM * DFF, PIN(I_WU) + (size_t)ll * DM * DFF, DFF}, DM, 2 * DFF, (bf16_t*)(wd + O_WGU), nullptr, scr, gw, NGW, lane);
                tr_job(MapPlain{PIN(I_WD) + (size_t)ll * DFF * DM, DM}, DFF, DM, (bf16_t*)(wd + O_WD), nullptr, scr, gw, NGW, lane);
                tr_job(MapUq{PIN(I_WUQ) + (size_t)ll * 384 * 768, 768}, 384, 768, (bf16_t*)(wd + O_WUQ), PIN(I_QNG) + ll * 384, scr, gw, NGW, lane);
                tr_job(MapUkv{PIN(I_WUKV) + (size_t)ll * 256 * 1024, 1024}, 256, 1024, (bf16_t*)(wd + O_WUKV), PIN(I_KVNG) + ll * 256, scr, gw, NGW, lane);
                for (int hd = 0; hd < 8; ++hd) { const int h = hd >> 1, d = hd & 1; const size_t wo = ((size_t)(ll * 2 + d) * 4 + h) * 16384;
                    tr_job(MapLru{PIN(I_LWR) + wo, PIN(I_LWI) + wo, 128}, 128, 256, (bf16_t*)(wd + O_WLRU) + (size_t)hd * 256 * 128, nullptr, scr, gw, NGW, lane); }
            }
            __syncthreads(); }
        } else if (EN(1) && ph == 1) {
            for (int row = gw; row < T; row += NGW) { const float* xr = row < NCTX ? PIN(I_CTX) + (size_t)row * DM : PIN(I_X) + (size_t)(row - NCTX) * DM; const float* md = MODS + (size_t)(row < NCTX ? 0 : 1) * 12288;
#pragma unroll
                for (int j = 0; j < 8; ++j) { const int c = 4 * lane + 256 * j; const f32x4 xv = *(const f32x4*)(xr + c), sh = *(const f32x4*)(md + c), sc = *(const f32x4*)(md + DM + c); st4bf(XMOD + (size_t)row * DM + c, xv * (sc + 1.f) + sh); if (row < NCTX) *(f32x4*)(XRES + (size_t)row * DM + c) = xv * ALPHA; } }
        } else if (EN(2) && sub == 0) {
            pg8::Gemm g{XMOD, WIN, T, NIN, DM}; pg8::StaticOrder S; S.init(T, NIN, G, bid);
            EpiInproj E{QDA, KDA, VTDA, LRUX, LRUG, CQ, CKV, KMLA, FX, CTXW, PARTQ, PARTKV, ROPE};
            for (int rg_ = 0; rg_ < DUP_GEMM; ++rg_) pg8::gemm_phase<EpiInproj, pg8::StaticOrder, true, true>(lds, g, S, E);
        } else if (EN(3) && sub == 1) {
            for (int rs_ = 0; rs_ < DUP_S1; ++rs_) {
            if (EN(11)) { const float* cw = PIN(I_CONVW) + (size_t)l * 4 * 512; const float* cbv = PIN(I_CONVB) + (size_t)l * 512;
              for (int idx = gtid; idx < T * 64; idx += NT_ALL) { const int row = idx >> 6, ch0 = (idx & 63) * 8; const int lo = row < NCTX ? 0 : NCTX, hi = row < NCTX ? NCTX : T;
                  float a[8];
#pragma unroll
                  for (int q = 0; q < 8; ++q) a[q] = cbv[ch0 + q];
#pragma unroll
                  for (int j = 0; j < 4; ++j) { const int r = row + j - 2; if (r >= lo && r < hi) { const u32x4 xw = *(const u32x4*)(LRUX + (size_t)r * 512 + ch0); const float* wj = cw + j * 512 + ch0;
#pragma unroll
                      for (int q = 0; q < 4; ++q) { a[2 * q] += wj[2 * q] * bf2f(xw[q] & 0xffffu); a[2 * q + 1] += wj[2 * q + 1] * bf2f(xw[q] >> 16); } } }
                  u32x4 o; o.x = pk2(a[0], a[1]); o.y = pk2(a[2], a[3]); o.z = pk2(a[4], a[5]); o.w = pk2(a[6], a[7]);
                  *(u32x4*)(XC + ((size_t)(ch0 >> 7) * T + row) * 128 + (ch0 & 127)) = o; } }
            if (EN(12)) { pg8::Gemm g{CQ, WUQ, T, 768, 384}; pg8::StaticOrder S; S.init(T, 768, G, bid); EpiUpq E{QMLA, PARTQ, ROPE}; pg8::gemm_phase<EpiUpq, pg8::StaticOrder, true, true>(lds, g, S, E); }
            if (EN(13)) { pg8::Gemm g{CKV, WUKV, T, 1024, 256}; pg8::StaticOrder S; S.init(T, 1024, G, (bid + G - 195 % G) % G);     EpiUpkv E{KMLA, VTMLA, PARTKV}; pg8::gemm_phase<EpiUpkv, pg8::StaticOrder, true, true>(lds, g, S, E); }
            if (EN(14)) { pg8::Gemm g{FX, F1T, 65536, 256, 256}; pg8::StaticOrder S; S.init(65536, 256, G, bid); EpiFftA E{FT}; pg8::gemm_phase<EpiFftA, pg8::StaticOrder, true, true>(lds, g, S, E); }
            __syncthreads();
            if (EN(15)) for (int k = bid; k < 256; k += G) {
                LAS float* tab = (LAS float*)lds; if (tid < 256) tab[tid] = cospif((float)tid * (1.f / 128.f)) * 0.0625f; __syncthreads();
                const int g = tid >> 7, j = tid & 127; float a = 0.f; const float* wp = CTXW + g * 256 + j;
                for (int n0 = 0; n0 < 256; n0 += 16) { float xr[16], xi[16];
#pragma unroll
                    for (int j = 0; j < 16; ++j) { xr[j] = wp[(size_t)(n0 + j) * 1024]; xi[j] = wp[(size_t)(n0 + j) * 1024 + 128]; }
#pragma unroll
                    for (int j = 0; j < 16; ++j) { const int mm = (k * (n0 + j)) & 255; a += tab[mm] * xr[j] + tab[(mm + 192) & 255] * xi[j]; } }
                MIX[(size_t)k * DM + 1536 + tid] = f2bf(a); __syncthreads(); }
            }
        } else if (EN(4) && sub == 2) {
            for (int rep_ = 0; rep_ < DUP_ATTN; ++rep_)
            if (EN(16)) for (int un = bid; un < 520; un += G) { const int hh = un < 512 ? (un & 7) : (un - 512), qb = un < 512 ? 1 + (un >> 3) : 0;
                attn_unit_da(QDA + hh * 64, KDA + hh * 64, VTDA + (size_t)(hh >> 1) * 128 * T, DAO + hh * 128, qb * 256, qb == 0 ? NCTX : T, lds); }
            for (int rs_ = 0; rs_ < DUP_S2; ++rs_) {
            if (EN(17)) { pg8::Gemm g{XC, WLRU, 4 * T, 2048, 128}; LruOrder S{G, bid}; EpiLru E{AU, XC, PIN(I_LBR) + (size_t)l * 1024, PIN(I_LBI) + (size_t)l * 1024, C8T + (size_t)l * 1024};
              pg8::gemm_phase<EpiLru, LruOrder, true, true>(lds, g, S, E); }
            if (EN(18)) { pg8::Gemm g{FT, F2T, 65536, 256, 256}; FftCOrder S{G, bid}; EpiFftC E{MIX}; pg8::gemm_phase<EpiFftC, FftCOrder, true, true>(lds, g, S, E); }
            }
        } else if (EN(5) && sub == 3) {
            for (int rep_ = 0; rep_ < DUP_ATTN; ++rep_)
            for (int un = bid; un < 260; un += G) { const int h = un < 256 ? (un & 3) : (un - 256), qb = un < 256 ? 1 + (un >> 2) : 0;
                attn_unit<192>(QMLA + h * 192, 768, KMLA + h * 192, 768, VTMLA + (size_t)h * 128 * T, MIX + 1024 + h * 128, DM, qb * 256, qb == 0 ? NCTX : T, lds); }
            for (int rs_ = 0; rs_ < DUP_S3; ++rs_)
            for (int un = bid; un < 512; un += G) { const int d = un >> 8, c = un & 255; const int cs = chunk_start(c), len = chunk_start(c + 1) - cs;
                const unsigned* au = AU + (size_t)d * T * 512 + tid; float h = 0.f, S = 0.f;
                for (int i0 = 0; i0 < len; i0 += 16) { unsigned w[16];
#pragma unroll
                    for (int j = 0; j < 16; ++j) { const int i = i0 + j < len ? i0 + j : len - 1; const int row = d == 0 ? cs + i : cs + len - 1 - i; w[j] = au[(size_t)row * 512]; }
#pragma unroll
                    for (int j = 0; j < 16; ++j) if (i0 + j < len) { const float l2a = bf2f(w[j] >> 16), uu = bf2f(w[j] & 0xffffu); h = ex2(l2a) * h + uu; S += l2a; } }
                SUMM[((size_t)(d * 256 + c) * 512 + tid) * 2] = S; SUMM[((size_t)(d * 256 + c) * 512 + tid) * 2 + 1] = h; }
        } else if (EN(6) && sub == 4) {
            for (int rs_ = 0; rs_ < DUP_S4; ++rs_) {
            __syncthreads();
            for (int c = bid; c < 256; c += G) { LAS float* hfs = (LAS float*)lds; const f32x2_t* S0 = (const f32x2_t*)SUMM + tid; const f32x2_t* S1 = S0 + (size_t)256 * 512;
                const int cs = chunk_start(c), len = chunk_start(c + 1) - cs;
                float hf = 0.f, hb = 0.f;
                for (int p0 = 0; p0 < c; p0 += 16) { f32x2_t sv[16];
#pragma unroll
                    for (int j = 0; j < 16; ++j) { const int k = p0 + j < c ? p0 + j : c - 1; sv[j] = S0[(size_t)k * 512]; }
#pragma unroll
                    for (int j = 0; j < 16; ++j) if (p0 + j < c) hf = ex2(sv[j][0]) * hf + sv[j][1]; }
                const int np = c < 4 ? 3 - c : 4 + 255 - c;
                for (int p0 = 0; p0 < np; p0 += 16) { f32x2_t sv[16];
#pragma unroll
                    for (int j = 0; j < 16; ++j) { const int p = p0 + j < np ? p0 + j : np - 1; const int k = p < 4 ? 3 - p : 259 - p; sv[j] = S1[(size_t)k * 512]; }
#pragma unroll
                    for (int j = 0; j < 16; ++j) if (p0 + j < np) hb = ex2(sv[j][0]) * hb + sv[j][1]; }
                const unsigned* a0 = AU + tid; const unsigned* a1 = AU + (size_t)T * 512 + tid;
                for (int i0 = 0; i0 < len; i0 += 16) { unsigned w[16];
#pragma unroll
                    for (int j = 0; j < 16; ++j) { const int i = i0 + j < len ? i0 + j : len - 1; w[j] = a0[(size_t)(cs + i) * 512]; }
#pragma unroll
                    for (int j = 0; j < 16; ++j) if (i0 + j < len) { hf = ex2(bf2f(w[j] >> 16)) * hf + bf2f(w[j] & 0xffffu); hfs[(i0 + j) * 512 + tid] = hf; } }
                for (int i0 = 0; i0 < len; i0 += 16) { unsigned w[16]; bf16_t gg[16];
#pragma unroll
                    for (int j = 0; j < 16; ++j) { const int i = i0 + j < len ? i0 + j : len - 1; const int row = cs + len - 1 - i; w[j] = a1[(size_t)row * 512]; gg[j] = LRUG[(size_t)row * 512 + tid]; }
#pragma unroll
                    for (int j = 0; j < 16; ++j) if (i0 + j < len) { const int ii = len - 1 - (i0 + j); hb = ex2(bf2f(w[j] >> 16)) * hb + bf2f(w[j] & 0xffffu);
                        MIX[(size_t)(cs + ii) * DM + 512 + tid] = f2bf((hfs[ii * 512 + tid] + hb) * gelu_tanh(bf2f(gg[j]))); } } }
            { const float linit = l == 0 ? 0.2f : 0.35550906759096926f;
              const float e1 = __expf(wave_sum(PIN(I_LQ1)[l * 64 + lane] * PIN(I_LK1)[l * 64 + lane])), e2 = __expf(wave_sum(PIN(I_LQ2)[l * 64 + lane] * PIN(I_LK2)[l * 64 + lane])); const float lam = e1 - e2 + linit;
              const float g0 = PIN(I_SUBLN)[l * 128 + 2 * lane] * (1.f - linit), g1 = PIN(I_SUBLN)[l * 128 + 2 * lane + 1] * (1.f - linit);
              for (int row = gw; row < T; row += NGW) { unsigned w1[4], w2[4];
#pragma unroll
                  for (int h = 0; h < 4; ++h) { w1[h] = *(const unsigned*)(DAO + (size_t)row * 1024 + h * 256 + 2 * lane); w2[h] = *(const unsigned*)(DAO + (size_t)row * 1024 + h * 256 + 128 + 2 * lane); }
#pragma unroll
                  for (int h = 0; h < 4; ++h) { const float y0 = bf2f(w1[h] & 0xffffu) - lam * bf2f(w2[h] & 0xffffu), y1 = bf2f(w1[h] >> 16) - lam * bf2f(w2[h] >> 16); const float inv = rsqrtf(wave_sum(y0 * y0 + y1 * y1) * (1.f / 128.f) + 1e-6f);
                      *(unsigned*)(MIX + (size_t)row * DM + h * 128 + 2 * lane) = pk2(y0 * inv * g0, y1 * inv * g1); } } }
            }
        } else if (EN(7) && sub == 5) {
            pg8::Gemm g{MIX + (size_t)256 * DM, WOUT, T - 256, DM, DM}; pg8::StaticOrder S; S.init(T - 256, DM, G, bid);
            EpiRes E{l == 0 ? PIN(I_CTX) : XRES, l == 0 ? PIN(I_X) : XRES + (size_t)NCTX * DM, XRES, mods_c + 2 * DM, mods_l + 2 * DM, 1};
            pg8::gemm_phase<EpiRes, pg8::StaticOrder, true, true>(lds, g, S, E);
            if (l == 0) for (int kp = 0; kp < 4; ++kp) {
                pg8::Gemm gc{MIX + kp * 512, WOUT + kp * 512, 256, DM, 512, DM}; pg8::StaticOrder Sc; Sc.init(256, DM, G, (bid + G - 8 * kp) % G); EpiResAtomic Ec{XRES, mods_c + 2 * DM};
                pg8::gemm_phase<EpiResAtomic, pg8::StaticOrder, true, true>(lds, gc, Sc, Ec); }
        } else if (EN(8) && (sub == 6 || sub == 9)) {
            const bool second = sub == 9, fin = second && l == 1;
            const float* gam = PIN(second ? I_LN2G : I_LN1G) + (size_t)l * DM; const float* bet = PIN(second ? I_LN2B : I_LN1B) + (size_t)l * DM;
#define LN_LOAD(V, R) do { _Pragma("unroll") for (int j_ = 0; j_ < 8; ++j_) V[j_] = *(const f32x4*)(XRES + (size_t)(R) * DM + 4 * lane + 256 * j_); } while (0)
#define LN_ROW(V, R) do { const int row_ = (R); float* yr_ = XRES + (size_t)row_ * DM; float s_ = 0.f; \
                _Pragma("unroll") for (int j_ = 0; j_ < 8; ++j_) s_ += (V[j_][0] + V[j_][1]) + (V[j_][2] + V[j_][3]); \
                const float mean_ = wave_sum(s_) * (1.f / DM); float s2_ = 0.f; \
                _Pragma("unroll") for (int j_ = 0; j_ < 8; ++j_) { V[j_] = V[j_] - mean_; s2_ += (V[j_][0] * V[j_][0] + V[j_][1] * V[j_][1]) + (V[j_][2] * V[j_][2] + V[j_][3] * V[j_][3]); } \
                const float rstd_ = rsqrtf(wave_sum(s2_) * (1.f / DM) + 1e-5f); \
                const float* md_ = second ? MODS + (size_t)((l + 1) * 2 + (row_ < NCTX ? 0 : 1)) * 12288 : MODS + (size_t)(l * 2 + (row_ < NCTX ? 0 : 1)) * 12288 + 3 * DM; \
                float* dst_ = fin ? ((float*)(GAS float*)pp->out) + (size_t)(row_ - NCTX) * DM : yr_; \
                const float rs2_ = (!second && row_ < NCTX) ? ALPHA : 1.f; \
                _Pragma("unroll") for (int j_ = 0; j_ < 8; ++j_) { const int c_ = 4 * lane + 256 * j_; const f32x4 xn_ = V[j_] * rstd_ * *(const f32x4*)(gam + c_) + *(const f32x4*)(bet + c_); *(f32x4*)(dst_ + c_) = xn_ * rs2_; \
                    if (!fin) { const f32x4 sh_ = *(const f32x4*)(md_ + c_), sc_ = *(const f32x4*)(md_ + DM + c_); st4bf(XMOD + (size_t)row_ * DM + c_, xn_ * (sc_ + 1.f) + sh_); } } } while (0)
            { f32x4 va[8], vb[8]; int row = gw + l * NCTX;
#pragma unroll
              for (int j = 0; j < 8; ++j) { va[j] = (f32x4){0.f, 0.f, 0.f, 0.f}; vb[j] = va[j]; }
              if (row < T) LN_LOAD(va, row);
              for (; row < T; row += 2 * NGW) {
                  const bool hb = row + NGW < T;
                  if (hb) LN_LOAD(vb, row + NGW);
                  LN_ROW(va, row);
                  if (row + 2 * NGW < T) LN_LOAD(va, row + 2 * NGW);
                  if (hb) LN_ROW(vb, row + NGW);
              } }
#undef LN_LOAD
#undef LN_ROW
        } else if (EN(9) && sub == 7) {
            pg8::Gemm g{XMOD + (size_t)l * 256 * DM, WGU, T - l * 256, 2 * DFF, DM}; pg8::StaticOrder S; S.init(T - l * 256, 2 * DFF, G, bid); EpiGU E{HB, l};
            for (int rg_ = 0; rg_ < DUP_GEMM; ++rg_) pg8::gemm_phase<EpiGU, pg8::StaticOrder, true, true>(lds, g, S, E);
        } else if (EN(10) && sub == 8) {
            pg8::Gemm g{HB + (size_t)256 * DFF, WD, T - 256, DM, DFF}; pg8::StaticOrder S; S.init(T - 256, DM, G, bid);
            EpiRes E{XRES, XRES + (size_t)NCTX * DM, XRES, mods_c + 5 * DM, mods_l + 5 * DM, 1};
            pg8::gemm_phase<EpiRes, pg8::StaticOrder, true, true>(lds, g, S, E);
            if (l == 0) for (int kp = 0; kp < 4; ++kp) {
                pg8::Gemm gc{HB + kp * 1408, WD + kp * 1408, 256, DM, 1408, DFF}; pg8::StaticOrder Sc; Sc.init(256, DM, G, (bid + G - 8 * kp) % G); EpiResAtomic Ec{XRES, mods_c + 5 * DM};
                pg8::gemm_phase<EpiResAtomic, pg8::StaticOrder, true, true>(lds, gc, Sc, Ec); }
        }
        if (ph + 1 < P.ph_hi) { if (ph == 0) grid.sync(); else xcd_barrier(xbar); }
    }
}

template <unsigned MASK> static void launch_one(int grid, Params p, hipStream_t stream, bool coop) {
    static bool attr_set = false;
    if (!attr_set) { (void)hipFuncSetAttribute((const void*)mega_fwd<MASK>, hipFuncAttributeMaxDynamicSharedMemorySize, LDS_BYTES); attr_set = true; }
    if (coop) { void* args[] = {&p}; hipError_t e = hipLaunchCooperativeKernel((const void*)mega_fwd<MASK>, dim3(grid), dim3(NTHR), args, LDS_BYTES, stream);
        if (e != hipSuccess) fprintf(stderr, "cooperative launch failed: %s (grid %d)\n", hipGetErrorString(e), grid); }
    else hipLaunchKernelGGL(mega_fwd<MASK>, dim3(grid), dim3(NTHR), LDS_BYTES, stream, p);
}
extern "C" void kernel_launch(void* const* d_in, const int* in_sizes, int n_in, void* d_out, int out_size, void* d_ws, size_t ws_size, hipStream_t stream) {
    static int grid = 0;
    if (grid == 0) {
        if (n_in != 31 || ws_size < WS_NEED) { fprintf(stderr, "kernel_launch: need 31 inputs and %zu bytes of workspace; got %d, %zu\n", (size_t)WS_NEED, n_in, ws_size); grid = -1; return; }
        int dev = 0, cus = 0;
        (void)hipGetDevice(&dev); (void)hipDeviceGetAttribute(&cus, hipDeviceAttributeMultiprocessorCount, dev);
        grid = cus;
#if !MK_MULTI
        int per_cu = 0;
        (void)hipFuncSetAttribute((const void*)mega_fwd<PH_MASK>, hipFuncAttributeMaxDynamicSharedMemorySize, LDS_BYTES);
        (void)hipOccupancyMaxActiveBlocksPerMultiprocessor(&per_cu, (const void*)mega_fwd<PH_MASK>, NTHR, LDS_BYTES);
        if (per_cu < 1) fprintf(stderr, "kernel_launch: occupancy query returned %d\n", per_cu);
        (void)hipGetLastError();
#endif
    }
    if (grid < 0) return;
    Params p{};
    for (int i = 0; i < 31; ++i) p.in[i] = (const float*)d_in[i];
    p.out = (float*)d_out; p.ws = (unsigned char*)d_ws;
#if MK_MULTI
#define L1(ph, mask) do { p.ph_lo = (ph); p.ph_hi = (ph) + 1; launch_one<(mask)>(grid, p, stream, false); } while (0)
    L1(0, 1u); L1(1, 2u);
    for (int l = 0; l < 2; ++l) { const int b = 2 + 10 * l;
        L1(b + 0, 1u << 2); L1(b + 1, (1u << 3) | (1u << 11) | (1u << 12) | (1u << 13)); L1(b + 1, (1u << 3) | (1u << 14) | (1u << 15));
        L1(b + 2, (1u << 4) | (1u << 16)); L1(b + 2, (1u << 4) | (1u << 17)); L1(b + 2, (1u << 4) | (1u << 18));
        L1(b + 3, 1u << 5); L1(b + 4, 1u << 6); L1(b + 5, 1u << 7); L1(b + 6, 1u << 8); L1(b + 7, 1u << 9); L1(b + 8, 1u << 10); L1(b + 9, 1u << 8); }
#else
    p.ph_lo = 0; p.ph_hi = N_PHASES;
    (void)hipMemsetAsync((unsigned char*)d_ws + O_BAR, 0, 16384, stream);
    launch_one<PH_MASK>(grid, p, stream, true);
#endif
}
```

```cpp
#include <hip/hip_runtime.h>
#include <hip/hip_cooperative_groups.h>
#include <cstdio>
#include <cstdint>
namespace cg = cooperative_groups;
#ifndef PH_MASK
#define PH_MASK 0xfffff
#endif
#define EN(k) (((MASK) >> (k)) & 1u)
#ifndef DUP_ATTN
#define DUP_ATTN 1
#endif
#ifndef DUP_S1
#define DUP_S1 1
#endif
#ifndef DUP_S2
#define DUP_S2 1
#endif
#ifndef DUP_S3
#define DUP_S3 1
#endif
#ifndef DUP_S4
#define DUP_S4 1
#endif
#ifndef DUP_GEMM
#define DUP_GEMM 1
#endif
#ifndef DUP_P0
#define DUP_P0 1
#endif
#ifndef MK_MULTI
#define MK_MULTI 0
#endif
namespace pg8 {
#define PG8_LAS __attribute__((address_space(3)))
typedef unsigned short bf16_t;
typedef short bf16x8 __attribute__((ext_vector_type(8)));
typedef float f32x4 __attribute__((ext_vector_type(4)));
typedef unsigned u32x4 __attribute__((ext_vector_type(4)));
constexpr int BM = 256, BK = 64, HALF = 128, HTB = HALF * BK * 2  , STAGE_BYTES = 8 * HTB, NXCD = 8, WGM = 8;

__host__ __device__ __forceinline__ int lds_byte(int r, int c) { const int st = (r >> 4) * 2 + (c >> 5), rr = r & 15, cc = c & 31, ob = rr * 64 + cc * 2; return st * 1024 + (ob ^ (((ob >> 9) & 1) << 5)); }
__host__ __device__ __forceinline__ void stage_rc(int b, int& R, int& C) { const int st = b / 1024, sb = b % 1024, swz = sb ^ (((sb >> 9) & 1) << 5); R = (st >> 1) * 16 + swz / 64; C = (st & 1) * 32 + (swz % 64) / 2; }
__host__ __device__ __forceinline__ int perm32(int rho) { const int n = rho >> 4, i = rho & 15; return 8 * (i >> 2) + 4 * n + (i & 3); }

struct Unit { int pm, pn; };
struct Gemm { const bf16_t* A; const bf16_t* Bt; int M, N, K; int ld; };

struct StaticOrder {
    int nM, nN, nwg, G, c;
    __host__ __device__ void init(int M, int N, int G_, int c_) { nM = M / BM; nN = N / BM; nwg = nM * nN; G = G_; c = c_; }
    __host__ __device__ bool next(int i, Unit& u) const {
        const long L = (long)i * G + c; if (L >= nwg) return false;
        int wgid = (int)L; { const int q = nwg / NXCD, r = nwg % NXCD, xcd = wgid % NXCD, off = wgid / NXCD; wgid = (xcd < r ? xcd * (q + 1) : r * (q + 1) + (xcd - r) * q) + off; }
        const int nig = WGM * nN, gid = wgid / nig, fm = gid * WGM, gsz = (nM - fm) < WGM ? (nM - fm) : WGM;
        u.pm = fm + ((wgid % nig) % gsz); u.pn = (wgid % nig) / gsz; return true;
    }
    __device__ __forceinline__ void a_ready(const Unit&) const {}
    __device__ __forceinline__ void done(const Unit&) const {}
};

template <class Epi, class Sched, bool ALIGN_EPI = false, bool SP2 = false>
__device__ __forceinline__ void gemm_phase(PG8_LAS unsigned char* lds, const Gemm g, const Sched& S, const Epi& E) {
    int tid_ = threadIdx.x; asm volatile("" : "+v"(tid_));
    const int tid = tid_, wid = __builtin_amdgcn_readfirstlane(tid >> 6), lane = tid & 63, wr = wid >> 2, wc = wid & 3, fr = lane & 15, fq = lane >> 4;
    int K_ = g.K; asm volatile("" : "+s"(K_));
    const int K = K_, nt = K / BK; int LD_ = g.ld ? g.ld : g.K; asm volatile("" : "+s"(LD_)); const int LD = LD_;
    unsigned voffA[2], voffB[2];
#pragma unroll
    for (int i = 0; i < 2; ++i) { int R, C; stage_rc(tid * 16 + i * 8192, R, C); const int Rb = Epi::PERM ? ((R & ~31) + perm32(R & 31)) : R;
        voffA[i] = (unsigned)(R * LD + C) * 2u; voffB[i] = (unsigned)(Rb * LD + C) * 2u; }
    const size_t kstep = (size_t)(BK * 2);
    const size_t hstep = (size_t)HALF * LD * 2;
    const size_t tstep = 2 * hstep;
    const unsigned ldsw = (unsigned)wid * 1024u;
    const int aoff = lds_byte(wr * 64 + fr, fq * 8), boff = lds_byte(wc * 32 + fr, fq * 8);
#define PG8_SA(b, h) (((b) * 2 + (h)) * HTB)
#define PG8_SB(b, h) ((4 + (b) * 2 + (h)) * HTB)
#define PG8_STAGE(bufoff, gbase, voff) do { _Pragma("unroll") for (int _i = 0; _i < 2; ++_i) \
        __builtin_amdgcn_global_load_lds((const unsigned*)((const char*)(gbase) + (voff)[_i]), (PG8_LAS unsigned*)(lds + (bufoff) + ldsw + _i * 8192), 16, 0, 0); } while (0)
#define PG8_LDA(dst, b, h) do { _Pragma("unroll") for (int m = 0; m < 4; ++m) _Pragma("unroll") for (int k = 0; k < 2; ++k) dst[m][k] = *(const PG8_LAS bf16x8*)(lds + PG8_SA(b, h) + aoff + m * 2048 + k * 1024); } while (0)
#define PG8_LDB(dst, b, h) do { _Pragma("unroll") for (int n = 0; n < 2; ++n) _Pragma("unroll") for (int k = 0; k < 2; ++k) dst[n][k] = *(const PG8_LAS bf16x8*)(lds + PG8_SB(b, h) + boff + n * 2048 + k * 1024); } while (0)
#define PG8_MMA(ai, bj, At, Bt) do { __builtin_amdgcn_s_setprio(1); _Pragma("unroll") for (int m = 0; m < 4; ++m) _Pragma("unroll") for (int n = 0; n < 2; ++n) _Pragma("unroll") for (int k = 0; k < 2; ++k) \
        acc[ai][bj][m][n] = __builtin_amdgcn_mfma_f32_16x16x32_bf16(Bt[n][k], At[m][k], acc[ai][bj][m][n], 0, 0, 0); __builtin_amdgcn_s_setprio(0); } while (0)
#define PG8_WAIT_V(n) asm volatile("s_waitcnt vmcnt(" #n ")" ::: "memory")
#define PG8_WAIT_L(n) asm volatile("s_waitcnt lgkmcnt(" #n ")" ::: "memory")
#define PG8_BAR __builtin_amdgcn_s_barrier()
#define PG8_SCHED __builtin_amdgcn_sched_barrier(0)
    Unit cur, nxt; int ui = 0;
    if (!S.next(0, cur)) return;
    f32x4 acc[2][2][4][2];
#pragma unroll
    for (int a = 0; a < 2; ++a)
#pragma unroll
        for (int b = 0; b < 2; ++b)
#pragma unroll
            for (int m = 0; m < 4; ++m)
#pragma unroll
                for (int n = 0; n < 2; ++n) acc[a][b][m][n] = (f32x4){0.f, 0.f, 0.f, 0.f};
    bf16x8 At[4][2], B0[2][2], B1[2][2];
    const char* cA = (const char*)g.A + (size_t)cur.pm * tstep; const char* cB = (const char*)g.Bt + (size_t)cur.pn * tstep;
    S.a_ready(cur);
    if constexpr (SP2) {
        PG8_STAGE(PG8_SB(0, 0), cB, voffB); PG8_STAGE(PG8_SB(0, 1), cB + hstep, voffB); PG8_STAGE(PG8_SA(0, 0), cA, voffA); PG8_STAGE(PG8_SA(0, 1), cA + hstep, voffA);
        if (wr == 1) PG8_BAR;
        PG8_WAIT_V(2); PG8_BAR;
        PG8_STAGE(PG8_SB(1, 0), cB + kstep, voffB); PG8_STAGE(PG8_SA(1, 0), cA + kstep, voffA); PG8_STAGE(PG8_SB(1, 1), cB + hstep + kstep, voffB);
        PG8_WAIT_V(6); PG8_BAR;
    } else {
        PG8_STAGE(PG8_SB(0, 0), cB, voffB); PG8_STAGE(PG8_SA(0, 0), cA, voffA); PG8_STAGE(PG8_SB(0, 1), cB + hstep, voffB); PG8_STAGE(PG8_SA(0, 1), cA + hstep, voffA);
        if (wr == 1) PG8_BAR;
        PG8_WAIT_V(4); PG8_BAR;
        PG8_STAGE(PG8_SB(1, 0), cB + kstep, voffB); PG8_STAGE(PG8_SA(1, 0), cA + kstep, voffA); PG8_STAGE(PG8_SB(1, 1), cB + hstep + kstep, voffB);
        PG8_WAIT_V(6); PG8_BAR;
    }
    for (;;) {
        const bool has_next = S.next(ui + 1, nxt);
        const char* nA = has_next ? (const char*)g.A + (size_t)nxt.pm * tstep : cA; const char* nB = has_next ? (const char*)g.Bt + (size_t)nxt.pn * tstep : cB;
        for (int t = 0; t < nt; t += 2) {
            const bool last = (t == nt - 2);
            const char* a1 = cA + (size_t)(t + 1) * kstep;
            const char* a2 = last ? nA : cA + (size_t)(t + 2) * kstep; const char* b2 = last ? nB : cB + (size_t)(t + 2) * kstep;
            const char* a3 = a2 + kstep; const char* b3 = b2 + kstep;
            if (last && has_next) S.a_ready(nxt);
            if constexpr (SP2) {
            PG8_LDB(B0, 0, 0); PG8_LDB(B1, 0, 1); PG8_SCHED; PG8_LDA(At, 0, 0); PG8_STAGE(PG8_SA(1, 1), a1 + hstep, voffA);
            PG8_WAIT_V(8); PG8_WAIT_L(0); PG8_BAR; PG8_MMA(0, 0, At, B0); PG8_MMA(0, 1, At, B1); PG8_BAR; PG8_SCHED;
            PG8_LDA(At, 0, 1); PG8_STAGE(PG8_SB(0, 0), b2, voffB); PG8_STAGE(PG8_SB(0, 1), b2 + hstep, voffB); PG8_STAGE(PG8_SA(0, 0), a2, voffA);
            PG8_WAIT_V(8); PG8_WAIT_L(0); PG8_BAR; PG8_MMA(1, 0, At, B0); PG8_MMA(1, 1, At, B1); PG8_BAR; PG8_SCHED;
            PG8_LDB(B0, 1, 0); PG8_LDB(B1, 1, 1); PG8_SCHED; PG8_LDA(At, 1, 0); PG8_STAGE(PG8_SA(0, 1), a2 + hstep, voffA);
            PG8_WAIT_V(8); PG8_WAIT_L(0); PG8_BAR; PG8_MMA(0, 0, At, B0); PG8_MMA(0, 1, At, B1); PG8_BAR; PG8_SCHED;
            PG8_LDA(At, 1, 1); PG8_STAGE(PG8_SB(1, 0), b3, voffB); PG8_STAGE(PG8_SB(1, 1), b3 + hstep, voffB); PG8_STAGE(PG8_SA(1, 0), a3, voffA);
            PG8_WAIT_V(8); PG8_WAIT_L(0); PG8_BAR; PG8_MMA(1, 0, At, B0); PG8_MMA(1, 1, At, B1); PG8_BAR; PG8_SCHED;
            } else {
            PG8_LDB(B0, 0, 0); PG8_SCHED; PG8_LDA(At, 0, 0); PG8_STAGE(PG8_SA(1, 1), a1 + hstep, voffA);
            PG8_WAIT_L(8); PG8_BAR; PG8_WAIT_L(0); PG8_MMA(0, 0, At, B0); PG8_BAR; PG8_SCHED;
            PG8_LDB(B1, 0, 1); PG8_STAGE(PG8_SB(0, 0), b2, voffB);
            PG8_BAR; PG8_WAIT_L(0); PG8_MMA(0, 1, At, B1); PG8_BAR;
            PG8_LDA(At, 0, 1); PG8_STAGE(PG8_SA(0, 0), a2, voffA);
            PG8_BAR; PG8_WAIT_L(0); PG8_MMA(1, 0, At, B0); PG8_BAR; PG8_SCHED;
            PG8_STAGE(PG8_SB(0, 1), b2 + hstep, voffB);
            PG8_WAIT_V(6); PG8_BAR; PG8_MMA(1, 1, At, B1); PG8_BAR;
            PG8_LDB(B0, 1, 0); PG8_SCHED; PG8_LDA(At, 1, 0); PG8_STAGE(PG8_SA(0, 1), a2 + hstep, voffA);
            PG8_WAIT_L(8); PG8_BAR; PG8_WAIT_L(0); PG8_MMA(0, 0, At, B0); PG8_BAR; PG8_SCHED;
            PG8_LDB(B1, 1, 1); PG8_STAGE(PG8_SB(1, 0), b3, voffB);
            PG8_BAR; PG8_WAIT_L(0); PG8_MMA(0, 1, At, B1); PG8_BAR;
            PG8_LDA(At, 1, 1); PG8_STAGE(PG8_SA(1, 0), a3, voffA);
            PG8_BAR; PG8_WAIT_L(0); PG8_MMA(1, 0, At, B0); PG8_BAR; PG8_SCHED;
            PG8_STAGE(PG8_SB(1, 1), b3 + hstep, voffB);
            PG8_WAIT_V(6); PG8_BAR; PG8_MMA(1, 1, At, B1); PG8_BAR;
            }
        }
        if constexpr (ALIGN_EPI) { if (wr == 0) PG8_BAR; }
        if constexpr (!Epi::AFTER_DRAIN) { E(acc, cur, wr, wc, fr, fq); S.done(cur); }
        if (!has_next) break;
#pragma unroll
        for (int a = 0; a < 2; ++a)
#pragma unroll
            for (int b = 0; b < 2; ++b)
#pragma unroll
                for (int m = 0; m < 4; ++m)
#pragma unroll
                    for (int n = 0; n < 2; ++n) acc[a][b][m][n] = (f32x4){0.f, 0.f, 0.f, 0.f};
        cur = nxt; cA = nA; cB = nB; ++ui;
        if constexpr (ALIGN_EPI) { if (wr == 1) PG8_BAR; }
    }
    PG8_WAIT_V(0);
    if constexpr (!ALIGN_EPI) { if (wr == 0) PG8_BAR; }
    PG8_BAR;
    if constexpr (Epi::AFTER_DRAIN) { E.fused(acc, cur, wr, wc, fr, fq, lds, wid, lane); S.done(cur); }
#undef PG8_SA
#undef PG8_SB
#undef PG8_STAGE
#undef PG8_LDA
#undef PG8_LDB
#undef PG8_MMA
#undef PG8_WAIT_V
#undef PG8_WAIT_L
#undef PG8_BAR
#undef PG8_SCHED
}
}

using pg8::bf16_t; using pg8::bf16x8; using pg8::f32x4; using pg8::u32x4;
typedef float f32x16 __attribute__((ext_vector_type(16)));
typedef unsigned u32x2 __attribute__((ext_vector_type(2)));
typedef float f32x2_t __attribute__((ext_vector_type(2)));
typedef __bf16 bf16x2_t __attribute__((ext_vector_type(2)));
#define LAS __attribute__((address_space(3)))

constexpr int T = 16640, NCTX = 256, DM = 2048, DFF = 5632, NIN = 4352, INW = 3776;
constexpr int NTHR = 512, NWV = 8;
constexpr float ALPHA = 1.4142135623730951f;
constexpr float LOG2E = 1.4426950408889634f;
constexpr float QS_DA = 0.125f * 1.4426950408889634f;
constexpr float QS_MLA = (float)(0.07216878364870323 * 1.4426950408889634);
constexpr float RSQ128 = 0.08838834764831845f;
constexpr int LDS_BYTES = 147456;

__device__ __forceinline__ unsigned pk2(float lo, float hi) { f32x2_t v = {lo, hi}; bf16x2_t b = __builtin_convertvector(v, bf16x2_t); return __builtin_bit_cast(unsigned, b); }
__device__ __forceinline__ bf16_t f2bf(float f) { return (bf16_t)(pk2(f, 0.f) & 0xffffu); }
__device__ __forceinline__ float bf2f(unsigned b) { return __uint_as_float(b << 16); }
__device__ __forceinline__ float ex2(float x) { return __builtin_amdgcn_exp2f(x); }
__device__ __forceinline__ int swap45(int o) { return (o & ~0x30) | ((o & 0x20) >> 1) | ((o & 0x10) << 1); }
__device__ __forceinline__ int swap23(int o) { return (o & ~0xC) | ((o & 0x4) << 1) | ((o & 0x8) >> 1); }
__device__ __forceinline__ float wave_sum(float v) {
#pragma unroll
    for (int o = 1; o < 64; o <<= 1) v += __shfl_xor(v, o);
    return v;
}
__device__ __forceinline__ float siluf(float x) { return x / (1.f + __expf(-x)); }
__device__ __forceinline__ float sigmf(float x) { return 1.f / (1.f + __expf(-x)); }
__device__ __forceinline__ float gelu_tanh(float x) { const float t = tanhf(0.7978845608028654f * (x + 0.044715f * x * x * x)); return 0.5f * x * (1.f + t); }

constexpr size_t al256(size_t x) { return (x + 255) & ~(size_t)255; }
constexpr size_t SZ_WIN = (size_t)NIN * DM * 2, SZ_WOUT = (size_t)DM * DM * 2, SZ_WGU = (size_t)2 * DFF * DM * 2, SZ_WD = (size_t)DM * DFF * 2;
constexpr size_t SZ_WUQ = (size_t)768 * 384 * 2, SZ_WUKV = (size_t)1024 * 256 * 2, SZ_WLRU = (size_t)8 * 256 * 128 * 2;
constexpr size_t O_WIN = 0, O_WOUT = O_WIN + SZ_WIN, O_WGU = O_WOUT + SZ_WOUT, O_WD = O_WGU + SZ_WGU, O_WUQ = O_WD + SZ_WD, O_WUKV = O_WUQ + SZ_WUQ, O_WLRU = O_WUKV + SZ_WUKV;
constexpr size_t SZ_WLAYER = O_WLRU + SZ_WLRU;
constexpr size_t O_F1T = 2 * SZ_WLAYER, O_F2T = O_F1T + 131072, O_ROPE = O_F2T + (size_t)128 * 131072, O_C8 = O_ROPE + 32768, O_MODS = O_C8 + 8192, O_BAR = al256(O_MODS + 2 * 2 * 12288 * 4), O_XMOD = al256(O_BAR + 16384);
constexpr size_t O_XRES = O_XMOD + (size_t)T * DM * 2, O_U = O_XRES + (size_t)T * DM * 4;
constexpr size_t O_QDA = O_U, O_KDA = O_QDA + (size_t)T * 512 * 2, O_VTDA = O_KDA + (size_t)T * 512 * 2, O_LRUX = O_VTDA + (size_t)T * 512 * 2, O_LRUG = O_LRUX + (size_t)T * 512 * 2;
constexpr size_t O_CQ = O_LRUG + (size_t)T * 512 * 2, O_CKV = O_CQ + (size_t)T * 384 * 2, O_PARTQ = O_CKV + (size_t)T * 256 * 2, O_PARTKV = O_PARTQ + (size_t)T * 8 * 4;
constexpr size_t O_QMLA = O_PARTKV + (size_t)T * 4 * 4, O_KMLA = O_QMLA + (size_t)T * 768 * 2, O_VTMLA = O_KMLA + (size_t)T * 768 * 2, O_FX = O_VTMLA + (size_t)T * 512 * 2;
constexpr size_t O_FT = O_FX + (size_t)65536 * 256 * 2, O_CTXW = O_FT + (size_t)65536 * 256 * 2, O_XC = O_CTXW + (size_t)256 * 1024 * 4, O_AU = O_XC + (size_t)4 * T * 128 * 2;
constexpr size_t O_SUMM = O_AU + (size_t)2 * T * 512 * 4, O_DAO = O_SUMM + (size_t)2 * 260 * 512 * 8, O_UEND = O_DAO + (size_t)T * 1024 * 2;
constexpr size_t O_H = O_U;
constexpr size_t WS_NEED = (O_UEND > O_H + (size_t)T * DFF * 2) ? O_UEND : (O_H + (size_t)T * DFF * 2);

struct Params { const float* in[31]; float* out; unsigned char* ws; int ph_lo, ph_hi; };
enum { I_X = 0, I_C, I_CTX, I_CCTX, I_WADA, I_BADA, I_WIN, I_WOUT, I_LN1G, I_LN1B, I_LN2G, I_LN2B, I_LQ1, I_LK1, I_LQ2, I_LK2, I_SUBLN, I_CONVW, I_CONVB, I_LWR, I_LBR, I_LWI, I_LBI, I_LLAM,
       I_QNG, I_WUQ, I_KVNG, I_WUKV, I_WG, I_WU, I_WD };

__device__ const float INVF[16] = {1.0f, 0.5623413324356079f, 0.3162277638912201f, 0.17782793939113617f, 0.10000000149011612f, 0.05623413249850273f, 0.03162277489900589f, 0.017782794311642647f,
                                   0.009999999776482582f, 0.005623413249850273f, 0.003162277629598975f, 0.0017782794311642647f, 0.0010000000474974513f, 0.000562341301701963f, 0.0003162277571391314f, 0.00017782794020604342f};

struct MapWin { const float* W; int stride;
    __device__ __forceinline__ const float* operator()(int d) const { const int tile = d >> 8, c = d & 255; int src;
        if (tile < 4) src = tile * 256 + swap45(c); else if (tile < 10) src = tile * 256 + c; else if (tile == 10) src = 2560 + c;
        else if (tile == 11) { if (c < 128) src = 2816 + c; else if (c < 192) src = 3200 + swap45(c - 128); else return nullptr; }
        else src = 2944 + c;
        return W + src; } };
struct MapPlain { const float* W; int stride; __device__ __forceinline__ const float* operator()(int d) const { return W + d; } };
struct MapGU { const float* Wg; const float* Wu; int stride;
    __device__ __forceinline__ const float* operator()(int d) const { const int tile = d >> 8, c = d & 255, n = (c >> 4) & 1, f = tile * 128 + 64 * (c >> 7) + 16 * ((c >> 5) & 3) + (c & 15); const long long dl = (const char*)Wu - (const char*)Wg; return (const float*)((const char*)Wg + (long long)n * dl) + f; } };
struct MapUq { const float* W; int stride;
    __device__ __forceinline__ const float* operator()(int d) const { if (d < 512) return W + (d >> 7) * 192 + (d & 127); const int c = d - 512; return W + (c >> 6) * 192 + 128 + swap45(c & 63); } };
struct MapUkv { const float* W; int stride;
    __device__ __forceinline__ const float* operator()(int d) const { if (d < 512) return W + (d >> 7) * 256 + (d & 127); const int e = d - 512; return W + (e >> 7) * 256 + 128 + (e & 127); } };
struct MapLru { const float* Wr; const float* Wi; int stride;
    __device__ __forceinline__ const float* operator()(int c) const { const int n = (c >> 4) & 1, j = 64 * (c >> 7) + 16 * ((c >> 5) & 3) + (c & 15); const long long dl = (const char*)Wi - (const char*)Wr; return (const float*)((const char*)Wr + (long long)n * dl) + j; } };

template <class Map>
__device__ __forceinline__ void tr_job(const Map mp, int Kd, int nrows, bf16_t* WT, const float* kscale, LAS float* scr, int gw, int NGW, int lane) {
    const int nblk = nrows / 32, items = (Kd / 64) * nblk, kr = lane >> 3, c4 = lane & 7;
    f32x4 cur[8], nxt[8];
#define TR_LOAD(dst, it_) do { const int kb_ = (it_) / nblk, nb_ = (it_) % nblk; const float* cp_ = mp(32 * nb_ + 4 * c4); const int st_ = mp.stride; \
        _Pragma("unroll") for (int i_ = 0; i_ < 8; ++i_) dst[i_] = cp_ ? *(const f32x4*)(cp_ + (size_t)(64 * kb_ + kr + 8 * i_) * st_) : (f32x4){0.f, 0.f, 0.f, 0.f}; } while (0)
    int it = gw;
    if (it < items) TR_LOAD(cur, it);
    for (; it < items; it += NGW) {
        const int kb = it / nblk, nb = it % nblk, k0 = 64 * kb, d0 = 32 * nb;
        if (it + NGW < items) TR_LOAD(nxt, it + NGW);
#pragma unroll
        for (int i = 0; i < 8; ++i) { const int kk = kr + 8 * i; f32x4 v = cur[i]; if (kscale) v = v * kscale[k0 + kk];
#pragma unroll
            for (int j = 0; j < 4; ++j) scr[kk * 33 + 4 * c4 + j] = v[j]; }
        asm volatile("s_waitcnt lgkmcnt(0)" ::: "memory");
        const int c = lane & 7;
#pragma unroll
        for (int j = 0; j < 4; ++j) { const int n = (lane >> 3) + 8 * j; const LAS float* sp = scr + (8 * c) * 33 + n;
            u32x4 o; o.x = pk2(sp[0 * 33], sp[1 * 33]); o.y = pk2(sp[2 * 33], sp[3 * 33]); o.z = pk2(sp[4 * 33], sp[5 * 33]); o.w = pk2(sp[6 * 33], sp[7 * 33]);
            *(u32x4*)(WT + (size_t)(d0 + n) * Kd + k0 + 8 * c) = o; }
        asm volatile("s_waitcnt lgkmcnt(0)" ::: "memory");
#pragma unroll
        for (int i = 0; i < 8; ++i) cur[i] = nxt[i];
    }
#undef TR_LOAD
}

#define EPI_ROWS_BEGIN _Pragma("unroll") for (int ai = 0; ai < 2; ++ai) _Pragma("unroll") for (int m = 0; m < 4; ++m) { const int row = u.pm * 256 + ai * 128 + wr * 64 + m * 16 + fr;
#define EPI_ROWS_END asm volatile("" ::: "memory"); __builtin_amdgcn_sched_barrier(0); }
__device__ __forceinline__ void st4bf(bf16_t* p, const f32x4 v) { u32x2 w; w.x = pk2(v[0], v[1]); w.y = pk2(v[2], v[3]); *(u32x2*)p = w; }

struct EpiInproj {
    static constexpr bool PERM = false, AFTER_DRAIN = false;
    bf16_t *QDA, *KDA, *VTDA, *LRUX, *LRUG, *CQ, *CKV, *KMLA, *FX; float *CTXW, *PARTQ, *PARTKV; const float* ROPE;
    __device__ __forceinline__ void rope_cs(int row, int wc, int fq, f32x4& c, f32x4& s) const {
        if (row < NCTX) { c = (f32x4){1.f, 1.f, 1.f, 1.f}; s = (f32x4){0.f, 0.f, 0.f, 0.f}; return; }
        const int nl = row - NCTX, pos = (wc & 1) ? (nl & 63) : (nl >> 6);
        const f32x4 a = *(const f32x4*)(ROPE + (pos * 16 + 4 * fq) * 2), b = *(const f32x4*)(ROPE + (pos * 16 + 4 * fq) * 2 + 4);
        c = (f32x4){a[0], a[2], b[0], b[2]}; s = (f32x4){a[1], a[3], b[1], b[3]};
    }
    __device__ __forceinline__ void operator()(const f32x4 (&acc)[2][2][4][2], const pg8::Unit& u, int wr, int wc, int fr, int fq) const {
        asm volatile("" : "+v"(fr), "+v"(fq));
        const int pn = u.pn;
        if (pn < 4) {
            bf16_t* dst = pn < 2 ? QDA : KDA; const float sc = pn < 2 ? QS_DA : 1.f; const int cb = (pn & 1) * 256 + 64 * (wc >> 1) + 16 * (wc & 1) + 4 * fq;
            EPI_ROWS_BEGIN  f32x4 c, s; rope_cs(row, wc, fq, c, s);
#pragma unroll
                for (int bj = 0; bj < 2; ++bj) { const f32x4 x1 = acc[ai][bj][m][0], x2 = acc[ai][bj][m][1];
                    st4bf(dst + (unsigned)row * 512 + cb + 128 * bj, (x1 * c - x2 * s) * sc); st4bf(dst + (unsigned)row * 512 + cb + 128 * bj + 32, (x1 * s + x2 * c) * sc); }  EPI_ROWS_END
        } else if (pn < 6) {
            EPI_ROWS_BEGIN
#pragma unroll
                for (int bj = 0; bj < 2; ++bj)
#pragma unroll
                    for (int n = 0; n < 2; ++n)
#pragma unroll
                        for (int j = 0; j < 4; ++j) VTDA[(unsigned)((pn - 4) * 256 + 128 * bj + 32 * wc + 16 * n + 4 * fq + j) * T + row] = f2bf(acc[ai][bj][m][n][j]);  EPI_ROWS_END
        } else if (pn < 10) {
            bf16_t* dst = pn < 8 ? LRUX : LRUG; const int cb = (pn & 1) * 256 + 32 * wc + 4 * fq;
            EPI_ROWS_BEGIN
#pragma unroll
                for (int bj = 0; bj < 2; ++bj)
#pragma unroll
                    for (int n = 0; n < 2; ++n) st4bf(dst + (unsigned)row * 512 + cb + 128 * bj + 16 * n, acc[ai][bj][m][n]);  EPI_ROWS_END
        } else if (pn == 10) {
            EPI_ROWS_BEGIN  float ss = 0.f;
#pragma unroll
                for (int bj = 0; bj < 2; ++bj)
#pragma unroll
                    for (int n = 0; n < 2; ++n) { const f32x4 v = acc[ai][bj][m][n]; st4bf(CQ + (unsigned)row * 384 + 128 * bj + 32 * wc + 16 * n + 4 * fq, v); ss += (v[0] * v[0] + v[1] * v[1]) + (v[2] * v[2] + v[3] * v[3]); }
                ss += __shfl_xor(ss, 16); ss += __shfl_xor(ss, 32); if (fq == 0) PARTQ[(unsigned)row * 8 + wc] = ss;  EPI_ROWS_END
        } else if (pn == 11) {
            EPI_ROWS_BEGIN  float ss = 0.f;
#pragma unroll
                for (int n = 0; n < 2; ++n) { const f32x4 v = acc[ai][0][m][n]; st4bf(CQ + (unsigned)row * 384 + 256 + 32 * wc + 16 * n + 4 * fq, v); ss += (v[0] * v[0] + v[1] * v[1]) + (v[2] * v[2] + v[3] * v[3]); }
                ss += __shfl_xor(ss, 16); ss += __shfl_xor(ss, 32); if (fq == 0) PARTQ[(unsigned)row * 8 + 4 + wc] = ss;
                if (wc < 2) { f32x4 c, s; rope_cs(row, wc, fq, c, s); const f32x4 x1 = acc[ai][1][m][0], x2 = acc[ai][1][m][1]; const f32x4 y1 = x1 * c - x2 * s, y2 = x1 * s + x2 * c;
#pragma unroll
                    for (int h = 0; h < 4; ++h) { bf16_t* kp = KMLA + (unsigned)row * 768 + h * 192 + 128 + 16 * (wc & 1) + 4 * fq; st4bf(kp, y1); st4bf(kp + 32, y2); } }  EPI_ROWS_END
        } else if (pn == 12) {
            EPI_ROWS_BEGIN  float ss = 0.f;
#pragma unroll
                for (int bj = 0; bj < 2; ++bj)
#pragma unroll
                    for (int n = 0; n < 2; ++n) { const f32x4 v = acc[ai][bj][m][n]; st4bf(CKV + (unsigned)row * 256 + 128 * bj + 32 * wc + 16 * n + 4 * fq, v); ss += (v[0] * v[0] + v[1] * v[1]) + (v[2] * v[2] + v[3] * v[3]); }
                ss += __shfl_xor(ss, 16); ss += __shfl_xor(ss, 32); if (fq == 0) PARTKV[(unsigned)row * 4 + wc] = ss;  EPI_ROWS_END
        } else {
            const int g = pn - 13;
            if (u.pm == 0) {
                EPI_ROWS_BEGIN
#pragma unroll
                    for (int bj = 0; bj < 2; ++bj)
#pragma unroll
                        for (int n = 0; n < 2; ++n) *(f32x4*)(CTXW + (unsigned)row * 1024 + g * 256 + 128 * bj + 32 * wc + 16 * n + 4 * fq) = acc[ai][bj][m][n];  EPI_ROWS_END
            } else {
                EPI_ROWS_BEGIN  const int nl = row - NCTX, n1 = nl >> 7, n2 = nl & 127;
#pragma unroll
                    for (int bj = 0; bj < 2; ++bj)
#pragma unroll
                        for (int n = 0; n < 2; ++n)
#pragma unroll
                            for (int j = 0; j < 4; ++j) FX[((unsigned)((n2 * 4 + g) * 128 + 32 * wc + 16 * n + 4 * fq + j)) * 256 + bj * 128 + n1] = f2bf(acc[ai][bj][m][n][j]);  EPI_ROWS_END
            }
        }
    }
};

struct EpiUpq {
    static constexpr bool PERM = false, AFTER_DRAIN = false;
    bf16_t* QMLA; const float* PARTQ; const float* ROPE;
    __device__ __forceinline__ void operator()(const f32x4 (&acc)[2][2][4][2], const pg8::Unit& u, int wr, int wc, int fr, int fq) const {
        asm volatile("" : "+v"(fr), "+v"(fq));
        const int pn = u.pn;
        EPI_ROWS_BEGIN  const f32x4 pa = *(const f32x4*)(PARTQ + (unsigned)row * 8), pb = *(const f32x4*)(PARTQ + (unsigned)row * 8 + 4);
            const float f = rsqrtf(((pa[0] + pa[1]) + (pa[2] + pa[3]) + (pb[0] + pb[1]) + (pb[2] + pb[3])) * (1.f / 384.f) + 1e-6f) * QS_MLA;
            if (pn < 2) {
#pragma unroll
                for (int bj = 0; bj < 2; ++bj)
#pragma unroll
                    for (int n = 0; n < 2; ++n) st4bf(QMLA + (unsigned)row * 768 + (2 * pn + bj) * 192 + 32 * wc + 16 * n + 4 * fq, acc[ai][bj][m][n] * f);
            } else {
                f32x4 c, s;
                if (row < NCTX) { c = (f32x4){1.f, 1.f, 1.f, 1.f}; s = (f32x4){0.f, 0.f, 0.f, 0.f}; }
                else { const int nl = row - NCTX, pos = (wc & 1) ? (nl & 63) : (nl >> 6);
                    const f32x4 a = *(const f32x4*)(ROPE + (pos * 16 + 4 * fq) * 2), b = *(const f32x4*)(ROPE + (pos * 16 + 4 * fq) * 2 + 4);
                    c = (f32x4){a[0], a[2], b[0], b[2]}; s = (f32x4){a[1], a[3], b[1], b[3]}; }
#pragma unroll
                for (int bj = 0; bj < 2; ++bj) { const f32x4 x1 = acc[ai][bj][m][0] * f, x2 = acc[ai][bj][m][1] * f; bf16_t* qp = QMLA + (unsigned)row * 768 + (2 * bj + (wc >> 1)) * 192 + 128 + 16 * (wc & 1) + 4 * fq;
                    st4bf(qp, x1 * c - x2 * s); st4bf(qp + 32, x1 * s + x2 * c); }
            }  EPI_ROWS_END
    }
};
struct EpiUpkv {
    static constexpr bool PERM = false, AFTER_DRAIN = false;
    bf16_t *KMLA, *VTMLA; const float* PARTKV;
    __device__ __forceinline__ void operator()(const f32x4 (&acc)[2][2][4][2], const pg8::Unit& u, int wr, int wc, int fr, int fq) const {
        asm volatile("" : "+v"(fr), "+v"(fq));
        const int pn = u.pn;
        EPI_ROWS_BEGIN  const f32x4 pa = *(const f32x4*)(PARTKV + (unsigned)row * 4);
            const float f = rsqrtf(((pa[0] + pa[1]) + (pa[2] + pa[3])) * (1.f / 256.f) + 1e-6f);
            if (pn < 2) {
#pragma unroll
                for (int bj = 0; bj < 2; ++bj)
#pragma unroll
                    for (int n = 0; n < 2; ++n) st4bf(KMLA + (unsigned)row * 768 + (2 * pn + bj) * 192 + 32 * wc + 16 * n + 4 * fq, acc[ai][bj][m][n] * f);
            } else {
#pragma unroll
                for (int bj = 0; bj < 2; ++bj)
#pragma unroll
                    for (int n = 0; n < 2; ++n)
#pragma unroll
                        for (int j = 0; j < 4; ++j) VTMLA[(unsigned)((pn - 2) * 256 + 128 * bj + 32 * wc + 16 * n + 4 * fq + j) * T + row] = f2bf(acc[ai][bj][m][n][j] * f);
            }  EPI_ROWS_END
    }
};
struct LruOrder {
    int G, c;
    __device__ bool next(int i, pg8::Unit& u) const { const long L = (long)i * G + c; if (L >= 520) return false; const int idx = (int)L, pmr = idx % 65, hd = idx / 65; u.pm = (hd >> 1) * 65 + pmr; u.pn = hd; return true; }
    __device__ __forceinline__ void a_ready(const pg8::Unit&) const {}
    __device__ __forceinline__ void done(const pg8::Unit&) const {}
};
__device__ __forceinline__ float neg_expm1(float x) {
    const float ser = -x * (1.f + x * (0.5f + x * (0.16666667f + x * 0.041666667f)));
    return x > -0.125f ? ser : 1.f - __expf(x);
}
struct EpiLru {
    static constexpr bool PERM = false, AFTER_DRAIN = false;
    unsigned* AU; const bf16_t* XC; const float *br, *bi, *c8;
    __device__ __forceinline__ void operator()(const f32x4 (&acc)[2][2][4][2], const pg8::Unit& u, int wr, int wc, int fr, int fq) const {
        asm volatile("" : "+v"(fr), "+v"(fq));
        const int h = u.pn >> 1, d = u.pn & 1, pmr = u.pm - h * 65;
#pragma unroll
        for (int bj = 0; bj < 2; ++bj) { const int chl = 64 * bj + 16 * wc + 4 * fq, ch = d * 512 + h * 128 + chl; const f32x4 vbr = *(const f32x4*)(br + ch), vbi = *(const f32x4*)(bi + ch), vc8 = *(const f32x4*)(c8 + ch);
#pragma unroll
            for (int ai = 0; ai < 2; ++ai)
#pragma unroll
                for (int m = 0; m < 4; ++m) { const int row = pmr * 256 + ai * 128 + wr * 64 + m * 16 + fr; const u32x2 xw = *(const u32x2*)(XC + ((unsigned)h * T + row) * 128 + chl); u32x4 o;
#pragma unroll
                    for (int j = 0; j < 4; ++j) { const float xv = bf2f(j & 1 ? (j < 2 ? xw.x : xw.y) >> 16 : (j < 2 ? xw.x : xw.y) & 0xffffu);
                        const float r = sigmf(acc[ai][bj][m][0][j] + vbr[j]), ig = sigmf(acc[ai][bj][m][1][j] + vbi[j]); const float la = vc8[j] * r;
                        const float uu = sqrtf(neg_expm1(2.f * la)) * (ig * xv); o[j] = pk2(uu, la * LOG2E); }
                    *(u32x4*)(AU + ((unsigned)d * T + row) * 512 + h * 128 + chl) = o; asm volatile("" ::: "memory"); __builtin_amdgcn_sched_barrier(0); } }
    }
};
struct EpiFftA {
    static constexpr bool PERM = false, AFTER_DRAIN = false;
    bf16_t* FT;
    __device__ __forceinline__ void operator()(const f32x4 (&acc)[2][2][4][2], const pg8::Unit& u, int wr, int wc, int fr, int fq) const {
        asm volatile("" : "+v"(fr), "+v"(fq));
        EPI_ROWS_BEGIN const int n2 = row >> 9, gj = row & 511; bf16_t* p0 = FT + ((unsigned)((16 * wc + 4 * fq) * 512 + gj)) * 256 + n2;
#pragma unroll
            for (int bj = 0; bj < 2; ++bj)
#pragma unroll
                for (int j = 0; j < 4; ++j) { bf16_t* p = p0 + (unsigned)(64 * bj + j) * 512 * 256; p[0] = f2bf(acc[ai][bj][m][0][j]); p[128] = f2bf(acc[ai][bj][m][1][j]); } EPI_ROWS_END
    }
};
struct FftCOrder {
    int G, c;
    __device__ bool next(int i, pg8::Unit& u) const { const long L = (long)i * G + c; if (L >= 256) return false; u.pm = (int)L; u.pn = (int)L >> 1; return true; }
    __device__ __forceinline__ void a_ready(const pg8::Unit&) const {}
    __device__ __forceinline__ void done(const pg8::Unit&) const {}
};
struct EpiFftC {
    static constexpr bool PERM = false, AFTER_DRAIN = false;
    bf16_t* MIX;
    __device__ __forceinline__ void operator()(const f32x4 (&acc)[2][2][4][2], const pg8::Unit& u, int wr, int wc, int fr, int fq) const {
        asm volatile("" : "+v"(fr), "+v"(fq));
        EPI_ROWS_BEGIN  const int k1 = row >> 9, gj = row & 511;
#pragma unroll
            for (int n = 0; n < 2; ++n)
#pragma unroll
                for (int j = 0; j < 4; ++j) { const int k2 = 32 * wc + 16 * n + 4 * fq + j; MIX[(unsigned)(NCTX + k1 + 128 * k2) * DM + 1536 + gj] = f2bf(acc[ai][0][m][n][j]); }  EPI_ROWS_END
    }
};
struct EpiRes {
    static constexpr bool PERM = false, AFTER_DRAIN = false;
    const float* xa; const float* xb; float* Y; const float* gate0; const float* gate1; int pm0;
    __device__ __forceinline__ void operator()(const f32x4 (&acc)[2][2][4][2], const pg8::Unit& u_, int wr, int wc, int fr, int fq) const {
        const pg8::Unit u{u_.pm + pm0, u_.pn};
        asm volatile("" : "+v"(fr), "+v"(fq));
        const float* gp = (u.pm == 0 ? gate0 : gate1) + u.pn * 256 + 32 * wc + 4 * fq;
        f32x4 gv[2][2];
#pragma unroll
        for (int bj = 0; bj < 2; ++bj)
#pragma unroll
            for (int n = 0; n < 2; ++n) gv[bj][n] = *(const f32x4*)(gp + 128 * bj + 16 * n);
        EPI_ROWS_BEGIN  const float* xo = (row < NCTX ? xa + (unsigned)row * DM : xb + (unsigned)(row - NCTX) * DM) + u.pn * 256 + 32 * wc + 4 * fq; float* yo = Y + (unsigned)row * DM + u.pn * 256 + 32 * wc + 4 * fq;
#pragma unroll
            for (int bj = 0; bj < 2; ++bj)
#pragma unroll
                for (int n = 0; n < 2; ++n) { const f32x4 xv = *(const f32x4*)(xo + 128 * bj + 16 * n); *(f32x4*)(yo + 128 * bj + 16 * n) = xv * ALPHA + gv[bj][n] * acc[ai][bj][m][n]; }  EPI_ROWS_END
    }
};
struct EpiResAtomic {
    static constexpr bool PERM = false, AFTER_DRAIN = false;
    float* Y; const float* gate;
    __device__ __forceinline__ void operator()(const f32x4 (&acc)[2][2][4][2], const pg8::Unit& u, int wr, int wc, int fr, int fq) const {
        asm volatile("" : "+v"(fr), "+v"(fq));
        const float* gp = gate + u.pn * 256 + 32 * wc + 4 * fq;
        EPI_ROWS_BEGIN float* yo = Y + (unsigned)row * DM + u.pn * 256 + 32 * wc + 4 * fq;
#pragma unroll
            for (int bj = 0; bj < 2; ++bj)
#pragma unroll
                for (int n = 0; n < 2; ++n) { const f32x4 gv = *(const f32x4*)(gp + 128 * bj + 16 * n);
#pragma unroll
                    for (int j = 0; j < 4; ++j) (void)unsafeAtomicAdd(yo + 128 * bj + 16 * n + j, gv[j] * acc[ai][bj][m][n][j]); } EPI_ROWS_END
    }
};
struct EpiGU {
    static constexpr bool PERM = false, AFTER_DRAIN = false;
    bf16_t* H; int pm0;
    __device__ __forceinline__ void operator()(const f32x4 (&acc)[2][2][4][2], const pg8::Unit& u_, int wr, int wc, int fr, int fq) const {
        const pg8::Unit u{u_.pm + pm0, u_.pn};
        asm volatile("" : "+v"(fr), "+v"(fq));
        EPI_ROWS_BEGIN
#pragma unroll
            for (int bj = 0; bj < 2; ++bj) { const f32x4 g = acc[ai][bj][m][0], v = acc[ai][bj][m][1]; f32x4 o;
#pragma unroll
                for (int j = 0; j < 4; ++j) o[j] = siluf(g[j]) * v[j];
                st4bf(H + (unsigned)row * DFF + u.pn * 128 + 64 * bj + 16 * wc + 4 * fq, o); }  EPI_ROWS_END
    }
};

template <int DQK>
__device__ __forceinline__ void attn_unit(const bf16_t* __restrict__ Q, int ldq, const bf16_t* __restrict__ K, int ldk, const bf16_t* __restrict__ Vt, bf16_t* O, int ldo, int q0, int nkeys, LAS unsigned char* lds) {
    constexpr int KS = DQK / 16, KROW = DQK + 8, KCH = DQK / 8, KLD = (64 * KCH) / NTHR, VROW = 72;
    LAS bf16_t* Ks = (LAS bf16_t*)lds; LAS bf16_t* Vs = (LAS bf16_t*)(lds + 2 * 64 * KROW * 2);
    int tid_ = threadIdx.x; asm volatile("" : "+v"(tid_));
    const int tid = tid_, lane = tid & 63, wid = tid >> 6, qi = lane & 31, hi = lane >> 5;
    bf16x8 qf[KS];
    { const bf16_t* qp = Q + (size_t)(q0 + wid * 32 + qi) * ldq + hi * 8;
#pragma unroll
      for (int ks = 0; ks < KS; ++ks) qf[ks] = *(const bf16x8*)(qp + ks * 16); }
    f32x16 o[4];
#pragma unroll
    for (int d0 = 0; d0 < 4; ++d0)
#pragma unroll
        for (int r = 0; r < 16; ++r) o[d0][r] = 0.f;
    float m_run = -1e30f, l_run = 0.f;
    const int NT = nkeys / 64;
    u32x4 kreg[KLD], vreg[2];
#define ATT_LOADK(t) do { _Pragma("unroll") for (int i_ = 0; i_ < KLD; ++i_) { const int c_ = tid + NTHR * i_, r_ = c_ / KCH, cc_ = c_ % KCH; kreg[i_] = *(const u32x4*)(K + (size_t)((t) * 64 + r_) * ldk + cc_ * 8); } } while (0)
#define ATT_LOADV(t) do { _Pragma("unroll") for (int i_ = 0; i_ < 2; ++i_) { const int c_ = tid + NTHR * i_, dv_ = c_ >> 3, k8_ = c_ & 7; vreg[i_] = *(const u32x4*)(Vt + (size_t)dv_ * T + (t) * 64 + k8_ * 8); } } while (0)
#define ATT_STOREK(b) do { _Pragma("unroll") for (int i_ = 0; i_ < KLD; ++i_) { const int c_ = tid + NTHR * i_, r_ = c_ / KCH, cc_ = c_ % KCH; *(LAS u32x4*)(Ks + (b) * 64 * KROW + r_ * KROW + cc_ * 8) = kreg[i_]; } } while (0)
#define ATT_STOREV(b) do { _Pragma("unroll") for (int i_ = 0; i_ < 2; ++i_) { const int c_ = tid + NTHR * i_, dv_ = c_ >> 3, k8_ = c_ & 7; *(LAS u32x4*)(Vs + (b) * 128 * VROW + dv_ * VROW + k8_ * 8) = vreg[i_]; } } while (0)
#define ATT_QK(S0, S1, b) do { const LAS bf16_t* kb_ = Ks + (b) * 64 * KROW + krow * KROW + hi * 8; \
        _Pragma("unroll") for (int r_ = 0; r_ < 16; ++r_) { S0[r_] = 0.f; S1[r_] = 0.f; } \
        _Pragma("unroll") for (int ks_ = 0; ks_ < KS; ++ks_) { const bf16x8 k0_ = *(const LAS bf16x8*)(kb_ + ks_ * 16), k1_ = *(const LAS bf16x8*)(kb_ + 32 * KROW + ks_ * 16); \
            S0 = __builtin_amdgcn_mfma_f32_32x32x16_bf16(k0_, qf[ks_], S0, 0, 0, 0); S1 = __builtin_amdgcn_mfma_f32_32x32x16_bf16(k1_, qf[ks_], S1, 0, 0, 0); } } while (0)
    const int krow = swap23(qi);
    ATT_LOADK(0); ATT_LOADV(0); ATT_STOREK(0); ATT_STOREV(0); ATT_LOADK(1); ATT_STOREK(1); __syncthreads();
    f32x16 s0, s1, n0, n1;
    ATT_QK(s0, s1, 0);
    for (int t = 0; t < NT; ++t) {
        const bool has1 = t + 1 < NT, has2 = t + 2 < NT;
        if (has2) ATT_LOADK(t + 2);
        if (has1) ATT_LOADV(t + 1);
        if (has1) ATT_QK(n0, n1, (t + 1) & 1);
        const LAS bf16_t* vb = Vs + (t & 1) * 128 * VROW + qi * VROW + hi * 8;
        float mx = fmaxf(s0[0], s1[0]);
#pragma unroll
        for (int r = 1; r < 16; ++r) mx = fmaxf(mx, fmaxf(s0[r], s1[r]));
        mx = fmaxf(mx, __shfl_xor(mx, 32));
        if (__any(mx > m_run + 8.f)) {
            const float m_new = fmaxf(m_run, mx), alpha = ex2(m_run - m_new); m_run = m_new; l_run *= alpha;
#pragma unroll
            for (int d0 = 0; d0 < 4; ++d0)
#pragma unroll
                for (int r = 0; r < 16; ++r) o[d0][r] *= alpha;
        }
        float ps = 0.f;
#pragma unroll
        for (int r = 0; r < 16; ++r) { s0[r] = ex2(s0[r] - m_run); s1[r] = ex2(s1[r] - m_run); ps += s0[r] + s1[r]; }
        l_run += ps;
        u32x4 pw[4];
#pragma unroll
        for (int i = 0; i < 4; ++i) { pw[0][i] = pk2(s0[2 * i], s0[2 * i + 1]); pw[1][i] = pk2(s0[8 + 2 * i], s0[8 + 2 * i + 1]); pw[2][i] = pk2(s1[2 * i], s1[2 * i + 1]); pw[3][i] = pk2(s1[8 + 2 * i], s1[8 + 2 * i + 1]); }
#pragma unroll
        for (int sp = 0; sp < 4; ++sp) { const bf16x8 pf = __builtin_bit_cast(bf16x8, pw[sp]);
#pragma unroll
            for (int d0 = 0; d0 < 4; ++d0) { const bf16x8 vf = *(const LAS bf16x8*)(vb + 32 * d0 * VROW + sp * 16); o[d0] = __builtin_amdgcn_mfma_f32_32x32x16_bf16(vf, pf, o[d0], 0, 0, 0); } }
        if (has2) ATT_STOREK(t & 1);
        if (has1) ATT_STOREV((t + 1) & 1);
        __syncthreads();
        s0 = n0; s1 = n1;
    }
#undef ATT_LOADK
#undef ATT_LOADV
#undef ATT_STOREK
#undef ATT_STOREV
#undef ATT_QK
    const float l = l_run + __shfl_xor(l_run, 32), inv = 1.f / l;
    bf16_t* op = O + (size_t)(q0 + wid * 32 + qi) * ldo + 4 * hi;
#pragma unroll
    for (int d0 = 0; d0 < 4; ++d0)
#pragma unroll
        for (int g = 0; g < 4; ++g) { u32x2 w; w.x = pk2(o[d0][4 * g] * inv, o[d0][4 * g + 1] * inv); w.y = pk2(o[d0][4 * g + 2] * inv, o[d0][4 * g + 3] * inv); *(u32x2*)(op + 32 * d0 + 8 * g) = w; }
}

__device__ __forceinline__ void attn_unit_da(const bf16_t* __restrict__ Q, const bf16_t* __restrict__ K, const bf16_t* __restrict__ Vt, bf16_t* O, int q0, int nkeys, LAS unsigned char* lds) {
    constexpr int KROW = 72, VROW = 72, LDQ = 512, LDO = 1024;
    LAS bf16_t* Ks = (LAS bf16_t*)lds; LAS bf16_t* Vs = (LAS bf16_t*)(lds + 2 * 64 * KROW * 2);
    int tid_ = threadIdx.x; asm volatile("" : "+v"(tid_));
    const int tid = tid_, lane = tid & 63, wid = tid >> 6, qi = lane & 31, hi = lane >> 5, qg = wid >> 1, kh = wid & 1;
    bf16x8 qf[2][4];
#pragma unroll
    for (int qs = 0; qs < 2; ++qs) { const bf16_t* qp = Q + (size_t)(q0 + qg * 64 + qs * 32 + qi) * LDQ + hi * 8;
#pragma unroll
        for (int ks = 0; ks < 4; ++ks) qf[qs][ks] = *(const bf16x8*)(qp + ks * 16); }
    f32x16 o[2][4];
#pragma unroll
    for (int qs = 0; qs < 2; ++qs)
#pragma unroll
        for (int d0 = 0; d0 < 4; ++d0)
#pragma unroll
            for (int r = 0; r < 16; ++r) o[qs][d0][r] = 0.f;
    float m_run[2] = {-1e30f, -1e30f}, l_run[2] = {0.f, 0.f};
    const int NT = nkeys / 64;
    u32x4 kreg, vreg[2];
#define DA_LOADG(t) do { { const int r_ = tid >> 3, cc_ = tid & 7; kreg = *(const u32x4*)(K + (size_t)((t) * 64 + r_) * 512 + cc_ * 8); } \
        _Pragma("unroll") for (int i_ = 0; i_ < 2; ++i_) { const int c_ = tid + NTHR * i_, dv_ = c_ >> 3, k8_ = c_ & 7; vreg[i_] = *(const u32x4*)(Vt + (size_t)dv_ * T + (t) * 64 + k8_ * 8); } } while (0)
#define DA_STOREL(b) do { { const int r_ = tid >> 3, cc_ = tid & 7; *(LAS u32x4*)(Ks + (b) * 64 * KROW + r_ * KROW + cc_ * 8) = kreg; } \
        _Pragma("unroll") for (int i_ = 0; i_ < 2; ++i_) { const int c_ = tid + NTHR * i_, dv_ = c_ >> 3, k8_ = c_ & 7; *(LAS u32x4*)(Vs + (b) * 128 * VROW + dv_ * VROW + k8_ * 8) = vreg[i_]; } } while (0)
    DA_LOADG(0); DA_STOREL(0); __syncthreads();
    const int krow = 32 * kh + swap23(qi);
    for (int t = 0; t < NT; ++t) {
        const int buf = t & 1;
        if (t + 1 < NT) DA_LOADG(t + 1);
        const LAS bf16_t* kb = Ks + buf * 64 * KROW + krow * KROW + hi * 8; const LAS bf16_t* vb = Vs + buf * 128 * VROW + qi * VROW + 32 * kh + hi * 8;
        f32x16 sc[2];
#pragma unroll
        for (int r = 0; r < 16; ++r) { sc[0][r] = 0.f; sc[1][r] = 0.f; }
#pragma unroll
        for (int ks = 0; ks < 4; ++ks) { const bf16x8 kf = *(const LAS bf16x8*)(kb + ks * 16);
            sc[0] = __builtin_amdgcn_mfma_f32_32x32x16_bf16(kf, qf[0][ks], sc[0], 0, 0, 0); sc[1] = __builtin_amdgcn_mfma_f32_32x32x16_bf16(kf, qf[1][ks], sc[1], 0, 0, 0); }
        u32x4 pw[2][2];
#pragma unroll
        for (int qs = 0; qs < 2; ++qs) {
            float mx = sc[qs][0];
#pragma unroll
            for (int r = 1; r < 16; ++r) mx = fmaxf(mx, sc[qs][r]);
            mx = fmaxf(mx, __shfl_xor(mx, 32));
            if (__any(mx > m_run[qs] + 8.f)) {
                const float m_new = fmaxf(m_run[qs], mx), alpha = ex2(m_run[qs] - m_new); m_run[qs] = m_new; l_run[qs] *= alpha;
#pragma unroll
                for (int d0 = 0; d0 < 4; ++d0)
#pragma unroll
                    for (int r = 0; r < 16; ++r) o[qs][d0][r] *= alpha;
            }
            float ps = 0.f;
#pragma unroll
            for (int r = 0; r < 16; ++r) { sc[qs][r] = ex2(sc[qs][r] - m_run[qs]); ps += sc[qs][r]; }
            l_run[qs] += ps;
#pragma unroll
            for (int i = 0; i < 4; ++i) { pw[qs][0][i] = pk2(sc[qs][2 * i], sc[qs][2 * i + 1]); pw[qs][1][i] = pk2(sc[qs][8 + 2 * i], sc[qs][8 + 2 * i + 1]); }
        }
#pragma unroll
        for (int sp = 0; sp < 2; ++sp)
#pragma unroll
            for (int d0 = 0; d0 < 4; ++d0) { const bf16x8 vf = *(const LAS bf16x8*)(vb + 32 * d0 * VROW + sp * 16);
                o[0][d0] = __builtin_amdgcn_mfma_f32_32x32x16_bf16(vf, __builtin_bit_cast(bf16x8, pw[0][sp]), o[0][d0], 0, 0, 0);
                o[1][d0] = __builtin_amdgcn_mfma_f32_32x32x16_bf16(vf, __builtin_bit_cast(bf16x8, pw[1][sp]), o[1][d0], 0, 0, 0); }
        if (t + 1 < NT) DA_STOREL(buf ^ 1);
        __syncthreads();
    }
#undef DA_LOADG
#undef DA_STOREL
    LAS float* xp = (LAS float*)lds + (size_t)qg * (130 * 64) + lane;
#pragma unroll
    for (int qs = 0; qs < 2; ++qs) {
        const float lt = l_run[qs] + __shfl_xor(l_run[qs], 32);
        if (kh == 1) { xp[128 * 64] = m_run[qs]; xp[129 * 64] = lt;
#pragma unroll
            for (int d0 = 0; d0 < 4; ++d0)
#pragma unroll
                for (int r = 0; r < 16; ++r) xp[(d0 * 16 + r) * 64] = o[qs][d0][r]; }
        __syncthreads();
        if (kh == 0) { const float mb = xp[128 * 64], lb = xp[129 * 64];
            const float m = fmaxf(m_run[qs], mb), fa = ex2(m_run[qs] - m), fb = ex2(mb - m), inv = 1.f / (lt * fa + lb * fb), ca = fa * inv, cb = fb * inv;
            bf16_t* op = O + (size_t)(q0 + qg * 64 + qs * 32 + qi) * LDO + 4 * hi;
#pragma unroll
            for (int d0 = 0; d0 < 4; ++d0)
#pragma unroll
                for (int g = 0; g < 4; ++g) { float v[4];
#pragma unroll
                    for (int j = 0; j < 4; ++j) v[j] = o[qs][d0][4 * g + j] * ca + xp[(d0 * 16 + 4 * g + j) * 64] * cb;
                    u32x2 w; w.x = pk2(v[0], v[1]); w.y = pk2(v[2], v[3]); *(u32x2*)(op + 32 * d0 + 8 * g) = w; } }
        __syncthreads();
    }
}

#define XB_TMO      128
#define XB_XCNT(j)  (256  + 64 * (j))
#define XB_XSUB(j)  (1280 + 64 * (j))
#define XB_XGEN(j)  (2304 + 64 * (j))
#define XB_TOP      3328
#define XB_TOPGEN   3392
#define XCD_BAR_WORDS 3456
#define XB_SPIN_CAP (1u << 18)

__device__ __forceinline__ unsigned xb_ld(unsigned* p)              { return __hip_atomic_load(p, __ATOMIC_RELAXED, __HIP_MEMORY_SCOPE_AGENT); }
__device__ __forceinline__ unsigned xb_add(unsigned* p, unsigned v) { return __hip_atomic_fetch_add(p, v, __ATOMIC_RELAXED, __HIP_MEMORY_SCOPE_AGENT); }
__device__ __forceinline__ unsigned xb_xcc_id() { return (unsigned)__builtin_amdgcn_s_getreg((3 << 11) | 20) & 0xFu; }
#define XB_SPIN(cond, bar) do { unsigned _sp = 0; while (cond) { __builtin_amdgcn_s_sleep(1); \
    if ((++_sp & 255u) == 0u) { if (xb_ld(&(bar)[XB_TMO])) break; if (_sp > XB_SPIN_CAP) { atomicAdd(&(bar)[XB_TMO], 1u); break; } } } } while (0)

struct XcdBarrier {
    unsigned* bar; unsigned x;
    volatile LAS unsigned* st;
};

__device__ __forceinline__ XcdBarrier xcd_barrier_post(unsigned* bar, volatile LAS unsigned* st) {
    XcdBarrier b; b.bar = bar; b.x = xb_xcc_id(); b.st = st;
    if (threadIdx.x == 0) (void)xb_add(&bar[XB_XCNT(b.x)], 1u);
    return b;
}
__device__ __forceinline__ void xcd_barrier_complete(unsigned* bar, unsigned x, unsigned& nloc, unsigned& nx) {
    const unsigned G = gridDim.x * gridDim.y * gridDim.z;
    unsigned sum, cnt, mine, sp = 0u;
    for (;;) {
        sum = 0u; cnt = 0u; mine = 0u;
#pragma unroll
        for (unsigned j = 0; j < 16; ++j) { const unsigned c = xb_ld(&bar[XB_XCNT(j)]); sum += c; cnt += (c > 0u) ? 1u : 0u; mine = (j == x) ? c : mine; }
        if (sum == G) break;
        __builtin_amdgcn_s_sleep(1);
        if ((++sp & 255u) == 0u) { if (xb_ld(&bar[XB_TMO])) break; if (sp > XB_SPIN_CAP) { atomicAdd(&bar[XB_TMO], 1u); break; } }
    }
    nloc = mine > 0u ? mine : 1u; nx = cnt > 0u ? cnt : 1u;
}

__device__ __forceinline__ void xcd_barrier(const XcdBarrier& b) {
    asm volatile("s_waitcnt vmcnt(0)" ::: "memory");
    __syncthreads();
    if (threadIdx.x == 0) {
        unsigned* bar = b.bar;
        __builtin_amdgcn_s_waitcnt(0);
        unsigned nloc = b.st[0], nx = b.st[1];
        if (nloc == 0u) { xcd_barrier_complete(bar, b.x, nloc, nx); b.st[0] = nloc; b.st[1] = nx; }
        const unsigned old = xb_add(&bar[XB_XSUB(b.x)], 1u);
        const unsigned gen = old / nloc;
        if (old + 1u == (gen + 1u) * nloc) {
            __builtin_amdgcn_fence(__ATOMIC_RELEASE, "agent");
            asm volatile("s_waitcnt vmcnt(0)" ::: "memory");
            const unsigned og = xb_add(&bar[XB_TOP], 1u);
            const unsigned tg = og / nx;
            if (og + 1u == (tg + 1u) * nx) xb_add(&bar[XB_TOPGEN], 1u);
            else XB_SPIN(xb_ld(&bar[XB_TOPGEN]) == tg, bar);
            __builtin_amdgcn_fence(__ATOMIC_ACQUIRE, "agent");
            xb_add(&bar[XB_XGEN(b.x)], 1u);
            asm volatile("s_waitcnt vmcnt(0)" ::: "memory");
        } else {
            XB_SPIN(xb_ld(&bar[XB_XGEN(b.x)]) == gen, bar);
            __builtin_amdgcn_fence(__ATOMIC_ACQUIRE, "agent");
            asm volatile("s_waitcnt vmcnt(0)" ::: "memory");
        }
    }
    __syncthreads();
}

#define GAS __attribute__((address_space(1)))
#define PIN(i) ((const float*)(const GAS float*)pp->in[i])
#define F1T ((bf16_t*)(ws + O_F1T))
#define F2T ((bf16_t*)(ws + O_F2T))
#define ROPE ((float*)(ws + O_ROPE))
#define C8T ((float*)(ws + O_C8))
#define MODS ((float*)(ws + O_MODS))
#define XMOD ((bf16_t*)(ws + O_XMOD))
#define XRES ((float*)(ws + O_XRES))
#define QDA ((bf16_t*)(ws + O_QDA))
#define KDA ((bf16_t*)(ws + O_KDA))
#define VTDA ((bf16_t*)(ws + O_VTDA))
#define LRUX ((bf16_t*)(ws + O_LRUX))
#define LRUG ((bf16_t*)(ws + O_LRUG))
#define CQ ((bf16_t*)(ws + O_CQ))
#define CKV ((bf16_t*)(ws + O_CKV))
#define PARTQ ((float*)(ws + O_PARTQ))
#define PARTKV ((float*)(ws + O_PARTKV))
#define QMLA ((bf16_t*)(ws + O_QMLA))
#define KMLA ((bf16_t*)(ws + O_KMLA))
#define VTMLA ((bf16_t*)(ws + O_VTMLA))
#define FX ((bf16_t*)(ws + O_FX))
#define FT ((bf16_t*)(ws + O_FT))
#define CTXW ((float*)(ws + O_CTXW))
#define XC ((bf16_t*)(ws + O_XC))
#define AU ((unsigned*)(ws + O_AU))
#define SUMM ((float*)(ws + O_SUMM))
#define DAO ((bf16_t*)(ws + O_DAO))
#define HB ((bf16_t*)(ws + O_H))
#define WIN ((bf16_t*)(wl + O_WIN))
#define WOUT ((bf16_t*)(wl + O_WOUT))
#define WGU ((bf16_t*)(wl + O_WGU))
#define WD ((bf16_t*)(wl + O_WD))
#define WUQ ((bf16_t*)(wl + O_WUQ))
#define WUKV ((bf16_t*)(wl + O_WUKV))
#define WLRU ((bf16_t*)(wl + O_WLRU))
#define MIX XMOD
#define mods_c (MODS + (size_t)(l * 2 + 0) * 12288)
#define mods_l (MODS + (size_t)(l * 2 + 1) * 12288)
__device__ __forceinline__ int chunk_start(int c) { if (c <= 4) return 64 * c; const int cl = c - 4; return NCTX + 65 * cl + (cl < 4 ? cl : 4); }
constexpr int N_PHASES = 22;
template <unsigned MASK>
__global__ void __launch_bounds__(NTHR, 2) mega_fwd(Params P) {
    extern __shared__ __attribute__((aligned(16))) unsigned char lds_raw[];
    LAS unsigned char* lds = (LAS unsigned char*)lds_raw;
    const int tid0 = threadIdx.x;
    const int G0 = gridDim.x, bid0 = blockIdx.x;
    cg::grid_group grid = cg::this_grid();
    volatile LAS unsigned* bst = (volatile LAS unsigned*)(lds + LDS_BYTES - 16);
    if (tid0 < 4) bst[tid0] = 0u;
    __syncthreads();
    XcdBarrier xbar = xcd_barrier_post((unsigned*)(P.ws + O_BAR), bst);

    for (int ph = P.ph_lo; ph < P.ph_hi; ++ph) {
        const __attribute__((address_space(4))) Params* pp = (const __attribute__((address_space(4))) Params*)__builtin_amdgcn_kernarg_segment_ptr(); asm volatile("" : "+s"(pp));
        int tid = tid0; asm volatile("" : "+v"(tid));
        int G = G0, bid = bid0; asm volatile("" : "+s"(G), "+s"(bid));
        const int NGW = G * NWV, NT_ALL = G * NTHR;
        const int lane = tid & 63, wid = __builtin_amdgcn_readfirstlane(tid >> 6), gw = bid * NWV + wid, gtid = bid * NTHR + tid;
        GAS unsigned char* ws = (GAS unsigned char*)pp->ws; asm volatile("" : "+s"(ws));
        const int l = ph >= 2 ? (ph - 2) / 10 : 0, sub = ph >= 2 ? (ph - 2) % 10 : -1;
        GAS unsigned char* wl = ws + (size_t)l * SZ_WLAYER;
        if (EN(0) && ph == 0) {
            for (int rp_ = 0; rp_ < DUP_P0; ++rp_) {
            for (int it = bid; it < 256; it += G) {
                const int ll = it >> 7, g = (it >> 5) & 3, kb = it & 31, k0 = 64 * kb;
                LAS float* wt = (LAS float*)lds; LAS float* tab = wt + 128 * 68;
                const float* wsrc = PIN(I_WIN) + (size_t)ll * DM * INW;
                for (int i = 0; i < 16; ++i) { const int e = tid + NTHR * i, kk = e >> 7, c = e & 127; wt[c * 68 + kk] = wsrc[(size_t)(k0 + kk) * INW + 3264 + 128 * g + c]; }
                if (tid < 128) tab[tid] = cospif((float)tid * (1.f / 64.f)) * RSQ128;
                __syncthreads();
                const int col = tid & 255, part = col >> 7, jj = col & 127, kh = tid >> 8; const int ph0 = part ? 96 : 0;
                bf16_t* dst = (bf16_t*)(ws + (size_t)ll * SZ_WLAYER + O_WIN) + (size_t)((13 + g) * 256 + col) * DM + k0 + 32 * kh;
                f32x4 a[8];
#pragma unroll
                for (int q = 0; q < 8; ++q) a[q] = (f32x4){0.f, 0.f, 0.f, 0.f};
                for (int c = 0; c < 128; ++c) { const float tv = tab[(jj * c + ph0) & 127]; const LAS f32x4* wr4 = (const LAS f32x4*)(wt + c * 68 + 32 * kh);
#pragma unroll
                    for (int q = 0; q < 8; ++q) a[q] += wr4[q] * tv; }
                const float sg = part ? -1.f : 1.f;
#pragma unroll
                for (int q = 0; q < 4; ++q) { u32x4 o; o.x = pk2(a[2 * q][0] * sg, a[2 * q][1] * sg); o.y = pk2(a[2 * q][2] * sg, a[2 * q][3] * sg); o.z = pk2(a[2 * q + 1][0] * sg, a[2 * q + 1][1] * sg); o.w = pk2(a[2 * q + 1][2] * sg, a[2 * q + 1][3] * sg);
                    *(u32x4*)(dst + 8 * q) = o; }
                __syncthreads();
            }
            for (int it = bid; it < 192; it += G) {
                const int ll = it / 96, nc = it % 96;
                LAS float* sv = (LAS float*)lds; LAS float* red = sv + 2 * DM;
                for (int i = tid; i < DM; i += NTHR) { sv[i] = siluf(PIN(I_CCTX)[i]); sv[DM + i] = siluf(PIN(I_C)[i]); }
                __syncthreads();
                const float* wp = PIN(I_WADA) + (size_t)ll * DM * 12288 + 128 * nc + 2 * lane;
                float a00 = 0.f, a01 = 0.f, a10 = 0.f, a11 = 0.f;
                for (int k0 = 256 * wid; k0 < 256 * wid + 256; k0 += 16) { f32x2_t w2[16];
#pragma unroll
                    for (int j = 0; j < 16; ++j) w2[j] = *(const f32x2_t*)(wp + (size_t)(k0 + j) * 12288);
#pragma unroll
                    for (int j = 0; j < 16; ++j) { const float s0 = sv[k0 + j], s1 = sv[DM + k0 + j]; a00 += s0 * w2[j][0]; a01 += s0 * w2[j][1]; a10 += s1 * w2[j][0]; a11 += s1 * w2[j][1]; } }
                red[(wid * 2 + 0) * 128 + 2 * lane] = a00; red[(wid * 2 + 0) * 128 + 2 * lane + 1] = a01; red[(wid * 2 + 1) * 128 + 2 * lane] = a10; red[(wid * 2 + 1) * 128 + 2 * lane + 1] = a11;
                __syncthreads();
                if (tid < 256) { const int v = tid >> 7, cc = tid & 127; float s = PIN(I_BADA)[(size_t)ll * 12288 + 128 * nc + cc];
                    for (int w = 0; w < 8; ++w) s += red[(w * 2 + v) * 128 + cc];
                    MODS[(size_t)(ll * 2 + v) * 12288 + 128 * nc + cc] = s; }
                __syncthreads();
            }
            for (int i = gtid; i < 4096; i += NT_ALL) { const int pos = i >> 4, f = i & 15; const float x = ((float)pos * INVF[f]) * 0.3183098861837907f; ROPE[2 * i] = cospif(x); ROPE[2 * i + 1] = sinpif(x); }
            for (int i = gtid; i < 65536; i += NT_ALL) { const int cp = i >> 8, kk = i & 255, part = kk >> 7, nn = kk & 127;
                const int n = (cp >> 4) & 1, k1 = 64 * (cp >> 7) + 16 * ((cp >> 5) & 3) + (cp & 15); const float ang = (float)((k1 * nn) & 127) * (1.f / 64.f); const float cv = cospif(ang) * RSQ128, sv = sinpif(ang) * RSQ128;
                F1T[i] = f2bf(n == 0 ? (part == 0 ? cv : sv) : (part == 0 ? -sv : cv)); }
            for (int i = gtid; i < 128 * 65536; i += NT_ALL) { const int k1 = i >> 16, cp = (i >> 8) & 255, kk = i & 255, part = kk >> 7, nn = kk & 127;
                float v = 0.f; if (cp < 128) { const float ang = (float)((nn * (k1 + 128 * cp)) & 16383) * (1.f / 8192.f); v = (part == 0 ? cospif(ang) : sinpif(ang)) * RSQ128; } F2T[i] = f2bf(v); }
            for (int i = gtid; i < 2048; i += NT_ALL) C8T[i] = -8.f * log1pf(__expf(-PIN(I_LLAM)[i]));
            LAS float* scr = (LAS float*)(lds + wid * 8704);
            for (int ll = 0; ll < 2; ++ll) {
                GAS unsigned char* wd = ws + (size_t)ll * SZ_WLAYER;
                tr_job(MapWin{PIN(I_WIN) + (size_t)ll * DM * INW, INW}, DM, 13 * 256, (bf16_t*)(wd + O_WIN), nullptr, scr, gw, NGW, lane);
                tr_job(MapPlain{PIN(I_WOUT) + (size_t)ll * DM * DM, DM}, DM, DM, (bf16_t*)(wd + O_WOUT), nullptr, scr, gw, NGW, lane);
                tr_job(MapGU{PIN(I_WG) + (size_t)ll * DM * DFF, PIN(I_WU) + (size_t)ll * DM * DFF, DFF}, DM, 2 * DFF, (bf16_t*)(wd + O_WGU), nullptr, scr, gw, NGW, lane);
                tr_job(MapPlain{PIN(I_WD) + (size_t)ll * DFF * DM, DM}, DFF, DM, (bf16_t*)(wd + O_WD), nullptr, scr, gw, NGW, lane);
                tr_job(MapUq{PIN(I_WUQ) + (size_t)ll * 384 * 768, 768}, 384, 768, (bf16_t*)(wd + O_WUQ), PIN(I_QNG) + ll * 384, scr, gw, NGW, lane);
                tr_job(MapUkv{PIN(I_WUKV) + (size_t)ll * 256 * 1024, 1024}, 256, 1024, (bf16_t*)(wd + O_WUKV), PIN(I_KVNG) + ll * 256, scr, gw, NGW, lane);
                for (int hd = 0; hd < 8; ++hd) { const int h = hd >> 1, d = hd & 1; const size_t wo = ((size_t)(ll * 2 + d) * 4 + h) * 16384;
                    tr_job(MapLru{PIN(I_LWR) + wo, PIN(I_LWI) + wo, 128}, 128, 256, (bf16_t*)(wd + O_WLRU) + (size_t)hd * 256 * 128, nullptr, scr, gw, NGW, lane); }
            }
            __syncthreads(); }
        } else if (EN(1) && ph == 1) {
            for (int row = gw; row < T; row += NGW) { const float* xr = row < NCTX ? PIN(I_CTX) + (size_t)row * DM : PIN(I_X) + (size_t)(row - NCTX) * DM; const float* md = MODS + (size_t)(row < NCTX ? 0 : 1) * 12288;
#pragma unroll
                for (int j = 0; j < 8; ++j) { const int c = 4 * lane + 256 * j; const f32x4 xv = *(const f32x4*)(xr + c), sh = *(const f32x4*)(md + c), sc = *(const f32x4*)(md + DM + c); st4bf(XMOD + (size_t)row * DM + c, xv * (sc + 1.f) + sh); if (row < NCTX) *(f32x4*)(XRES + (size_t)row * DM + c) = xv * ALPHA; } }
        } else if (EN(2) && sub == 0) {
            pg8::Gemm g{XMOD, WIN, T, NIN, DM}; pg8::StaticOrder S; S.init(T, NIN, G, bid);
            EpiInproj E{QDA, KDA, VTDA, LRUX, LRUG, CQ, CKV, KMLA, FX, CTXW, PARTQ, PARTKV, ROPE};
            for (int rg_ = 0; rg_ < DUP_GEMM; ++rg_) pg8::gemm_phase<EpiInproj, pg8::StaticOrder, true, true>(lds, g, S, E);
        } else if (EN(3) && sub == 1) {
            for (int rs_ = 0; rs_ < DUP_S1; ++rs_) {
            if (EN(11)) { const float* cw = PIN(I_CONVW) + (size_t)l * 4 * 512; const float* cbv = PIN(I_CONVB) + (size_t)l * 512;
              for (int idx = gtid; idx < T * 64; idx += NT_ALL) { const int row = idx >> 6, ch0 = (idx & 63) * 8; const int lo = row < NCTX ? 0 : NCTX, hi = row < NCTX ? NCTX : T;
                  float a[8];
#pragma unroll
                  for (int q = 0; q < 8; ++q) a[q] = cbv[ch0 + q];
#pragma unroll
                  for (int j = 0; j < 4; ++j) { const int r = row + j - 2; if (r >= lo && r < hi) { const u32x4 xw = *(const u32x4*)(LRUX + (size_t)r * 512 + ch0); const float* wj = cw + j * 512 + ch0;
#pragma unroll
                      for (int q = 0; q < 4; ++q) { a[2 * q] += wj[2 * q] * bf2f(xw[q] & 0xffffu); a[2 * q + 1] += wj[2 * q + 1] * bf2f(xw[q] >> 16); } } }
                  u32x4 o; o.x = pk2(a[0], a[1]); o.y = pk2(a[2], a[3]); o.z = pk2(a[4], a[5]); o.w = pk2(a[6], a[7]);
                  *(u32x4*)(XC + ((size_t)(ch0 >> 7) * T + row) * 128 + (ch0 & 127)) = o; } }
            if (EN(12)) { pg8::Gemm g{CQ, WUQ, T, 768, 384}; pg8::StaticOrder S; S.init(T, 768, G, bid); EpiUpq E{QMLA, PARTQ, ROPE}; pg8::gemm_phase<EpiUpq, pg8::StaticOrder, true, true>(lds, g, S, E); }
            if (EN(13)) { pg8::Gemm g{CKV, WUKV, T, 1024, 256}; pg8::StaticOrder S; S.init(T, 1024, G, (bid + G - 195 % G) % G);     EpiUpkv E{KMLA, VTMLA, PARTKV}; pg8::gemm_phase<EpiUpkv, pg8::StaticOrder, true, true>(lds, g, S, E); }
            if (EN(14)) { pg8::Gemm g{FX, F1T, 65536, 256, 256}; pg8::StaticOrder S; S.init(65536, 256, G, bid); EpiFftA E{FT}; pg8::gemm_phase<EpiFftA, pg8::StaticOrder, true, true>(lds, g, S, E); }
            __syncthreads();
            if (EN(15)) for (int k = bid; k < 256; k += G) {
                LAS float* tab = (LAS float*)lds; LAS float* red = tab + 256; if (tid < 256) tab[tid] = cospif((float)tid * (1.f / 128.f)) * 0.0625f; __syncthreads();
                const float* wp = CTXW + (lane >> 4) * 256 + (lane & 15) * 8; f32x4 a0 = {0.f, 0.f, 0.f, 0.f}, a1 = a0;
                for (int n0 = 32 * wid; n0 < 32 * wid + 32; n0 += 8) { f32x4 xr[8][2], xi[8][2];
#pragma unroll
                    for (int j = 0; j < 8; ++j) { const float* p = wp + (size_t)(n0 + j) * 1024; xr[j][0] = *(const f32x4*)p; xr[j][1] = *(const f32x4*)(p + 4); xi[j][0] = *(const f32x4*)(p + 128); xi[j][1] = *(const f32x4*)(p + 132); }
#pragma unroll
                    for (int j = 0; j < 8; ++j) { const int mm = (k * (n0 + j)) & 255; const float cv = tab[mm], sv = tab[(mm + 192) & 255]; a0 += xr[j][0] * cv + xi[j][0] * sv; a1 += xr[j][1] * cv + xi[j][1] * sv; } }
                *(LAS f32x4*)(red + wid * 512 + lane * 8) = a0; *(LAS f32x4*)(red + wid * 512 + lane * 8 + 4) = a1;
                __syncthreads();
                { float t = 0.f;
#pragma unroll
                  for (int w = 0; w < 8; ++w) t += red[w * 512 + tid];
                  MIX[(size_t)k * DM + 1536 + tid] = f2bf(t); }
                __syncthreads(); }
            }
        } else if (EN(4) && sub == 2) {
            for (int rep_ = 0; rep_ < DUP_ATTN; ++rep_)
            if (EN(16)) for (int un = bid; un < 520; un += G) { const int hh = un < 512 ? (un & 7) : (un - 512), qb = un < 512 ? 1 + (un >> 3) : 0;
                attn_unit_da(QDA + hh * 64, KDA + hh * 64, VTDA + (size_t)(hh >> 1) * 128 * T, DAO + hh * 128, qb * 256, qb == 0 ? NCTX : T, lds); }
            for (int rs_ = 0; rs_ < DUP_S2; ++rs_) {
            if (EN(17)) { pg8::Gemm g{XC, WLRU, 4 * T, 2048, 128}; LruOrder S{G, bid}; EpiLru E{AU, XC, PIN(I_LBR) + (size_t)l * 1024, PIN(I_LBI) + (size_t)l * 1024, C8T + (size_t)l * 1024};
              pg8::gemm_phase<EpiLru, LruOrder, true, true>(lds, g, S, E); }
            if (EN(18)) { pg8::Gemm g{FT, F2T, 65536, 256, 256}; FftCOrder S{G, bid}; EpiFftC E{MIX}; pg8::gemm_phase<EpiFftC, FftCOrder, true, true>(lds, g, S, E); }
            }
        } else if (EN(5) && sub == 3) {
            for (int rep_ = 0; rep_ < DUP_ATTN; ++rep_)
            for (int un = bid; un < 260; un += G) { const int h = un < 256 ? (un & 3) : (un - 256), qb = un < 256 ? 1 + (un >> 2) : 0;
                attn_unit<192>(QMLA + h * 192, 768, KMLA + h * 192, 768, VTMLA + (size_t)h * 128 * T, MIX + 1024 + h * 128, DM, qb * 256, qb == 0 ? NCTX : T, lds); }
            for (int rs_ = 0; rs_ < DUP_S3; ++rs_)
            for (int un = bid; un < 512; un += G) { const int d = un >> 8, c = un & 255; const int cs = chunk_start(c), len = chunk_start(c + 1) - cs;
                const unsigned* au = AU + (size_t)d * T * 512 + tid; float h = 0.f, S = 0.f;
                for (int i0 = 0; i0 < len; i0 += 16) { unsigned w[16];
#pragma unroll
                    for (int j = 0; j < 16; ++j) { const int i = i0 + j < len ? i0 + j : len - 1; const int row = d == 0 ? cs + i : cs + len - 1 - i; w[j] = au[(size_t)row * 512]; }
#pragma unroll
                    for (int j = 0; j < 16; ++j) if (i0 + j < len) { const float l2a = bf2f(w[j] >> 16), uu = bf2f(w[j] & 0xffffu); h = ex2(l2a) * h + uu; S += l2a; } }
                SUMM[((size_t)(d * 256 + c) * 512 + tid) * 2] = S; SUMM[((size_t)(d * 256 + c) * 512 + tid) * 2 + 1] = h; }
        } else if (EN(6) && sub == 4) {
            for (int rs_ = 0; rs_ < DUP_S4; ++rs_) {
            __syncthreads();
            for (int c = bid; c < 256; c += G) { LAS float* hfs = (LAS float*)lds; const f32x2_t* S0 = (const f32x2_t*)SUMM + tid; const f32x2_t* S1 = S0 + (size_t)256 * 512;
                const int cs = chunk_start(c), len = chunk_start(c + 1) - cs;
                float hf = 0.f, hb = 0.f;
                for (int p0 = 0; p0 < c; p0 += 16) { f32x2_t sv[16];
#pragma unroll
                    for (int j = 0; j < 16; ++j) { const int k = p0 + j < c ? p0 + j : c - 1; sv[j] = S0[(size_t)k * 512]; }
#pragma unroll
                    for (int j = 0; j < 16; ++j) if (p0 + j < c) hf = ex2(sv[j][0]) * hf + sv[j][1]; }
                const int np = c < 4 ? 3 - c : 4 + 255 - c;
                for (int p0 = 0; p0 < np; p0 += 16) { f32x2_t sv[16];
#pragma unroll
                    for (int j = 0; j < 16; ++j) { const int p = p0 + j < np ? p0 + j : np - 1; const int k = p < 4 ? 3 - p : 259 - p; sv[j] = S1[(size_t)k * 512]; }
#pragma unroll
                    for (int j = 0; j < 16; ++j) if (p0 + j < np) hb = ex2(sv[j][0]) * hb + sv[j][1]; }
                const unsigned* a0 = AU + tid; const unsigned* a1 = AU + (size_t)T * 512 + tid;
                for (int i0 = 0; i0 < len; i0 += 16) { unsigned w[16];
#pragma unroll
                    for (int j = 0; j < 16; ++j) { const int i = i0 + j < len ? i0 + j : len - 1; w[j] = a0[(size_t)(cs + i) * 512]; }
#pragma unroll
                    for (int j = 0; j < 16; ++j) if (i0 + j < len) { hf = ex2(bf2f(w[j] >> 16)) * hf + bf2f(w[j] & 0xffffu); hfs[(i0 + j) * 512 + tid] = hf; } }
                for (int i0 = 0; i0 < len; i0 += 16) { unsigned w[16]; bf16_t gg[16];
#pragma unroll
                    for (int j = 0; j < 16; ++j) { const int i = i0 + j < len ? i0 + j : len - 1; const int row = cs + len - 1 - i; w[j] = a1[(size_t)row * 512]; gg[j] = LRUG[(size_t)row * 512 + tid]; }
#pragma unroll
                    for (int j = 0; j < 16; ++j) if (i0 + j < len) { const int ii = len - 1 - (i0 + j); hb = ex2(bf2f(w[j] >> 16)) * hb + bf2f(w[j] & 0xffffu);
                        MIX[(size_t)(cs + ii) * DM + 512 + tid] = f2bf((hfs[ii * 512 + tid] + hb) * gelu_tanh(bf2f(gg[j]))); } } }
            { const float linit = l == 0 ? 0.2f : 0.35550906759096926f;
              const float e1 = __expf(wave_sum(PIN(I_LQ1)[l * 64 + lane] * PIN(I_LK1)[l * 64 + lane])), e2 = __expf(wave_sum(PIN(I_LQ2)[l * 64 + lane] * PIN(I_LK2)[l * 64 + lane])); const float lam = e1 - e2 + linit;
              const float g0 = PIN(I_SUBLN)[l * 128 + 2 * lane] * (1.f - linit), g1 = PIN(I_SUBLN)[l * 128 + 2 * lane + 1] * (1.f - linit);
              for (int row = gw; row < T; row += NGW) { unsigned w1[4], w2[4];
#pragma unroll
                  for (int h = 0; h < 4; ++h) { w1[h] = *(const unsigned*)(DAO + (size_t)row * 1024 + h * 256 + 2 * lane); w2[h] = *(const unsigned*)(DAO + (size_t)row * 1024 + h * 256 + 128 + 2 * lane); }
#pragma unroll
                  for (int h = 0; h < 4; ++h) { const float y0 = bf2f(w1[h] & 0xffffu) - lam * bf2f(w2[h] & 0xffffu), y1 = bf2f(w1[h] >> 16) - lam * bf2f(w2[h] >> 16); const float inv = rsqrtf(wave_sum(y0 * y0 + y1 * y1) * (1.f / 128.f) + 1e-6f);
                      *(unsigned*)(MIX + (size_t)row * DM + h * 128 + 2 * lane) = pk2(y0 * inv * g0, y1 * inv * g1); } } }
            }
        } else if (EN(7) && sub == 5) {
            pg8::Gemm g{MIX + (size_t)256 * DM, WOUT, T - 256, DM, DM}; pg8::StaticOrder S; S.init(T - 256, DM, G, bid);
            EpiRes E{l == 0 ? PIN(I_CTX) : XRES, l == 0 ? PIN(I_X) : XRES + (size_t)NCTX * DM, XRES, mods_c + 2 * DM, mods_l + 2 * DM, 1};
            pg8::gemm_phase<EpiRes, pg8::StaticOrder, true, true>(lds, g, S, E);
            if (l == 0) for (int kp = 0; kp < 4; ++kp) {
                pg8::Gemm gc{MIX + kp * 512, WOUT + kp * 512, 256, DM, 512, DM}; pg8::StaticOrder Sc; Sc.init(256, DM, G, (bid + G - 8 * kp) % G); EpiResAtomic Ec{XRES, mods_c + 2 * DM};
                pg8::gemm_phase<EpiResAtomic, pg8::StaticOrder, true, true>(lds, gc, Sc, Ec); }
        } else if (EN(8) && (sub == 6 || sub == 9)) {
            const bool second = sub == 9, fin = second && l == 1;
            const float* gam = PIN(second ? I_LN2G : I_LN1G) + (size_t)l * DM; const float* bet = PIN(second ? I_LN2B : I_LN1B) + (size_t)l * DM;
#define LN_LOAD(V, R) do { _Pragma("unroll") for (int j_ = 0; j_ < 8; ++j_) V[j_] = *(const f32x4*)(XRES + (size_t)(R) * DM + 4 * lane + 256 * j_); } while (0)
#define LN_ROW(V, R) do { const int row_ = (R); float* yr_ = XRES + (size_t)row_ * DM; float s_ = 0.f; \
                _Pragma("unroll") for (int j_ = 0; j_ < 8; ++j_) s_ += (V[j_][0] + V[j_][1]) + (V[j_][2] + V[j_][3]); \
                const float mean_ = wave_sum(s_) * (1.f / DM); float s2_ = 0.f; \
                _Pragma("unroll") for (int j_ = 0; j_ < 8; ++j_) { V[j_] = V[j_] - mean_; s2_ += (V[j_][0] * V[j_][0] + V[j_][1] * V[j_][1]) + (V[j_][2] * V[j_][2] + V[j_][3] * V[j_][3]); } \
                const float rstd_ = rsqrtf(wave_sum(s2_) * (1.f / DM) + 1e-5f); \
                const float* md_ = second ? MODS + (size_t)((l + 1) * 2 + (row_ < NCTX ? 0 : 1)) * 12288 : MODS + (size_t)(l * 2 + (row_ < NCTX ? 0 : 1)) * 12288 + 3 * DM; \
                float* dst_ = fin ? ((float*)(GAS float*)pp->out) + (size_t)(row_ - NCTX) * DM : yr_; \
                const float rs2_ = (!second && row_ < NCTX) ? ALPHA : 1.f; \
                _Pragma("unroll") for (int j_ = 0; j_ < 8; ++j_) { const int c_ = 4 * lane + 256 * j_; const f32x4 xn_ = V[j_] * rstd_ * *(const f32x4*)(gam + c_) + *(const f32x4*)(bet + c_); *(f32x4*)(dst_ + c_) = xn_ * rs2_; \
                    if (!fin) { const f32x4 sh_ = *(const f32x4*)(md_ + c_), sc_ = *(const f32x4*)(md_ + DM + c_); st4bf(XMOD + (size_t)row_ * DM + c_, xn_ * (sc_ + 1.f) + sh_); } } } while (0)
            { f32x4 va[8], vb[8]; int row = gw + l * NCTX;
#pragma unroll
              for (int j = 0; j < 8; ++j) { va[j] = (f32x4){0.f, 0.f, 0.f, 0.f}; vb[j] = va[j]; }
              if (row < T) LN_LOAD(va, row);
              for (; row < T; row += 2 * NGW) {
                  const bool hb = row + NGW < T;
                  if (hb) LN_LOAD(vb, row + NGW);
                  LN_ROW(va, row);
                  if (row + 2 * NGW < T) LN_LOAD(va, row + 2 * NGW);
                  if (hb) LN_ROW(vb, row + NGW);
              } }
#undef LN_LOAD
#undef LN_ROW
        } else if (EN(9) && sub == 7) {
            pg8::Gemm g{XMOD + (size_t)l * 256 * DM, WGU, T - l * 256, 2 * DFF, DM}; pg8::StaticOrder S; S.init(T - l * 256, 2 * DFF, G, bid); EpiGU E{HB, l};
            for (int rg_ = 0; rg_ < DUP_GEMM; ++rg_) pg8::gemm_phase<EpiGU, pg8::StaticOrder, true, true>(lds, g, S, E);
        } else if (EN(10) && sub == 8) {
            pg8::Gemm g{HB + (size_t)256 * DFF, WD, T - 256, DM, DFF}; pg8::StaticOrder S; S.init(T - 256, DM, G, bid);
            EpiRes E{XRES, XRES + (size_t)NCTX * DM, XRES, mods_c + 5 * DM, mods_l + 5 * DM, 1};
            pg8::gemm_phase<EpiRes, pg8::StaticOrder, true, true>(lds, g, S, E);
            if (l == 0) for (int kp = 0; kp < 4; ++kp) {
                pg8::Gemm gc{HB + kp * 1408, WD + kp * 1408, 256, DM, 1408, DFF}; pg8::StaticOrder Sc; Sc.init(256, DM, G, (bid + G - 8 * kp) % G); EpiResAtomic Ec{XRES, mods_c + 5 * DM};
                pg8::gemm_phase<EpiResAtomic, pg8::StaticOrder, true, true>(lds, gc, Sc, Ec); }
        }
        if (ph + 1 < P.ph_hi) { if (ph == 0) grid.sync(); else xcd_barrier(xbar); }
    }
}

template <unsigned MASK> static void launch_one(int grid, Params p, hipStream_t stream, bool coop) {
    static bool attr_set = false;
    if (!attr_set) { (void)hipFuncSetAttribute((const void*)mega_fwd<MASK>, hipFuncAttributeMaxDynamicSharedMemorySize, LDS_BYTES); attr_set = true; }
    if (coop) { void* args[] = {&p}; hipError_t e = hipLaunchCooperativeKernel((const void*)mega_fwd<MASK>, dim3(grid), dim3(NTHR), args, LDS_BYTES, stream);
        if (e != hipSuccess) fprintf(stderr, "cooperative launch failed: %s (grid %d)\n", hipGetErrorString(e), grid); }
    else hipLaunchKernelGGL(mega_fwd<MASK>, dim3(grid), dim3(NTHR), LDS_BYTES, stream, p);
}
extern "C" void kernel_launch(void* const* d_in, const int* in_sizes, int n_in, void* d_out, int out_size, void* d_ws, size_t ws_size, hipStream_t stream) {
    static int grid = 0;
    if (grid == 0) {
        if (n_in != 31 || ws_size < WS_NEED) { fprintf(stderr, "kernel_launch: need 31 inputs and %zu bytes of workspace; got %d, %zu\n", (size_t)WS_NEED, n_in, ws_size); grid = -1; return; }
        int dev = 0, cus = 0;
        (void)hipGetDevice(&dev); (void)hipDeviceGetAttribute(&cus, hipDeviceAttributeMultiprocessorCount, dev);
        grid = cus;
#if !MK_MULTI
        int per_cu = 0;
        (void)hipFuncSetAttribute((const void*)mega_fwd<PH_MASK>, hipFuncAttributeMaxDynamicSharedMemorySize, LDS_BYTES);
        (void)hipOccupancyMaxActiveBlocksPerMultiprocessor(&per_cu, (const void*)mega_fwd<PH_MASK>, NTHR, LDS_BYTES);
        if (per_cu < 1) fprintf(stderr, "kernel_launch: occupancy query returned %d\n", per_cu);
        (void)hipGetLastError();
#endif
    }
    if (grid < 0) return;
    Params p{};
    for (int i = 0; i < 31; ++i) p.in[i] = (const float*)d_in[i];
    p.out = (float*)d_out; p.ws = (unsigned char*)d_ws;
#if MK_MULTI
#define L1(ph, mask) do { p.ph_lo = (ph); p.ph_hi = (ph) + 1; launch_one<(mask)>(grid, p, stream, false); } while (0)
    L1(0, 1u); L1(1, 2u);
    for (int l = 0; l < 2; ++l) { const int b = 2 + 10 * l;
        L1(b + 0, 1u << 2); L1(b + 1, (1u << 3) | (1u << 11) | (1u << 12) | (1u << 13)); L1(b + 1, (1u << 3) | (1u << 14) | (1u << 15));
        L1(b + 2, (1u << 4) | (1u << 16)); L1(b + 2, (1u << 4) | (1u << 17)); L1(b + 2, (1u << 4) | (1u << 18));
        L1(b + 3, 1u << 5); L1(b + 4, 1u << 6); L1(b + 5, 1u << 7); L1(b + 6, 1u << 8); L1(b + 7, 1u << 9); L1(b + 8, 1u << 10); L1(b + 9, 1u << 8); }
#else
    p.ph_lo = 0; p.ph_hi = N_PHASES;
    (void)hipMemsetAsync((unsigned char*)d_ws + O_BAR, 0, 16384, stream);
    launch_one<PH_MASK>(grid, p, stream, true);
#endif
}
```

```cpp
#include <hip/hip_runtime.h>
#include <hip/hip_cooperative_groups.h>
#include <cstdio>
#include <cstdint>
namespace cg = cooperative_groups;
#ifndef PH_MASK
#define PH_MASK 0xfffff
#endif
#define EN(k) (((MASK) >> (k)) & 1u)
#ifndef DUP_ATTN
#define DUP_ATTN 1
#endif
#ifndef DUP_S1
#define DUP_S1 1
#endif
#ifndef DUP_S2
#define DUP_S2 1
#endif
#ifndef DUP_S3
#define DUP_S3 1
#endif
#ifndef DUP_S4
#define DUP_S4 1
#endif
#ifndef DUP_GEMM
#define DUP_GEMM 1
#endif
#ifndef DUP_P0
#define DUP_P0 1
#endif
#ifndef MLA_DMA
#define MLA_DMA 1
#endif
#ifndef MK_MULTI
#define MK_MULTI 0
#endif
namespace pg8 {
#define PG8_LAS __attribute__((address_space(3)))
typedef unsigned short bf16_t;
typedef short bf16x8 __attribute__((ext_vector_type(8)));
typedef float f32x4 __attribute__((ext_vector_type(4)));
typedef unsigned u32x4 __attribute__((ext_vector_type(4)));
constexpr int BM = 256, BK = 64, HALF = 128, HTB = HALF * BK * 2  , STAGE_BYTES = 8 * HTB, NXCD = 8, WGM = 8;

__host__ __device__ __forceinline__ int lds_byte(int r, int c) { const int st = (r >> 4) * 2 + (c >> 5), rr = r & 15, cc = c & 31, ob = rr * 64 + cc * 2; return st * 1024 + (ob ^ (((ob >> 9) & 1) << 5)); }
__host__ __device__ __forceinline__ void stage_rc(int b, int& R, int& C) { const int st = b / 1024, sb = b % 1024, swz = sb ^ (((sb >> 9) & 1) << 5); R = (st >> 1) * 16 + swz / 64; C = (st & 1) * 32 + (swz % 64) / 2; }
__host__ __device__ __forceinline__ int perm32(int rho) { const int n = rho >> 4, i = rho & 15; return 8 * (i >> 2) + 4 * n + (i & 3); }

struct Unit { int pm, pn; };
struct Gemm { const bf16_t* A; const bf16_t* Bt; int M, N, K; int ld; };

struct StaticOrder {
    int nM, nN, nwg, G, c;
    __host__ __device__ void init(int M, int N, int G_, int c_) { nM = M / BM; nN = N / BM; nwg = nM * nN; G = G_; c = c_; }
    __host__ __device__ bool next(int i, Unit& u) const {
        const long L = (long)i * G + c; if (L >= nwg) return false;
        int wgid = (int)L; { const int q = nwg / NXCD, r = nwg % NXCD, xcd = wgid % NXCD, off = wgid / NXCD; wgid = (xcd < r ? xcd * (q + 1) : r * (q + 1) + (xcd - r) * q) + off; }
        const int nig = WGM * nN, gid = wgid / nig, fm = gid * WGM, gsz = (nM - fm) < WGM ? (nM - fm) : WGM;
        u.pm = fm + ((wgid % nig) % gsz); u.pn = (wgid % nig) / gsz; return true;
    }
    __device__ __forceinline__ void a_ready(const Unit&) const {}
    __device__ __forceinline__ void done(const Unit&) const {}
};

template <class Epi, class Sched, bool ALIGN_EPI = false, bool SP2 = false>
__device__ __forceinline__ void gemm_phase(PG8_LAS unsigned char* lds, const Gemm g, const Sched& S, const Epi& E) {
    int tid_ = threadIdx.x; asm volatile("" : "+v"(tid_));
    const int tid = tid_, wid = __builtin_amdgcn_readfirstlane(tid >> 6), lane = tid & 63, wr = wid >> 2, wc = wid & 3, fr = lane & 15, fq = lane >> 4;
    int K_ = g.K; asm volatile("" : "+s"(K_));
    const int K = K_, nt = K / BK; int LD_ = g.ld ? g.ld : g.K; asm volatile("" : "+s"(LD_)); const int LD = LD_;
    unsigned voffA[2], voffB[2];
#pragma unroll
    for (int i = 0; i < 2; ++i) { int R, C; stage_rc(tid * 16 + i * 8192, R, C); const int Rb = Epi::PERM ? ((R & ~31) + perm32(R & 31)) : R;
        voffA[i] = (unsigned)(R * LD + C) * 2u; voffB[i] = (unsigned)(Rb * LD + C) * 2u; }
    const size_t kstep = (size_t)(BK * 2);
    const size_t hstep = (size_t)HALF * LD * 2;
    const size_t tstep = 2 * hstep;
    const unsigned ldsw = (unsigned)wid * 1024u;
    const int aoff = lds_byte(wr * 64 + fr, fq * 8), boff = lds_byte(wc * 32 + fr, fq * 8);
#define PG8_SA(b, h) (((b) * 2 + (h)) * HTB)
#define PG8_SB(b, h) ((4 + (b) * 2 + (h)) * HTB)
#define PG8_STAGE(bufoff, gbase, voff) do { _Pragma("unroll") for (int _i = 0; _i < 2; ++_i) \
        __builtin_amdgcn_global_load_lds((const unsigned*)((const char*)(gbase) + (voff)[_i]), (PG8_LAS unsigned*)(lds + (bufoff) + ldsw + _i * 8192), 16, 0, 0); } while (0)
#define PG8_LDA(dst, b, h) do { _Pragma("unroll") for (int m = 0; m < 4; ++m) _Pragma("unroll") for (int k = 0; k < 2; ++k) dst[m][k] = *(const PG8_LAS bf16x8*)(lds + PG8_SA(b, h) + aoff + m * 2048 + k * 1024); } while (0)
#define PG8_LDB(dst, b, h) do { _Pragma("unroll") for (int n = 0; n < 2; ++n) _Pragma("unroll") for (int k = 0; k < 2; ++k) dst[n][k] = *(const PG8_LAS bf16x8*)(lds + PG8_SB(b, h) + boff + n * 2048 + k * 1024); } while (0)
#define PG8_MMA(ai, bj, At, Bt) do { __builtin_amdgcn_s_setprio(1); _Pragma("unroll") for (int m = 0; m < 4; ++m) _Pragma("unroll") for (int n = 0; n < 2; ++n) _Pragma("unroll") for (int k = 0; k < 2; ++k) \
        acc[ai][bj][m][n] = __builtin_amdgcn_mfma_f32_16x16x32_bf16(Bt[n][k], At[m][k], acc[ai][bj][m][n], 0, 0, 0); __builtin_amdgcn_s_setprio(0); } while (0)
#define PG8_WAIT_V(n) asm volatile("s_waitcnt vmcnt(" #n ")" ::: "memory")
#define PG8_WAIT_L(n) asm volatile("s_waitcnt lgkmcnt(" #n ")" ::: "memory")
#define PG8_BAR __builtin_amdgcn_s_barrier()
#define PG8_SCHED __builtin_amdgcn_sched_barrier(0)
    Unit cur, nxt; int ui = 0;
    if (!S.next(0, cur)) return;
    f32x4 acc[2][2][4][2];
#pragma unroll
    for (int a = 0; a < 2; ++a)
#pragma unroll
        for (int b = 0; b < 2; ++b)
#pragma unroll
            for (int m = 0; m < 4; ++m)
#pragma unroll
                for (int n = 0; n < 2; ++n) acc[a][b][m][n] = (f32x4){0.f, 0.f, 0.f, 0.f};
    bf16x8 At[4][2], B0[2][2], B1[2][2];
    const char* cA = (const char*)g.A + (size_t)cur.pm * tstep; const char* cB = (const char*)g.Bt + (size_t)cur.pn * tstep;
    S.a_ready(cur);
    if constexpr (SP2) {
        PG8_STAGE(PG8_SB(0, 0), cB, voffB); PG8_STAGE(PG8_SB(0, 1), cB + hstep, voffB); PG8_STAGE(PG8_SA(0, 0), cA, voffA); PG8_STAGE(PG8_SA(0, 1), cA + hstep, voffA);
        if (wr == 1) PG8_BAR;
        PG8_WAIT_V(2); PG8_BAR;
        PG8_STAGE(PG8_SB(1, 0), cB + kstep, voffB); PG8_STAGE(PG8_SA(1, 0), cA + kstep, voffA); PG8_STAGE(PG8_SB(1, 1), cB + hstep + kstep, voffB);
        PG8_WAIT_V(6); PG8_BAR;
    } else {
        PG8_STAGE(PG8_SB(0, 0), cB, voffB); PG8_STAGE(PG8_SA(0, 0), cA, voffA); PG8_STAGE(PG8_SB(0, 1), cB + hstep, voffB); PG8_STAGE(PG8_SA(0, 1), cA + hstep, voffA);
        if (wr == 1) PG8_BAR;
        PG8_WAIT_V(4); PG8_BAR;
        PG8_STAGE(PG8_SB(1, 0), cB + kstep, voffB); PG8_STAGE(PG8_SA(1, 0), cA + kstep, voffA); PG8_STAGE(PG8_SB(1, 1), cB + hstep + kstep, voffB);
        PG8_WAIT_V(6); PG8_BAR;
    }
    for (;;) {
        const bool has_next = S.next(ui + 1, nxt);
        const char* nA = has_next ? (const char*)g.A + (size_t)nxt.pm * tstep : cA; const char* nB = has_next ? (const char*)g.Bt + (size_t)nxt.pn * tstep : cB;
        for (int t = 0; t < nt; t += 2) {
            const bool last = (t == nt - 2);
            const char* a1 = cA + (size_t)(t + 1) * kstep;
            const char* a2 = last ? nA : cA + (size_t)(t + 2) * kstep; const char* b2 = last ? nB : cB + (size_t)(t + 2) * kstep;
            const char* a3 = a2 + kstep; const char* b3 = b2 + kstep;
            if (last && has_next) S.a_ready(nxt);
            if constexpr (SP2) {
            PG8_LDB(B0, 0, 0); PG8_LDB(B1, 0, 1); PG8_SCHED; PG8_LDA(At, 0, 0); PG8_STAGE(PG8_SA(1, 1), a1 + hstep, voffA);
            PG8_WAIT_V(8); PG8_WAIT_L(0); PG8_BAR; PG8_MMA(0, 0, At, B0); PG8_MMA(0, 1, At, B1); PG8_BAR; PG8_SCHED;
            PG8_LDA(At, 0, 1); PG8_STAGE(PG8_SB(0, 0), b2, voffB); PG8_STAGE(PG8_SB(0, 1), b2 + hstep, voffB); PG8_STAGE(PG8_SA(0, 0), a2, voffA);
            PG8_WAIT_V(8); PG8_WAIT_L(0); PG8_BAR; PG8_MMA(1, 0, At, B0); PG8_MMA(1, 1, At, B1); PG8_BAR; PG8_SCHED;
            PG8_LDB(B0, 1, 0); PG8_LDB(B1, 1, 1); PG8_SCHED; PG8_LDA(At, 1, 0); PG8_STAGE(PG8_SA(0, 1), a2 + hstep, voffA);
            PG8_WAIT_V(8); PG8_WAIT_L(0); PG8_BAR; PG8_MMA(0, 0, At, B0); PG8_MMA(0, 1, At, B1); PG8_BAR; PG8_SCHED;
            PG8_LDA(At, 1, 1); PG8_STAGE(PG8_SB(1, 0), b3, voffB); PG8_STAGE(PG8_SB(1, 1), b3 + hstep, voffB); PG8_STAGE(PG8_SA(1, 0), a3, voffA);
            PG8_WAIT_V(8); PG8_WAIT_L(0); PG8_BAR; PG8_MMA(1, 0, At, B0); PG8_MMA(1, 1, At, B1); PG8_BAR; PG8_SCHED;
            } else {
            PG8_LDB(B0, 0, 0); PG8_SCHED; PG8_LDA(At, 0, 0); PG8_STAGE(PG8_SA(1, 1), a1 + hstep, voffA);
            PG8_WAIT_L(8); PG8_BAR; PG8_WAIT_L(0); PG8_MMA(0, 0, At, B0); PG8_BAR; PG8_SCHED;
            PG8_LDB(B1, 0, 1); PG8_STAGE(PG8_SB(0, 0), b2, voffB);
            PG8_BAR; PG8_WAIT_L(0); PG8_MMA(0, 1, At, B1); PG8_BAR;
            PG8_LDA(At, 0, 1); PG8_STAGE(PG8_SA(0, 0), a2, voffA);
            PG8_BAR; PG8_WAIT_L(0); PG8_MMA(1, 0, At, B0); PG8_BAR; PG8_SCHED;
            PG8_STAGE(PG8_SB(0, 1), b2 + hstep, voffB);
            PG8_WAIT_V(6); PG8_BAR; PG8_MMA(1, 1, At, B1); PG8_BAR;
            PG8_LDB(B0, 1, 0); PG8_SCHED; PG8_LDA(At, 1, 0); PG8_STAGE(PG8_SA(0, 1), a2 + hstep, voffA);
            PG8_WAIT_L(8); PG8_BAR; PG8_WAIT_L(0); PG8_MMA(0, 0, At, B0); PG8_BAR; PG8_SCHED;
            PG8_LDB(B1, 1, 1); PG8_STAGE(PG8_SB(1, 0), b3, voffB);
            PG8_BAR; PG8_WAIT_L(0); PG8_MMA(0, 1, At, B1); PG8_BAR;
            PG8_LDA(At, 1, 1); PG8_STAGE(PG8_SA(1, 0), a3, voffA);
            PG8_BAR; PG8_WAIT_L(0); PG8_MMA(1, 0, At, B0); PG8_BAR; PG8_SCHED;
            PG8_STAGE(PG8_SB(1, 1), b3 + hstep, voffB);
            PG8_WAIT_V(6); PG8_BAR; PG8_MMA(1, 1, At, B1); PG8_BAR;
            }
        }
        if constexpr (ALIGN_EPI) { if (wr == 0) PG8_BAR; }
        if constexpr (!Epi::AFTER_DRAIN) { E(acc, cur, wr, wc, fr, fq); S.done(cur); }
        if (!has_next) break;
#pragma unroll
        for (int a = 0; a < 2; ++a)
#pragma unroll
            for (int b = 0; b < 2; ++b)
#pragma unroll
                for (int m = 0; m < 4; ++m)
#pragma unroll
                    for (int n = 0; n < 2; ++n) acc[a][b][m][n] = (f32x4){0.f, 0.f, 0.f, 0.f};
        cur = nxt; cA = nA; cB = nB; ++ui;
        if constexpr (ALIGN_EPI) { if (wr == 1) PG8_BAR; }
    }
    PG8_WAIT_V(0);
    if constexpr (!ALIGN_EPI) { if (wr == 0) PG8_BAR; }
    PG8_BAR;
    if constexpr (Epi::AFTER_DRAIN) { E.fused(acc, cur, wr, wc, fr, fq, lds, wid, lane); S.done(cur); }
#undef PG8_SA
#undef PG8_SB
#undef PG8_STAGE
#undef PG8_LDA
#undef PG8_LDB
#undef PG8_MMA
#undef PG8_WAIT_V
#undef PG8_WAIT_L
#undef PG8_BAR
#undef PG8_SCHED
}
}

using pg8::bf16_t; using pg8::bf16x8; using pg8::f32x4; using pg8::u32x4;
typedef float f32x16 __attribute__((ext_vector_type(16)));
typedef unsigned u32x2 __attribute__((ext_vector_type(2)));
typedef float f32x2_t __attribute__((ext_vector_type(2)));
typedef __bf16 bf16x2_t __attribute__((ext_vector_type(2)));
#define LAS __attribute__((address_space(3)))

constexpr int T = 16640, NCTX = 256, DM = 2048, DFF = 5632, NIN = 4352, INW = 3776;
constexpr int NTHR = 512, NWV = 8;
constexpr float ALPHA = 1.4142135623730951f;
constexpr float LOG2E = 1.4426950408889634f;
constexpr float QS_DA = 0.125f * 1.4426950408889634f;
constexpr float QS_MLA = (float)(0.07216878364870323 * 1.4426950408889634);
constexpr float RSQ128 = 0.08838834764831845f;
constexpr int LDS_BYTES = 147456;

__device__ __forceinline__ unsigned pk2(float lo, float hi) { f32x2_t v = {lo, hi}; bf16x2_t b = __builtin_convertvector(v, bf16x2_t); return __builtin_bit_cast(unsigned, b); }
__device__ __forceinline__ bf16_t f2bf(float f) { return (bf16_t)(pk2(f, 0.f) & 0xffffu); }
__device__ __forceinline__ float bf2f(unsigned b) { return __uint_as_float(b << 16); }
__device__ __forceinline__ float ex2(float x) { return __builtin_amdgcn_exp2f(x); }
__device__ __forceinline__ float max3f(float a, float b, float c) { return __builtin_fmaxf(__builtin_fmaxf(a, b), c); }
__device__ __forceinline__ int swap45(int o) { return (o & ~0x30) | ((o & 0x20) >> 1) | ((o & 0x10) << 1); }
__device__ __forceinline__ int swap23(int o) { return (o & ~0xC) | ((o & 0x4) << 1) | ((o & 0x8) >> 1); }
__device__ __forceinline__ float wave_sum(float v) {
#pragma unroll
    for (int o = 1; o < 64; o <<= 1) v += __shfl_xor(v, o);
    return v;
}
__device__ __forceinline__ float siluf(float x) { return x / (1.f + __expf(-x)); }
__device__ __forceinline__ float sigmf(float x) { return 1.f / (1.f + __expf(-x)); }
__device__ __forceinline__ float gelu_tanh(float x) { const float t = tanhf(0.7978845608028654f * (x + 0.044715f * x * x * x)); return 0.5f * x * (1.f + t); }

constexpr size_t al256(size_t x) { return (x + 255) & ~(size_t)255; }
constexpr size_t SZ_WIN = (size_t)NIN * DM * 2, SZ_WOUT = (size_t)DM * DM * 2, SZ_WGU = (size_t)2 * DFF * DM * 2, SZ_WD = (size_t)DM * DFF * 2;
constexpr size_t SZ_WUQ = (size_t)768 * 384 * 2, SZ_WUKV = (size_t)1024 * 256 * 2, SZ_WLRU = (size_t)8 * 256 * 128 * 2;
constexpr size_t O_WIN = 0, O_WOUT = O_WIN + SZ_WIN, O_WGU = O_WOUT + SZ_WOUT, O_WD = O_WGU + SZ_WGU, O_WUQ = O_WD + SZ_WD, O_WUKV = O_WUQ + SZ_WUQ, O_WLRU = O_WUKV + SZ_WUKV;
constexpr size_t SZ_WLAYER = O_WLRU + SZ_WLRU;
constexpr size_t O_F1T = 2 * SZ_WLAYER, O_F2T = O_F1T + 131072, O_ROPE = O_F2T + (size_t)128 * 131072, O_C8 = O_ROPE + 32768, O_MODS = O_C8 + 8192, O_BAR = al256(O_MODS + 2 * 2 * 12288 * 4), O_XMOD = al256(O_BAR + 16384);
constexpr size_t O_XRES = O_XMOD + (size_t)T * DM * 2, O_U = O_XRES + (size_t)T * DM * 4;
constexpr size_t O_QDA = O_U, O_KDA = O_QDA + (size_t)T * 512 * 2, O_VTDA = O_KDA + (size_t)T * 512 * 2, O_LRUX = O_VTDA + (size_t)T * 512 * 2, O_LRUG = O_LRUX + (size_t)T * 512 * 2;
constexpr size_t O_CQ = O_LRUG + (size_t)T * 512 * 2, O_CKV = O_CQ + (size_t)T * 384 * 2, O_PARTQ = O_CKV + (size_t)T * 256 * 2, O_PARTKV = O_PARTQ + (size_t)T * 8 * 4;
constexpr size_t O_QMLA = O_PARTKV + (size_t)T * 4 * 4, O_KMLA = O_QMLA + (size_t)T * 768 * 2, O_VTMLA = O_KMLA + (size_t)T * 768 * 2, O_FX = O_VTMLA + (size_t)T * 512 * 2;
constexpr size_t O_FT = O_FX + (size_t)65536 * 256 * 2, O_CTXW = O_FT + (size_t)65536 * 256 * 2, O_XC = O_CTXW + (size_t)256 * 1024 * 4, O_AU = O_XC + (size_t)4 * T * 128 * 2;
constexpr size_t O_SUMM = O_AU + (size_t)2 * T * 512 * 4, O_DAO = O_SUMM + (size_t)2 * 260 * 512 * 8, O_UEND = O_DAO + (size_t)T * 1024 * 2;
constexpr size_t O_H = O_U;
constexpr size_t WS_NEED = (O_UEND > O_H + (size_t)T * DFF * 2) ? O_UEND : (O_H + (size_t)T * DFF * 2);

struct Params { const float* in[31]; float* out; unsigned char* ws; int ph_lo, ph_hi; };
enum { I_X = 0, I_C, I_CTX, I_CCTX, I_WADA, I_BADA, I_WIN, I_WOUT, I_LN1G, I_LN1B, I_LN2G, I_LN2B, I_LQ1, I_LK1, I_LQ2, I_LK2, I_SUBLN, I_CONVW, I_CONVB, I_LWR, I_LBR, I_LWI, I_LBI, I_LLAM,
       I_QNG, I_WUQ, I_KVNG, I_WUKV, I_WG, I_WU, I_WD };

__device__ const float INVF[16] = {1.0f, 0.5623413324356079f, 0.3162277638912201f, 0.17782793939113617f, 0.10000000149011612f, 0.05623413249850273f, 0.03162277489900589f, 0.017782794311642647f,
                                   0.009999999776482582f, 0.005623413249850273f, 0.003162277629598975f, 0.0017782794311642647f, 0.0010000000474974513f, 0.000562341301701963f, 0.0003162277571391314f, 0.00017782794020604342f};

struct MapWin { const float* W; int stride;
    __device__ __forceinline__ const float* operator()(int d) const { const int tile = d >> 8, c = d & 255; int src;
        if (tile < 4) src = tile * 256 + swap45(c); else if (tile < 10) src = tile * 256 + c; else if (tile == 10) src = 2560 + c;
        else if (tile == 11) { if (c < 128) src = 2816 + c; else if (c < 192) src = 3200 + swap45(c - 128); else return nullptr; }
        else src = 2944 + c;
        return W + src; } };
struct MapPlain { const float* W; int stride; __device__ __forceinline__ const float* operator()(int d) const { return W + d; } };
struct MapGU { const float* Wg; const float* Wu; int stride;
    __device__ __forceinline__ const float* operator()(int d) const { const int tile = d >> 8, c = d & 255, n = (c >> 4) & 1, f = tile * 128 + 64 * (c >> 7) + 16 * ((c >> 5) & 3) + (c & 15); const long long dl = (const char*)Wu - (const char*)Wg; return (const float*)((const char*)Wg + (long long)n * dl) + f; } };
struct MapUq { const float* W; int stride;
    __device__ __forceinline__ const float* operator()(int d) const { if (d < 512) return W + (d >> 7) * 192 + (d & 127); const int c = d - 512; return W + (c >> 6) * 192 + 128 + swap45(c & 63); } };
struct MapUkv { const float* W; int stride;
    __device__ __forceinline__ const float* operator()(int d) const { if (d < 512) return W + (d >> 7) * 256 + (d & 127); const int e = d - 512; return W + (e >> 7) * 256 + 128 + (e & 127); } };
struct MapLru { const float* Wr; const float* Wi; int stride;
    __device__ __forceinline__ const float* operator()(int c) const { const int n = (c >> 4) & 1, j = 64 * (c >> 7) + 16 * ((c >> 5) & 3) + (c & 15); const long long dl = (const char*)Wi - (const char*)Wr; return (const float*)((const char*)Wr + (long long)n * dl) + j; } };

template <class Map>
__device__ __forceinline__ void tr_job(const Map mp, int Kd, int nrows, bf16_t* WT, const float* kscale, LAS float* scr, int gw, int NGW, int lane) {
    const int nblk = nrows / 32, items = (Kd / 64) * nblk, kr = lane >> 3, c4 = lane & 7;
    f32x4 cur[8], nxt[8];
#define TR_LOAD(dst, it_) do { const int kb_ = (it_) / nblk, nb_ = (it_) % nblk; const float* cp_ = mp(32 * nb_ + 4 * c4); const int st_ = mp.stride; \
        _Pragma("unroll") for (int i_ = 0; i_ < 8; ++i_) dst[i_] = cp_ ? *(const f32x4*)(cp_ + (size_t)(64 * kb_ + kr + 8 * i_) * st_) : (f32x4){0.f, 0.f, 0.f, 0.f}; } while (0)
    int it = gw;
    if (it < items) TR_LOAD(cur, it);
    for (; it < items; it += NGW) {
        const int kb = it / nblk, nb = it % nblk, k0 = 64 * kb, d0 = 32 * nb;
        if (it + NGW < items) TR_LOAD(nxt, it + NGW);
#pragma unroll
        for (int i = 0; i < 8; ++i) { const int kk = kr + 8 * i; f32x4 v = cur[i]; if (kscale) v = v * kscale[k0 + kk];
#pragma unroll
            for (int j = 0; j < 4; ++j) scr[kk * 33 + 4 * c4 + j] = v[j]; }
        asm volatile("s_waitcnt lgkmcnt(0)" ::: "memory");
        const int c = lane & 7;
#pragma unroll
        for (int j = 0; j < 4; ++j) { const int n = (lane >> 3) + 8 * j; const LAS float* sp = scr + (8 * c) * 33 + n;
            u32x4 o; o.x = pk2(sp[0 * 33], sp[1 * 33]); o.y = pk2(sp[2 * 33], sp[3 * 33]); o.z = pk2(sp[4 * 33], sp[5 * 33]); o.w = pk2(sp[6 * 33], sp[7 * 33]);
            *(u32x4*)(WT + (size_t)(d0 + n) * Kd + k0 + 8 * c) = o; }
        asm volatile("s_waitcnt lgkmcnt(0)" ::: "memory");
#pragma unroll
        for (int i = 0; i < 8; ++i) cur[i] = nxt[i];
    }
#undef TR_LOAD
}

#define EPI_ROWS_BEGIN _Pragma("unroll") for (int ai = 0; ai < 2; ++ai) _Pragma("unroll") for (int m = 0; m < 4; ++m) { const int row = u.pm * 256 + ai * 128 + wr * 64 + m * 16 + fr;
#define EPI_ROWS_END asm volatile("" ::: "memory"); __builtin_amdgcn_sched_barrier(0); }
__device__ __forceinline__ void st4bf(bf16_t* p, const f32x4 v) { u32x2 w; w.x = pk2(v[0], v[1]); w.y = pk2(v[2], v[3]); *(u32x2*)p = w; }

struct EpiInproj {
    static constexpr bool PERM = false, AFTER_DRAIN = false;
    bf16_t *QDA, *KDA, *VTDA, *LRUX, *LRUG, *CQ, *CKV, *KMLA, *FX; float *CTXW, *PARTQ, *PARTKV; const float* ROPE;
    __device__ __forceinline__ void rope_cs(int row, int wc, int fq, f32x4& c, f32x4& s) const {
        if (row < NCTX) { c = (f32x4){1.f, 1.f, 1.f, 1.f}; s = (f32x4){0.f, 0.f, 0.f, 0.f}; return; }
        const int nl = row - NCTX, pos = (wc & 1) ? (nl & 63) : (nl >> 6);
        const f32x4 a = *(const f32x4*)(ROPE + (pos * 16 + 4 * fq) * 2), b = *(const f32x4*)(ROPE + (pos * 16 + 4 * fq) * 2 + 4);
        c = (f32x4){a[0], a[2], b[0], b[2]}; s = (f32x4){a[1], a[3], b[1], b[3]};
    }
    __device__ __forceinline__ void operator()(const f32x4 (&acc)[2][2][4][2], const pg8::Unit& u, int wr, int wc, int fr, int fq) const {
        asm volatile("" : "+v"(fr), "+v"(fq));
        const int pn = u.pn;
        if (pn < 4) {
            bf16_t* dst = pn < 2 ? QDA : KDA; const float sc = pn < 2 ? QS_DA : 1.f; const int cb = (pn & 1) * 256 + 64 * (wc >> 1) + 16 * (wc & 1) + 4 * fq;
            EPI_ROWS_BEGIN  f32x4 c, s; rope_cs(row, wc, fq, c, s);
#pragma unroll
                for (int bj = 0; bj < 2; ++bj) { const f32x4 x1 = acc[ai][bj][m][0], x2 = acc[ai][bj][m][1];
                    st4bf(dst + (unsigned)row * 512 + cb + 128 * bj, (x1 * c - x2 * s) * sc); st4bf(dst + (unsigned)row * 512 + cb + 128 * bj + 32, (x1 * s + x2 * c) * sc); }  EPI_ROWS_END
        } else if (pn < 6) {
            EPI_ROWS_BEGIN
#pragma unroll
                for (int bj = 0; bj < 2; ++bj)
#pragma unroll
                    for (int n = 0; n < 2; ++n)
#pragma unroll
                        for (int j = 0; j < 4; ++j) VTDA[(unsigned)((pn - 4) * 256 + 128 * bj + 32 * wc + 16 * n + 4 * fq + j) * T + row] = f2bf(acc[ai][bj][m][n][j]);  EPI_ROWS_END
        } else if (pn < 10) {
            bf16_t* dst = pn < 8 ? LRUX : LRUG; const int cb = (pn & 1) * 256 + 32 * wc + 4 * fq;
            EPI_ROWS_BEGIN
#pragma unroll
                for (int bj = 0; bj < 2; ++bj)
#pragma unroll
                    for (int n = 0; n < 2; ++n) st4bf(dst + (unsigned)row * 512 + cb + 128 * bj + 16 * n, acc[ai][bj][m][n]);  EPI_ROWS_END
        } else if (pn == 10) {
            EPI_ROWS_BEGIN  float ss = 0.f;
#pragma unroll
                for (int bj = 0; bj < 2; ++bj)
#pragma unroll
                    for (int n = 0; n < 2; ++n) { const f32x4 v = acc[ai][bj][m][n]; st4bf(CQ + (unsigned)row * 384 + 128 * bj + 32 * wc + 16 * n + 4 * fq, v); ss += (v[0] * v[0] + v[1] * v[1]) + (v[2] * v[2] + v[3] * v[3]); }
                ss += __shfl_xor(ss, 16); ss += __shfl_xor(ss, 32); if (fq == 0) PARTQ[(unsigned)row * 8 + wc] = ss;  EPI_ROWS_END
        } else if (pn == 11) {
            EPI_ROWS_BEGIN  float ss = 0.f;
#pragma unroll
                for (int n = 0; n < 2; ++n) { const f32x4 v = acc[ai][0][m][n]; st4bf(CQ + (unsigned)row * 384 + 256 + 32 * wc + 16 * n + 4 * fq, v); ss += (v[0] * v[0] + v[1] * v[1]) + (v[2] * v[2] + v[3] * v[3]); }
                ss += __shfl_xor(ss, 16); ss += __shfl_xor(ss, 32); if (fq == 0) PARTQ[(unsigned)row * 8 + 4 + wc] = ss;
                if (wc < 2) { f32x4 c, s; rope_cs(row, wc, fq, c, s); const f32x4 x1 = acc[ai][1][m][0], x2 = acc[ai][1][m][1]; const f32x4 y1 = x1 * c - x2 * s, y2 = x1 * s + x2 * c;
#pragma unroll
                    for (int h = 0; h < 4; ++h) { bf16_t* kp = KMLA + (unsigned)row * 768 + h * 192 + 128 + 16 * (wc & 1) + 4 * fq; st4bf(kp, y1); st4bf(kp + 32, y2); } }  EPI_ROWS_END
        } else if (pn == 12) {
            EPI_ROWS_BEGIN  float ss = 0.f;
#pragma unroll
                for (int bj = 0; bj < 2; ++bj)
#pragma unroll
                    for (int n = 0; n < 2; ++n) { const f32x4 v = acc[ai][bj][m][n]; st4bf(CKV + (unsigned)row * 256 + 128 * bj + 32 * wc + 16 * n + 4 * fq, v); ss += (v[0] * v[0] + v[1] * v[1]) + (v[2] * v[2] + v[3] * v[3]); }
                ss += __shfl_xor(ss, 16); ss += __shfl_xor(ss, 32); if (fq == 0) PARTKV[(unsigned)row * 4 + wc] = ss;  EPI_ROWS_END
        } else {
            const int g = pn - 13;
            if (u.pm == 0) {
                EPI_ROWS_BEGIN
#pragma unroll
                    for (int bj = 0; bj < 2; ++bj)
#pragma unroll
                        for (int n = 0; n < 2; ++n) *(f32x4*)(CTXW + (unsigned)row * 1024 + g * 256 + 128 * bj + 32 * wc + 16 * n + 4 * fq) = acc[ai][bj][m][n];  EPI_ROWS_END
            } else {
                EPI_ROWS_BEGIN  const int nl = row - NCTX, n1 = nl >> 7, n2 = nl & 127;
#pragma unroll
                    for (int bj = 0; bj < 2; ++bj)
#pragma unroll
                        for (int n = 0; n < 2; ++n)
#pragma unroll
                            for (int j = 0; j < 4; ++j) FX[((unsigned)((n2 * 4 + g) * 128 + 32 * wc + 16 * n + 4 * fq + j)) * 256 + bj * 128 + n1] = f2bf(acc[ai][bj][m][n][j]);  EPI_ROWS_END
            }
        }
    }
};

struct EpiUpq {
    static constexpr bool PERM = false, AFTER_DRAIN = false;
    bf16_t* QMLA; const float* PARTQ; const float* ROPE;
    __device__ __forceinline__ void operator()(const f32x4 (&acc)[2][2][4][2], const pg8::Unit& u, int wr, int wc, int fr, int fq) const {
        asm volatile("" : "+v"(fr), "+v"(fq));
        const int pn = u.pn;
        EPI_ROWS_BEGIN  const f32x4 pa = *(const f32x4*)(PARTQ + (unsigned)row * 8), pb = *(const f32x4*)(PARTQ + (unsigned)row * 8 + 4);
            const float f = rsqrtf(((pa[0] + pa[1]) + (pa[2] + pa[3]) + (pb[0] + pb[1]) + (pb[2] + pb[3])) * (1.f / 384.f) + 1e-6f) * QS_MLA;
            if (pn < 2) {
#pragma unroll
                for (int bj = 0; bj < 2; ++bj)
#pragma unroll
                    for (int n = 0; n < 2; ++n) st4bf(QMLA + (unsigned)row * 768 + (2 * pn + bj) * 192 + 32 * wc + 16 * n + 4 * fq, acc[ai][bj][m][n] * f);
            } else {
                f32x4 c, s;
                if (row < NCTX) { c = (f32x4){1.f, 1.f, 1.f, 1.f}; s = (f32x4){0.f, 0.f, 0.f, 0.f}; }
                else { const int nl = row - NCTX, pos = (wc & 1) ? (nl & 63) : (nl >> 6);
                    const f32x4 a = *(const f32x4*)(ROPE + (pos * 16 + 4 * fq) * 2), b = *(const f32x4*)(ROPE + (pos * 16 + 4 * fq) * 2 + 4);
                    c = (f32x4){a[0], a[2], b[0], b[2]}; s = (f32x4){a[1], a[3], b[1], b[3]}; }
#pragma unroll
                for (int bj = 0; bj < 2; ++bj) { const f32x4 x1 = acc[ai][bj][m][0] * f, x2 = acc[ai][bj][m][1] * f; bf16_t* qp = QMLA + (unsigned)row * 768 + (2 * bj + (wc >> 1)) * 192 + 128 + 16 * (wc & 1) + 4 * fq;
                    st4bf(qp, x1 * c - x2 * s); st4bf(qp + 32, x1 * s + x2 * c); }
            }  EPI_ROWS_END
    }
};
struct EpiUpkv {
    static constexpr bool PERM = false, AFTER_DRAIN = false;
    bf16_t *KMLA, *VTMLA; const float* PARTKV;
    __device__ __forceinline__ void operator()(const f32x4 (&acc)[2][2][4][2], const pg8::Unit& u, int wr, int wc, int fr, int fq) const {
        asm volatile("" : "+v"(fr), "+v"(fq));
        const int pn = u.pn;
        EPI_ROWS_BEGIN  const f32x4 pa = *(const f32x4*)(PARTKV + (unsigned)row * 4);
            const float f = rsqrtf(((pa[0] + pa[1]) + (pa[2] + pa[3])) * (1.f / 256.f) + 1e-6f);
            if (pn < 2) {
#pragma unroll
                for (int bj = 0; bj < 2; ++bj)
#pragma unroll
                    for (int n = 0; n < 2; ++n) st4bf(KMLA + (unsigned)row * 768 + (2 * pn + bj) * 192 + 32 * wc + 16 * n + 4 * fq, acc[ai][bj][m][n] * f);
            } else {
#pragma unroll
                for (int bj = 0; bj < 2; ++bj)
#pragma unroll
                    for (int n = 0; n < 2; ++n)
#pragma unroll
                        for (int j = 0; j < 4; ++j) VTMLA[(unsigned)((pn - 2) * 256 + 128 * bj + 32 * wc + 16 * n + 4 * fq + j) * T + row] = f2bf(acc[ai][bj][m][n][j] * f);
            }  EPI_ROWS_END
    }
};
struct LruOrder {
    int G, c;
    __device__ bool next(int i, pg8::Unit& u) const { const long L = (long)i * G + c; if (L >= 520) return false; const int idx = (int)L, pmr = idx % 65, hd = idx / 65; u.pm = (hd >> 1) * 65 + pmr; u.pn = hd; return true; }
    __device__ __forceinline__ void a_ready(const pg8::Unit&) const {}
    __device__ __forceinline__ void done(const pg8::Unit&) const {}
};
__device__ __forceinline__ float neg_expm1(float x) {
    const float ser = -x * (1.f + x * (0.5f + x * (0.16666667f + x * 0.041666667f)));
    return x > -0.125f ? ser : 1.f - __expf(x);
}
struct EpiLru {
    static constexpr bool PERM = false, AFTER_DRAIN = false;
    unsigned* AU; const bf16_t* XC; const float *br, *bi, *c8;
    __device__ __forceinline__ void operator()(const f32x4 (&acc)[2][2][4][2], const pg8::Unit& u, int wr, int wc, int fr, int fq) const {
        asm volatile("" : "+v"(fr), "+v"(fq));
        const int h = u.pn >> 1, d = u.pn & 1, pmr = u.pm - h * 65;
#pragma unroll
        for (int bj = 0; bj < 2; ++bj) { const int chl = 64 * bj + 16 * wc + 4 * fq, ch = d * 512 + h * 128 + chl; const f32x4 vbr = *(const f32x4*)(br + ch), vbi = *(const f32x4*)(bi + ch), vc8 = *(const f32x4*)(c8 + ch);
#pragma unroll
            for (int ai = 0; ai < 2; ++ai)
#pragma unroll
                for (int m = 0; m < 4; ++m) { const int row = pmr * 256 + ai * 128 + wr * 64 + m * 16 + fr; const u32x2 xw = *(const u32x2*)(XC + ((unsigned)h * T + row) * 128 + chl); u32x4 o;
#pragma unroll
                    for (int j = 0; j < 4; ++j) { const float xv = bf2f(j & 1 ? (j < 2 ? xw.x : xw.y) >> 16 : (j < 2 ? xw.x : xw.y) & 0xffffu);
                        const float r = sigmf(acc[ai][bj][m][0][j] + vbr[j]), ig = sigmf(acc[ai][bj][m][1][j] + vbi[j]); const float la = vc8[j] * r;
                        const float uu = sqrtf(neg_expm1(2.f * la)) * (ig * xv); o[j] = pk2(uu, la * LOG2E); }
                    *(u32x4*)(AU + ((unsigned)d * T + row) * 512 + h * 128 + chl) = o; asm volatile("" ::: "memory"); __builtin_amdgcn_sched_barrier(0); } }
    }
};
struct EpiFftA {
    static constexpr bool PERM = false, AFTER_DRAIN = false;
    bf16_t* FT;
    __device__ __forceinline__ void operator()(const f32x4 (&acc)[2][2][4][2], const pg8::Unit& u, int wr, int wc, int fr, int fq) const {
        asm volatile("" : "+v"(fr), "+v"(fq));
        EPI_ROWS_BEGIN const int n2 = row >> 9, gj = row & 511; bf16_t* p0 = FT + ((unsigned)((16 * wc + 4 * fq) * 512 + gj)) * 256 + n2;
#pragma unroll
            for (int bj = 0; bj < 2; ++bj)
#pragma unroll
                for (int j = 0; j < 4; ++j) { bf16_t* p = p0 + (unsigned)(64 * bj + j) * 512 * 256; p[0] = f2bf(acc[ai][bj][m][0][j]); p[128] = f2bf(acc[ai][bj][m][1][j]); } EPI_ROWS_END
    }
};
struct FftCOrder {
    int G, c;
    __device__ bool next(int i, pg8::Unit& u) const { const long L = (long)i * G + c; if (L >= 256) return false; u.pm = (int)L; u.pn = (int)L >> 1; return true; }
    __device__ __forceinline__ void a_ready(const pg8::Unit&) const {}
    __device__ __forceinline__ void done(const pg8::Unit&) const {}
};
struct EpiFftC {
    static constexpr bool PERM = false, AFTER_DRAIN = false;
    bf16_t* MIX;
    __device__ __forceinline__ void operator()(const f32x4 (&acc)[2][2][4][2], const pg8::Unit& u, int wr, int wc, int fr, int fq) const {
        asm volatile("" : "+v"(fr), "+v"(fq));
        EPI_ROWS_BEGIN  const int k1 = row >> 9, gj = row & 511;
#pragma unroll
            for (int n = 0; n < 2; ++n)
#pragma unroll
                for (int j = 0; j < 4; ++j) { const int k2 = 32 * wc + 16 * n + 4 * fq + j; MIX[(unsigned)(NCTX + k1 + 128 * k2) * DM + 1536 + gj] = f2bf(acc[ai][0][m][n][j]); }  EPI_ROWS_END
    }
};
struct EpiRes {
    static constexpr bool PERM = false, AFTER_DRAIN = false;
    const float* xa; const float* xb; float* Y; const float* gate0; const float* gate1; int pm0;
    __device__ __forceinline__ void operator()(const f32x4 (&acc)[2][2][4][2], const pg8::Unit& u_, int wr, int wc, int fr, int fq) const {
        const pg8::Unit u{u_.pm + pm0, u_.pn};
        asm volatile("" : "+v"(fr), "+v"(fq));
        const float* gp = (u.pm == 0 ? gate0 : gate1) + u.pn * 256 + 32 * wc + 4 * fq;
        f32x4 gv[2][2];
#pragma unroll
        for (int bj = 0; bj < 2; ++bj)
#pragma unroll
            for (int n = 0; n < 2; ++n) gv[bj][n] = *(const f32x4*)(gp + 128 * bj + 16 * n);
        EPI_ROWS_BEGIN  const float* xo = (row < NCTX ? xa + (unsigned)row * DM : xb + (unsigned)(row - NCTX) * DM) + u.pn * 256 + 32 * wc + 4 * fq; float* yo = Y + (unsigned)row * DM + u.pn * 256 + 32 * wc + 4 * fq;
#pragma unroll
            for (int bj = 0; bj < 2; ++bj)
#pragma unroll
                for (int n = 0; n < 2; ++n) { const f32x4 xv = *(const f32x4*)(xo + 128 * bj + 16 * n); *(f32x4*)(yo + 128 * bj + 16 * n) = xv * ALPHA + gv[bj][n] * acc[ai][bj][m][n]; }  EPI_ROWS_END
    }
};
struct EpiResAtomic {
    static constexpr bool PERM = false, AFTER_DRAIN = false;
    float* Y; const float* gate;
    __device__ __forceinline__ void operator()(const f32x4 (&acc)[2][2][4][2], const pg8::Unit& u, int wr, int wc, int fr, int fq) const {
        asm volatile("" : "+v"(fr), "+v"(fq));
        const float* gp = gate + u.pn * 256 + 32 * wc + 4 * fq;
        EPI_ROWS_BEGIN float* yo = Y + (unsigned)row * DM + u.pn * 256 + 32 * wc + 4 * fq;
#pragma unroll
            for (int bj = 0; bj < 2; ++bj)
#pragma unroll
                for (int n = 0; n < 2; ++n) { const f32x4 gv = *(const f32x4*)(gp + 128 * bj + 16 * n);
#pragma unroll
                    for (int j = 0; j < 4; ++j) (void)unsafeAtomicAdd(yo + 128 * bj + 16 * n + j, gv[j] * acc[ai][bj][m][n][j]); } EPI_ROWS_END
    }
};
struct EpiGU {
    static constexpr bool PERM = false, AFTER_DRAIN = false;
    bf16_t* H; int pm0;
    __device__ __forceinline__ void operator()(const f32x4 (&acc)[2][2][4][2], const pg8::Unit& u_, int wr, int wc, int fr, int fq) const {
        const pg8::Unit u{u_.pm + pm0, u_.pn};
        asm volatile("" : "+v"(fr), "+v"(fq));
        EPI_ROWS_BEGIN
#pragma unroll
            for (int bj = 0; bj < 2; ++bj) { const f32x4 g = acc[ai][bj][m][0], v = acc[ai][bj][m][1]; f32x4 o;
#pragma unroll
                for (int j = 0; j < 4; ++j) o[j] = siluf(g[j]) * v[j];
                st4bf(H + (unsigned)row * DFF + u.pn * 128 + 64 * bj + 16 * wc + 4 * fq, o); }  EPI_ROWS_END
    }
};

template <int DQK>
__device__ __forceinline__ void attn_unit(const bf16_t* __restrict__ Q, int ldq, const bf16_t* __restrict__ K, int ldk, const bf16_t* __restrict__ Vt, bf16_t* O, int ldo, int q0, int nkeys, LAS unsigned char* lds) {
    constexpr int KS = DQK / 16, KROW = DQK + 8, KCH = DQK / 8, KLD = (64 * KCH) / NTHR, VROW = 72;
    LAS bf16_t* Ks = (LAS bf16_t*)lds; LAS bf16_t* Vs = (LAS bf16_t*)(lds + 2 * 64 * KROW * 2);
    int tid_ = threadIdx.x; asm volatile("" : "+v"(tid_));
    const int tid = tid_, lane = tid & 63, wid = tid >> 6, qi = lane & 31, hi = lane >> 5;
    bf16x8 qf[KS];
    { const bf16_t* qp = Q + (size_t)(q0 + wid * 32 + qi) * ldq + hi * 8;
#pragma unroll
      for (int ks = 0; ks < KS; ++ks) qf[ks] = *(const bf16x8*)(qp + ks * 16); }
    f32x16 o[4];
#pragma unroll
    for (int d0 = 0; d0 < 4; ++d0)
#pragma unroll
        for (int r = 0; r < 16; ++r) o[d0][r] = 0.f;
    float m_run = -1e30f, l_run = 0.f;
    const int NT = nkeys / 64;
    u32x4 kreg[KLD], vreg[2];
#define ATT_LOADK(t) do { _Pragma("unroll") for (int i_ = 0; i_ < KLD; ++i_) { const int c_ = tid + NTHR * i_, r_ = c_ / KCH, cc_ = c_ % KCH; kreg[i_] = *(const u32x4*)(K + (size_t)((t) * 64 + r_) * ldk + cc_ * 8); } } while (0)
#define ATT_LOADV(t) do { _Pragma("unroll") for (int i_ = 0; i_ < 2; ++i_) { const int c_ = tid + NTHR * i_, dv_ = c_ >> 3, k8_ = c_ & 7; vreg[i_] = *(const u32x4*)(Vt + (size_t)dv_ * T + (t) * 64 + k8_ * 8); } } while (0)
#define ATT_STOREK(b) do { _Pragma("unroll") for (int i_ = 0; i_ < KLD; ++i_) { const int c_ = tid + NTHR * i_, r_ = c_ / KCH, cc_ = c_ % KCH; *(LAS u32x4*)(Ks + (b) * 64 * KROW + r_ * KROW + cc_ * 8) = kreg[i_]; } } while (0)
#define ATT_STOREV(b) do { _Pragma("unroll") for (int i_ = 0; i_ < 2; ++i_) { const int c_ = tid + NTHR * i_, dv_ = c_ >> 3, k8_ = c_ & 7; *(LAS u32x4*)(Vs + (b) * 128 * VROW + dv_ * VROW + k8_ * 8) = vreg[i_]; } } while (0)
#define ATT_QK(S0, S1, b) do { const LAS bf16_t* kb_ = Ks + (b) * 64 * KROW + krow * KROW + hi * 8; \
        _Pragma("unroll") for (int r_ = 0; r_ < 16; ++r_) { S0[r_] = 0.f; S1[r_] = 0.f; } \
        _Pragma("unroll") for (int ks_ = 0; ks_ < KS; ++ks_) { const bf16x8 k0_ = *(const LAS bf16x8*)(kb_ + ks_ * 16), k1_ = *(const LAS bf16x8*)(kb_ + 32 * KROW + ks_ * 16); \
            S0 = __builtin_amdgcn_mfma_f32_32x32x16_bf16(k0_, qf[ks_], S0, 0, 0, 0); S1 = __builtin_amdgcn_mfma_f32_32x32x16_bf16(k1_, qf[ks_], S1, 0, 0, 0); } } while (0)
    const int krow = swap23(qi);
    ATT_LOADK(0); ATT_LOADV(0); ATT_STOREK(0); ATT_STOREV(0); ATT_LOADK(1); ATT_STOREK(1); __syncthreads();
    f32x16 s0, s1, n0, n1;
    ATT_QK(s0, s1, 0);
    for (int t = 0; t < NT; ++t) {
        const bool has1 = t + 1 < NT, has2 = t + 2 < NT;
        if (has2) ATT_LOADK(t + 2);
        if (has1) ATT_LOADV(t + 1);
        if (has1) ATT_QK(n0, n1, (t + 1) & 1);
        const LAS bf16_t* vb = Vs + (t & 1) * 128 * VROW + qi * VROW + hi * 8;
        float mx = fmaxf(s0[0], s1[0]);
#pragma unroll
        for (int r = 1; r < 16; ++r) mx = fmaxf(mx, fmaxf(s0[r], s1[r]));
        mx = fmaxf(mx, __shfl_xor(mx, 32));
        if (__any(mx > m_run + 8.f)) {
            const float m_new = fmaxf(m_run, mx), alpha = ex2(m_run - m_new); m_run = m_new; l_run *= alpha;
#pragma unroll
            for (int d0 = 0; d0 < 4; ++d0)
#pragma unroll
                for (int r = 0; r < 16; ++r) o[d0][r] *= alpha;
        }
        float ps = 0.f;
#pragma unroll
        for (int r = 0; r < 16; ++r) { s0[r] = ex2(s0[r] - m_run); s1[r] = ex2(s1[r] - m_run); ps += s0[r] + s1[r]; }
        l_run += ps;
        u32x4 pw[4];
#pragma unroll
        for (int i = 0; i < 4; ++i) { pw[0][i] = pk2(s0[2 * i], s0[2 * i + 1]); pw[1][i] = pk2(s0[8 + 2 * i], s0[8 + 2 * i + 1]); pw[2][i] = pk2(s1[2 * i], s1[2 * i + 1]); pw[3][i] = pk2(s1[8 + 2 * i], s1[8 + 2 * i + 1]); }
#pragma unroll
        for (int sp = 0; sp < 4; ++sp) { const bf16x8 pf = __builtin_bit_cast(bf16x8, pw[sp]);
#pragma unroll
            for (int d0 = 0; d0 < 4; ++d0) { const bf16x8 vf = *(const LAS bf16x8*)(vb + 32 * d0 * VROW + sp * 16); o[d0] = __builtin_amdgcn_mfma_f32_32x32x16_bf16(vf, pf, o[d0], 0, 0, 0); } }
        if (has2) ATT_STOREK(t & 1);
        if (has1) ATT_STOREV((t + 1) & 1);
        __syncthreads();
        s0 = n0; s1 = n1;
    }
#undef ATT_LOADK
#undef ATT_LOADV
#undef ATT_STOREK
#undef ATT_STOREV
#undef ATT_QK
    const float l = l_run + __shfl_xor(l_run, 32), inv = 1.f / l;
    bf16_t* op = O + (size_t)(q0 + wid * 32 + qi) * ldo + 4 * hi;
#pragma unroll
    for (int d0 = 0; d0 < 4; ++d0)
#pragma unroll
        for (int g = 0; g < 4; ++g) { u32x2 w; w.x = pk2(o[d0][4 * g] * inv, o[d0][4 * g + 1] * inv); w.y = pk2(o[d0][4 * g + 2] * inv, o[d0][4 * g + 3] * inv); *(u32x2*)(op + 32 * d0 + 8 * g) = w; }
}

__device__ __forceinline__ void glds16(const void* gsrc, unsigned lds_dst) { unsigned keep;
    asm volatile("s_mov_b32 %0, m0\n\ts_mov_b32 m0, %2\n\ts_nop 0\n\tglobal_load_lds_dwordx4 %1, off\n\ts_mov_b32 m0, %0" : "=&s"(keep) : "v"(gsrc), "s"(lds_dst) : "memory"); }
template <int DQK>
__device__ __forceinline__ void attn_unit_dma(const bf16_t* __restrict__ Q, int ldq, const bf16_t* __restrict__ K, int ldk, const bf16_t* __restrict__ Vt, bf16_t* O, int ldo, int q0, int nkeys, LAS unsigned char* lds) {
    constexpr int KS = DQK / 16, KROW = DQK + 8, KCH = DQK / 8, VROW = 72, KSL = KCH + 1, KCHUNKS = KSL, VCHUNKS = 18, NJ = (KCHUNKS + VCHUNKS + NWV - 1) / NWV;
    constexpr int KBYTES = KCHUNKS * 1024, VBYTES = VCHUNKS * 1024, SLOT = KBYTES + VBYTES, DUMMY = 3 * SLOT;
    static_assert(KROW * 2 == KSL * 16 && 64 * KROW * 2 == KBYTES && 128 * VROW * 2 == VBYTES && DUMMY + 1024 <= LDS_BYTES - 16, "attention LDS image");
    int tid_ = threadIdx.x; asm volatile("" : "+v"(tid_));
    const int tid = tid_, lane = tid & 63, wid = tid >> 6, qi = lane & 31, hi = lane >> 5;
    const int widu = __builtin_amdgcn_readfirstlane(wid);
    const unsigned lds0 = (unsigned)(size_t)lds;
    unsigned goff[NJ];
#pragma unroll
    for (int j = 0; j < NJ; ++j) { const int c = j * NWV + widu;
        if (c < KCHUNKS) { const int sl = c * 64 + lane, r = sl / KSL, cc = sl - r * KSL; goff[j] = (unsigned)(r * ldk + (cc == KCH ? 0 : cc) * 8); }
        else if (c < KCHUNKS + VCHUNKS) { const int sl = (c - KCHUNKS) * 64 + lane, r = sl / 9, cc = sl - r * 9; goff[j] = (unsigned)(r * T + (cc == 8 ? 0 : cc) * 8); }
        else goff[j] = 0u; }
#define AD_DMA(t, slot) do { _Pragma("unroll") for (int j_ = 0; j_ < NJ; ++j_) { const int c_ = j_ * NWV + widu; \
        if (c_ < KCHUNKS) glds16(K + (size_t)(t) * 64 * ldk + goff[j_], lds0 + (slot) * SLOT + c_ * 1024); \
        else if (c_ < KCHUNKS + VCHUNKS) glds16(Vt + (size_t)(t) * 64 + goff[j_], lds0 + (slot) * SLOT + KBYTES + (c_ - KCHUNKS) * 1024); \
        else glds16(K + goff[j_], lds0 + DUMMY); } } while (0)
    bf16x8 qf[KS];
    { const bf16_t* qp = Q + (size_t)(q0 + wid * 32 + qi) * ldq + hi * 8;
#pragma unroll
      for (int ks = 0; ks < KS; ++ks) qf[ks] = *(const bf16x8*)(qp + ks * 16); }
    f32x16 o[4];
#pragma unroll
    for (int d0 = 0; d0 < 4; ++d0)
#pragma unroll
        for (int r = 0; r < 16; ++r) o[d0][r] = 0.f;
    float m_run = -1e30f, l_run = 0.f;
    const int NT = nkeys / 64;
    const int krow = swap23(qi);
    AD_DMA(0, 0); AD_DMA(1, 1);
    asm volatile("s_waitcnt vmcnt(0) lgkmcnt(0)" ::: "memory"); __builtin_amdgcn_s_barrier(); asm volatile("" ::: "memory");
    int slot = 0, slot2 = 2;
    for (int t = 0; t < NT; ++t) {
        if (t + 2 < NT) AD_DMA(t + 2, slot2);
        const LAS bf16_t* kb = (const LAS bf16_t*)(lds + slot * SLOT) + krow * KROW + hi * 8; const LAS bf16_t* vb = (const LAS bf16_t*)(lds + slot * SLOT + KBYTES) + qi * VROW + hi * 8;
        f32x16 s0, s1;
#pragma unroll
        for (int r = 0; r < 16; ++r) { s0[r] = 0.f; s1[r] = 0.f; }
#pragma unroll
        for (int ks = 0; ks < KS; ++ks) { const bf16x8 k0 = *(const LAS bf16x8*)(kb + ks * 16), k1 = *(const LAS bf16x8*)(kb + 32 * KROW + ks * 16);
            s0 = __builtin_amdgcn_mfma_f32_32x32x16_bf16(k0, qf[ks], s0, 0, 0, 0); s1 = __builtin_amdgcn_mfma_f32_32x32x16_bf16(k1, qf[ks], s1, 0, 0, 0); }
        float mx = fmaxf(s0[0], s1[0]);
#pragma unroll
        for (int r = 1; r < 16; ++r) mx = max3f(mx, s0[r], s1[r]);
        mx = fmaxf(mx, __shfl_xor(mx, 32));
        if (__any(mx > m_run + 8.f)) {
            const float m_new = fmaxf(m_run, mx), alpha = ex2(m_run - m_new); m_run = m_new; l_run *= alpha;
#pragma unroll
            for (int d0 = 0; d0 < 4; ++d0)
#pragma unroll
                for (int r = 0; r < 16; ++r) o[d0][r] *= alpha;
        }
        const f32x2_t nm = {-m_run, -m_run}; f32x2_t ps2 = {0.f, 0.f};
        u32x4 pw[4];
#pragma unroll
        for (int i = 0; i < 8; ++i) { f32x2_t e = (f32x2_t){s0[2 * i], s0[2 * i + 1]} + nm, f = (f32x2_t){s1[2 * i], s1[2 * i + 1]} + nm; e[0] = ex2(e[0]); e[1] = ex2(e[1]); f[0] = ex2(f[0]); f[1] = ex2(f[1]);
            ps2 = ps2 + e; ps2 = ps2 + f; pw[i >> 2][i & 3] = pk2(e[0], e[1]); pw[2 + (i >> 2)][i & 3] = pk2(f[0], f[1]); }
        l_run += ps2[0] + ps2[1];
#pragma unroll
        for (int sp = 0; sp < 4; ++sp) { const bf16x8 pf = __builtin_bit_cast(bf16x8, pw[sp]);
#pragma unroll
            for (int d0 = 0; d0 < 4; ++d0) { const bf16x8 vf = *(const LAS bf16x8*)(vb + 32 * d0 * VROW + sp * 16); o[d0] = __builtin_amdgcn_mfma_f32_32x32x16_bf16(vf, pf, o[d0], 0, 0, 0); } }
        if (t + 2 < NT) asm volatile("s_waitcnt vmcnt(%0) lgkmcnt(0)" :: "n"(NJ) : "memory"); else asm volatile("s_waitcnt vmcnt(0) lgkmcnt(0)" ::: "memory");
        __builtin_amdgcn_s_barrier(); asm volatile("" ::: "memory");
        slot2 = slot; slot = slot == 2 ? 0 : slot + 1;
    }
#undef AD_DMA
    const float l = l_run + __shfl_xor(l_run, 32), inv = 1.f / l;
    bf16_t* op = O + (size_t)(q0 + wid * 32 + qi) * ldo + 4 * hi;
#pragma unroll
    for (int d0 = 0; d0 < 4; ++d0)
#pragma unroll
        for (int g = 0; g < 4; ++g) { u32x2 w; w.x = pk2(o[d0][4 * g] * inv, o[d0][4 * g + 1] * inv); w.y = pk2(o[d0][4 * g + 2] * inv, o[d0][4 * g + 3] * inv); *(u32x2*)(op + 32 * d0 + 8 * g) = w; }
}

__device__ __forceinline__ void attn_unit_da(const bf16_t* __restrict__ Q, const bf16_t* __restrict__ K, const bf16_t* __restrict__ Vt, bf16_t* O, int q0, int nkeys, LAS unsigned char* lds) {
    constexpr int KROW = 72, VROW = 72, LDQ = 512, LDO = 1024;
    LAS bf16_t* Ks = (LAS bf16_t*)lds; LAS bf16_t* Vs = (LAS bf16_t*)(lds + 2 * 64 * KROW * 2);
    int tid_ = threadIdx.x; asm volatile("" : "+v"(tid_));
    const int tid = tid_, lane = tid & 63, wid = tid >> 6, qi = lane & 31, hi = lane >> 5, qg = wid >> 1, kh = wid & 1;
    bf16x8 qf[2][4];
#pragma unroll
    for (int qs = 0; qs < 2; ++qs) { const bf16_t* qp = Q + (size_t)(q0 + qg * 64 + qs * 32 + qi) * LDQ + hi * 8;
#pragma unroll
        for (int ks = 0; ks < 4; ++ks) qf[qs][ks] = *(const bf16x8*)(qp + ks * 16); }
    f32x16 o[2][4];
#pragma unroll
    for (int qs = 0; qs < 2; ++qs)
#pragma unroll
        for (int d0 = 0; d0 < 4; ++d0)
#pragma unroll
            for (int r = 0; r < 16; ++r) o[qs][d0][r] = 0.f;
    float m_run[2] = {-1e30f, -1e30f}, l_run[2] = {0.f, 0.f};
    const int NT = nkeys / 64;
    u32x4 kreg, vreg[2];
#define DA_LOADG(t) do { { const int r_ = tid >> 3, cc_ = tid & 7; kreg = *(const u32x4*)(K + (size_t)((t) * 64 + r_) * 512 + cc_ * 8); } \
        _Pragma("unroll") for (int i_ = 0; i_ < 2; ++i_) { const int c_ = tid + NTHR * i_, dv_ = c_ >> 3, k8_ = c_ & 7; vreg[i_] = *(const u32x4*)(Vt + (size_t)dv_ * T + (t) * 64 + k8_ * 8); } } while (0)
#define DA_STOREL(b) do { { const int r_ = tid >> 3, cc_ = tid & 7; *(LAS u32x4*)(Ks + (b) * 64 * KROW + r_ * KROW + cc_ * 8) = kreg; } \
        _Pragma("unroll") for (int i_ = 0; i_ < 2; ++i_) { const int c_ = tid + NTHR * i_, dv_ = c_ >> 3, k8_ = c_ & 7; *(LAS u32x4*)(Vs + (b) * 128 * VROW + dv_ * VROW + k8_ * 8) = vreg[i_]; } } while (0)
    DA_LOADG(0); DA_STOREL(0); __syncthreads();
    const int krow = 32 * kh + swap23(qi);
    for (int t = 0; t < NT; ++t) {
        const int buf = t & 1;
        if (t + 1 < NT) DA_LOADG(t + 1);
        const LAS bf16_t* kb = Ks + buf * 64 * KROW + krow * KROW + hi * 8; const LAS bf16_t* vb = Vs + buf * 128 * VROW + qi * VROW + 32 * kh + hi * 8;
        f32x16 sc[2];
#pragma unroll
        for (int r = 0; r < 16; ++r) { sc[0][r] = 0.f; sc[1][r] = 0.f; }
#pragma unroll
        for (int ks = 0; ks < 4; ++ks) { const bf16x8 kf = *(const LAS bf16x8*)(kb + ks * 16);
            sc[0] = __builtin_amdgcn_mfma_f32_32x32x16_bf16(kf, qf[0][ks], sc[0], 0, 0, 0); sc[1] = __builtin_amdgcn_mfma_f32_32x32x16_bf16(kf, qf[1][ks], sc[1], 0, 0, 0); }
        u32x4 pw[2][2];
#pragma unroll
        for (int qs = 0; qs < 2; ++qs) {
            float mx = sc[qs][0];
#pragma unroll
            for (int r = 1; r < 16; ++r) mx = fmaxf(mx, sc[qs][r]);
            mx = fmaxf(mx, __shfl_xor(mx, 32));
            if (__any(mx > m_run[qs] + 8.f)) {
                const float m_new = fmaxf(m_run[qs], mx), alpha = ex2(m_run[qs] - m_new); m_run[qs] = m_new; l_run[qs] *= alpha;
#pragma unroll
                for (int d0 = 0; d0 < 4; ++d0)
#pragma unroll
                    for (int r = 0; r < 16; ++r) o[qs][d0][r] *= alpha;
            }
            float ps = 0.f;
#pragma unroll
            for (int r = 0; r < 16; ++r) { sc[qs][r] = ex2(sc[qs][r] - m_run[qs]); ps += sc[qs][r]; }
            l_run[qs] += ps;
#pragma unroll
            for (int i = 0; i < 4; ++i) { pw[qs][0][i] = pk2(sc[qs][2 * i], sc[qs][2 * i + 1]); pw[qs][1][i] = pk2(sc[qs][8 + 2 * i], sc[qs][8 + 2 * i + 1]); }
        }
#pragma unroll
        for (int sp = 0; sp < 2; ++sp)
#pragma unroll
            for (int d0 = 0; d0 < 4; ++d0) { const bf16x8 vf = *(const LAS bf16x8*)(vb + 32 * d0 * VROW + sp * 16);
                o[0][d0] = __builtin_amdgcn_mfma_f32_32x32x16_bf16(vf, __builtin_bit_cast(bf16x8, pw[0][sp]), o[0][d0], 0, 0, 0);
                o[1][d0] = __builtin_amdgcn_mfma_f32_32x32x16_bf16(vf, __builtin_bit_cast(bf16x8, pw[1][sp]), o[1][d0], 0, 0, 0); }
        if (t + 1 < NT) DA_STOREL(buf ^ 1);
        __syncthreads();
    }
#undef DA_LOADG
#undef DA_STOREL
    LAS float* xp = (LAS float*)lds + (size_t)qg * (130 * 64) + lane;
#pragma unroll
    for (int qs = 0; qs < 2; ++qs) {
        const float lt = l_run[qs] + __shfl_xor(l_run[qs], 32);
        if (kh == 1) { xp[128 * 64] = m_run[qs]; xp[129 * 64] = lt;
#pragma unroll
            for (int d0 = 0; d0 < 4; ++d0)
#pragma unroll
                for (int r = 0; r < 16; ++r) xp[(d0 * 16 + r) * 64] = o[qs][d0][r]; }
        __syncthreads();
        if (kh == 0) { const float mb = xp[128 * 64], lb = xp[129 * 64];
            const float m = fmaxf(m_run[qs], mb), fa = ex2(m_run[qs] - m), fb = ex2(mb - m), inv = 1.f / (lt * fa + lb * fb), ca = fa * inv, cb = fb * inv;
            bf16_t* op = O + (size_t)(q0 + qg * 64 + qs * 32 + qi) * LDO + 4 * hi;
#pragma unroll
            for (int d0 = 0; d0 < 4; ++d0)
#pragma unroll
                for (int g = 0; g < 4; ++g) { float v[4];
#pragma unroll
                    for (int j = 0; j < 4; ++j) v[j] = o[qs][d0][4 * g + j] * ca + xp[(d0 * 16 + 4 * g + j) * 64] * cb;
                    u32x2 w; w.x = pk2(v[0], v[1]); w.y = pk2(v[2], v[3]); *(u32x2*)(op + 32 * d0 + 8 * g) = w; } }
        __syncthreads();
    }
}

#define XB_TMO      128
#define XB_XCNT(j)  (256  + 64 * (j))
#define XB_XSUB(j)  (1280 + 64 * (j))
#define XB_XGEN(j)  (2304 + 64 * (j))
#define XB_TOP      3328
#define XB_TOPGEN   3392
#define XCD_BAR_WORDS 3456
#define XB_SPIN_CAP (1u << 18)

__device__ __forceinline__ unsigned xb_ld(unsigned* p)              { return __hip_atomic_load(p, __ATOMIC_RELAXED, __HIP_MEMORY_SCOPE_AGENT); }
__device__ __forceinline__ unsigned xb_add(unsigned* p, unsigned v) { return __hip_atomic_fetch_add(p, v, __ATOMIC_RELAXED, __HIP_MEMORY_SCOPE_AGENT); }
__device__ __forceinline__ unsigned xb_xcc_id() { return (unsigned)__builtin_amdgcn_s_getreg((3 << 11) | 20) & 0xFu; }
#define XB_SPIN(cond, bar) do { unsigned _sp = 0; while (cond) { __builtin_amdgcn_s_sleep(1); \
    if ((++_sp & 255u) == 0u) { if (xb_ld(&(bar)[XB_TMO])) break; if (_sp > XB_SPIN_CAP) { atomicAdd(&(bar)[XB_TMO], 1u); break; } } } } while (0)

struct XcdBarrier {
    unsigned* bar; unsigned x;
    volatile LAS unsigned* st;
};

__device__ __forceinline__ XcdBarrier xcd_barrier_post(unsigned* bar, volatile LAS unsigned* st) {
    XcdBarrier b; b.bar = bar; b.x = xb_xcc_id(); b.st = st;
    if (threadIdx.x == 0) (void)xb_add(&bar[XB_XCNT(b.x)], 1u);
    return b;
}
__device__ __forceinline__ void xcd_barrier_complete(unsigned* bar, unsigned x, unsigned& nloc, unsigned& nx) {
    const unsigned G = gridDim.x * gridDim.y * gridDim.z;
    unsigned sum, cnt, mine, sp = 0u;
    for (;;) {
        sum = 0u; cnt = 0u; mine = 0u;
#pragma unroll
        for (unsigned j = 0; j < 16; ++j) { const unsigned c = xb_ld(&bar[XB_XCNT(j)]); sum += c; cnt += (c > 0u) ? 1u : 0u; mine = (j == x) ? c : mine; }
        if (sum == G) break;
        __builtin_amdgcn_s_sleep(1);
        if ((++sp & 255u) == 0u) { if (xb_ld(&bar[XB_TMO])) break; if (sp > XB_SPIN_CAP) { atomicAdd(&bar[XB_TMO], 1u); break; } }
    }
    nloc = mine > 0u ? mine : 1u; nx = cnt > 0u ? cnt : 1u;
}

__device__ __forceinline__ void xcd_barrier(const XcdBarrier& b) {
    asm volatile("s_waitcnt vmcnt(0)" ::: "memory");
    __syncthreads();
    if (threadIdx.x == 0) {
        unsigned* bar = b.bar;
        __builtin_amdgcn_s_waitcnt(0);
        unsigned nloc = b.st[0], nx = b.st[1];
        if (nloc == 0u) { xcd_barrier_complete(bar, b.x, nloc, nx); b.st[0] = nloc; b.st[1] = nx; }
        const unsigned old = xb_add(&bar[XB_XSUB(b.x)], 1u);
        const unsigned gen = old / nloc;
        if (old + 1u == (gen + 1u) * nloc) {
            __builtin_amdgcn_fence(__ATOMIC_RELEASE, "agent");
            asm volatile("s_waitcnt vmcnt(0)" ::: "memory");
            const unsigned og = xb_add(&bar[XB_TOP], 1u);
            const unsigned tg = og / nx;
            if (og + 1u == (tg + 1u) * nx) xb_add(&bar[XB_TOPGEN], 1u);
            else XB_SPIN(xb_ld(&bar[XB_TOPGEN]) == tg, bar);
            __builtin_amdgcn_fence(__ATOMIC_ACQUIRE, "agent");
            xb_add(&bar[XB_XGEN(b.x)], 1u);
            asm volatile("s_waitcnt vmcnt(0)" ::: "memory");
        } else {
            XB_SPIN(xb_ld(&bar[XB_XGEN(b.x)]) == gen, bar);
            __builtin_amdgcn_fence(__ATOMIC_ACQUIRE, "agent");
            asm volatile("s_waitcnt vmcnt(0)" ::: "memory");
        }
    }
    __syncthreads();
}

#define GAS __attribute__((address_space(1)))
#define PIN(i) ((const float*)(const GAS float*)pp->in[i])
#define F1T ((bf16_t*)(ws + O_F1T))
#define F2T ((bf16_t*)(ws + O_F2T))
#define ROPE ((float*)(ws + O_ROPE))
#define C8T ((float*)(ws + O_C8))
#define MODS ((float*)(ws + O_MODS))
#define XMOD ((bf16_t*)(ws + O_XMOD))
#define XRES ((float*)(ws + O_XRES))
#define QDA ((bf16_t*)(ws + O_QDA))
#define KDA ((bf16_t*)(ws + O_KDA))
#define VTDA ((bf16_t*)(ws + O_VTDA))
#define LRUX ((bf16_t*)(ws + O_LRUX))
#define LRUG ((bf16_t*)(ws + O_LRUG))
#define CQ ((bf16_t*)(ws + O_CQ))
#define CKV ((bf16_t*)(ws + O_CKV))
#define PARTQ ((float*)(ws + O_PARTQ))
#define PARTKV ((float*)(ws + O_PARTKV))
#define QMLA ((bf16_t*)(ws + O_QMLA))
#define KMLA ((bf16_t*)(ws + O_KMLA))
#define VTMLA ((bf16_t*)(ws + O_VTMLA))
#define FX ((bf16_t*)(ws + O_FX))
#define FT ((bf16_t*)(ws + O_FT))
#define CTXW ((float*)(ws + O_CTXW))
#define XC ((bf16_t*)(ws + O_XC))
#define AU ((unsigned*)(ws + O_AU))
#define SUMM ((float*)(ws + O_SUMM))
#define DAO ((bf16_t*)(ws + O_DAO))
#define HB ((bf16_t*)(ws + O_H))
#define WIN ((bf16_t*)(wl + O_WIN))
#define WOUT ((bf16_t*)(wl + O_WOUT))
#define WGU ((bf16_t*)(wl + O_WGU))
#define WD ((bf16_t*)(wl + O_WD))
#define WUQ ((bf16_t*)(wl + O_WUQ))
#define WUKV ((bf16_t*)(wl + O_WUKV))
#define WLRU ((bf16_t*)(wl + O_WLRU))
#define MIX XMOD
#define mods_c (MODS + (size_t)(l * 2 + 0) * 12288)
#define mods_l (MODS + (size_t)(l * 2 + 1) * 12288)
__device__ __forceinline__ int chunk_start(int c) { if (c <= 4) return 64 * c; const int cl = c - 4; return NCTX + 65 * cl + (cl < 4 ? cl : 4); }
constexpr int N_PHASES = 22;
template <unsigned MASK>
__global__ void __launch_bounds__(NTHR, 2) mega_fwd(Params P) {
    extern __shared__ __attribute__((aligned(16))) unsigned char lds_raw[];
    LAS unsigned char* lds = (LAS unsigned char*)lds_raw;
    const int tid0 = threadIdx.x;
    const int G0 = gridDim.x, bid0 = blockIdx.x;
    cg::grid_group grid = cg::this_grid();
    volatile LAS unsigned* bst = (volatile LAS unsigned*)(lds + LDS_BYTES - 16);
    if (tid0 < 4) bst[tid0] = 0u;
    __syncthreads();
    XcdBarrier xbar = xcd_barrier_post((unsigned*)(P.ws + O_BAR), bst);

    for (int ph = P.ph_lo; ph < P.ph_hi; ++ph) {
        const __attribute__((address_space(4))) Params* pp = (const __attribute__((address_space(4))) Params*)__builtin_amdgcn_kernarg_segment_ptr(); asm volatile("" : "+s"(pp));
        int tid = tid0; asm volatile("" : "+v"(tid));
        int G = G0, bid = bid0; asm volatile("" : "+s"(G), "+s"(bid));
        const int NGW = G * NWV, NT_ALL = G * NTHR;
        const int lane = tid & 63, wid = __builtin_amdgcn_readfirstlane(tid >> 6), gw = bid * NWV + wid, gtid = bid * NTHR + tid;
        GAS unsigned char* ws = (GAS unsigned char*)pp->ws; asm volatile("" : "+s"(ws));
        const int l = ph >= 2 ? (ph - 2) / 10 : 0, sub = ph >= 2 ? (ph - 2) % 10 : -1;
        GAS unsigned char* wl = ws + (size_t)l * SZ_WLAYER;
        if (EN(0) && ph == 0) {
            for (int rp_ = 0; rp_ < DUP_P0; ++rp_) {
            for (int it = bid; it < 256; it += G) {
                const int ll = it >> 7, g = (it >> 5) & 3, kb = it & 31, k0 = 64 * kb;
                LAS float* wt = (LAS float*)lds; LAS float* tab = wt + 128 * 68;
                const float* wsrc = PIN(I_WIN) + (size_t)ll * DM * INW;
                for (int i = 0; i < 16; ++i) { const int e = tid + NTHR * i, kk = e >> 7, c = e & 127; wt[c * 68 + kk] = wsrc[(size_t)(k0 + kk) * INW + 3264 + 128 * g + c]; }
                if (tid < 128) tab[tid] = cospif((float)tid * (1.f / 64.f)) * RSQ128;
                __syncthreads();
                const int col = tid & 255, part = col >> 7, jj = col & 127, kh = tid >> 8; const int ph0 = part ? 96 : 0;
                bf16_t* dst = (bf16_t*)(ws + (size_t)ll * SZ_WLAYER + O_WIN) + (size_t)((13 + g) * 256 + col) * DM + k0 + 32 * kh;
                f32x4 a[8];
#pragma unroll
                for (int q = 0; q < 8; ++q) a[q] = (f32x4){0.f, 0.f, 0.f, 0.f};
                for (int c = 0; c < 128; ++c) { const float tv = tab[(jj * c + ph0) & 127]; const LAS f32x4* wr4 = (const LAS f32x4*)(wt + c * 68 + 32 * kh);
#pragma unroll
                    for (int q = 0; q < 8; ++q) a[q] += wr4[q] * tv; }
                const float sg = part ? -1.f : 1.f;
#pragma unroll
                for (int q = 0; q < 4; ++q) { u32x4 o; o.x = pk2(a[2 * q][0] * sg, a[2 * q][1] * sg); o.y = pk2(a[2 * q][2] * sg, a[2 * q][3] * sg); o.z = pk2(a[2 * q + 1][0] * sg, a[2 * q + 1][1] * sg); o.w = pk2(a[2 * q + 1][2] * sg, a[2 * q + 1][3] * sg);
                    *(u32x4*)(dst + 8 * q) = o; }
                __syncthreads();
            }
            for (int it = bid; it < 192; it += G) {
                const int ll = it / 96, nc = it % 96;
                LAS float* sv = (LAS float*)lds; LAS float* red = sv + 2 * DM;
                for (int i = tid; i < DM; i += NTHR) { sv[i] = siluf(PIN(I_CCTX)[i]); sv[DM + i] = siluf(PIN(I_C)[i]); }
                __syncthreads();
                const float* wp = PIN(I_WADA) + (size_t)ll * DM * 12288 + 128 * nc + 2 * lane;
                float a00 = 0.f, a01 = 0.f, a10 = 0.f, a11 = 0.f;
                for (int k0 = 256 * wid; k0 < 256 * wid + 256; k0 += 16) { f32x2_t w2[16];
#pragma unroll
                    for (int j = 0; j < 16; ++j) w2[j] = *(const f32x2_t*)(wp + (size_t)(k0 + j) * 12288);
#pragma unroll
                    for (int j = 0; j < 16; ++j) { const float s0 = sv[k0 + j], s1 = sv[DM + k0 + j]; a00 += s0 * w2[j][0]; a01 += s0 * w2[j][1]; a10 += s1 * w2[j][0]; a11 += s1 * w2[j][1]; } }
                red[(wid * 2 + 0) * 128 + 2 * lane] = a00; red[(wid * 2 + 0) * 128 + 2 * lane + 1] = a01; red[(wid * 2 + 1) * 128 + 2 * lane] = a10; red[(wid * 2 + 1) * 128 + 2 * lane + 1] = a11;
                __syncthreads();
                if (tid < 256) { const int v = tid >> 7, cc = tid & 127; float s = PIN(I_BADA)[(size_t)ll * 12288 + 128 * nc + cc];
                    for (int w = 0; w < 8; ++w) s += red[(w * 2 + v) * 128 + cc];
                    MODS[(size_t)(ll * 2 + v) * 12288 + 128 * nc + cc] = s; }
                __syncthreads();
            }
            for (int i = gtid; i < 4096; i += NT_ALL) { const int pos = i >> 4, f = i & 15; const float x = ((float)pos * INVF[f]) * 0.3183098861837907f; ROPE[2 * i] = cospif(x); ROPE[2 * i + 1] = sinpif(x); }
            for (int i = gtid; i < 65536; i += NT_ALL) { const int cp = i >> 8, kk = i & 255, part = kk >> 7, nn = kk & 127;
                const int n = (cp >> 4) & 1, k1 = 64 * (cp >> 7) + 16 * ((cp >> 5) & 3) + (cp & 15); const float ang = (float)((k1 * nn) & 127) * (1.f / 64.f); const float cv = cospif(ang) * RSQ128, sv = sinpif(ang) * RSQ128;
                F1T[i] = f2bf(n == 0 ? (part == 0 ? cv : sv) : (part == 0 ? -sv : cv)); }
            for (int i = gtid; i < 128 * 65536; i += NT_ALL) { const int k1 = i >> 16, cp = (i >> 8) & 255, kk = i & 255, part = kk >> 7, nn = kk & 127;
                float v = 0.f; if (cp < 128) { const float ang = (float)((nn * (k1 + 128 * cp)) & 16383) * (1.f / 8192.f); v = (part == 0 ? cospif(ang) : sinpif(ang)) * RSQ128; } F2T[i] = f2bf(v); }
            for (int i = gtid; i < 2048; i += NT_ALL) C8T[i] = -8.f * log1pf(__expf(-PIN(I_LLAM)[i]));
            LAS float* scr = (LAS float*)(lds + wid * 8704);
            for (int ll = 0; ll < 2; ++ll) {
                GAS unsigned char* wd = ws + (size_t)ll * SZ_WLAYER;
                tr_job(MapWin{PIN(I_WIN) + (size_t)ll * DM * INW, INW}, DM, 13 * 256, (bf16_t*)(wd + O_WIN), nullptr, scr, gw, NGW, lane);
                tr_job(MapPlain{PIN(I_WOUT) + (size_t)ll * DM * DM, DM}, DM, DM, (bf16_t*)(wd + O_WOUT), nullptr, scr, gw, NGW, lane);
                tr_job(MapGU{PIN(I_WG) + (size_t)ll * DM * DFF, PIN(I_WU) + (size_t)ll * DM * DFF, DFF}, DM, 2 * DFF, (bf16_t*)(wd + O_WGU), nullptr, scr, gw, NGW, lane);
                tr_job(MapPlain{PIN(I_WD) + (size_t)ll * DFF * DM, DM}, DFF, DM, (bf16_t*)(wd + O_WD), nullptr, scr, gw, NGW, lane);
                tr_job(MapUq{PIN(I_WUQ) + (size_t)ll * 384 * 768, 768}, 384, 768, (bf16_t*)(wd + O_WUQ), PIN(I_QNG) + ll * 384, scr, gw, NGW, lane);
                tr_job(MapUkv{PIN(I_WUKV) + (size_t)ll * 256 * 1024, 1024}, 256, 1024, (bf16_t*)(wd + O_WUKV), PIN(I_KVNG) + ll * 256, scr, gw, NGW, lane);
                for (int hd = 0; hd < 8; ++hd) { const int h = hd >> 1, d = hd & 1; const size_t wo = ((size_t)(ll * 2 + d) * 4 + h) * 16384;
                    tr_job(MapLru{PIN(I_LWR) + wo, PIN(I_LWI) + wo, 128}, 128, 256, (bf16_t*)(wd + O_WLRU) + (size_t)hd * 256 * 128, nullptr, scr, gw, NGW, lane); }
            }
            __syncthreads(); }
        } else if (EN(1) && ph == 1) {
            for (int row = gw; row < T; row += NGW) { const float* xr = row < NCTX ? PIN(I_CTX) + (size_t)row * DM : PIN(I_X) + (size_t)(row - NCTX) * DM; const float* md = MODS + (size_t)(row < NCTX ? 0 : 1) * 12288;
#pragma unroll
                for (int j = 0; j < 8; ++j) { const int c = 4 * lane + 256 * j; const f32x4 xv = *(const f32x4*)(xr + c), sh = *(const f32x4*)(md + c), sc = *(const f32x4*)(md + DM + c); st4bf(XMOD + (size_t)row * DM + c, xv * (sc + 1.f) + sh); if (row < NCTX) *(f32x4*)(XRES + (size_t)row * DM + c) = xv * ALPHA; } }
        } else if (EN(2) && sub == 0) {
            pg8::Gemm g{XMOD, WIN, T, NIN, DM}; pg8::StaticOrder S; S.init(T, NIN, G, bid);
            EpiInproj E{QDA, KDA, VTDA, LRUX, LRUG, CQ, CKV, KMLA, FX, CTXW, PARTQ, PARTKV, ROPE};
            for (int rg_ = 0; rg_ < DUP_GEMM; ++rg_) pg8::gemm_phase<EpiInproj, pg8::StaticOrder, true, true>(lds, g, S, E);
        } else if (EN(3) && sub == 1) {
            for (int rs_ = 0; rs_ < DUP_S1; ++rs_) {
            if (EN(11)) { const float* cw = PIN(I_CONVW) + (size_t)l * 4 * 512; const float* cbv = PIN(I_CONVB) + (size_t)l * 512;
              for (int idx = gtid; idx < T * 64; idx += NT_ALL) { const int row = idx >> 6, ch0 = (idx & 63) * 8; const int lo = row < NCTX ? 0 : NCTX, hi = row < NCTX ? NCTX : T;
                  float a[8];
#pragma unroll
                  for (int q = 0; q < 8; ++q) a[q] = cbv[ch0 + q];
#pragma unroll
                  for (int j = 0; j < 4; ++j) { const int r = row + j - 2; if (r >= lo && r < hi) { const u32x4 xw = *(const u32x4*)(LRUX + (size_t)r * 512 + ch0); const float* wj = cw + j * 512 + ch0;
#pragma unroll
                      for (int q = 0; q < 4; ++q) { a[2 * q] += wj[2 * q] * bf2f(xw[q] & 0xffffu); a[2 * q + 1] += wj[2 * q + 1] * bf2f(xw[q] >> 16); } } }
                  u32x4 o; o.x = pk2(a[0], a[1]); o.y = pk2(a[2], a[3]); o.z = pk2(a[4], a[5]); o.w = pk2(a[6], a[7]);
                  *(u32x4*)(XC + ((size_t)(ch0 >> 7) * T + row) * 128 + (ch0 & 127)) = o; } }
            if (EN(12)) { pg8::Gemm g{CQ, WUQ, T, 768, 384}; pg8::StaticOrder S; S.init(T, 768, G, bid); EpiUpq E{QMLA, PARTQ, ROPE}; pg8::gemm_phase<EpiUpq, pg8::StaticOrder, true, true>(lds, g, S, E); }
            if (EN(13)) { pg8::Gemm g{CKV, WUKV, T, 1024, 256}; pg8::StaticOrder S; S.init(T, 1024, G, (bid + G - 195 % G) % G);     EpiUpkv E{KMLA, VTMLA, PARTKV}; pg8::gemm_phase<EpiUpkv, pg8::StaticOrder, true, true>(lds, g, S, E); }
            if (EN(14)) { pg8::Gemm g{FX, F1T, 65536, 256, 256}; pg8::StaticOrder S; S.init(65536, 256, G, bid); EpiFftA E{FT}; pg8::gemm_phase<EpiFftA, pg8::StaticOrder, true, true>(lds, g, S, E); }
            __syncthreads();
            if (EN(15)) for (int k = bid; k < 256; k += G) {
                LAS float* tab = (LAS float*)lds; LAS float* red = tab + 256; if (tid < 256) tab[tid] = cospif((float)tid * (1.f / 128.f)) * 0.0625f; __syncthreads();
                const float* wp = CTXW + (lane >> 4) * 256 + (lane & 15) * 8; f32x4 a0 = {0.f, 0.f, 0.f, 0.f}, a1 = a0;
                for (int n0 = 32 * wid; n0 < 32 * wid + 32; n0 += 8) { f32x4 xr[8][2], xi[8][2];
#pragma unroll
                    for (int j = 0; j < 8; ++j) { const float* p = wp + (size_t)(n0 + j) * 1024; xr[j][0] = *(const f32x4*)p; xr[j][1] = *(const f32x4*)(p + 4); xi[j][0] = *(const f32x4*)(p + 128); xi[j][1] = *(const f32x4*)(p + 132); }
#pragma unroll
                    for (int j = 0; j < 8; ++j) { const int mm = (k * (n0 + j)) & 255; const float cv = tab[mm], sv = tab[(mm + 192) & 255]; a0 += xr[j][0] * cv + xi[j][0] * sv; a1 += xr[j][1] * cv + xi[j][1] * sv; } }
                *(LAS f32x4*)(red + wid * 512 + lane * 8) = a0; *(LAS f32x4*)(red + wid * 512 + lane * 8 + 4) = a1;
                __syncthreads();
                { float t = 0.f;
#pragma unroll
                  for (int w = 0; w < 8; ++w) t += red[w * 512 + tid];
                  MIX[(size_t)k * DM + 1536 + tid] = f2bf(t); }
                __syncthreads(); }
            }
        } else if (EN(4) && sub == 2) {
            for (int rep_ = 0; rep_ < DUP_ATTN; ++rep_)
            if (EN(16)) for (int un = bid; un < 520; un += G) { const int hh = un < 512 ? (un & 7) : (un - 512), qb = un < 512 ? 1 + (un >> 3) : 0;
                attn_unit_da(QDA + hh * 64, KDA + hh * 64, VTDA + (size_t)(hh >> 1) * 128 * T, DAO + hh * 128, qb * 256, qb == 0 ? NCTX : T, lds); }
            for (int rs_ = 0; rs_ < DUP_S2; ++rs_) {
            if (EN(17)) { pg8::Gemm g{XC, WLRU, 4 * T, 2048, 128}; LruOrder S{G, bid}; EpiLru E{AU, XC, PIN(I_LBR) + (size_t)l * 1024, PIN(I_LBI) + (size_t)l * 1024, C8T + (size_t)l * 1024};
              pg8::gemm_phase<EpiLru, LruOrder, true, true>(lds, g, S, E); }
            if (EN(18)) { pg8::Gemm g{FT, F2T, 65536, 256, 256}; FftCOrder S{G, bid}; EpiFftC E{MIX}; pg8::gemm_phase<EpiFftC, FftCOrder, true, true>(lds, g, S, E); }
            }
        } else if (EN(5) && sub == 3) {
            for (int rep_ = 0; rep_ < DUP_ATTN; ++rep_)
            for (int un = bid; un < 260; un += G) { const int h = un < 256 ? (un & 3) : (un - 256), qb = un < 256 ? 1 + (un >> 2) : 0;
                if (MLA_DMA) attn_unit_dma<192>(QMLA + h * 192, 768, KMLA + h * 192, 768, VTMLA + (size_t)h * 128 * T, MIX + 1024 + h * 128, DM, qb * 256, qb == 0 ? NCTX : T, lds);
                else attn_unit<192>(QMLA + h * 192, 768, KMLA + h * 192, 768, VTMLA + (size_t)h * 128 * T, MIX + 1024 + h * 128, DM, qb * 256, qb == 0 ? NCTX : T, lds); }
            for (int rs_ = 0; rs_ < DUP_S3; ++rs_)
            for (int un = bid; un < 512; un += G) { const int d = un >> 8, c = un & 255; const int cs = chunk_start(c), len = chunk_start(c + 1) - cs;
                const unsigned* au = AU + (size_t)d * T * 512 + tid; float h = 0.f, S = 0.f;
                for (int i0 = 0; i0 < len; i0 += 16) { unsigned w[16];
#pragma unroll
                    for (int j = 0; j < 16; ++j) { const int i = i0 + j < len ? i0 + j : len - 1; const int row = d == 0 ? cs + i : cs + len - 1 - i; w[j] = au[(size_t)row * 512]; }
#pragma unroll
                    for (int j = 0; j < 16; ++j) if (i0 + j < len) { const float l2a = bf2f(w[j] >> 16), uu = bf2f(w[j] & 0xffffu); h = ex2(l2a) * h + uu; S += l2a; } }
                SUMM[((size_t)(d * 256 + c) * 512 + tid) * 2] = S; SUMM[((size_t)(d * 256 + c) * 512 + tid) * 2 + 1] = h; }
        } else if (EN(6) && sub == 4) {
            for (int rs_ = 0; rs_ < DUP_S4; ++rs_) {
            __syncthreads();
            for (int c = bid; c < 256; c += G) { LAS float* hfs = (LAS float*)lds; const f32x2_t* S0 = (const f32x2_t*)SUMM + tid; const f32x2_t* S1 = S0 + (size_t)256 * 512;
                const int cs = chunk_start(c), len = chunk_start(c + 1) - cs;
                float hf = 0.f, hb = 0.f;
                for (int p0 = 0; p0 < c; p0 += 16) { f32x2_t sv[16];
#pragma unroll
                    for (int j = 0; j < 16; ++j) { const int k = p0 + j < c ? p0 + j : c - 1; sv[j] = S0[(size_t)k * 512]; }
#pragma unroll
                    for (int j = 0; j < 16; ++j) if (p0 + j < c) hf = ex2(sv[j][0]) * hf + sv[j][1]; }
                const int np = c < 4 ? 3 - c : 4 + 255 - c;
                for (int p0 = 0; p0 < np; p0 += 16) { f32x2_t sv[16];
#pragma unroll
                    for (int j = 0; j < 16; ++j) { const int p = p0 + j < np ? p0 + j : np - 1; const int k = p < 4 ? 3 - p : 259 - p; sv[j] = S1[(size_t)k * 512]; }
#pragma unroll
                    for (int j = 0; j < 16; ++j) if (p0 + j < np) hb = ex2(sv[j][0]) * hb + sv[j][1]; }
                const unsigned* a0 = AU + tid; const unsigned* a1 = AU + (size_t)T * 512 + tid;
                for (int i0 = 0; i0 < len; i0 += 16) { unsigned w[16];
#pragma unroll
                    for (int j = 0; j < 16; ++j) { const int i = i0 + j < len ? i0 + j : len - 1; w[j] = a0[(size_t)(cs + i) * 512]; }
#pragma unroll
                    for (int j = 0; j < 16; ++j) if (i0 + j < len) { hf = ex2(bf2f(w[j] >> 16)) * hf + bf2f(w[j] & 0xffffu); hfs[(i0 + j) * 512 + tid] = hf; } }
                for (int i0 = 0; i0 < len; i0 += 16) { unsigned w[16]; bf16_t gg[16];
#pragma unroll
                    for (int j = 0; j < 16; ++j) { const int i = i0 + j < len ? i0 + j : len - 1; const int row = cs + len - 1 - i; w[j] = a1[(size_t)row * 512]; gg[j] = LRUG[(size_t)row * 512 + tid]; }
#pragma unroll
                    for (int j = 0; j < 16; ++j) if (i0 + j < len) { const int ii = len - 1 - (i0 + j); hb = ex2(bf2f(w[j] >> 16)) * hb + bf2f(w[j] & 0xffffu);
                        MIX[(size_t)(cs + ii) * DM + 512 + tid] = f2bf((hfs[ii * 512 + tid] + hb) * gelu_tanh(bf2f(gg[j]))); } } }
            { const float linit = l == 0 ? 0.2f : 0.35550906759096926f;
              const float e1 = __expf(wave_sum(PIN(I_LQ1)[l * 64 + lane] * PIN(I_LK1)[l * 64 + lane])), e2 = __expf(wave_sum(PIN(I_LQ2)[l * 64 + lane] * PIN(I_LK2)[l * 64 + lane])); const float lam = e1 - e2 + linit;
              const float g0 = PIN(I_SUBLN)[l * 128 + 2 * lane] * (1.f - linit), g1 = PIN(I_SUBLN)[l * 128 + 2 * lane + 1] * (1.f - linit);
              for (int row = gw; row < T; row += NGW) { unsigned w1[4], w2[4];
#pragma unroll
                  for (int h = 0; h < 4; ++h) { w1[h] = *(const unsigned*)(DAO + (size_t)row * 1024 + h * 256 + 2 * lane); w2[h] = *(const unsigned*)(DAO + (size_t)row * 1024 + h * 256 + 128 + 2 * lane); }
#pragma unroll
                  for (int h = 0; h < 4; ++h) { const float y0 = bf2f(w1[h] & 0xffffu) - lam * bf2f(w2[h] & 0xffffu), y1 = bf2f(w1[h] >> 16) - lam * bf2f(w2[h] >> 16); const float inv = rsqrtf(wave_sum(y0 * y0 + y1 * y1) * (1.f / 128.f) + 1e-6f);
                      *(unsigned*)(MIX + (size_t)row * DM + h * 128 + 2 * lane) = pk2(y0 * inv * g0, y1 * inv * g1); } } }
            }
        } else if (EN(7) && sub == 5) {
            pg8::Gemm g{MIX + (size_t)256 * DM, WOUT, T - 256, DM, DM}; pg8::StaticOrder S; S.init(T - 256, DM, G, bid);
            EpiRes E{l == 0 ? PIN(I_CTX) : XRES, l == 0 ? PIN(I_X) : XRES + (size_t)NCTX * DM, XRES, mods_c + 2 * DM, mods_l + 2 * DM, 1};
            pg8::gemm_phase<EpiRes, pg8::StaticOrder, true, true>(lds, g, S, E);
            if (l == 0) for (int kp = 0; kp < 4; ++kp) {
                pg8::Gemm gc{MIX + kp * 512, WOUT + kp * 512, 256, DM, 512, DM}; pg8::StaticOrder Sc; Sc.init(256, DM, G, (bid + G - 8 * kp) % G); EpiResAtomic Ec{XRES, mods_c + 2 * DM};
                pg8::gemm_phase<EpiResAtomic, pg8::StaticOrder, true, true>(lds, gc, Sc, Ec); }
        } else if (EN(8) && (sub == 6 || sub == 9)) {
            const bool second = sub == 9, fin = second && l == 1;
            const float* gam = PIN(second ? I_LN2G : I_LN1G) + (size_t)l * DM; const float* bet = PIN(second ? I_LN2B : I_LN1B) + (size_t)l * DM;
#define LN_LOAD(V, R) do { _Pragma("unroll") for (int j_ = 0; j_ < 8; ++j_) V[j_] = *(const f32x4*)(XRES + (size_t)(R) * DM + 4 * lane + 256 * j_); } while (0)
#define LN_ROW(V, R) do { const int row_ = (R); float* yr_ = XRES + (size_t)row_ * DM; float s_ = 0.f; \
                _Pragma("unroll") for (int j_ = 0; j_ < 8; ++j_) s_ += (V[j_][0] + V[j_][1]) + (V[j_][2] + V[j_][3]); \
                const float mean_ = wave_sum(s_) * (1.f / DM); float s2_ = 0.f; \
                _Pragma("unroll") for (int j_ = 0; j_ < 8; ++j_) { V[j_] = V[j_] - mean_; s2_ += (V[j_][0] * V[j_][0] + V[j_][1] * V[j_][1]) + (V[j_][2] * V[j_][2] + V[j_][3] * V[j_][3]); } \
                const float rstd_ = rsqrtf(wave_sum(s2_) * (1.f / DM) + 1e-5f); \
                const float* md_ = second ? MODS + (size_t)((l + 1) * 2 + (row_ < NCTX ? 0 : 1)) * 12288 : MODS + (size_t)(l * 2 + (row_ < NCTX ? 0 : 1)) * 12288 + 3 * DM; \
                float* dst_ = fin ? ((float*)(GAS float*)pp->out) + (size_t)(row_ - NCTX) * DM : yr_; \
                const float rs2_ = (!second && row_ < NCTX) ? ALPHA : 1.f; \
                _Pragma("unroll") for (int j_ = 0; j_ < 8; ++j_) { const int c_ = 4 * lane + 256 * j_; const f32x4 xn_ = V[j_] * rstd_ * *(const f32x4*)(gam + c_) + *(const f32x4*)(bet + c_); *(f32x4*)(dst_ + c_) = xn_ * rs2_; \
                    if (!fin) { const f32x4 sh_ = *(const f32x4*)(md_ + c_), sc_ = *(const f32x4*)(md_ + DM + c_); st4bf(XMOD + (size_t)row_ * DM + c_, xn_ * (sc_ + 1.f) + sh_); } } } while (0)
            { f32x4 va[8], vb[8]; int row = gw + l * NCTX;
#pragma unroll
              for (int j = 0; j < 8; ++j) { va[j] = (f32x4){0.f, 0.f, 0.f, 0.f}; vb[j] = va[j]; }
              if (row < T) LN_LOAD(va, row);
              for (; row < T; row += 2 * NGW) {
                  const bool hb = row + NGW < T;
                  if (hb) LN_LOAD(vb, row + NGW);
                  LN_ROW(va, row);
                  if (row + 2 * NGW < T) LN_LOAD(va, row + 2 * NGW);
                  if (hb) LN_ROW(vb, row + NGW);
              } }
#undef LN_LOAD
#undef LN_ROW
        } else if (EN(9) && sub == 7) {
            pg8::Gemm g{XMOD + (size_t)l * 256 * DM, WGU, T - l * 256, 2 * DFF, DM}; pg8::StaticOrder S; S.init(T - l * 256, 2 * DFF, G, bid); EpiGU E{HB, l};
            for (int rg_ = 0; rg_ < DUP_GEMM; ++rg_) pg8::gemm_phase<EpiGU, pg8::StaticOrder, true, true>(lds, g, S, E);
        } else if (EN(10) && sub == 8) {
            pg8::Gemm g{HB + (size_t)256 * DFF, WD, T - 256, DM, DFF}; pg8::StaticOrder S; S.init(T - 256, DM, G, bid);
            EpiRes E{XRES, XRES + (size_t)NCTX * DM, XRES, mods_c + 5 * DM, mods_l + 5 * DM, 1};
            pg8::gemm_phase<EpiRes, pg8::StaticOrder, true, true>(lds, g, S, E);
            if (l == 0) for (int kp = 0; kp < 4; ++kp) {
                pg8::Gemm gc{HB + kp * 1408, WD + kp * 1408, 256, DM, 1408, DFF}; pg8::StaticOrder Sc; Sc.init(256, DM, G, (bid + G - 8 * kp) % G); EpiResAtomic Ec{XRES, mods_c + 5 * DM};
                pg8::gemm_phase<EpiResAtomic, pg8::StaticOrder, true, true>(lds, gc, Sc, Ec); }
        }
        if (ph + 1 < P.ph_hi) { if (ph == 0) grid.sync(); else xcd_barrier(xbar); }
    }
}

template <unsigned MASK> static void launch_one(int grid, Params p, hipStream_t stream, bool coop) {
    static bool attr_set = false;
    if (!attr_set) { (void)hipFuncSetAttribute((const void*)mega_fwd<MASK>, hipFuncAttributeMaxDynamicSharedMemorySize, LDS_BYTES); attr_set = true; }
    if (coop) { void* args[] = {&p}; hipError_t e = hipLaunchCooperativeKernel((const void*)mega_fwd<MASK>, dim3(grid), dim3(NTHR), args, LDS_BYTES, stream);
        if (e != hipSuccess) fprintf(stderr, "cooperative launch failed: %s (grid %d)\n", hipGetErrorString(e), grid); }
    else hipLaunchKernelGGL(mega_fwd<MASK>, dim3(grid), dim3(NTHR), LDS_BYTES, stream, p);
}
extern "C" void kernel_launch(void* const* d_in, const int* in_sizes, int n_in, void* d_out, int out_size, void* d_ws, size_t ws_size, hipStream_t stream) {
    static int grid = 0;
    if (grid == 0) {
        if (n_in != 31 || ws_size < WS_NEED) { fprintf(stderr, "kernel_launch: need 31 inputs and %zu bytes of workspace; got %d, %zu\n", (size_t)WS_NEED, n_in, ws_size); grid = -1; return; }
        int dev = 0, cus = 0;
        (void)hipGetDevice(&dev); (void)hipDeviceGetAttribute(&cus, hipDeviceAttributeMultiprocessorCount, dev);
        grid = cus;
#if !MK_MULTI
        int per_cu = 0;
        (void)hipFuncSetAttribute((const void*)mega_fwd<PH_MASK>, hipFuncAttributeMaxDynamicSharedMemorySize, LDS_BYTES);
        (void)hipOccupancyMaxActiveBlocksPerMultiprocessor(&per_cu, (const void*)mega_fwd<PH_MASK>, NTHR, LDS_BYTES);
        if (per_cu < 1) fprintf(stderr, "kernel_launch: occupancy query returned %d\n", per_cu);
        (void)hipGetLastError();
#endif
    }
    if (grid < 0) return;
    Params p{};
    for (int i = 0; i < 31; ++i) p.in[i] = (const float*)d_in[i];
    p.out = (float*)d_out; p.ws = (unsigned char*)d_ws;
#if MK_MULTI
#define L1(ph, mask) do { p.ph_lo = (ph); p.ph_hi = (ph) + 1; launch_one<(mask)>(grid, p, stream, false); } while (0)
    L1(0, 1u); L1(1, 2u);
    for (int l = 0; l < 2; ++l) { const int b = 2 + 10 * l;
        L1(b + 0, 1u << 2); L1(b + 1, (1u << 3) | (1u << 11) | (1u << 12) | (1u << 13)); L1(b + 1, (1u << 3) | (1u << 14) | (1u << 15));
        L1(b + 2, (1u << 4) | (1u << 16)); L1(b + 2, (1u << 4) | (1u << 17)); L1(b + 2, (1u << 4) | (1u << 18));
        L1(b + 3, 1u << 5); L1(b + 4, 1u << 6); L1(b + 5, 1u << 7); L1(b + 6, 1u << 8); L1(b + 7, 1u << 9); L1(b + 8, 1u << 10); L1(b + 9, 1u << 8); }
#else
    p.ph_lo = 0; p.ph_hi = N_PHASES;
    (void)hipMemsetAsync((unsigned char*)d_ws + O_BAR, 0, 16384, stream);
    launch_one<PH_MASK>(grid, p, stream, true);
#endif
}
```

```cpp
#include <hip/hip_runtime.h>
#include <hip/hip_cooperative_groups.h>
#include <cstdio>
#include <cstdint>
namespace cg = cooperative_groups;
#ifndef PH_MASK
#define PH_MASK 0xfffff
#endif
#define EN(k) (((MASK) >> (k)) & 1u)
#ifndef DUP_ATTN
#define DUP_ATTN 1
#endif
#ifndef DUP_S1
#define DUP_S1 1
#endif
#ifndef DUP_S2
#define DUP_S2 1
#endif
#ifndef DUP_S3
#define DUP_S3 1
#endif
#ifndef DUP_S4
#define DUP_S4 1
#endif
#ifndef DUP_GEMM
#define DUP_GEMM 1
#endif
#ifndef DUP_P0
#define DUP_P0 1
#endif
#ifndef MLA_DMA
#define MLA_DMA 1
#endif
#ifndef MK_MULTI
#define MK_MULTI 0
#endif
namespace pg8 {
#define PG8_LAS __attribute__((address_space(3)))
typedef unsigned short bf16_t;
typedef short bf16x8 __attribute__((ext_vector_type(8)));
typedef float f32x4 __attribute__((ext_vector_type(4)));
typedef unsigned u32x4 __attribute__((ext_vector_type(4)));
constexpr int BM = 256, BK = 64, HALF = 128, HTB = HALF * BK * 2  , STAGE_BYTES = 8 * HTB, NXCD = 8, WGM = 8;

__host__ __device__ __forceinline__ int lds_byte(int r, int c) { const int st = (r >> 4) * 2 + (c >> 5), rr = r & 15, cc = c & 31, ob = rr * 64 + cc * 2; return st * 1024 + (ob ^ (((ob >> 9) & 1) << 5)); }
__host__ __device__ __forceinline__ void stage_rc(int b, int& R, int& C) { const int st = b / 1024, sb = b % 1024, swz = sb ^ (((sb >> 9) & 1) << 5); R = (st >> 1) * 16 + swz / 64; C = (st & 1) * 32 + (swz % 64) / 2; }
__host__ __device__ __forceinline__ int perm32(int rho) { const int n = rho >> 4, i = rho & 15; return 8 * (i >> 2) + 4 * n + (i & 3); }

struct Unit { int pm, pn; };
struct Gemm { const bf16_t* A; const bf16_t* Bt; int M, N, K; int ld; };

struct StaticOrder {
    int nM, nN, nwg, G, c;
    __host__ __device__ void init(int M, int N, int G_, int c_) { nM = M / BM; nN = N / BM; nwg = nM * nN; G = G_; c = c_; }
    __host__ __device__ bool next(int i, Unit& u) const {
        const long L = (long)i * G + c; if (L >= nwg) return false;
        int wgid = (int)L; { const int q = nwg / NXCD, r = nwg % NXCD, xcd = wgid % NXCD, off = wgid / NXCD; wgid = (xcd < r ? xcd * (q + 1) : r * (q + 1) + (xcd - r) * q) + off; }
        const int nig = WGM * nN, gid = wgid / nig, fm = gid * WGM, gsz = (nM - fm) < WGM ? (nM - fm) : WGM;
        u.pm = fm + ((wgid % nig) % gsz); u.pn = (wgid % nig) / gsz; return true;
    }
    __device__ __forceinline__ void a_ready(const Unit&) const {}
    __device__ __forceinline__ void done(const Unit&) const {}
};

template <class Epi, class Sched, bool ALIGN_EPI = false, bool SP2 = false>
__device__ __forceinline__ void gemm_phase(PG8_LAS unsigned char* lds, const Gemm g, const Sched& S, const Epi& E) {
    int tid_ = threadIdx.x; asm volatile("" : "+v"(tid_));
    const int tid = tid_, wid = __builtin_amdgcn_readfirstlane(tid >> 6), lane = tid & 63, wr = wid >> 2, wc = wid & 3, fr = lane & 15, fq = lane >> 4;
    int K_ = g.K; asm volatile("" : "+s"(K_));
    const int K = K_, nt = K / BK; int LD_ = g.ld ? g.ld : g.K; asm volatile("" : "+s"(LD_)); const int LD = LD_;
    unsigned voffA[2], voffB[2];
#pragma unroll
    for (int i = 0; i < 2; ++i) { int R, C; stage_rc(tid * 16 + i * 8192, R, C); const int Rb = Epi::PERM ? ((R & ~31) + perm32(R & 31)) : R;
        voffA[i] = (unsigned)(R * LD + C) * 2u; voffB[i] = (unsigned)(Rb * LD + C) * 2u; }
    const size_t kstep = (size_t)(BK * 2);
    const size_t hstep = (size_t)HALF * LD * 2;
    const size_t tstep = 2 * hstep;
    const unsigned ldsw = (unsigned)wid * 1024u;
    const int aoff = lds_byte(wr * 64 + fr, fq * 8), boff = lds_byte(wc * 32 + fr, fq * 8);
#define PG8_SA(b, h) (((b) * 2 + (h)) * HTB)
#define PG8_SB(b, h) ((4 + (b) * 2 + (h)) * HTB)
#define PG8_STAGE(bufoff, gbase, voff) do { _Pragma("unroll") for (int _i = 0; _i < 2; ++_i) \
        __builtin_amdgcn_global_load_lds((const unsigned*)((const char*)(gbase) + (voff)[_i]), (PG8_LAS unsigned*)(lds + (bufoff) + ldsw + _i * 8192), 16, 0, 0); } while (0)
#define PG8_LDA(dst, b, h) do { _Pragma("unroll") for (int m = 0; m < 4; ++m) _Pragma("unroll") for (int k = 0; k < 2; ++k) dst[m][k] = *(const PG8_LAS bf16x8*)(lds + PG8_SA(b, h) + aoff + m * 2048 + k * 1024); } while (0)
#define PG8_LDB(dst, b, h) do { _Pragma("unroll") for (int n = 0; n < 2; ++n) _Pragma("unroll") for (int k = 0; k < 2; ++k) dst[n][k] = *(const PG8_LAS bf16x8*)(lds + PG8_SB(b, h) + boff + n * 2048 + k * 1024); } while (0)
#define PG8_MMA(ai, bj, At, Bt) do { __builtin_amdgcn_s_setprio(1); _Pragma("unroll") for (int m = 0; m < 4; ++m) _Pragma("unroll") for (int n = 0; n < 2; ++n) _Pragma("unroll") for (int k = 0; k < 2; ++k) \
        acc[ai][bj][m][n] = __builtin_amdgcn_mfma_f32_16x16x32_bf16(Bt[n][k], At[m][k], acc[ai][bj][m][n], 0, 0, 0); __builtin_amdgcn_s_setprio(0); } while (0)
#define PG8_WAIT_V(n) asm volatile("s_waitcnt vmcnt(" #n ")" ::: "memory")
#define PG8_WAIT_L(n) asm volatile("s_waitcnt lgkmcnt(" #n ")" ::: "memory")
#define PG8_BAR __builtin_amdgcn_s_barrier()
#define PG8_SCHED __builtin_amdgcn_sched_barrier(0)
    Unit cur, nxt; int ui = 0;
    if (!S.next(0, cur)) return;
    f32x4 acc[2][2][4][2];
#pragma unroll
    for (int a = 0; a < 2; ++a)
#pragma unroll
        for (int b = 0; b < 2; ++b)
#pragma unroll
            for (int m = 0; m < 4; ++m)
#pragma unroll
                for (int n = 0; n < 2; ++n) acc[a][b][m][n] = (f32x4){0.f, 0.f, 0.f, 0.f};
    bf16x8 At[4][2], B0[2][2], B1[2][2];
    const char* cA = (const char*)g.A + (size_t)cur.pm * tstep; const char* cB = (const char*)g.Bt + (size_t)cur.pn * tstep;
    S.a_ready(cur);
    if constexpr (SP2) {
        PG8_STAGE(PG8_SB(0, 0), cB, voffB); PG8_STAGE(PG8_SB(0, 1), cB + hstep, voffB); PG8_STAGE(PG8_SA(0, 0), cA, voffA); PG8_STAGE(PG8_SA(0, 1), cA + hstep, voffA);
        if (wr == 1) PG8_BAR;
        PG8_WAIT_V(2); PG8_BAR;
        PG8_STAGE(PG8_SB(1, 0), cB + kstep, voffB); PG8_STAGE(PG8_SA(1, 0), cA + kstep, voffA); PG8_STAGE(PG8_SB(1, 1), cB + hstep + kstep, voffB);
        PG8_WAIT_V(6); PG8_BAR;
    } else {
        PG8_STAGE(PG8_SB(0, 0), cB, voffB); PG8_STAGE(PG8_SA(0, 0), cA, voffA); PG8_STAGE(PG8_SB(0, 1), cB + hstep, voffB); PG8_STAGE(PG8_SA(0, 1), cA + hstep, voffA);
        if (wr == 1) PG8_BAR;
        PG8_WAIT_V(4); PG8_BAR;
        PG8_STAGE(PG8_SB(1, 0), cB + kstep, voffB); PG8_STAGE(PG8_SA(1, 0), cA + kstep, voffA); PG8_STAGE(PG8_SB(1, 1), cB + hstep + kstep, voffB);
        PG8_WAIT_V(6); PG8_BAR;
    }
    for (;;) {
        const bool has_next = S.next(ui + 1, nxt);
        const char* nA = has_next ? (const char*)g.A + (size_t)nxt.pm * tstep : cA; const char* nB = has_next ? (const char*)g.Bt + (size_t)nxt.pn * tstep : cB;
        for (int t = 0; t < nt; t += 2) {
            const bool last = (t == nt - 2);
            const char* a1 = cA + (size_t)(t + 1) * kstep;
            const char* a2 = last ? nA : cA + (size_t)(t + 2) * kstep; const char* b2 = last ? nB : cB + (size_t)(t + 2) * kstep;
            const char* a3 = a2 + kstep; const char* b3 = b2 + kstep;
            if (last && has_next) S.a_ready(nxt);
            if constexpr (SP2) {
            PG8_LDB(B0, 0, 0); PG8_LDB(B1, 0, 1); PG8_SCHED; PG8_LDA(At, 0, 0); PG8_STAGE(PG8_SA(1, 1), a1 + hstep, voffA);
            PG8_WAIT_V(8); PG8_WAIT_L(0); PG8_BAR; PG8_MMA(0, 0, At, B0); PG8_MMA(0, 1, At, B1); PG8_BAR; PG8_SCHED;
            PG8_LDA(At, 0, 1); PG8_STAGE(PG8_SB(0, 0), b2, voffB); PG8_STAGE(PG8_SB(0, 1), b2 + hstep, voffB); PG8_STAGE(PG8_SA(0, 0), a2, voffA);
            PG8_WAIT_V(8); PG8_WAIT_L(0); PG8_BAR; PG8_MMA(1, 0, At, B0); PG8_MMA(1, 1, At, B1); PG8_BAR; PG8_SCHED;
            PG8_LDB(B0, 1, 0); PG8_LDB(B1, 1, 1); PG8_SCHED; PG8_LDA(At, 1, 0); PG8_STAGE(PG8_SA(0, 1), a2 + hstep, voffA);
            PG8_WAIT_V(8); PG8_WAIT_L(0); PG8_BAR; PG8_MMA(0, 0, At, B0); PG8_MMA(0, 1, At, B1); PG8_BAR; PG8_SCHED;
            PG8_LDA(At, 1, 1); PG8_STAGE(PG8_SB(1, 0), b3, voffB); PG8_STAGE(PG8_SB(1, 1), b3 + hstep, voffB); PG8_STAGE(PG8_SA(1, 0), a3, voffA);
            PG8_WAIT_V(8); PG8_WAIT_L(0); PG8_BAR; PG8_MMA(1, 0, At, B0); PG8_MMA(1, 1, At, B1); PG8_BAR; PG8_SCHED;
            } else {
            PG8_LDB(B0, 0, 0); PG8_SCHED; PG8_LDA(At, 0, 0); PG8_STAGE(PG8_SA(1, 1), a1 + hstep, voffA);
            PG8_WAIT_L(8); PG8_BAR; PG8_WAIT_L(0); PG8_MMA(0, 0, At, B0); PG8_BAR; PG8_SCHED;
            PG8_LDB(B1, 0, 1); PG8_STAGE(PG8_SB(0, 0), b2, voffB);
            PG8_BAR; PG8_WAIT_L(0); PG8_MMA(0, 1, At, B1); PG8_BAR;
            PG8_LDA(At, 0, 1); PG8_STAGE(PG8_SA(0, 0), a2, voffA);
            PG8_BAR; PG8_WAIT_L(0); PG8_MMA(1, 0, At, B0); PG8_BAR; PG8_SCHED;
            PG8_STAGE(PG8_SB(0, 1), b2 + hstep, voffB);
            PG8_WAIT_V(6); PG8_BAR; PG8_MMA(1, 1, At, B1); PG8_BAR;
            PG8_LDB(B0, 1, 0); PG8_SCHED; PG8_LDA(At, 1, 0); PG8_STAGE(PG8_SA(0, 1), a2 + hstep, voffA);
            PG8_WAIT_L(8); PG8_BAR; PG8_WAIT_L(0); PG8_MMA(0, 0, At, B0); PG8_BAR; PG8_SCHED;
            PG8_LDB(B1, 1, 1); PG8_STAGE(PG8_SB(1, 0), b3, voffB);
            PG8_BAR; PG8_WAIT_L(0); PG8_MMA(0, 1, At, B1); PG8_BAR;
            PG8_LDA(At, 1, 1); PG8_STAGE(PG8_SA(1, 0), a3, voffA);
            PG8_BAR; PG8_WAIT_L(0); PG8_MMA(1, 0, At, B0); PG8_BAR; PG8_SCHED;
            PG8_STAGE(PG8_SB(1, 1), b3 + hstep, voffB);
            PG8_WAIT_V(6); PG8_BAR; PG8_MMA(1, 1, At, B1); PG8_BAR;
            }
        }
        if constexpr (ALIGN_EPI) { if (wr == 0) PG8_BAR; }
        if constexpr (!Epi::AFTER_DRAIN) { E(acc, cur, wr, wc, fr, fq); S.done(cur); }
        if (!has_next) break;
#pragma unroll
        for (int a = 0; a < 2; ++a)
#pragma unroll
            for (int b = 0; b < 2; ++b)
#pragma unroll
                for (int m = 0; m < 4; ++m)
#pragma unroll
                    for (int n = 0; n < 2; ++n) acc[a][b][m][n] = (f32x4){0.f, 0.f, 0.f, 0.f};
        cur = nxt; cA = nA; cB = nB; ++ui;
        if constexpr (ALIGN_EPI) { if (wr == 1) PG8_BAR; }
    }
    PG8_WAIT_V(0);
    if constexpr (!ALIGN_EPI) { if (wr == 0) PG8_BAR; }
    PG8_BAR;
    if constexpr (Epi::AFTER_DRAIN) { E.fused(acc, cur, wr, wc, fr, fq, lds, wid, lane); S.done(cur); }
#undef PG8_SA
#undef PG8_SB
#undef PG8_STAGE
#undef PG8_LDA
#undef PG8_LDB
#undef PG8_MMA
#undef PG8_WAIT_V
#undef PG8_WAIT_L
#undef PG8_BAR
#undef PG8_SCHED
}
}

using pg8::bf16_t; using pg8::bf16x8; using pg8::f32x4; using pg8::u32x4;
typedef float f32x16 __attribute__((ext_vector_type(16)));
typedef unsigned u32x2 __attribute__((ext_vector_type(2)));
typedef float f32x2_t __attribute__((ext_vector_type(2)));
typedef __bf16 bf16x2_t __attribute__((ext_vector_type(2)));
#define LAS __attribute__((address_space(3)))

constexpr int T = 16640, NCTX = 256, DM = 2048, DFF = 5632, NIN = 4352, INW = 3776;
constexpr int NTHR = 512, NWV = 8;
constexpr float ALPHA = 1.4142135623730951f;
constexpr float LOG2E = 1.4426950408889634f;
constexpr float QS_DA = 0.125f * 1.4426950408889634f;
constexpr float QS_MLA = (float)(0.07216878364870323 * 1.4426950408889634);
constexpr float RSQ128 = 0.08838834764831845f;
constexpr int LDS_BYTES = 147456;

__device__ __forceinline__ unsigned pk2(float lo, float hi) { f32x2_t v = {lo, hi}; bf16x2_t b = __builtin_convertvector(v, bf16x2_t); return __builtin_bit_cast(unsigned, b); }
__device__ __forceinline__ bf16_t f2bf(float f) { return (bf16_t)(pk2(f, 0.f) & 0xffffu); }
__device__ __forceinline__ float bf2f(unsigned b) { return __uint_as_float(b << 16); }
__device__ __forceinline__ float ex2(float x) { return __builtin_amdgcn_exp2f(x); }
__device__ __forceinline__ float max3f(float a, float b, float c) { return __builtin_fmaxf(__builtin_fmaxf(a, b), c); }
__device__ __forceinline__ int swap45(int o) { return (o & ~0x30) | ((o & 0x20) >> 1) | ((o & 0x10) << 1); }
__device__ __forceinline__ int swap23(int o) { return (o & ~0xC) | ((o & 0x4) << 1) | ((o & 0x8) >> 1); }
__device__ __forceinline__ float wave_sum(float v) {
#pragma unroll
    for (int o = 1; o < 64; o <<= 1) v += __shfl_xor(v, o);
    return v;
}
__device__ __forceinline__ float siluf(float x) { return x / (1.f + __expf(-x)); }
__device__ __forceinline__ float sigmf(float x) { return 1.f / (1.f + __expf(-x)); }
__device__ __forceinline__ float gelu_tanh(float x) { const float t = tanhf(0.7978845608028654f * (x + 0.044715f * x * x * x)); return 0.5f * x * (1.f + t); }

constexpr size_t al256(size_t x) { return (x + 255) & ~(size_t)255; }
constexpr size_t SZ_WIN = (size_t)NIN * DM * 2, SZ_WOUT = (size_t)DM * DM * 2, SZ_WGU = (size_t)2 * DFF * DM * 2, SZ_WD = (size_t)DM * DFF * 2;
constexpr size_t SZ_WUQ = (size_t)768 * 384 * 2, SZ_WUKV = (size_t)1024 * 256 * 2, SZ_WLRU = (size_t)8 * 256 * 128 * 2;
constexpr size_t O_WIN = 0, O_WOUT = O_WIN + SZ_WIN, O_WGU = O_WOUT + SZ_WOUT, O_WD = O_WGU + SZ_WGU, O_WUQ = O_WD + SZ_WD, O_WUKV = O_WUQ + SZ_WUQ, O_WLRU = O_WUKV + SZ_WUKV;
constexpr size_t SZ_WLAYER = O_WLRU + SZ_WLRU;
constexpr size_t O_F1T = 2 * SZ_WLAYER, O_F2T = O_F1T + 131072, O_ROPE = O_F2T + (size_t)128 * 131072, O_C8 = O_ROPE + 32768, O_MODS = O_C8 + 8192, O_BAR = al256(O_MODS + 2 * 2 * 12288 * 4), O_XMOD = al256(O_BAR + 16384);
constexpr size_t O_XRES = O_XMOD + (size_t)T * DM * 2, O_U = O_XRES + (size_t)T * DM * 4;
constexpr size_t O_QDA = O_U, O_KDA = O_QDA + (size_t)T * 512 * 2, O_VTDA = O_KDA + (size_t)T * 512 * 2, O_LRUX = O_VTDA + (size_t)T * 512 * 2, O_LRUG = O_LRUX + (size_t)T * 512 * 2;
constexpr size_t O_CQ = O_LRUG + (size_t)T * 512 * 2, O_CKV = O_CQ + (size_t)T * 384 * 2, O_PARTQ = O_CKV + (size_t)T * 256 * 2, O_PARTKV = O_PARTQ + (size_t)T * 8 * 4;
constexpr size_t O_QMLA = O_PARTKV + (size_t)T * 4 * 4, O_KMLA = O_QMLA + (size_t)T * 768 * 2, O_VTMLA = O_KMLA + (size_t)T * 768 * 2, O_FX = O_VTMLA + (size_t)T * 512 * 2;
constexpr size_t O_FT = O_FX + (size_t)65536 * 256 * 2, O_CTXW = O_FT + (size_t)65536 * 256 * 2, O_XC = O_CTXW + (size_t)256 * 1024 * 4, O_AU = O_XC + (size_t)4 * T * 128 * 2;
constexpr size_t O_SUMM = O_AU + (size_t)2 * T * 512 * 4, O_DAO = O_SUMM + (size_t)2 * 260 * 512 * 8, O_UEND = O_DAO + (size_t)T * 1024 * 2;
constexpr size_t O_H = O_U;
constexpr size_t WS_NEED = (O_UEND > O_H + (size_t)T * DFF * 2) ? O_UEND : (O_H + (size_t)T * DFF * 2);

struct Params { const float* in[31]; float* out; unsigned char* ws; int ph_lo, ph_hi; };
enum { I_X = 0, I_C, I_CTX, I_CCTX, I_WADA, I_BADA, I_WIN, I_WOUT, I_LN1G, I_LN1B, I_LN2G, I_LN2B, I_LQ1, I_LK1, I_LQ2, I_LK2, I_SUBLN, I_CONVW, I_CONVB, I_LWR, I_LBR, I_LWI, I_LBI, I_LLAM,
       I_QNG, I_WUQ, I_KVNG, I_WUKV, I_WG, I_WU, I_WD };

__device__ const float INVF[16] = {1.0f, 0.5623413324356079f, 0.3162277638912201f, 0.17782793939113617f, 0.10000000149011612f, 0.05623413249850273f, 0.03162277489900589f, 0.017782794311642647f,
                                   0.009999999776482582f, 0.005623413249850273f, 0.003162277629598975f, 0.0017782794311642647f, 0.0010000000474974513f, 0.000562341301701963f, 0.0003162277571391314f, 0.00017782794020604342f};

struct MapWin { const float* W; int stride;
    __device__ __forceinline__ const float* operator()(int d) const { const int tile = d >> 8, c = d & 255; int src;
        if (tile < 4) src = tile * 256 + swap45(c); else if (tile < 10) src = tile * 256 + c; else if (tile == 10) src = 2560 + c;
        else if (tile == 11) { if (c < 128) src = 2816 + c; else if (c < 192) src = 3200 + swap45(c - 128); else return nullptr; }
        else src = 2944 + c;
        return W + src; } };
struct MapPlain { const float* W; int stride; __device__ __forceinline__ const float* operator()(int d) const { return W + d; } };
struct MapGU { const float* Wg; const float* Wu; int stride;
    __device__ __forceinline__ const float* operator()(int d) const { const int tile = d >> 8, c = d & 255, n = (c >> 4) & 1, f = tile * 128 + 64 * (c >> 7) + 16 * ((c >> 5) & 3) + (c & 15); const long long dl = (const char*)Wu - (const char*)Wg; return (const float*)((const char*)Wg + (long long)n * dl) + f; } };
struct MapUq { const float* W; int stride;
    __device__ __forceinline__ const float* operator()(int d) const { if (d < 512) return W + (d >> 7) * 192 + (d & 127); const int c = d - 512; return W + (c >> 6) * 192 + 128 + swap45(c & 63); } };
struct MapUkv { const float* W; int stride;
    __device__ __forceinline__ const float* operator()(int d) const { if (d < 512) return W + (d >> 7) * 256 + (d & 127); const int e = d - 512; return W + (e >> 7) * 256 + 128 + (e & 127); } };
struct MapLru { const float* Wr; const float* Wi; int stride;
    __device__ __forceinline__ const float* operator()(int c) const { const int n = (c >> 4) & 1, j = 64 * (c >> 7) + 16 * ((c >> 5) & 3) + (c & 15); const long long dl = (const char*)Wi - (const char*)Wr; return (const float*)((const char*)Wr + (long long)n * dl) + j; } };

template <class Map>
__device__ __forceinline__ void tr_job(const Map mp, int Kd, int nrows, bf16_t* WT, const float* kscale, LAS float* scr, int gw, int NGW, int lane) {
    const int nblk = nrows / 32, items = (Kd / 64) * nblk, kr = lane >> 3, c4 = lane & 7;
    f32x4 cur[8], nxt[8];
#define TR_LOAD(dst, it_) do { const int kb_ = (it_) / nblk, nb_ = (it_) % nblk; const float* cp_ = mp(32 * nb_ + 4 * c4); const int st_ = mp.stride; \
        _Pragma("unroll") for (int i_ = 0; i_ < 8; ++i_) dst[i_] = cp_ ? *(const f32x4*)(cp_ + (size_t)(64 * kb_ + kr + 8 * i_) * st_) : (f32x4){0.f, 0.f, 0.f, 0.f}; } while (0)
    int it = gw;
    if (it < items) TR_LOAD(cur, it);
    for (; it < items; it += NGW) {
        const int kb = it / nblk, nb = it % nblk, k0 = 64 * kb, d0 = 32 * nb;
        if (it + NGW < items) TR_LOAD(nxt, it + NGW);
#pragma unroll
        for (int i = 0; i < 8; ++i) { const int kk = kr + 8 * i; f32x4 v = cur[i]; if (kscale) v = v * kscale[k0 + kk];
#pragma unroll
            for (int j = 0; j < 4; ++j) scr[kk * 33 + 4 * c4 + j] = v[j]; }
        asm volatile("s_waitcnt lgkmcnt(0)" ::: "memory");
        const int c = lane & 7;
#pragma unroll
        for (int j = 0; j < 4; ++j) { const int n = (lane >> 3) + 8 * j; const LAS float* sp = scr + (8 * c) * 33 + n;
            u32x4 o; o.x = pk2(sp[0 * 33], sp[1 * 33]); o.y = pk2(sp[2 * 33], sp[3 * 33]); o.z = pk2(sp[4 * 33], sp[5 * 33]); o.w = pk2(sp[6 * 33], sp[7 * 33]);
            *(u32x4*)(WT + (size_t)(d0 + n) * Kd + k0 + 8 * c) = o; }
        asm volatile("s_waitcnt lgkmcnt(0)" ::: "memory");
#pragma unroll
        for (int i = 0; i < 8; ++i) cur[i] = nxt[i];
    }
#undef TR_LOAD
}

#define EPI_ROWS_BEGIN _Pragma("unroll") for (int ai = 0; ai < 2; ++ai) _Pragma("unroll") for (int m = 0; m < 4; ++m) { const int row = u.pm * 256 + ai * 128 + wr * 64 + m * 16 + fr;
#define EPI_ROWS_END asm volatile("" ::: "memory"); __builtin_amdgcn_sched_barrier(0); }
__device__ __forceinline__ void st4bf(bf16_t* p, const f32x4 v) { u32x2 w; w.x = pk2(v[0], v[1]); w.y = pk2(v[2], v[3]); *(u32x2*)p = w; }

struct EpiInproj {
    static constexpr bool PERM = false, AFTER_DRAIN = false;
    bf16_t *QDA, *KDA, *VTDA, *LRUX, *LRUG, *CQ, *CKV, *KMLA, *FX; float *CTXW, *PARTQ, *PARTKV; const float* ROPE;
    __device__ __forceinline__ void rope_cs(int row, int wc, int fq, f32x4& c, f32x4& s) const {
        if (row < NCTX) { c = (f32x4){1.f, 1.f, 1.f, 1.f}; s = (f32x4){0.f, 0.f, 0.f, 0.f}; return; }
        const int nl = row - NCTX, pos = (wc & 1) ? (nl & 63) : (nl >> 6);
        const f32x4 a = *(const f32x4*)(ROPE + (pos * 16 + 4 * fq) * 2), b = *(const f32x4*)(ROPE + (pos * 16 + 4 * fq) * 2 + 4);
        c = (f32x4){a[0], a[2], b[0], b[2]}; s = (f32x4){a[1], a[3], b[1], b[3]};
    }
    __device__ __forceinline__ void operator()(const f32x4 (&acc)[2][2][4][2], const pg8::Unit& u, int wr, int wc, int fr, int fq) const {
        asm volatile("" : "+v"(fr), "+v"(fq));
        const int pn = u.pn;
        if (pn < 4) {
            bf16_t* dst = pn < 2 ? QDA : KDA; const float sc = pn < 2 ? QS_DA : 1.f; const int cb = (pn & 1) * 256 + 64 * (wc >> 1) + 16 * (wc & 1) + 4 * fq;
            EPI_ROWS_BEGIN  f32x4 c, s; rope_cs(row, wc, fq, c, s);
#pragma unroll
                for (int bj = 0; bj < 2; ++bj) { const f32x4 x1 = acc[ai][bj][m][0], x2 = acc[ai][bj][m][1];
                    st4bf(dst + (unsigned)row * 512 + cb + 128 * bj, (x1 * c - x2 * s) * sc); st4bf(dst + (unsigned)row * 512 + cb + 128 * bj + 32, (x1 * s + x2 * c) * sc); }  EPI_ROWS_END
        } else if (pn < 6) {
            EPI_ROWS_BEGIN
#pragma unroll
                for (int bj = 0; bj < 2; ++bj)
#pragma unroll
                    for (int n = 0; n < 2; ++n)
#pragma unroll
                        for (int j = 0; j < 4; ++j) VTDA[(unsigned)((pn - 4) * 256 + 128 * bj + 32 * wc + 16 * n + 4 * fq + j) * T + row] = f2bf(acc[ai][bj][m][n][j]);  EPI_ROWS_END
        } else if (pn < 10) {
            bf16_t* dst = pn < 8 ? LRUX : LRUG; const int cb = (pn & 1) * 256 + 32 * wc + 4 * fq;
            EPI_ROWS_BEGIN
#pragma unroll
                for (int bj = 0; bj < 2; ++bj)
#pragma unroll
                    for (int n = 0; n < 2; ++n) st4bf(dst + (unsigned)row * 512 + cb + 128 * bj + 16 * n, acc[ai][bj][m][n]);  EPI_ROWS_END
        } else if (pn == 10) {
            EPI_ROWS_BEGIN  float ss = 0.f;
#pragma unroll
                for (int bj = 0; bj < 2; ++bj)
#pragma unroll
                    for (int n = 0; n < 2; ++n) { const f32x4 v = acc[ai][bj][m][n]; st4bf(CQ + (unsigned)row * 384 + 128 * bj + 32 * wc + 16 * n + 4 * fq, v); ss += (v[0] * v[0] + v[1] * v[1]) + (v[2] * v[2] + v[3] * v[3]); }
                ss += __shfl_xor(ss, 16); ss += __shfl_xor(ss, 32); if (fq == 0) PARTQ[(unsigned)row * 8 + wc] = ss;  EPI_ROWS_END
        } else if (pn == 11) {
            EPI_ROWS_BEGIN  float ss = 0.f;
#pragma unroll
                for (int n = 0; n < 2; ++n) { const f32x4 v = acc[ai][0][m][n]; st4bf(CQ + (unsigned)row * 384 + 256 + 32 * wc + 16 * n + 4 * fq, v); ss += (v[0] * v[0] + v[1] * v[1]) + (v[2] * v[2] + v[3] * v[3]); }
                ss += __shfl_xor(ss, 16); ss += __shfl_xor(ss, 32); if (fq == 0) PARTQ[(unsigned)row * 8 + 4 + wc] = ss;
                if (wc < 2) { f32x4 c, s; rope_cs(row, wc, fq, c, s); const f32x4 x1 = acc[ai][1][m][0], x2 = acc[ai][1][m][1]; const f32x4 y1 = x1 * c - x2 * s, y2 = x1 * s + x2 * c;
#pragma unroll
                    for (int h = 0; h < 4; ++h) { bf16_t* kp = KMLA + (unsigned)row * 768 + h * 192 + 128 + 16 * (wc & 1) + 4 * fq; st4bf(kp, y1); st4bf(kp + 32, y2); } }  EPI_ROWS_END
        } else if (pn == 12) {
            EPI_ROWS_BEGIN  float ss = 0.f;
#pragma unroll
                for (int bj = 0; bj < 2; ++bj)
#pragma unroll
                    for (int n = 0; n < 2; ++n) { const f32x4 v = acc[ai][bj][m][n]; st4bf(CKV + (unsigned)row * 256 + 128 * bj + 32 * wc + 16 * n + 4 * fq, v); ss += (v[0] * v[0] + v[1] * v[1]) + (v[2] * v[2] + v[3] * v[3]); }
                ss += __shfl_xor(ss, 16); ss += __shfl_xor(ss, 32); if (fq == 0) PARTKV[(unsigned)row * 4 + wc] = ss;  EPI_ROWS_END
        } else {
            const int g = pn - 13;
            if (u.pm == 0) {
                EPI_ROWS_BEGIN
#pragma unroll
                    for (int bj = 0; bj < 2; ++bj)
#pragma unroll
                        for (int n = 0; n < 2; ++n) *(f32x4*)(CTXW + (unsigned)row * 1024 + g * 256 + 128 * bj + 32 * wc + 16 * n + 4 * fq) = acc[ai][bj][m][n];  EPI_ROWS_END
            } else {
                EPI_ROWS_BEGIN  const int nl = row - NCTX, n1 = nl >> 7, n2 = nl & 127;
#pragma unroll
                    for (int bj = 0; bj < 2; ++bj)
#pragma unroll
                        for (int n = 0; n < 2; ++n)
#pragma unroll
                            for (int j = 0; j < 4; ++j) FX[((unsigned)((n2 * 4 + g) * 128 + 32 * wc + 16 * n + 4 * fq + j)) * 256 + bj * 128 + n1] = f2bf(acc[ai][bj][m][n][j]);  EPI_ROWS_END
            }
        }
    }
};

struct EpiUpq {
    static constexpr bool PERM = false, AFTER_DRAIN = false;
    bf16_t* QMLA; const float* PARTQ; const float* ROPE;
    __device__ __forceinline__ void operator()(const f32x4 (&acc)[2][2][4][2], const pg8::Unit& u, int wr, int wc, int fr, int fq) const {
        asm volatile("" : "+v"(fr), "+v"(fq));
        const int pn = u.pn;
        EPI_ROWS_BEGIN  const f32x4 pa = *(const f32x4*)(PARTQ + (unsigned)row * 8), pb = *(const f32x4*)(PARTQ + (unsigned)row * 8 + 4);
            const float f = rsqrtf(((pa[0] + pa[1]) + (pa[2] + pa[3]) + (pb[0] + pb[1]) + (pb[2] + pb[3])) * (1.f / 384.f) + 1e-6f) * QS_MLA;
            if (pn < 2) {
#pragma unroll
                for (int bj = 0; bj < 2; ++bj)
#pragma unroll
                    for (int n = 0; n < 2; ++n) st4bf(QMLA + (unsigned)row * 768 + (2 * pn + bj) * 192 + 32 * wc + 16 * n + 4 * fq, acc[ai][bj][m][n] * f);
            } else {
                f32x4 c, s;
                if (row < NCTX) { c = (f32x4){1.f, 1.f, 1.f, 1.f}; s = (f32x4){0.f, 0.f, 0.f, 0.f}; }
                else { const int nl = row - NCTX, pos = (wc & 1) ? (nl & 63) : (nl >> 6);
                    const f32x4 a = *(const f32x4*)(ROPE + (pos * 16 + 4 * fq) * 2), b = *(const f32x4*)(ROPE + (pos * 16 + 4 * fq) * 2 + 4);
                    c = (f32x4){a[0], a[2], b[0], b[2]}; s = (f32x4){a[1], a[3], b[1], b[3]}; }
#pragma unroll
                for (int bj = 0; bj < 2; ++bj) { const f32x4 x1 = acc[ai][bj][m][0] * f, x2 = acc[ai][bj][m][1] * f; bf16_t* qp = QMLA + (unsigned)row * 768 + (2 * bj + (wc >> 1)) * 192 + 128 + 16 * (wc & 1) + 4 * fq;
                    st4bf(qp, x1 * c - x2 * s); st4bf(qp + 32, x1 * s + x2 * c); }
            }  EPI_ROWS_END
    }
};
struct EpiUpkv {
    static constexpr bool PERM = false, AFTER_DRAIN = false;
    bf16_t *KMLA, *VTMLA; const float* PARTKV;
    __device__ __forceinline__ void operator()(const f32x4 (&acc)[2][2][4][2], const pg8::Unit& u, int wr, int wc, int fr, int fq) const {
        asm volatile("" : "+v"(fr), "+v"(fq));
        const int pn = u.pn;
        EPI_ROWS_BEGIN  const f32x4 pa = *(const f32x4*)(PARTKV + (unsigned)row * 4);
            const float f = rsqrtf(((pa[0] + pa[1]) + (pa[2] + pa[3])) * (1.f / 256.f) + 1e-6f);
            if (pn < 2) {
#pragma unroll
                for (int bj = 0; bj < 2; ++bj)
#pragma unroll
                    for (int n = 0; n < 2; ++n) st4bf(KMLA + (unsigned)row * 768 + (2 * pn + bj) * 192 + 32 * wc + 16 * n + 4 * fq, acc[ai][bj][m][n] * f);
            } else {
#pragma unroll
                for (int bj = 0; bj < 2; ++bj)
#pragma unroll
                    for (int n = 0; n < 2; ++n)
#pragma unroll
                        for (int j = 0; j < 4; ++j) VTMLA[(unsigned)((pn - 2) * 256 + 128 * bj + 32 * wc + 16 * n + 4 * fq + j) * T + row] = f2bf(acc[ai][bj][m][n][j] * f);
            }  EPI_ROWS_END
    }
};
struct LruOrder {
    int G, c;
    __device__ bool next(int i, pg8::Unit& u) const { const long L = (long)i * G + c; if (L >= 520) return false; const int idx = (int)L, pmr = idx % 65, hd = idx / 65; u.pm = (hd >> 1) * 65 + pmr; u.pn = hd; return true; }
    __device__ __forceinline__ void a_ready(const pg8::Unit&) const {}
    __device__ __forceinline__ void done(const pg8::Unit&) const {}
};
__device__ __forceinline__ float neg_expm1(float x) {
    const float ser = -x * (1.f + x * (0.5f + x * (0.16666667f + x * 0.041666667f)));
    return x > -0.125f ? ser : 1.f - __expf(x);
}
struct EpiLru {
    static constexpr bool PERM = false, AFTER_DRAIN = false;
    unsigned* AU; const bf16_t* XC; const float *br, *bi, *c8;
    __device__ __forceinline__ void operator()(const f32x4 (&acc)[2][2][4][2], const pg8::Unit& u, int wr, int wc, int fr, int fq) const {
        asm volatile("" : "+v"(fr), "+v"(fq));
        const int h = u.pn >> 1, d = u.pn & 1, pmr = u.pm - h * 65;
#pragma unroll
        for (int bj = 0; bj < 2; ++bj) { const int chl = 64 * bj + 16 * wc + 4 * fq, ch = d * 512 + h * 128 + chl; const f32x4 vbr = *(const f32x4*)(br + ch), vbi = *(const f32x4*)(bi + ch), vc8 = *(const f32x4*)(c8 + ch);
#pragma unroll
            for (int ai = 0; ai < 2; ++ai)
#pragma unroll
                for (int m = 0; m < 4; ++m) { const int row = pmr * 256 + ai * 128 + wr * 64 + m * 16 + fr; const u32x2 xw = *(const u32x2*)(XC + ((unsigned)h * T + row) * 128 + chl); u32x4 o;
#pragma unroll
                    for (int j = 0; j < 4; ++j) { const float xv = bf2f(j & 1 ? (j < 2 ? xw.x : xw.y) >> 16 : (j < 2 ? xw.x : xw.y) & 0xffffu);
                        const float r = sigmf(acc[ai][bj][m][0][j] + vbr[j]), ig = sigmf(acc[ai][bj][m][1][j] + vbi[j]); const float la = vc8[j] * r;
                        const float uu = sqrtf(neg_expm1(2.f * la)) * (ig * xv); o[j] = pk2(uu, la * LOG2E); }
                    *(u32x4*)(AU + ((unsigned)d * T + row) * 512 + h * 128 + chl) = o; asm volatile("" ::: "memory"); __builtin_amdgcn_sched_barrier(0); } }
    }
};
struct EpiFftA {
    static constexpr bool PERM = false, AFTER_DRAIN = false;
    bf16_t* FT;
    __device__ __forceinline__ void operator()(const f32x4 (&acc)[2][2][4][2], const pg8::Unit& u, int wr, int wc, int fr, int fq) const {
        asm volatile("" : "+v"(fr), "+v"(fq));
        EPI_ROWS_BEGIN const int n2 = row >> 9, gj = row & 511; bf16_t* p0 = FT + ((unsigned)((16 * wc + 4 * fq) * 512 + gj)) * 256 + n2;
#pragma unroll
            for (int bj = 0; bj < 2; ++bj)
#pragma unroll
                for (int j = 0; j < 4; ++j) { bf16_t* p = p0 + (unsigned)(64 * bj + j) * 512 * 256; p[0] = f2bf(acc[ai][bj][m][0][j]); p[128] = f2bf(acc[ai][bj][m][1][j]); } EPI_ROWS_END
    }
};
struct FftCOrder {
    int G, c;
    __device__ bool next(int i, pg8::Unit& u) const { const long L = (long)i * G + c; if (L >= 256) return false; u.pm = (int)L; u.pn = (int)L >> 1; return true; }
    __device__ __forceinline__ void a_ready(const pg8::Unit&) const {}
    __device__ __forceinline__ void done(const pg8::Unit&) const {}
};
struct EpiFftC {
    static constexpr bool PERM = false, AFTER_DRAIN = false;
    bf16_t* MIX;
    __device__ __forceinline__ void operator()(const f32x4 (&acc)[2][2][4][2], const pg8::Unit& u, int wr, int wc, int fr, int fq) const {
        asm volatile("" : "+v"(fr), "+v"(fq));
        EPI_ROWS_BEGIN  const int k1 = row >> 9, gj = row & 511;
#pragma unroll
            for (int n = 0; n < 2; ++n)
#pragma unroll
                for (int j = 0; j < 4; ++j) { const int k2 = 32 * wc + 16 * n + 4 * fq + j; MIX[(unsigned)(NCTX + k1 + 128 * k2) * DM + 1536 + gj] = f2bf(acc[ai][0][m][n][j]); }  EPI_ROWS_END
    }
};
struct EpiRes {
    static constexpr bool PERM = false, AFTER_DRAIN = false;
    const float* xa; const float* xb; float* Y; const float* gate0; const float* gate1; int pm0;
    __device__ __forceinline__ void operator()(const f32x4 (&acc)[2][2][4][2], const pg8::Unit& u_, int wr, int wc, int fr, int fq) const {
        const pg8::Unit u{u_.pm + pm0, u_.pn};
        asm volatile("" : "+v"(fr), "+v"(fq));
        const float* gp = (u.pm == 0 ? gate0 : gate1) + u.pn * 256 + 32 * wc + 4 * fq;
        f32x4 gv[2][2];
#pragma unroll
        for (int bj = 0; bj < 2; ++bj)
#pragma unroll
            for (int n = 0; n < 2; ++n) gv[bj][n] = *(const f32x4*)(gp + 128 * bj + 16 * n);
        EPI_ROWS_BEGIN  const float* xo = (row < NCTX ? xa + (unsigned)row * DM : xb + (unsigned)(row - NCTX) * DM) + u.pn * 256 + 32 * wc + 4 * fq; float* yo = Y + (unsigned)row * DM + u.pn * 256 + 32 * wc + 4 * fq;
#pragma unroll
            for (int bj = 0; bj < 2; ++bj)
#pragma unroll
                for (int n = 0; n < 2; ++n) { const f32x4 xv = *(const f32x4*)(xo + 128 * bj + 16 * n); *(f32x4*)(yo + 128 * bj + 16 * n) = xv * ALPHA + gv[bj][n] * acc[ai][bj][m][n]; }  EPI_ROWS_END
    }
};
struct EpiResAtomic {
    static constexpr bool PERM = false, AFTER_DRAIN = false;
    float* Y; const float* gate;
    __device__ __forceinline__ void operator()(const f32x4 (&acc)[2][2][4][2], const pg8::Unit& u, int wr, int wc, int fr, int fq) const {
        asm volatile("" : "+v"(fr), "+v"(fq));
        const float* gp = gate + u.pn * 256 + 32 * wc + 4 * fq;
        EPI_ROWS_BEGIN float* yo = Y + (unsigned)row * DM + u.pn * 256 + 32 * wc + 4 * fq;
#pragma unroll
            for (int bj = 0; bj < 2; ++bj)
#pragma unroll
                for (int n = 0; n < 2; ++n) { const f32x4 gv = *(const f32x4*)(gp + 128 * bj + 16 * n);
#pragma unroll
                    for (int j = 0; j < 4; ++j) (void)unsafeAtomicAdd(yo + 128 * bj + 16 * n + j, gv[j] * acc[ai][bj][m][n][j]); } EPI_ROWS_END
    }
};
struct EpiGU {
    static constexpr bool PERM = false, AFTER_DRAIN = false;
    bf16_t* H; int pm0;
    __device__ __forceinline__ void operator()(const f32x4 (&acc)[2][2][4][2], const pg8::Unit& u_, int wr, int wc, int fr, int fq) const {
        const pg8::Unit u{u_.pm + pm0, u_.pn};
        asm volatile("" : "+v"(fr), "+v"(fq));
        EPI_ROWS_BEGIN
#pragma unroll
            for (int bj = 0; bj < 2; ++bj) { const f32x4 g = acc[ai][bj][m][0], v = acc[ai][bj][m][1]; f32x4 o;
#pragma unroll
                for (int j = 0; j < 4; ++j) o[j] = siluf(g[j]) * v[j];
                st4bf(H + (unsigned)row * DFF + u.pn * 128 + 64 * bj + 16 * wc + 4 * fq, o); }  EPI_ROWS_END
    }
};

template <int DQK>
__device__ __forceinline__ void attn_unit(const bf16_t* __restrict__ Q, int ldq, const bf16_t* __restrict__ K, int ldk, const bf16_t* __restrict__ Vt, bf16_t* O, int ldo, int q0, int nkeys, LAS unsigned char* lds) {
    constexpr int KS = DQK / 16, KROW = DQK + 8, KCH = DQK / 8, KLD = (64 * KCH) / NTHR, VROW = 72;
    LAS bf16_t* Ks = (LAS bf16_t*)lds; LAS bf16_t* Vs = (LAS bf16_t*)(lds + 2 * 64 * KROW * 2);
    int tid_ = threadIdx.x; asm volatile("" : "+v"(tid_));
    const int tid = tid_, lane = tid & 63, wid = tid >> 6, qi = lane & 31, hi = lane >> 5;
    bf16x8 qf[KS];
    { const bf16_t* qp = Q + (size_t)(q0 + wid * 32 + qi) * ldq + hi * 8;
#pragma unroll
      for (int ks = 0; ks < KS; ++ks) qf[ks] = *(const bf16x8*)(qp + ks * 16); }
    f32x16 o[4];
#pragma unroll
    for (int d0 = 0; d0 < 4; ++d0)
#pragma unroll
        for (int r = 0; r < 16; ++r) o[d0][r] = 0.f;
    float m_run = -1e30f, l_run = 0.f;
    const int NT = nkeys / 64;
    u32x4 kreg[KLD], vreg[2];
#define ATT_LOADK(t) do { _Pragma("unroll") for (int i_ = 0; i_ < KLD; ++i_) { const int c_ = tid + NTHR * i_, r_ = c_ / KCH, cc_ = c_ % KCH; kreg[i_] = *(const u32x4*)(K + (size_t)((t) * 64 + r_) * ldk + cc_ * 8); } } while (0)
#define ATT_LOADV(t) do { _Pragma("unroll") for (int i_ = 0; i_ < 2; ++i_) { const int c_ = tid + NTHR * i_, dv_ = c_ >> 3, k8_ = c_ & 7; vreg[i_] = *(const u32x4*)(Vt + (size_t)dv_ * T + (t) * 64 + k8_ * 8); } } while (0)
#define ATT_STOREK(b) do { _Pragma("unroll") for (int i_ = 0; i_ < KLD; ++i_) { const int c_ = tid + NTHR * i_, r_ = c_ / KCH, cc_ = c_ % KCH; *(LAS u32x4*)(Ks + (b) * 64 * KROW + r_ * KROW + cc_ * 8) = kreg[i_]; } } while (0)
#define ATT_STOREV(b) do { _Pragma("unroll") for (int i_ = 0; i_ < 2; ++i_) { const int c_ = tid + NTHR * i_, dv_ = c_ >> 3, k8_ = c_ & 7; *(LAS u32x4*)(Vs + (b) * 128 * VROW + dv_ * VROW + k8_ * 8) = vreg[i_]; } } while (0)
#define ATT_QK(S0, S1, b) do { const LAS bf16_t* kb_ = Ks + (b) * 64 * KROW + krow * KROW + hi * 8; \
        _Pragma("unroll") for (int r_ = 0; r_ < 16; ++r_) { S0[r_] = 0.f; S1[r_] = 0.f; } \
        _Pragma("unroll") for (int ks_ = 0; ks_ < KS; ++ks_) { const bf16x8 k0_ = *(const LAS bf16x8*)(kb_ + ks_ * 16), k1_ = *(const LAS bf16x8*)(kb_ + 32 * KROW + ks_ * 16); \
            S0 = __builtin_amdgcn_mfma_f32_32x32x16_bf16(k0_, qf[ks_], S0, 0, 0, 0); S1 = __builtin_amdgcn_mfma_f32_32x32x16_bf16(k1_, qf[ks_], S1, 0, 0, 0); } } while (0)
    const int krow = swap23(qi);
    ATT_LOADK(0); ATT_LOADV(0); ATT_STOREK(0); ATT_STOREV(0); ATT_LOADK(1); ATT_STOREK(1); __syncthreads();
    f32x16 s0, s1, n0, n1;
    ATT_QK(s0, s1, 0);
    for (int t = 0; t < NT; ++t) {
        const bool has1 = t + 1 < NT, has2 = t + 2 < NT;
        if (has2) ATT_LOADK(t + 2);
        if (has1) ATT_LOADV(t + 1);
        if (has1) ATT_QK(n0, n1, (t + 1) & 1);
        const LAS bf16_t* vb = Vs + (t & 1) * 128 * VROW + qi * VROW + hi * 8;
        float mx = fmaxf(s0[0], s1[0]);
#pragma unroll
        for (int r = 1; r < 16; ++r) mx = fmaxf(mx, fmaxf(s0[r], s1[r]));
        mx = fmaxf(mx, __shfl_xor(mx, 32));
        if (__any(mx > m_run + 8.f)) {
            const float m_new = fmaxf(m_run, mx), alpha = ex2(m_run - m_new); m_run = m_new; l_run *= alpha;
#pragma unroll
            for (int d0 = 0; d0 < 4; ++d0)
#pragma unroll
                for (int r = 0; r < 16; ++r) o[d0][r] *= alpha;
        }
        float ps = 0.f;
#pragma unroll
        for (int r = 0; r < 16; ++r) { s0[r] = ex2(s0[r] - m_run); s1[r] = ex2(s1[r] - m_run); ps += s0[r] + s1[r]; }
        l_run += ps;
        u32x4 pw[4];
#pragma unroll
        for (int i = 0; i < 4; ++i) { pw[0][i] = pk2(s0[2 * i], s0[2 * i + 1]); pw[1][i] = pk2(s0[8 + 2 * i], s0[8 + 2 * i + 1]); pw[2][i] = pk2(s1[2 * i], s1[2 * i + 1]); pw[3][i] = pk2(s1[8 + 2 * i], s1[8 + 2 * i + 1]); }
#pragma unroll
        for (int sp = 0; sp < 4; ++sp) { const bf16x8 pf = __builtin_bit_cast(bf16x8, pw[sp]);
#pragma unroll
            for (int d0 = 0; d0 < 4; ++d0) { const bf16x8 vf = *(const LAS bf16x8*)(vb + 32 * d0 * VROW + sp * 16); o[d0] = __builtin_amdgcn_mfma_f32_32x32x16_bf16(vf, pf, o[d0], 0, 0, 0); } }
        if (has2) ATT_STOREK(t & 1);
        if (has1) ATT_STOREV((t + 1) & 1);
        __syncthreads();
        s0 = n0; s1 = n1;
    }
#undef ATT_LOADK
#undef ATT_LOADV
#undef ATT_STOREK
#undef ATT_STOREV
#undef ATT_QK
    const float l = l_run + __shfl_xor(l_run, 32), inv = 1.f / l;
    bf16_t* op = O + (size_t)(q0 + wid * 32 + qi) * ldo + 4 * hi;
#pragma unroll
    for (int d0 = 0; d0 < 4; ++d0)
#pragma unroll
        for (int g = 0; g < 4; ++g) { u32x2 w; w.x = pk2(o[d0][4 * g] * inv, o[d0][4 * g + 1] * inv); w.y = pk2(o[d0][4 * g + 2] * inv, o[d0][4 * g + 3] * inv); *(u32x2*)(op + 32 * d0 + 8 * g) = w; }
}

__device__ __forceinline__ void glds16(const void* gsrc, unsigned lds_dst) { unsigned keep;
    asm volatile("s_mov_b32 %0, m0\n\ts_mov_b32 m0, %2\n\ts_nop 0\n\tglobal_load_lds_dwordx4 %1, off\n\ts_mov_b32 m0, %0" : "=&s"(keep) : "v"(gsrc), "s"(lds_dst) : "memory"); }
template <int DQK>
__device__ __forceinline__ void attn_unit_dma(const bf16_t* __restrict__ Q, int ldq, const bf16_t* __restrict__ K, int ldk, const bf16_t* __restrict__ Vt, bf16_t* O, int ldo, int q0, int nkeys, LAS unsigned char* lds) {
    constexpr int KS = DQK / 16, KROW = DQK + 8, KCH = DQK / 8, VROW = 72, KSL = KCH + 1, KCHUNKS = KSL, VCHUNKS = 18, NJ = (KCHUNKS + VCHUNKS + NWV - 1) / NWV;
    constexpr int KBYTES = KCHUNKS * 1024, VBYTES = VCHUNKS * 1024, SLOT = KBYTES + VBYTES, DUMMY = 3 * SLOT;
    static_assert(KROW * 2 == KSL * 16 && 64 * KROW * 2 == KBYTES && 128 * VROW * 2 == VBYTES && DUMMY + 1024 <= LDS_BYTES - 16, "attention LDS image");
    int tid_ = threadIdx.x; asm volatile("" : "+v"(tid_));
    const int tid = tid_, lane = tid & 63, wid = tid >> 6, qi = lane & 31, hi = lane >> 5;
    const int widu = __builtin_amdgcn_readfirstlane(wid);
    const unsigned lds0 = (unsigned)(size_t)lds;
    unsigned goff[NJ];
#pragma unroll
    for (int j = 0; j < NJ; ++j) { const int c = j * NWV + widu;
        if (c < KCHUNKS) { const int sl = c * 64 + lane, r = sl / KSL, cc = sl - r * KSL; goff[j] = (unsigned)(r * ldk + (cc == KCH ? 0 : cc) * 8); }
        else if (c < KCHUNKS + VCHUNKS) { const int sl = (c - KCHUNKS) * 64 + lane, r = sl / 9, cc = sl - r * 9; goff[j] = (unsigned)(r * T + (cc == 8 ? 0 : cc) * 8); }
        else goff[j] = 0u; }
#define AD_DMA(t, slot) do { _Pragma("unroll") for (int j_ = 0; j_ < NJ; ++j_) { const int c_ = j_ * NWV + widu; \
        if (c_ < KCHUNKS) glds16(K + (size_t)(t) * 64 * ldk + goff[j_], lds0 + (slot) * SLOT + c_ * 1024); \
        else if (c_ < KCHUNKS + VCHUNKS) glds16(Vt + (size_t)(t) * 64 + goff[j_], lds0 + (slot) * SLOT + KBYTES + (c_ - KCHUNKS) * 1024); \
        else glds16(K + goff[j_], lds0 + DUMMY); } } while (0)
    bf16x8 qf[KS];
    { const bf16_t* qp = Q + (size_t)(q0 + wid * 32 + qi) * ldq + hi * 8;
#pragma unroll
      for (int ks = 0; ks < KS; ++ks) qf[ks] = *(const bf16x8*)(qp + ks * 16); }
    f32x16 o[4];
#pragma unroll
    for (int d0 = 0; d0 < 4; ++d0)
#pragma unroll
        for (int r = 0; r < 16; ++r) o[d0][r] = 0.f;
    float l_run = 0.f;
    f32x16 negm;
#pragma unroll
    for (int r = 0; r < 16; ++r) negm[r] = 0.f;
    const int NT = nkeys / 64;
    const int krow = swap23(qi);
    AD_DMA(0, 0); AD_DMA(1, 1);
    asm volatile("s_waitcnt vmcnt(0) lgkmcnt(0)" ::: "memory"); __builtin_amdgcn_s_barrier(); asm volatile("" ::: "memory");
    int slot = 0, slot2 = 2;
    for (int t = 0; t < NT; ++t) {
        if (t + 2 < NT) AD_DMA(t + 2, slot2);
        const LAS bf16_t* kb = (const LAS bf16_t*)(lds + slot * SLOT) + krow * KROW + hi * 8; const LAS bf16_t* vb = (const LAS bf16_t*)(lds + slot * SLOT + KBYTES) + qi * VROW + hi * 8;
        f32x16 s0, s1;
        { const bf16x8 k0 = *(const LAS bf16x8*)(kb), k1 = *(const LAS bf16x8*)(kb + 32 * KROW);
          s0 = __builtin_amdgcn_mfma_f32_32x32x16_bf16(k0, qf[0], negm, 0, 0, 0); s1 = __builtin_amdgcn_mfma_f32_32x32x16_bf16(k1, qf[0], negm, 0, 0, 0); }
#pragma unroll
        for (int ks = 1; ks < KS; ++ks) { const bf16x8 k0 = *(const LAS bf16x8*)(kb + ks * 16), k1 = *(const LAS bf16x8*)(kb + 32 * KROW + ks * 16);
            s0 = __builtin_amdgcn_mfma_f32_32x32x16_bf16(k0, qf[ks], s0, 0, 0, 0); s1 = __builtin_amdgcn_mfma_f32_32x32x16_bf16(k1, qf[ks], s1, 0, 0, 0); }
        float mx = fmaxf(s0[0], s1[0]);
#pragma unroll
        for (int r = 1; r < 16; ++r) mx = max3f(mx, s0[r], s1[r]);
        mx = fmaxf(mx, __shfl_xor(mx, 32));
        if (t == 0 || __any(mx > 8.f)) {
            const float delta = t == 0 ? mx : fmaxf(mx, 0.f), alpha = t == 0 ? 1.f : ex2(-delta); l_run *= alpha;
#pragma unroll
            for (int r = 0; r < 16; ++r) { negm[r] -= delta; s0[r] -= delta; s1[r] -= delta; }
#pragma unroll
            for (int d0 = 0; d0 < 4; ++d0)
#pragma unroll
                for (int r = 0; r < 16; ++r) o[d0][r] *= alpha;
        }
        f32x2_t ps2 = {0.f, 0.f};
        u32x4 pw[4];
#pragma unroll
        for (int i = 0; i < 8; ++i) { f32x2_t e = (f32x2_t){s0[2 * i], s0[2 * i + 1]}, f = (f32x2_t){s1[2 * i], s1[2 * i + 1]}; e[0] = ex2(e[0]); e[1] = ex2(e[1]); f[0] = ex2(f[0]); f[1] = ex2(f[1]);
            ps2 = ps2 + e; ps2 = ps2 + f; pw[i >> 2][i & 3] = pk2(e[0], e[1]); pw[2 + (i >> 2)][i & 3] = pk2(f[0], f[1]); }
        l_run += ps2[0] + ps2[1];
#pragma unroll
        for (int sp = 0; sp < 4; ++sp) { const bf16x8 pf = __builtin_bit_cast(bf16x8, pw[sp]);
#pragma unroll
            for (int d0 = 0; d0 < 4; ++d0) { const bf16x8 vf = *(const LAS bf16x8*)(vb + 32 * d0 * VROW + sp * 16); o[d0] = __builtin_amdgcn_mfma_f32_32x32x16_bf16(vf, pf, o[d0], 0, 0, 0); } }
        if (t + 2 < NT) asm volatile("s_waitcnt vmcnt(%0) lgkmcnt(0)" :: "n"(NJ) : "memory"); else asm volatile("s_waitcnt vmcnt(0) lgkmcnt(0)" ::: "memory");
        __builtin_amdgcn_s_barrier(); asm volatile("" ::: "memory");
        slot2 = slot; slot = slot == 2 ? 0 : slot + 1;
    }
#undef AD_DMA
    const float l = l_run + __shfl_xor(l_run, 32), inv = 1.f / l;
    bf16_t* op = O + (size_t)(q0 + wid * 32 + qi) * ldo + 4 * hi;
#pragma unroll
    for (int d0 = 0; d0 < 4; ++d0)
#pragma unroll
        for (int g = 0; g < 4; ++g) { u32x2 w; w.x = pk2(o[d0][4 * g] * inv, o[d0][4 * g + 1] * inv); w.y = pk2(o[d0][4 * g + 2] * inv, o[d0][4 * g + 3] * inv); *(u32x2*)(op + 32 * d0 + 8 * g) = w; }
}

__device__ __forceinline__ void attn_unit_da(const bf16_t* __restrict__ Q, const bf16_t* __restrict__ K, const bf16_t* __restrict__ Vt, bf16_t* O, int q0, int nkeys, LAS unsigned char* lds) {
    constexpr int KROW = 72, VROW = 72, LDQ = 512, LDO = 1024;
    LAS bf16_t* Ks = (LAS bf16_t*)lds; LAS bf16_t* Vs = (LAS bf16_t*)(lds + 2 * 64 * KROW * 2);
    int tid_ = threadIdx.x; asm volatile("" : "+v"(tid_));
    const int tid = tid_, lane = tid & 63, wid = tid >> 6, qi = lane & 31, hi = lane >> 5, qg = wid >> 1, kh = wid & 1;
    bf16x8 qf[2][4];
#pragma unroll
    for (int qs = 0; qs < 2; ++qs) { const bf16_t* qp = Q + (size_t)(q0 + qg * 64 + qs * 32 + qi) * LDQ + hi * 8;
#pragma unroll
        for (int ks = 0; ks < 4; ++ks) qf[qs][ks] = *(const bf16x8*)(qp + ks * 16); }
    f32x16 o[2][4];
#pragma unroll
    for (int qs = 0; qs < 2; ++qs)
#pragma unroll
        for (int d0 = 0; d0 < 4; ++d0)
#pragma unroll
            for (int r = 0; r < 16; ++r) o[qs][d0][r] = 0.f;
    float m_run[2] = {-1e30f, -1e30f}, l_run[2] = {0.f, 0.f};
    const int NT = nkeys / 64;
    u32x4 kreg, vreg[2];
#define DA_LOADG(t) do { { const int r_ = tid >> 3, cc_ = tid & 7; kreg = *(const u32x4*)(K + (size_t)((t) * 64 + r_) * 512 + cc_ * 8); } \
        _Pragma("unroll") for (int i_ = 0; i_ < 2; ++i_) { const int c_ = tid + NTHR * i_, dv_ = c_ >> 3, k8_ = c_ & 7; vreg[i_] = *(const u32x4*)(Vt + (size_t)dv_ * T + (t) * 64 + k8_ * 8); } } while (0)
#define DA_STOREL(b) do { { const int r_ = tid >> 3, cc_ = tid & 7; *(LAS u32x4*)(Ks + (b) * 64 * KROW + r_ * KROW + cc_ * 8) = kreg; } \
        _Pragma("unroll") for (int i_ = 0; i_ < 2; ++i_) { const int c_ = tid + NTHR * i_, dv_ = c_ >> 3, k8_ = c_ & 7; *(LAS u32x4*)(Vs + (b) * 128 * VROW + dv_ * VROW + k8_ * 8) = vreg[i_]; } } while (0)
    DA_LOADG(0); DA_STOREL(0); __syncthreads();
    const int krow = 32 * kh + swap23(qi);
    for (int t = 0; t < NT; ++t) {
        const int buf = t & 1;
        if (t + 1 < NT) DA_LOADG(t + 1);
        const LAS bf16_t* kb = Ks + buf * 64 * KROW + krow * KROW + hi * 8; const LAS bf16_t* vb = Vs + buf * 128 * VROW + qi * VROW + 32 * kh + hi * 8;
        f32x16 sc[2];
#pragma unroll
        for (int r = 0; r < 16; ++r) { sc[0][r] = 0.f; sc[1][r] = 0.f; }
#pragma unroll
        for (int ks = 0; ks < 4; ++ks) { const bf16x8 kf = *(const LAS bf16x8*)(kb + ks * 16);
            sc[0] = __builtin_amdgcn_mfma_f32_32x32x16_bf16(kf, qf[0][ks], sc[0], 0, 0, 0); sc[1] = __builtin_amdgcn_mfma_f32_32x32x16_bf16(kf, qf[1][ks], sc[1], 0, 0, 0); }
        u32x4 pw[2][2];
#pragma unroll
        for (int qs = 0; qs < 2; ++qs) {
            float mx = sc[qs][0];
#pragma unroll
            for (int r = 1; r < 16; ++r) mx = fmaxf(mx, sc[qs][r]);
            mx = fmaxf(mx, __shfl_xor(mx, 32));
            if (__any(mx > m_run[qs] + 8.f)) {
                const float m_new = fmaxf(m_run[qs], mx), alpha = ex2(m_run[qs] - m_new); m_run[qs] = m_new; l_run[qs] *= alpha;
#pragma unroll
                for (int d0 = 0; d0 < 4; ++d0)
#pragma unroll
                    for (int r = 0; r < 16; ++r) o[qs][d0][r] *= alpha;
            }
            float ps = 0.f;
#pragma unroll
            for (int r = 0; r < 16; ++r) { sc[qs][r] = ex2(sc[qs][r] - m_run[qs]); ps += sc[qs][r]; }
            l_run[qs] += ps;
#pragma unroll
            for (int i = 0; i < 4; ++i) { pw[qs][0][i] = pk2(sc[qs][2 * i], sc[qs][2 * i + 1]); pw[qs][1][i] = pk2(sc[qs][8 + 2 * i], sc[qs][8 + 2 * i + 1]); }
        }
#pragma unroll
        for (int sp = 0; sp < 2; ++sp)
#pragma unroll
            for (int d0 = 0; d0 < 4; ++d0) { const bf16x8 vf = *(const LAS bf16x8*)(vb + 32 * d0 * VROW + sp * 16);
                o[0][d0] = __builtin_amdgcn_mfma_f32_32x32x16_bf16(vf, __builtin_bit_cast(bf16x8, pw[0][sp]), o[0][d0], 0, 0, 0);
                o[1][d0] = __builtin_amdgcn_mfma_f32_32x32x16_bf16(vf, __builtin_bit_cast(bf16x8, pw[1][sp]), o[1][d0], 0, 0, 0); }
        if (t + 1 < NT) DA_STOREL(buf ^ 1);
        __syncthreads();
    }
#undef DA_LOADG
#undef DA_STOREL
    LAS float* xp = (LAS float*)lds + (size_t)qg * (130 * 64) + lane;
#pragma unroll
    for (int qs = 0; qs < 2; ++qs) {
        const float lt = l_run[qs] + __shfl_xor(l_run[qs], 32);
        if (kh == 1) { xp[128 * 64] = m_run[qs]; xp[129 * 64] = lt;
#pragma unroll
            for (int d0 = 0; d0 < 4; ++d0)
#pragma unroll
                for (int r = 0; r < 16; ++r) xp[(d0 * 16 + r) * 64] = o[qs][d0][r]; }
        __syncthreads();
        if (kh == 0) { const float mb = xp[128 * 64], lb = xp[129 * 64];
            const float m = fmaxf(m_run[qs], mb), fa = ex2(m_run[qs] - m), fb = ex2(mb - m), inv = 1.f / (lt * fa + lb * fb), ca = fa * inv, cb = fb * inv;
            bf16_t* op = O + (size_t)(q0 + qg * 64 + qs * 32 + qi) * LDO + 4 * hi;
#pragma unroll
            for (int d0 = 0; d0 < 4; ++d0)
#pragma unroll
                for (int g = 0; g < 4; ++g) { float v[4];
#pragma unroll
                    for (int j = 0; j < 4; ++j) v[j] = o[qs][d0][4 * g + j] * ca + xp[(d0 * 16 + 4 * g + j) * 64] * cb;
                    u32x2 w; w.x = pk2(v[0], v[1]); w.y = pk2(v[2], v[3]); *(u32x2*)(op + 32 * d0 + 8 * g) = w; } }
        __syncthreads();
    }
}

#define XB_TMO      128
#define XB_XCNT(j)  (256  + 64 * (j))
#define XB_XSUB(j)  (1280 + 64 * (j))
#define XB_XGEN(j)  (2304 + 64 * (j))
#define XB_TOP      3328
#define XB_TOPGEN   3392
#define XCD_BAR_WORDS 3456
#define XB_SPIN_CAP (1u << 18)

__device__ __forceinline__ unsigned xb_ld(unsigned* p)              { return __hip_atomic_load(p, __ATOMIC_RELAXED, __HIP_MEMORY_SCOPE_AGENT); }
__device__ __forceinline__ unsigned xb_add(unsigned* p, unsigned v) { return __hip_atomic_fetch_add(p, v, __ATOMIC_RELAXED, __HIP_MEMORY_SCOPE_AGENT); }
__device__ __forceinline__ unsigned xb_xcc_id() { return (unsigned)__builtin_amdgcn_s_getreg((3 << 11) | 20) & 0xFu; }
#define XB_SPIN(cond, bar) do { unsigned _sp = 0; while (cond) { __builtin_amdgcn_s_sleep(1); \
    if ((++_sp & 255u) == 0u) { if (xb_ld(&(bar)[XB_TMO])) break; if (_sp > XB_SPIN_CAP) { atomicAdd(&(bar)[XB_TMO], 1u); break; } } } } while (0)

struct XcdBarrier {
    unsigned* bar; unsigned x;
    volatile LAS unsigned* st;
};

__device__ __forceinline__ XcdBarrier xcd_barrier_post(unsigned* bar, volatile LAS unsigned* st) {
    XcdBarrier b; b.bar = bar; b.x = xb_xcc_id(); b.st = st;
    if (threadIdx.x == 0) (void)xb_add(&bar[XB_XCNT(b.x)], 1u);
    return b;
}
__device__ __forceinline__ void xcd_barrier_complete(unsigned* bar, unsigned x, unsigned& nloc, unsigned& nx) {
    const unsigned G = gridDim.x * gridDim.y * gridDim.z;
    unsigned sum, cnt, mine, sp = 0u;
    for (;;) {
        sum = 0u; cnt = 0u; mine = 0u;
#pragma unroll
        for (unsigned j = 0; j < 16; ++j) { const unsigned c = xb_ld(&bar[XB_XCNT(j)]); sum += c; cnt += (c > 0u) ? 1u : 0u; mine = (j == x) ? c : mine; }
        if (sum == G) break;
        __builtin_amdgcn_s_sleep(1);
        if ((++sp & 255u) == 0u) { if (xb_ld(&bar[XB_TMO])) break; if (sp > XB_SPIN_CAP) { atomicAdd(&bar[XB_TMO], 1u); break; } }
    }
    nloc = mine > 0u ? mine : 1u; nx = cnt > 0u ? cnt : 1u;
}

__device__ __forceinline__ void xcd_barrier(const XcdBarrier& b) {
    asm volatile("s_waitcnt vmcnt(0)" ::: "memory");
    __syncthreads();
    if (threadIdx.x == 0) {
        unsigned* bar = b.bar;
        __builtin_amdgcn_s_waitcnt(0);
        unsigned nloc = b.st[0], nx = b.st[1];
        if (nloc == 0u) { xcd_barrier_complete(bar, b.x, nloc, nx); b.st[0] = nloc; b.st[1] = nx; }
        const unsigned old = xb_add(&bar[XB_XSUB(b.x)], 1u);
        const unsigned gen = old / nloc;
        if (old + 1u == (gen + 1u) * nloc) {
            __builtin_amdgcn_fence(__ATOMIC_RELEASE, "agent");
            asm volatile("s_waitcnt vmcnt(0)" ::: "memory");
            const unsigned og = xb_add(&bar[XB_TOP], 1u);
            const unsigned tg = og / nx;
            if (og + 1u == (tg + 1u) * nx) xb_add(&bar[XB_TOPGEN], 1u);
            else XB_SPIN(xb_ld(&bar[XB_TOPGEN]) == tg, bar);
            __builtin_amdgcn_fence(__ATOMIC_ACQUIRE, "agent");
            xb_add(&bar[XB_XGEN(b.x)], 1u);
            asm volatile("s_waitcnt vmcnt(0)" ::: "memory");
        } else {
            XB_SPIN(xb_ld(&bar[XB_XGEN(b.x)]) == gen, bar);
            __builtin_amdgcn_fence(__ATOMIC_ACQUIRE, "agent");
            asm volatile("s_waitcnt vmcnt(0)" ::: "memory");
        }
    }
    __syncthreads();
}

#define GAS __attribute__((address_space(1)))
#define PIN(i) ((const float*)(const GAS float*)pp->in[i])
#define F1T ((bf16_t*)(ws + O_F1T))
#define F2T ((bf16_t*)(ws + O_F2T))
#define ROPE ((float*)(ws + O_ROPE))
#define C8T ((float*)(ws + O_C8))
#define MODS ((float*)(ws + O_MODS))
#define XMOD ((bf16_t*)(ws + O_XMOD))
#define XRES ((float*)(ws + O_XRES))
#define QDA ((bf16_t*)(ws + O_QDA))
#define KDA ((bf16_t*)(ws + O_KDA))
#define VTDA ((bf16_t*)(ws + O_VTDA))
#define LRUX ((bf16_t*)(ws + O_LRUX))
#define LRUG ((bf16_t*)(ws + O_LRUG))
#define CQ ((bf16_t*)(ws + O_CQ))
#define CKV ((bf16_t*)(ws + O_CKV))
#define PARTQ ((float*)(ws + O_PARTQ))
#define PARTKV ((float*)(ws + O_PARTKV))
#define QMLA ((bf16_t*)(ws + O_QMLA))
#define KMLA ((bf16_t*)(ws + O_KMLA))
#define VTMLA ((bf16_t*)(ws + O_VTMLA))
#define FX ((bf16_t*)(ws + O_FX))
#define FT ((bf16_t*)(ws + O_FT))
#define CTXW ((float*)(ws + O_CTXW))
#define XC ((bf16_t*)(ws + O_XC))
#define AU ((unsigned*)(ws + O_AU))
#define SUMM ((float*)(ws + O_SUMM))
#define DAO ((bf16_t*)(ws + O_DAO))
#define HB ((bf16_t*)(ws + O_H))
#define WIN ((bf16_t*)(wl + O_WIN))
#define WOUT ((bf16_t*)(wl + O_WOUT))
#define WGU ((bf16_t*)(wl + O_WGU))
#define WD ((bf16_t*)(wl + O_WD))
#define WUQ ((bf16_t*)(wl + O_WUQ))
#define WUKV ((bf16_t*)(wl + O_WUKV))
#define WLRU ((bf16_t*)(wl + O_WLRU))
#define MIX XMOD
#define mods_c (MODS + (size_t)(l * 2 + 0) * 12288)
#define mods_l (MODS + (size_t)(l * 2 + 1) * 12288)
__device__ __forceinline__ int chunk_start(int c) { if (c <= 4) return 64 * c; const int cl = c - 4; return NCTX + 65 * cl + (cl < 4 ? cl : 4); }
constexpr int N_PHASES = 22;
template <unsigned MASK>
__global__ void __launch_bounds__(NTHR, 2) mega_fwd(Params P) {
    extern __shared__ __attribute__((aligned(16))) unsigned char lds_raw[];
    LAS unsigned char* lds = (LAS unsigned char*)lds_raw;
    const int tid0 = threadIdx.x;
    const int G0 = gridDim.x, bid0 = blockIdx.x;
    cg::grid_group grid = cg::this_grid();
    volatile LAS unsigned* bst = (volatile LAS unsigned*)(lds + LDS_BYTES - 16);
    if (tid0 < 4) bst[tid0] = 0u;
    __syncthreads();
    XcdBarrier xbar = xcd_barrier_post((unsigned*)(P.ws + O_BAR), bst);

    for (int ph = P.ph_lo; ph < P.ph_hi; ++ph) {
        const __attribute__((address_space(4))) Params* pp = (const __attribute__((address_space(4))) Params*)__builtin_amdgcn_kernarg_segment_ptr(); asm volatile("" : "+s"(pp));
        int tid = tid0; asm volatile("" : "+v"(tid));
        int G = G0, bid = bid0; asm volatile("" : "+s"(G), "+s"(bid));
        const int NGW = G * NWV, NT_ALL = G * NTHR;
        const int lane = tid & 63, wid = __builtin_amdgcn_readfirstlane(tid >> 6), gw = bid * NWV + wid, gtid = bid * NTHR + tid;
        GAS unsigned char* ws = (GAS unsigned char*)pp->ws; asm volatile("" : "+s"(ws));
        const int l = ph >= 2 ? (ph - 2) / 10 : 0, sub = ph >= 2 ? (ph - 2) % 10 : -1;
        GAS unsigned char* wl = ws + (size_t)l * SZ_WLAYER;
        if (EN(0) && ph == 0) {
            for (int rp_ = 0; rp_ < DUP_P0; ++rp_) {
            for (int it = bid; it < 256; it += G) {
                const int ll = it >> 7, g = (it >> 5) & 3, kb = it & 31, k0 = 64 * kb;
                LAS float* wt = (LAS float*)lds; LAS float* tab = wt + 128 * 68;
                const float* wsrc = PIN(I_WIN) + (size_t)ll * DM * INW;
                for (int i = 0; i < 16; ++i) { const int e = tid + NTHR * i, kk = e >> 7, c = e & 127; wt[c * 68 + kk] = wsrc[(size_t)(k0 + kk) * INW + 3264 + 128 * g + c]; }
                if (tid < 128) tab[tid] = cospif((float)tid * (1.f / 64.f)) * RSQ128;
                __syncthreads();
                const int col = tid & 255, part = col >> 7, jj = col & 127, kh = tid >> 8; const int ph0 = part ? 96 : 0;
                bf16_t* dst = (bf16_t*)(ws + (size_t)ll * SZ_WLAYER + O_WIN) + (size_t)((13 + g) * 256 + col) * DM + k0 + 32 * kh;
                f32x4 a[8];
#pragma unroll
                for (int q = 0; q < 8; ++q) a[q] = (f32x4){0.f, 0.f, 0.f, 0.f};
                for (int c = 0; c < 128; ++c) { const float tv = tab[(jj * c + ph0) & 127]; const LAS f32x4* wr4 = (const LAS f32x4*)(wt + c * 68 + 32 * kh);
#pragma unroll
                    for (int q = 0; q < 8; ++q) a[q] += wr4[q] * tv; }
                const float sg = part ? -1.f : 1.f;
#pragma unroll
                for (int q = 0; q < 4; ++q) { u32x4 o; o.x = pk2(a[2 * q][0] * sg, a[2 * q][1] * sg); o.y = pk2(a[2 * q][2] * sg, a[2 * q][3] * sg); o.z = pk2(a[2 * q + 1][0] * sg, a[2 * q + 1][1] * sg); o.w = pk2(a[2 * q + 1][2] * sg, a[2 * q + 1][3] * sg);
                    *(u32x4*)(dst + 8 * q) = o; }
                __syncthreads();
            }
            for (int it = bid; it < 192; it += G) {
                const int ll = it / 96, nc = it % 96;
                LAS float* sv = (LAS float*)lds; LAS float* red = sv + 2 * DM;
                for (int i = tid; i < DM; i += NTHR) { sv[i] = siluf(PIN(I_CCTX)[i]); sv[DM + i] = siluf(PIN(I_C)[i]); }
                __syncthreads();
                const float* wp = PIN(I_WADA) + (size_t)ll * DM * 12288 + 128 * nc + 2 * lane;
                float a00 = 0.f, a01 = 0.f, a10 = 0.f, a11 = 0.f;
                for (int k0 = 256 * wid; k0 < 256 * wid + 256; k0 += 16) { f32x2_t w2[16];
#pragma unroll
                    for (int j = 0; j < 16; ++j) w2[j] = *(const f32x2_t*)(wp + (size_t)(k0 + j) * 12288);
#pragma unroll
                    for (int j = 0; j < 16; ++j) { const float s0 = sv[k0 + j], s1 = sv[DM + k0 + j]; a00 += s0 * w2[j][0]; a01 += s0 * w2[j][1]; a10 += s1 * w2[j][0]; a11 += s1 * w2[j][1]; } }
                red[(wid * 2 + 0) * 128 + 2 * lane] = a00; red[(wid * 2 + 0) * 128 + 2 * lane + 1] = a01; red[(wid * 2 + 1) * 128 + 2 * lane] = a10; red[(wid * 2 + 1) * 128 + 2 * lane + 1] = a11;
                __syncthreads();
                if (tid < 256) { const int v = tid >> 7, cc = tid & 127; float s = PIN(I_BADA)[(size_t)ll * 12288 + 128 * nc + cc];
                    for (int w = 0; w < 8; ++w) s += red[(w * 2 + v) * 128 + cc];
                    MODS[(size_t)(ll * 2 + v) * 12288 + 128 * nc + cc] = s; }
                __syncthreads();
            }
            for (int i = gtid; i < 4096; i += NT_ALL) { const int pos = i >> 4, f = i & 15; const float x = ((float)pos * INVF[f]) * 0.3183098861837907f; ROPE[2 * i] = cospif(x); ROPE[2 * i + 1] = sinpif(x); }
            for (int i = gtid; i < 65536; i += NT_ALL) { const int cp = i >> 8, kk = i & 255, part = kk >> 7, nn = kk & 127;
                const int n = (cp >> 4) & 1, k1 = 64 * (cp >> 7) + 16 * ((cp >> 5) & 3) + (cp & 15); const float ang = (float)((k1 * nn) & 127) * (1.f / 64.f); const float cv = cospif(ang) * RSQ128, sv = sinpif(ang) * RSQ128;
                F1T[i] = f2bf(n == 0 ? (part == 0 ? cv : sv) : (part == 0 ? -sv : cv)); }
            for (int i = gtid; i < 128 * 65536; i += NT_ALL) { const int k1 = i >> 16, cp = (i >> 8) & 255, kk = i & 255, part = kk >> 7, nn = kk & 127;
                float v = 0.f; if (cp < 128) { const float ang = (float)((nn * (k1 + 128 * cp)) & 16383) * (1.f / 8192.f); v = (part == 0 ? cospif(ang) : sinpif(ang)) * RSQ128; } F2T[i] = f2bf(v); }
            for (int i = gtid; i < 2048; i += NT_ALL) C8T[i] = -8.f * log1pf(__expf(-PIN(I_LLAM)[i]));
            LAS float* scr = (LAS float*)(lds + wid * 8704);
            for (int ll = 0; ll < 2; ++ll) {
                GAS unsigned char* wd = ws + (size_t)ll * SZ_WLAYER;
                tr_job(MapWin{PIN(I_WIN) + (size_t)ll * DM * INW, INW}, DM, 13 * 256, (bf16_t*)(wd + O_WIN), nullptr, scr, gw, NGW, lane);
                tr_job(MapPlain{PIN(I_WOUT) + (size_t)ll * DM * DM, DM}, DM, DM, (bf16_t*)(wd + O_WOUT), nullptr, scr, gw, NGW, lane);
                tr_job(MapGU{PIN(I_WG) + (size_t)ll * DM * DFF, PIN(I_WU) + (size_t)ll * DM * DFF, DFF}, DM, 2 * DFF, (bf16_t*)(wd + O_WGU), nullptr, scr, gw, NGW, lane);
                tr_job(MapPlain{PIN(I_WD) + (size_t)ll * DFF * DM, DM}, DFF, DM, (bf16_t*)(wd + O_WD), nullptr, scr, gw, NGW, lane);
                tr_job(MapUq{PIN(I_WUQ) + (size_t)ll * 384 * 768, 768}, 384, 768, (bf16_t*)(wd + O_WUQ), PIN(I_QNG) + ll * 384, scr, gw, NGW, lane);
                tr_job(MapUkv{PIN(I_WUKV) + (size_t)ll * 256 * 1024, 1024}, 256, 1024, (bf16_t*)(wd + O_WUKV), PIN(I_KVNG) + ll * 256, scr, gw, NGW, lane);
                for (int hd = 0; hd < 8; ++hd) { const int h = hd >> 1, d = hd & 1; const size_t wo = ((size_t)(ll * 2 + d) * 4 + h) * 16384;
                    tr_job(MapLru{PIN(I_LWR) + wo, PIN(I_LWI) + wo, 128}, 128, 256, (bf16_t*)(wd + O_WLRU) + (size_t)hd * 256 * 128, nullptr, scr, gw, NGW, lane); }
            }
            __syncthreads(); }
        } else if (EN(1) && ph == 1) {
            for (int row = gw; row < T; row += NGW) { const float* xr = row < NCTX ? PIN(I_CTX) + (size_t)row * DM : PIN(I_X) + (size_t)(row - NCTX) * DM; const float* md = MODS + (size_t)(row < NCTX ? 0 : 1) * 12288;
#pragma unroll
                for (int j = 0; j < 8; ++j) { const int c = 4 * lane + 256 * j; const f32x4 xv = *(const f32x4*)(xr + c), sh = *(const f32x4*)(md + c), sc = *(const f32x4*)(md + DM + c); st4bf(XMOD + (size_t)row * DM + c, xv * (sc + 1.f) + sh); if (row < NCTX) *(f32x4*)(XRES + (size_t)row * DM + c) = xv * ALPHA; } }
        } else if (EN(2) && sub == 0) {
            pg8::Gemm g{XMOD, WIN, T, NIN, DM}; pg8::StaticOrder S; S.init(T, NIN, G, bid);
            EpiInproj E{QDA, KDA, VTDA, LRUX, LRUG, CQ, CKV, KMLA, FX, CTXW, PARTQ, PARTKV, ROPE};
            for (int rg_ = 0; rg_ < DUP_GEMM; ++rg_) pg8::gemm_phase<EpiInproj, pg8::StaticOrder, true, true>(lds, g, S, E);
        } else if (EN(3) && sub == 1) {
            for (int rs_ = 0; rs_ < DUP_S1; ++rs_) {
            if (EN(11)) { const float* cw = PIN(I_CONVW) + (size_t)l * 4 * 512; const float* cbv = PIN(I_CONVB) + (size_t)l * 512;
              for (int idx = gtid; idx < T * 64; idx += NT_ALL) { const int row = idx >> 6, ch0 = (idx & 63) * 8; const int lo = row < NCTX ? 0 : NCTX, hi = row < NCTX ? NCTX : T;
                  float a[8];
#pragma unroll
                  for (int q = 0; q < 8; ++q) a[q] = cbv[ch0 + q];
#pragma unroll
                  for (int j = 0; j < 4; ++j) { const int r = row + j - 2; if (r >= lo && r < hi) { const u32x4 xw = *(const u32x4*)(LRUX + (size_t)r * 512 + ch0); const float* wj = cw + j * 512 + ch0;
#pragma unroll
                      for (int q = 0; q < 4; ++q) { a[2 * q] += wj[2 * q] * bf2f(xw[q] & 0xffffu); a[2 * q + 1] += wj[2 * q + 1] * bf2f(xw[q] >> 16); } } }
                  u32x4 o; o.x = pk2(a[0], a[1]); o.y = pk2(a[2], a[3]); o.z = pk2(a[4], a[5]); o.w = pk2(a[6], a[7]);
                  *(u32x4*)(XC + ((size_t)(ch0 >> 7) * T + row) * 128 + (ch0 & 127)) = o; } }
            if (EN(12)) { pg8::Gemm g{CQ, WUQ, T, 768, 384}; pg8::StaticOrder S; S.init(T, 768, G, bid); EpiUpq E{QMLA, PARTQ, ROPE}; pg8::gemm_phase<EpiUpq, pg8::StaticOrder, true, true>(lds, g, S, E); }
            if (EN(13)) { pg8::Gemm g{CKV, WUKV, T, 1024, 256}; pg8::StaticOrder S; S.init(T, 1024, G, (bid + G - 195 % G) % G);     EpiUpkv E{KMLA, VTMLA, PARTKV}; pg8::gemm_phase<EpiUpkv, pg8::StaticOrder, true, true>(lds, g, S, E); }
            if (EN(14)) { pg8::Gemm g{FX, F1T, 65536, 256, 256}; pg8::StaticOrder S; S.init(65536, 256, G, bid); EpiFftA E{FT}; pg8::gemm_phase<EpiFftA, pg8::StaticOrder, true, true>(lds, g, S, E); }
            __syncthreads();
            if (EN(15)) for (int k = bid; k < 256; k += G) {
                LAS float* tab = (LAS float*)lds; LAS float* red = tab + 256; if (tid < 256) tab[tid] = cospif((float)tid * (1.f / 128.f)) * 0.0625f; __syncthreads();
                const float* wp = CTXW + (lane >> 4) * 256 + (lane & 15) * 8; f32x4 a0 = {0.f, 0.f, 0.f, 0.f}, a1 = a0;
                for (int n0 = 32 * wid; n0 < 32 * wid + 32; n0 += 8) { f32x4 xr[8][2], xi[8][2];
#pragma unroll
                    for (int j = 0; j < 8; ++j) { const float* p = wp + (size_t)(n0 + j) * 1024; xr[j][0] = *(const f32x4*)p; xr[j][1] = *(const f32x4*)(p + 4); xi[j][0] = *(const f32x4*)(p + 128); xi[j][1] = *(const f32x4*)(p + 132); }
#pragma unroll
                    for (int j = 0; j < 8; ++j) { const int mm = (k * (n0 + j)) & 255; const float cv = tab[mm], sv = tab[(mm + 192) & 255]; a0 += xr[j][0] * cv + xi[j][0] * sv; a1 += xr[j][1] * cv + xi[j][1] * sv; } }
                *(LAS f32x4*)(red + wid * 512 + lane * 8) = a0; *(LAS f32x4*)(red + wid * 512 + lane * 8 + 4) = a1;
                __syncthreads();
                { float t = 0.f;
#pragma unroll
                  for (int w = 0; w < 8; ++w) t += red[w * 512 + tid];
                  MIX[(size_t)k * DM + 1536 + tid] = f2bf(t); }
                __syncthreads(); }
            }
        } else if (EN(4) && sub == 2) {
            for (int rep_ = 0; rep_ < DUP_ATTN; ++rep_)
            if (EN(16)) for (int un = bid; un < 520; un += G) { const int hh = un < 512 ? (un & 7) : (un - 512), qb = un < 512 ? 1 + (un >> 3) : 0;
                attn_unit_da(QDA + hh * 64, KDA + hh * 64, VTDA + (size_t)(hh >> 1) * 128 * T, DAO + hh * 128, qb * 256, qb == 0 ? NCTX : T, lds); }
            for (int rs_ = 0; rs_ < DUP_S2; ++rs_) {
            if (EN(17)) { pg8::Gemm g{XC, WLRU, 4 * T, 2048, 128}; LruOrder S{G, bid}; EpiLru E{AU, XC, PIN(I_LBR) + (size_t)l * 1024, PIN(I_LBI) + (size_t)l * 1024, C8T + (size_t)l * 1024};
              pg8::gemm_phase<EpiLru, LruOrder, true, true>(lds, g, S, E); }
            if (EN(18)) { pg8::Gemm g{FT, F2T, 65536, 256, 256}; FftCOrder S{G, bid}; EpiFftC E{MIX}; pg8::gemm_phase<EpiFftC, FftCOrder, true, true>(lds, g, S, E); }
            }
        } else if (EN(5) && sub == 3) {
            for (int rep_ = 0; rep_ < DUP_ATTN; ++rep_)
            for (int un = bid; un < 260; un += G) { const int h = un < 256 ? (un & 3) : (un - 256), qb = un < 256 ? 1 + (un >> 2) : 0;
                if (MLA_DMA) attn_unit_dma<192>(QMLA + h * 192, 768, KMLA + h * 192, 768, VTMLA + (size_t)h * 128 * T, MIX + 1024 + h * 128, DM, qb * 256, qb == 0 ? NCTX : T, lds);
                else attn_unit<192>(QMLA + h * 192, 768, KMLA + h * 192, 768, VTMLA + (size_t)h * 128 * T, MIX + 1024 + h * 128, DM, qb * 256, qb == 0 ? NCTX : T, lds); }
            for (int rs_ = 0; rs_ < DUP_S3; ++rs_)
            for (int un = bid; un < 512; un += G) { const int d = un >> 8, c = un & 255; const int cs = chunk_start(c), len = chunk_start(c + 1) - cs;
                const unsigned* au = AU + (size_t)d * T * 512 + tid; float h = 0.f, S = 0.f;
                for (int i0 = 0; i0 < len; i0 += 16) { unsigned w[16];
#pragma unroll
                    for (int j = 0; j < 16; ++j) { const int i = i0 + j < len ? i0 + j : len - 1; const int row = d == 0 ? cs + i : cs + len - 1 - i; w[j] = au[(size_t)row * 512]; }
#pragma unroll
                    for (int j = 0; j < 16; ++j) if (i0 + j < len) { const float l2a = bf2f(w[j] >> 16), uu = bf2f(w[j] & 0xffffu); h = ex2(l2a) * h + uu; S += l2a; } }
                SUMM[((size_t)(d * 256 + c) * 512 + tid) * 2] = S; SUMM[((size_t)(d * 256 + c) * 512 + tid) * 2 + 1] = h; }
        } else if (EN(6) && sub == 4) {
            for (int rs_ = 0; rs_ < DUP_S4; ++rs_) {
            __syncthreads();
            for (int c = bid; c < 256; c += G) { LAS float* hfs = (LAS float*)lds; const f32x2_t* S0 = (const f32x2_t*)SUMM + tid; const f32x2_t* S1 = S0 + (size_t)256 * 512;
                const int cs = chunk_start(c), len = chunk_start(c + 1) - cs;
                float hf = 0.f, hb = 0.f;
                for (int p0 = 0; p0 < c; p0 += 16) { f32x2_t sv[16];
#pragma unroll
                    for (int j = 0; j < 16; ++j) { const int k = p0 + j < c ? p0 + j : c - 1; sv[j] = S0[(size_t)k * 512]; }
#pragma unroll
                    for (int j = 0; j < 16; ++j) if (p0 + j < c) hf = ex2(sv[j][0]) * hf + sv[j][1]; }
                const int np = c < 4 ? 3 - c : 4 + 255 - c;
                for (int p0 = 0; p0 < np; p0 += 16) { f32x2_t sv[16];
#pragma unroll
                    for (int j = 0; j < 16; ++j) { const int p = p0 + j < np ? p0 + j : np - 1; const int k = p < 4 ? 3 - p : 259 - p; sv[j] = S1[(size_t)k * 512]; }
#pragma unroll
                    for (int j = 0; j < 16; ++j) if (p0 + j < np) hb = ex2(sv[j][0]) * hb + sv[j][1]; }
                const unsigned* a0 = AU + tid; const unsigned* a1 = AU + (size_t)T * 512 + tid;
                for (int i0 = 0; i0 < len; i0 += 16) { unsigned w[16];
#pragma unroll
                    for (int j = 0; j < 16; ++j) { const int i = i0 + j < len ? i0 + j : len - 1; w[j] = a0[(size_t)(cs + i) * 512]; }
#pragma unroll
                    for (int j = 0; j < 16; ++j) if (i0 + j < len) { hf = ex2(bf2f(w[j] >> 16)) * hf + bf2f(w[j] & 0xffffu); hfs[(i0 + j) * 512 + tid] = hf; } }
                for (int i0 = 0; i0 < len; i0 += 16) { unsigned w[16]; bf16_t gg[16];
#pragma unroll
                    for (int j = 0; j < 16; ++j) { const int i = i0 + j < len ? i0 + j : len - 1; const int row = cs + len - 1 - i; w[j] = a1[(size_t)row * 512]; gg[j] = LRUG[(size_t)row * 512 + tid]; }
#pragma unroll
                    for (int j = 0; j < 16; ++j) if (i0 + j < len) { const int ii = len - 1 - (i0 + j); hb = ex2(bf2f(w[j] >> 16)) * hb + bf2f(w[j] & 0xffffu);
                        MIX[(size_t)(cs + ii) * DM + 512 + tid] = f2bf((hfs[ii * 512 + tid] + hb) * gelu_tanh(bf2f(gg[j]))); } } }
            { const float linit = l == 0 ? 0.2f : 0.35550906759096926f;
              const float e1 = __expf(wave_sum(PIN(I_LQ1)[l * 64 + lane] * PIN(I_LK1)[l * 64 + lane])), e2 = __expf(wave_sum(PIN(I_LQ2)[l * 64 + lane] * PIN(I_LK2)[l * 64 + lane])); const float lam = e1 - e2 + linit;
              const float g0 = PIN(I_SUBLN)[l * 128 + 2 * lane] * (1.f - linit), g1 = PIN(I_SUBLN)[l * 128 + 2 * lane + 1] * (1.f - linit);
              for (int row = gw; row < T; row += NGW) { unsigned w1[4], w2[4];
#pragma unroll
                  for (int h = 0; h < 4; ++h) { w1[h] = *(const unsigned*)(DAO + (size_t)row * 1024 + h * 256 + 2 * lane); w2[h] = *(const unsigned*)(DAO + (size_t)row * 1024 + h * 256 + 128 + 2 * lane); }
#pragma unroll
                  for (int h = 0; h < 4; ++h) { const float y0 = bf2f(w1[h] & 0xffffu) - lam * bf2f(w2[h] & 0xffffu), y1 = bf2f(w1[h] >> 16) - lam * bf2f(w2[h] >> 16); const float inv = rsqrtf(wave_sum(y0 * y0 + y1 * y1) * (1.f / 128.f) + 1e-6f);
                      *(unsigned*)(MIX + (size_t)row * DM + h * 128 + 2 * lane) = pk2(y0 * inv * g0, y1 * inv * g1); } } }
            }
        } else if (EN(7) && sub == 5) {
            pg8::Gemm g{MIX + (size_t)256 * DM, WOUT, T - 256, DM, DM}; pg8::StaticOrder S; S.init(T - 256, DM, G, bid);
            EpiRes E{l == 0 ? PIN(I_CTX) : XRES, l == 0 ? PIN(I_X) : XRES + (size_t)NCTX * DM, XRES, mods_c + 2 * DM, mods_l + 2 * DM, 1};
            pg8::gemm_phase<EpiRes, pg8::StaticOrder, true, true>(lds, g, S, E);
            if (l == 0) for (int kp = 0; kp < 4; ++kp) {
                pg8::Gemm gc{MIX + kp * 512, WOUT + kp * 512, 256, DM, 512, DM}; pg8::StaticOrder Sc; Sc.init(256, DM, G, (bid + G - 8 * kp) % G); EpiResAtomic Ec{XRES, mods_c + 2 * DM};
                pg8::gemm_phase<EpiResAtomic, pg8::StaticOrder, true, true>(lds, gc, Sc, Ec); }
        } else if (EN(8) && (sub == 6 || sub == 9)) {
            const bool second = sub == 9, fin = second && l == 1;
            const float* gam = PIN(second ? I_LN2G : I_LN1G) + (size_t)l * DM; const float* bet = PIN(second ? I_LN2B : I_LN1B) + (size_t)l * DM;
#define LN_LOAD(V, R) do { _Pragma("unroll") for (int j_ = 0; j_ < 8; ++j_) V[j_] = *(const f32x4*)(XRES + (size_t)(R) * DM + 4 * lane + 256 * j_); } while (0)
#define LN_ROW(V, R) do { const int row_ = (R); float* yr_ = XRES + (size_t)row_ * DM; float s_ = 0.f; \
                _Pragma("unroll") for (int j_ = 0; j_ < 8; ++j_) s_ += (V[j_][0] + V[j_][1]) + (V[j_][2] + V[j_][3]); \
                const float mean_ = wave_sum(s_) * (1.f / DM); float s2_ = 0.f; \
                _Pragma("unroll") for (int j_ = 0; j_ < 8; ++j_) { V[j_] = V[j_] - mean_; s2_ += (V[j_][0] * V[j_][0] + V[j_][1] * V[j_][1]) + (V[j_][2] * V[j_][2] + V[j_][3] * V[j_][3]); } \
                const float rstd_ = rsqrtf(wave_sum(s2_) * (1.f / DM) + 1e-5f); \
                const float* md_ = second ? MODS + (size_t)((l + 1) * 2 + (row_ < NCTX ? 0 : 1)) * 12288 : MODS + (size_t)(l * 2 + (row_ < NCTX ? 0 : 1)) * 12288 + 3 * DM; \
                float* dst_ = fin ? ((float*)(GAS float*)pp->out) + (size_t)(row_ - NCTX) * DM : yr_; \
                const float rs2_ = (!second && row_ < NCTX) ? ALPHA : 1.f; \
                _Pragma("unroll") for (int j_ = 0; j_ < 8; ++j_) { const int c_ = 4 * lane + 256 * j_; const f32x4 xn_ = V[j_] * rstd_ * *(const f32x4*)(gam + c_) + *(const f32x4*)(bet + c_); *(f32x4*)(dst_ + c_) = xn_ * rs2_; \
                    if (!fin) { const f32x4 sh_ = *(const f32x4*)(md_ + c_), sc_ = *(const f32x4*)(md_ + DM + c_); st4bf(XMOD + (size_t)row_ * DM + c_, xn_ * (sc_ + 1.f) + sh_); } } } while (0)
            { f32x4 va[8], vb[8]; int row = gw + l * NCTX;
#pragma unroll
              for (int j = 0; j < 8; ++j) { va[j] = (f32x4){0.f, 0.f, 0.f, 0.f}; vb[j] = va[j]; }
              if (row < T) LN_LOAD(va, row);
              for (; row < T; row += 2 * NGW) {
                  const bool hb = row + NGW < T;
                  if (hb) LN_LOAD(vb, row + NGW);
                  LN_ROW(va, row);
                  if (row + 2 * NGW < T) LN_LOAD(va, row + 2 * NGW);
                  if (hb) LN_ROW(vb, row + NGW);
              } }
#undef LN_LOAD
#undef LN_ROW
        } else if (EN(9) && sub == 7) {
            pg8::Gemm g{XMOD + (size_t)l * 256 * DM, WGU, T - l * 256, 2 * DFF, DM}; pg8::StaticOrder S; S.init(T - l * 256, 2 * DFF, G, bid); EpiGU E{HB, l};
            for (int rg_ = 0; rg_ < DUP_GEMM; ++rg_) pg8::gemm_phase<EpiGU, pg8::StaticOrder, true, true>(lds, g, S, E);
        } else if (EN(10) && sub == 8) {
            pg8::Gemm g{HB + (size_t)256 * DFF, WD, T - 256, DM, DFF}; pg8::StaticOrder S; S.init(T - 256, DM, G, bid);
            EpiRes E{XRES, XRES + (size_t)NCTX * DM, XRES, mods_c + 5 * DM, mods_l + 5 * DM, 1};
            pg8::gemm_phase<EpiRes, pg8::StaticOrder, true, true>(lds, g, S, E);
            if (l == 0) for (int kp = 0; kp < 4; ++kp) {
                pg8::Gemm gc{HB + kp * 1408, WD + kp * 1408, 256, DM, 1408, DFF}; pg8::StaticOrder Sc; Sc.init(256, DM, G, (bid + G - 8 * kp) % G); EpiResAtomic Ec{XRES, mods_c + 5 * DM};
                pg8::gemm_phase<EpiResAtomic, pg8::StaticOrder, true, true>(lds, gc, Sc, Ec); }
        }
        if (ph + 1 < P.ph_hi) { if (ph == 0) grid.sync(); else xcd_barrier(xbar); }
    }
}

template <unsigned MASK> static void launch_one(int grid, Params p, hipStream_t stream, bool coop) {
    static bool attr_set = false;
    if (!attr_set) { (void)hipFuncSetAttribute((const void*)mega_fwd<MASK>, hipFuncAttributeMaxDynamicSharedMemorySize, LDS_BYTES); attr_set = true; }
    if (coop) { void* args[] = {&p}; hipError_t e = hipLaunchCooperativeKernel((const void*)mega_fwd<MASK>, dim3(grid), dim3(NTHR), args, LDS_BYTES, stream);
        if (e != hipSuccess) fprintf(stderr, "cooperative launch failed: %s (grid %d)\n", hipGetErrorString(e), grid); }
    else hipLaunchKernelGGL(mega_fwd<MASK>, dim3(grid), dim3(NTHR), LDS_BYTES, stream, p);
}
extern "C" void kernel_launch(void* const* d_in, const int* in_sizes, int n_in, void* d_out, int out_size, void* d_ws, size_t ws_size, hipStream_t stream) {
    static int grid = 0;
    if (grid == 0) {
        if (n_in != 31 || ws_size < WS_NEED) { fprintf(stderr, "kernel_launch: need 31 inputs and %zu bytes of workspace; got %d, %zu\n", (size_t)WS_NEED, n_in, ws_size); grid = -1; return; }
        int dev = 0, cus = 0;
        (void)hipGetDevice(&dev); (void)hipDeviceGetAttribute(&cus, hipDeviceAttributeMultiprocessorCount, dev);
        grid = cus;
#if !MK_MULTI
        int per_cu = 0;
        (void)hipFuncSetAttribute((const void*)mega_fwd<PH_MASK>, hipFuncAttributeMaxDynamicSharedMemorySize, LDS_BYTES);
        (void)hipOccupancyMaxActiveBlocksPerMultiprocessor(&per_cu, (const void*)mega_fwd<PH_MASK>, NTHR, LDS_BYTES);
        if (per_cu < 1) fprintf(stderr, "kernel_launch: occupancy query returned %d\n", per_cu);
        (void)hipGetLastError();
#endif
    }
    if (grid < 0) return;
    Params p{};
    for (int i = 0; i < 31; ++i) p.in[i] = (const float*)d_in[i];
    p.out = (float*)d_out; p.ws = (unsigned char*)d_ws;
#if MK_MULTI
#define L1(ph, mask) do { p.ph_lo = (ph); p.ph_hi = (ph) + 1; launch_one<(mask)>(grid, p, stream, false); } while (0)
    L1(0, 1u); L1(1, 2u);
    for (int l = 0; l < 2; ++l) { const int b = 2 + 10 * l;
        L1(b + 0, 1u << 2); L1(b + 1, (1u << 3) | (1u << 11) | (1u << 12) | (1u << 13)); L1(b + 1, (1u << 3) | (1u << 14) | (1u << 15));
        L1(b + 2, (1u << 4) | (1u << 16)); L1(b + 2, (1u << 4) | (1u << 17)); L1(b + 2, (1u << 4) | (1u << 18));
        L1(b + 3, 1u << 5); L1(b + 4, 1u << 6); L1(b + 5, 1u << 7); L1(b + 6, 1u << 8); L1(b + 7, 1u << 9); L1(b + 8, 1u << 10); L1(b + 9, 1u << 8); }
#else
    p.ph_lo = 0; p.ph_hi = N_PHASES;
    (void)hipMemsetAsync((unsigned char*)d_ws + O_BAR, 0, 16384, stream);
    launch_one<PH_MASK>(grid, p, stream, true);
#endif
}
```

```cpp
#include <hip/hip_runtime.h>
#include <hip/hip_cooperative_groups.h>
#include <cstdio>
#include <cstdint>
namespace cg = cooperative_groups;
#ifndef PH_MASK
#define PH_MASK 0xfffff
#endif
#define EN(k) (((MASK) >> (k)) & 1u)
#ifndef DUP_ATTN
#define DUP_ATTN 1
#endif
#ifndef DUP_S1
#define DUP_S1 1
#endif
#ifndef DUP_S2
#define DUP_S2 1
#endif
#ifndef DUP_S3
#define DUP_S3 1
#endif
#ifndef DUP_S4
#define DUP_S4 1
#endif
#ifndef DUP_GEMM
#define DUP_GEMM 1
#endif
#ifndef DUP_P0
#define DUP_P0 1
#endif
#ifndef MLA_DMA
#define MLA_DMA 1
#endif
#ifndef MK_MULTI
#define MK_MULTI 0
#endif
namespace pg8 {
#define PG8_LAS __attribute__((address_space(3)))
typedef unsigned short bf16_t;
typedef short bf16x8 __attribute__((ext_vector_type(8)));
typedef float f32x4 __attribute__((ext_vector_type(4)));
typedef unsigned u32x4 __attribute__((ext_vector_type(4)));
constexpr int BM = 256, BK = 64, HALF = 128, HTB = HALF * BK * 2  , STAGE_BYTES = 8 * HTB, NXCD = 8, WGM = 8;

__host__ __device__ __forceinline__ int lds_byte(int r, int c) { const int st = (r >> 4) * 2 + (c >> 5), rr = r & 15, cc = c & 31, ob = rr * 64 + cc * 2; return st * 1024 + (ob ^ (((ob >> 9) & 1) << 5)); }
__host__ __device__ __forceinline__ void stage_rc(int b, int& R, int& C) { const int st = b / 1024, sb = b % 1024, swz = sb ^ (((sb >> 9) & 1) << 5); R = (st >> 1) * 16 + swz / 64; C = (st & 1) * 32 + (swz % 64) / 2; }
__host__ __device__ __forceinline__ int perm32(int rho) { const int n = rho >> 4, i = rho & 15; return 8 * (i >> 2) + 4 * n + (i & 3); }

struct Unit { int pm, pn; };
struct Gemm { const bf16_t* A; const bf16_t* Bt; int M, N, K; int ld; };

struct StaticOrder {
    int nM, nN, nwg, G, c;
    __host__ __device__ void init(int M, int N, int G_, int c_) { nM = M / BM; nN = N / BM; nwg = nM * nN; G = G_; c = c_; }
    __host__ __device__ bool next(int i, Unit& u) const {
        const long L = (long)i * G + c; if (L >= nwg) return false;
        int wgid = (int)L; { const int q = nwg / NXCD, r = nwg % NXCD, xcd = wgid % NXCD, off = wgid / NXCD; wgid = (xcd < r ? xcd * (q + 1) : r * (q + 1) + (xcd - r) * q) + off; }
        const int nig = WGM * nN, gid = wgid / nig, fm = gid * WGM, gsz = (nM - fm) < WGM ? (nM - fm) : WGM;
        u.pm = fm + ((wgid % nig) % gsz); u.pn = (wgid % nig) / gsz; return true;
    }
    __device__ __forceinline__ void a_ready(const Unit&) const {}
    __device__ __forceinline__ void done(const Unit&) const {}
};

template <class Epi, class Sched, bool ALIGN_EPI = false, bool SP2 = false>
__device__ __forceinline__ void gemm_phase(PG8_LAS unsigned char* lds, const Gemm g, const Sched& S, const Epi& E) {
    int tid_ = threadIdx.x; asm volatile("" : "+v"(tid_));
    const int tid = tid_, wid = __builtin_amdgcn_readfirstlane(tid >> 6), lane = tid & 63, wr = wid >> 2, wc = wid & 3, fr = lane & 15, fq = lane >> 4;
    int K_ = g.K; asm volatile("" : "+s"(K_));
    const int K = K_, nt = K / BK; int LD_ = g.ld ? g.ld : g.K; asm volatile("" : "+s"(LD_)); const int LD = LD_;
    unsigned voffA[2], voffB[2];
#pragma unroll
    for (int i = 0; i < 2; ++i) { int R, C; stage_rc(tid * 16 + i * 8192, R, C); const int Rb = Epi::PERM ? ((R & ~31) + perm32(R & 31)) : R;
        voffA[i] = (unsigned)(R * LD + C) * 2u; voffB[i] = (unsigned)(Rb * LD + C) * 2u; }
    const size_t kstep = (size_t)(BK * 2);
    const size_t hstep = (size_t)HALF * LD * 2;
    const size_t tstep = 2 * hstep;
    const unsigned ldsw = (unsigned)wid * 1024u;
    const int aoff = lds_byte(wr * 64 + fr, fq * 8), boff = lds_byte(wc * 32 + fr, fq * 8);
#define PG8_SA(b, h) (((b) * 2 + (h)) * HTB)
#define PG8_SB(b, h) ((4 + (b) * 2 + (h)) * HTB)
#define PG8_STAGE(bufoff, gbase, voff) do { _Pragma("unroll") for (int _i = 0; _i < 2; ++_i) \
        __builtin_amdgcn_global_load_lds((const unsigned*)((const char*)(gbase) + (voff)[_i]), (PG8_LAS unsigned*)(lds + (bufoff) + ldsw + _i * 8192), 16, 0, 0); } while (0)
#define PG8_LDA(dst, b, h) do { _Pragma("unroll") for (int m = 0; m < 4; ++m) _Pragma("unroll") for (int k = 0; k < 2; ++k) dst[m][k] = *(const PG8_LAS bf16x8*)(lds + PG8_SA(b, h) + aoff + m * 2048 + k * 1024); } while (0)
#define PG8_LDB(dst, b, h) do { _Pragma("unroll") for (int n = 0; n < 2; ++n) _Pragma("unroll") for (int k = 0; k < 2; ++k) dst[n][k] = *(const PG8_LAS bf16x8*)(lds + PG8_SB(b, h) + boff + n * 2048 + k * 1024); } while (0)
#define PG8_MMA(ai, bj, At, Bt) do { __builtin_amdgcn_s_setprio(1); _Pragma("unroll") for (int m = 0; m < 4; ++m) _Pragma("unroll") for (int n = 0; n < 2; ++n) _Pragma("unroll") for (int k = 0; k < 2; ++k) \
        acc[ai][bj][m][n] = __builtin_amdgcn_mfma_f32_16x16x32_bf16(Bt[n][k], At[m][k], acc[ai][bj][m][n], 0, 0, 0); __builtin_amdgcn_s_setprio(0); } while (0)
#define PG8_WAIT_V(n) asm volatile("s_waitcnt vmcnt(" #n ")" ::: "memory")
#define PG8_WAIT_L(n) asm volatile("s_waitcnt lgkmcnt(" #n ")" ::: "memory")
#define PG8_BAR __builtin_amdgcn_s_barrier()
#define PG8_SCHED __builtin_amdgcn_sched_barrier(0)
    Unit cur, nxt; int ui = 0;
    if (!S.next(0, cur)) return;
    f32x4 acc[2][2][4][2];
#pragma unroll
    for (int a = 0; a < 2; ++a)
#pragma unroll
        for (int b = 0; b < 2; ++b)
#pragma unroll
            for (int m = 0; m < 4; ++m)
#pragma unroll
                for (int n = 0; n < 2; ++n) acc[a][b][m][n] = (f32x4){0.f, 0.f, 0.f, 0.f};
    bf16x8 At[4][2], B0[2][2], B1[2][2];
    const char* cA = (const char*)g.A + (size_t)cur.pm * tstep; const char* cB = (const char*)g.Bt + (size_t)cur.pn * tstep;
    S.a_ready(cur);
    if constexpr (SP2) {
        PG8_STAGE(PG8_SB(0, 0), cB, voffB); PG8_STAGE(PG8_SB(0, 1), cB + hstep, voffB); PG8_STAGE(PG8_SA(0, 0), cA, voffA); PG8_STAGE(PG8_SA(0, 1), cA + hstep, voffA);
        if (wr == 1) PG8_BAR;
        PG8_WAIT_V(2); PG8_BAR;
        PG8_STAGE(PG8_SB(1, 0), cB + kstep, voffB); PG8_STAGE(PG8_SA(1, 0), cA + kstep, voffA); PG8_STAGE(PG8_SB(1, 1), cB + hstep + kstep, voffB);
        PG8_WAIT_V(6); PG8_BAR;
    } else {
        PG8_STAGE(PG8_SB(0, 0), cB, voffB); PG8_STAGE(PG8_SA(0, 0), cA, voffA); PG8_STAGE(PG8_SB(0, 1), cB + hstep, voffB); PG8_STAGE(PG8_SA(0, 1), cA + hstep, voffA);
        if (wr == 1) PG8_BAR;
        PG8_WAIT_V(4); PG8_BAR;
        PG8_STAGE(PG8_SB(1, 0), cB + kstep, voffB); PG8_STAGE(PG8_SA(1, 0), cA + kstep, voffA); PG8_STAGE(PG8_SB(1, 1), cB + hstep + kstep, voffB);
        PG8_WAIT_V(6); PG8_BAR;
    }
    for (;;) {
        const bool has_next = S.next(ui + 1, nxt);
        const char* nA = has_next ? (const char*)g.A + (size_t)nxt.pm * tstep : cA; const char* nB = has_next ? (const char*)g.Bt + (size_t)nxt.pn * tstep : cB;
        for (int t = 0; t < nt; t += 2) {
            const bool last = (t == nt - 2);
            const char* a1 = cA + (size_t)(t + 1) * kstep;
            const char* a2 = last ? nA : cA + (size_t)(t + 2) * kstep; const char* b2 = last ? nB : cB + (size_t)(t + 2) * kstep;
            const char* a3 = a2 + kstep; const char* b3 = b2 + kstep;
            if (last && has_next) S.a_ready(nxt);
            if constexpr (SP2) {
            PG8_LDB(B0, 0, 0); PG8_LDB(B1, 0, 1); PG8_SCHED; PG8_LDA(At, 0, 0); PG8_STAGE(PG8_SA(1, 1), a1 + hstep, voffA);
            PG8_WAIT_V(8); PG8_WAIT_L(0); PG8_BAR; PG8_MMA(0, 0, At, B0); PG8_MMA(0, 1, At, B1); PG8_BAR; PG8_SCHED;
            PG8_LDA(At, 0, 1); PG8_STAGE(PG8_SB(0, 0), b2, voffB); PG8_STAGE(PG8_SB(0, 1), b2 + hstep, voffB); PG8_STAGE(PG8_SA(0, 0), a2, voffA);
            PG8_WAIT_V(8); PG8_WAIT_L(0); PG8_BAR; PG8_MMA(1, 0, At, B0); PG8_MMA(1, 1, At, B1); PG8_BAR; PG8_SCHED;
            PG8_LDB(B0, 1, 0); PG8_LDB(B1, 1, 1); PG8_SCHED; PG8_LDA(At, 1, 0); PG8_STAGE(PG8_SA(0, 1), a2 + hstep, voffA);
            PG8_WAIT_V(8); PG8_WAIT_L(0); PG8_BAR; PG8_MMA(0, 0, At, B0); PG8_MMA(0, 1, At, B1); PG8_BAR; PG8_SCHED;
            PG8_LDA(At, 1, 1); PG8_STAGE(PG8_SB(1, 0), b3, voffB); PG8_STAGE(PG8_SB(1, 1), b3 + hstep, voffB); PG8_STAGE(PG8_SA(1, 0), a3, voffA);
            PG8_WAIT_V(8); PG8_WAIT_L(0); PG8_BAR; PG8_MMA(1, 0, At, B0); PG8_MMA(1, 1, At, B1); PG8_BAR; PG8_SCHED;
            } else {
            PG8_LDB(B0, 0, 0); PG8_SCHED; PG8_LDA(At, 0, 0); PG8_STAGE(PG8_SA(1, 1), a1 + hstep, voffA);
            PG8_WAIT_L(8); PG8_BAR; PG8_WAIT_L(0); PG8_MMA(0, 0, At, B0); PG8_BAR; PG8_SCHED;
            PG8_LDB(B1, 0, 1); PG8_STAGE(PG8_SB(0, 0), b2, voffB);
            PG8_BAR; PG8_WAIT_L(0); PG8_MMA(0, 1, At, B1); PG8_BAR;
            PG8_LDA(At, 0, 1); PG8_STAGE(PG8_SA(0, 0), a2, voffA);
            PG8_BAR; PG8_WAIT_L(0); PG8_MMA(1, 0, At, B0); PG8_BAR; PG8_SCHED;
            PG8_STAGE(PG8_SB(0, 1), b2 + hstep, voffB);
            PG8_WAIT_V(6); PG8_BAR; PG8_MMA(1, 1, At, B1); PG8_BAR;
            PG8_LDB(B0, 1, 0); PG8_SCHED; PG8_LDA(At, 1, 0); PG8_STAGE(PG8_SA(0, 1), a2 + hstep, voffA);
            PG8_WAIT_L(8); PG8_BAR; PG8_WAIT_L(0); PG8_MMA(0, 0, At, B0); PG8_BAR; PG8_SCHED;
            PG8_LDB(B1, 1, 1); PG8_STAGE(PG8_SB(1, 0), b3, voffB);
            PG8_BAR; PG8_WAIT_L(0); PG8_MMA(0, 1, At, B1); PG8_BAR;
            PG8_LDA(At, 1, 1); PG8_STAGE(PG8_SA(1, 0), a3, voffA);
            PG8_BAR; PG8_WAIT_L(0); PG8_MMA(1, 0, At, B0); PG8_BAR; PG8_SCHED;
            PG8_STAGE(PG8_SB(1, 1), b3 + hstep, voffB);
            PG8_WAIT_V(6); PG8_BAR; PG8_MMA(1, 1, At, B1); PG8_BAR;
            }
        }
        if constexpr (ALIGN_EPI) { if (wr == 0) PG8_BAR; }
        if constexpr (!Epi::AFTER_DRAIN) { E(acc, cur, wr, wc, fr, fq); S.done(cur); }
        if (!has_next) break;
#pragma unroll
        for (int a = 0; a < 2; ++a)
#pragma unroll
            for (int b = 0; b < 2; ++b)
#pragma unroll
                for (int m = 0; m < 4; ++m)
#pragma unroll
                    for (int n = 0; n < 2; ++n) acc[a][b][m][n] = (f32x4){0.f, 0.f, 0.f, 0.f};
        cur = nxt; cA = nA; cB = nB; ++ui;
        if constexpr (ALIGN_EPI) { if (wr == 1) PG8_BAR; }
    }
    PG8_WAIT_V(0);
    if constexpr (!ALIGN_EPI) { if (wr == 0) PG8_BAR; }
    PG8_BAR;
    if constexpr (Epi::AFTER_DRAIN) { E.fused(acc, cur, wr, wc, fr, fq, lds, wid, lane); S.done(cur); }
#undef PG8_SA
#undef PG8_SB
#undef PG8_STAGE
#undef PG8_LDA
#undef PG8_LDB
#undef PG8_MMA
#undef PG8_WAIT_V
#undef PG8_WAIT_L
#undef PG8_BAR
#undef PG8_SCHED
}
}

using pg8::bf16_t; using pg8::bf16x8; using pg8::f32x4; using pg8::u32x4;
typedef float f32x16 __attribute__((ext_vector_type(16)));
typedef unsigned u32x2 __attribute__((ext_vector_type(2)));
typedef float f32x2_t __attribute__((ext_vector_type(2)));
typedef __bf16 bf16x2_t __attribute__((ext_vector_type(2)));
#define LAS __attribute__((address_space(3)))

constexpr int T = 16640, NCTX = 256, DM = 2048, DFF = 5632, NIN = 4352, INW = 3776;
constexpr int NTHR = 512, NWV = 8;
constexpr float ALPHA = 1.4142135623730951f;
constexpr float LOG2E = 1.4426950408889634f;
constexpr float QS_DA = 0.125f * 1.4426950408889634f;
constexpr float QS_MLA = (float)(0.07216878364870323 * 1.4426950408889634);
constexpr float RSQ128 = 0.08838834764831845f;
constexpr int LDS_BYTES = 147456;

__device__ __forceinline__ unsigned pk2(float lo, float hi) { f32x2_t v = {lo, hi}; bf16x2_t b = __builtin_convertvector(v, bf16x2_t); return __builtin_bit_cast(unsigned, b); }
__device__ __forceinline__ bf16_t f2bf(float f) { return (bf16_t)(pk2(f, 0.f) & 0xffffu); }
__device__ __forceinline__ float bf2f(unsigned b) { return __uint_as_float(b << 16); }
__device__ __forceinline__ float ex2(float x) { return __builtin_amdgcn_exp2f(x); }
__device__ __forceinline__ float max3f(float a, float b, float c) { return __builtin_fmaxf(__builtin_fmaxf(a, b), c); }
__device__ __forceinline__ int swap45(int o) { return (o & ~0x30) | ((o & 0x20) >> 1) | ((o & 0x10) << 1); }
__device__ __forceinline__ int swap23(int o) { return (o & ~0xC) | ((o & 0x4) << 1) | ((o & 0x8) >> 1); }
__device__ __forceinline__ float wave_sum(float v) {
#pragma unroll
    for (int o = 1; o < 64; o <<= 1) v += __shfl_xor(v, o);
    return v;
}
__device__ __forceinline__ float siluf(float x) { return x / (1.f + __expf(-x)); }
__device__ __forceinline__ float sigmf(float x) { return 1.f / (1.f + __expf(-x)); }
__device__ __forceinline__ float gelu_tanh(float x) { const float t = tanhf(0.7978845608028654f * (x + 0.044715f * x * x * x)); return 0.5f * x * (1.f + t); }

constexpr size_t al256(size_t x) { return (x + 255) & ~(size_t)255; }
constexpr size_t SZ_WIN = (size_t)NIN * DM * 2, SZ_WOUT = (size_t)DM * DM * 2, SZ_WGU = (size_t)2 * DFF * DM * 2, SZ_WD = (size_t)DM * DFF * 2;
constexpr size_t SZ_WUQ = (size_t)768 * 384 * 2, SZ_WUKV = (size_t)1024 * 256 * 2, SZ_WLRU = (size_t)8 * 256 * 128 * 2;
constexpr size_t O_WIN = 0, O_WOUT = O_WIN + SZ_WIN, O_WGU = O_WOUT + SZ_WOUT, O_WD = O_WGU + SZ_WGU, O_WUQ = O_WD + SZ_WD, O_WUKV = O_WUQ + SZ_WUQ, O_WLRU = O_WUKV + SZ_WUKV;
constexpr size_t SZ_WLAYER = O_WLRU + SZ_WLRU;
constexpr size_t O_F1T = 2 * SZ_WLAYER, O_F2T = O_F1T + 131072, O_ROPE = O_F2T + (size_t)128 * 131072, O_C8 = O_ROPE + 32768, O_MODS = O_C8 + 8192, O_BAR = al256(O_MODS + 2 * 2 * 12288 * 4), O_XMOD = al256(O_BAR + 16384);
constexpr size_t O_XRES = O_XMOD + (size_t)T * DM * 2, O_U = O_XRES + (size_t)T * DM * 4;
constexpr size_t O_QDA = O_U, O_KDA = O_QDA + (size_t)T * 512 * 2, O_VTDA = O_KDA + (size_t)T * 512 * 2, O_LRUX = O_VTDA + (size_t)T * 512 * 2, O_LRUG = O_LRUX + (size_t)T * 512 * 2;
constexpr size_t O_CQ = O_LRUG + (size_t)T * 512 * 2, O_CKV = O_CQ + (size_t)T * 384 * 2, O_PARTQ = O_CKV + (size_t)T * 256 * 2, O_PARTKV = O_PARTQ + (size_t)T * 8 * 4;
constexpr size_t O_QMLA = O_PARTKV + (size_t)T * 4 * 4, O_KMLA = O_QMLA + (size_t)T * 768 * 2, O_VTMLA = O_KMLA + (size_t)T * 768 * 2, O_FX = O_VTMLA + (size_t)T * 512 * 2;
constexpr size_t O_FT = O_FX + (size_t)65536 * 256 * 2, O_CTXW = O_FT + (size_t)65536 * 256 * 2, O_XC = O_CTXW + (size_t)256 * 1024 * 4, O_AU = O_XC + (size_t)4 * T * 128 * 2;
constexpr size_t O_SUMM = O_AU + (size_t)2 * T * 512 * 4, O_DAO = O_SUMM + (size_t)2 * 260 * 512 * 8, O_UEND = O_DAO + (size_t)T * 1024 * 2;
constexpr size_t O_H = O_U;
constexpr size_t WS_NEED = (O_UEND > O_H + (size_t)T * DFF * 2) ? O_UEND : (O_H + (size_t)T * DFF * 2);

struct Params { const float* in[31]; float* out; unsigned char* ws; int ph_lo, ph_hi; };
enum { I_X = 0, I_C, I_CTX, I_CCTX, I_WADA, I_BADA, I_WIN, I_WOUT, I_LN1G, I_LN1B, I_LN2G, I_LN2B, I_LQ1, I_LK1, I_LQ2, I_LK2, I_SUBLN, I_CONVW, I_CONVB, I_LWR, I_LBR, I_LWI, I_LBI, I_LLAM,
       I_QNG, I_WUQ, I_KVNG, I_WUKV, I_WG, I_WU, I_WD };

__device__ const float INVF[16] = {1.0f, 0.5623413324356079f, 0.3162277638912201f, 0.17782793939113617f, 0.10000000149011612f, 0.05623413249850273f, 0.03162277489900589f, 0.017782794311642647f,
                                   0.009999999776482582f, 0.005623413249850273f, 0.003162277629598975f, 0.0017782794311642647f, 0.0010000000474974513f, 0.000562341301701963f, 0.0003162277571391314f, 0.00017782794020604342f};

struct MapWin { const float* W; int stride;
    __device__ __forceinline__ const float* operator()(int d) const { const int tile = d >> 8, c = d & 255; int src;
        if (tile < 4) src = tile * 256 + swap45(c); else if (tile < 10) src = tile * 256 + c; else if (tile == 10) src = 2560 + c;
        else if (tile == 11) { if (c < 128) src = 2816 + c; else if (c < 192) src = 3200 + swap45(c - 128); else return nullptr; }
        else src = 2944 + c;
        return W + src; } };
struct MapPlain { const float* W; int stride; __device__ __forceinline__ const float* operator()(int d) const { return W + d; } };
struct MapGU { const float* Wg; const float* Wu; int stride;
    __device__ __forceinline__ const float* operator()(int d) const { const int tile = d >> 8, c = d & 255, n = (c >> 4) & 1, f = tile * 128 + 64 * (c >> 7) + 16 * ((c >> 5) & 3) + (c & 15); const long long dl = (const char*)Wu - (const char*)Wg; return (const float*)((const char*)Wg + (long long)n * dl) + f; } };
struct MapUq { const float* W; int stride;
    __device__ __forceinline__ const float* operator()(int d) const { if (d < 512) return W + (d >> 7) * 192 + (d & 127); const int c = d - 512; return W + (c >> 6) * 192 + 128 + swap45(c & 63); } };
struct MapUkv { const float* W; int stride;
    __device__ __forceinline__ const float* operator()(int d) const { if (d < 512) return W + (d >> 7) * 256 + (d & 127); const int e = d - 512; return W + (e >> 7) * 256 + 128 + (e & 127); } };
struct MapLru { const float* Wr; const float* Wi; int stride;
    __device__ __forceinline__ const float* operator()(int c) const { const int n = (c >> 4) & 1, j = 64 * (c >> 7) + 16 * ((c >> 5) & 3) + (c & 15); const long long dl = (const char*)Wi - (const char*)Wr; return (const float*)((const char*)Wr + (long long)n * dl) + j; } };

template <class Map>
__device__ __forceinline__ void tr_job(const Map mp, int Kd, int nrows, bf16_t* WT, const float* kscale, LAS float* scr, int gw, int NGW, int lane) {
    const int nblk = nrows / 32, items = (Kd / 64) * nblk, kr = lane >> 3, c4 = lane & 7;
    f32x4 cur[8], nxt[8];
#define TR_LOAD(dst, it_) do { const int kb_ = (it_) / nblk, nb_ = (it_) % nblk; const float* cp_ = mp(32 * nb_ + 4 * c4); const int st_ = mp.stride; \
        _Pragma("unroll") for (int i_ = 0; i_ < 8; ++i_) dst[i_] = cp_ ? *(const f32x4*)(cp_ + (size_t)(64 * kb_ + kr + 8 * i_) * st_) : (f32x4){0.f, 0.f, 0.f, 0.f}; } while (0)
    int it = gw;
    if (it < items) TR_LOAD(cur, it);
    for (; it < items; it += NGW) {
        const int kb = it / nblk, nb = it % nblk, k0 = 64 * kb, d0 = 32 * nb;
        if (it + NGW < items) TR_LOAD(nxt, it + NGW);
#pragma unroll
        for (int i = 0; i < 8; ++i) { const int kk = kr + 8 * i; f32x4 v = cur[i]; if (kscale) v = v * kscale[k0 + kk];
#pragma unroll
            for (int j = 0; j < 4; ++j) scr[kk * 33 + 4 * c4 + j] = v[j]; }
        asm volatile("s_waitcnt lgkmcnt(0)" ::: "memory");
        const int c = lane & 7;
#pragma unroll
        for (int j = 0; j < 4; ++j) { const int n = (lane >> 3) + 8 * j; const LAS float* sp = scr + (8 * c) * 33 + n;
            u32x4 o; o.x = pk2(sp[0 * 33], sp[1 * 33]); o.y = pk2(sp[2 * 33], sp[3 * 33]); o.z = pk2(sp[4 * 33], sp[5 * 33]); o.w = pk2(sp[6 * 33], sp[7 * 33]);
            *(u32x4*)(WT + (size_t)(d0 + n) * Kd + k0 + 8 * c) = o; }
        asm volatile("s_waitcnt lgkmcnt(0)" ::: "memory");
#pragma unroll
        for (int i = 0; i < 8; ++i) cur[i] = nxt[i];
    }
#undef TR_LOAD
}

#define EPI_ROWS_BEGIN _Pragma("unroll") for (int ai = 0; ai < 2; ++ai) _Pragma("unroll") for (int m = 0; m < 4; ++m) { const int row = u.pm * 256 + ai * 128 + wr * 64 + m * 16 + fr;
#define EPI_ROWS_END asm volatile("" ::: "memory"); __builtin_amdgcn_sched_barrier(0); }
__device__ __forceinline__ void st4bf(bf16_t* p, const f32x4 v) { u32x2 w; w.x = pk2(v[0], v[1]); w.y = pk2(v[2], v[3]); *(u32x2*)p = w; }

struct EpiInproj {
    static constexpr bool PERM = false, AFTER_DRAIN = false;
    bf16_t *QDA, *KDA, *VTDA, *LRUX, *LRUG, *CQ, *CKV, *KMLA, *FX; float *CTXW, *PARTQ, *PARTKV; const float* ROPE;
    __device__ __forceinline__ void rope_cs(int row, int wc, int fq, f32x4& c, f32x4& s) const {
        if (row < NCTX) { c = (f32x4){1.f, 1.f, 1.f, 1.f}; s = (f32x4){0.f, 0.f, 0.f, 0.f}; return; }
        const int nl = row - NCTX, pos = (wc & 1) ? (nl & 63) : (nl >> 6);
        const f32x4 a = *(const f32x4*)(ROPE + (pos * 16 + 4 * fq) * 2), b = *(const f32x4*)(ROPE + (pos * 16 + 4 * fq) * 2 + 4);
        c = (f32x4){a[0], a[2], b[0], b[2]}; s = (f32x4){a[1], a[3], b[1], b[3]};
    }
    __device__ __forceinline__ void operator()(const f32x4 (&acc)[2][2][4][2], const pg8::Unit& u, int wr, int wc, int fr, int fq) const {
        asm volatile("" : "+v"(fr), "+v"(fq));
        const int pn = u.pn;
        if (pn < 4) {
            bf16_t* dst = pn < 2 ? QDA : KDA; const float sc = pn < 2 ? QS_DA : 1.f; const int cb = (pn & 1) * 256 + 64 * (wc >> 1) + 16 * (wc & 1) + 4 * fq;
            EPI_ROWS_BEGIN  f32x4 c, s; rope_cs(row, wc, fq, c, s);
#pragma unroll
                for (int bj = 0; bj < 2; ++bj) { const f32x4 x1 = acc[ai][bj][m][0], x2 = acc[ai][bj][m][1];
                    st4bf(dst + (unsigned)row * 512 + cb + 128 * bj, (x1 * c - x2 * s) * sc); st4bf(dst + (unsigned)row * 512 + cb + 128 * bj + 32, (x1 * s + x2 * c) * sc); }  EPI_ROWS_END
        } else if (pn < 6) {
            EPI_ROWS_BEGIN
#pragma unroll
                for (int bj = 0; bj < 2; ++bj)
#pragma unroll
                    for (int n = 0; n < 2; ++n)
#pragma unroll
                        for (int j = 0; j < 4; ++j) VTDA[(unsigned)((pn - 4) * 256 + 128 * bj + 32 * wc + 16 * n + 4 * fq + j) * T + row] = f2bf(acc[ai][bj][m][n][j]);  EPI_ROWS_END
        } else if (pn < 10) {
            bf16_t* dst = pn < 8 ? LRUX : LRUG; const int cb = (pn & 1) * 256 + 32 * wc + 4 * fq;
            EPI_ROWS_BEGIN
#pragma unroll
                for (int bj = 0; bj < 2; ++bj)
#pragma unroll
                    for (int n = 0; n < 2; ++n) st4bf(dst + (unsigned)row * 512 + cb + 128 * bj + 16 * n, acc[ai][bj][m][n]);  EPI_ROWS_END
        } else if (pn == 10) {
            EPI_ROWS_BEGIN  float ss = 0.f;
#pragma unroll
                for (int bj = 0; bj < 2; ++bj)
#pragma unroll
                    for (int n = 0; n < 2; ++n) { const f32x4 v = acc[ai][bj][m][n]; st4bf(CQ + (unsigned)row * 384 + 128 * bj + 32 * wc + 16 * n + 4 * fq, v); ss += (v[0] * v[0] + v[1] * v[1]) + (v[2] * v[2] + v[3] * v[3]); }
                ss += __shfl_xor(ss, 16); ss += __shfl_xor(ss, 32); if (fq == 0) PARTQ[(unsigned)row * 8 + wc] = ss;  EPI_ROWS_END
        } else if (pn == 11) {
            EPI_ROWS_BEGIN  float ss = 0.f;
#pragma unroll
                for (int n = 0; n < 2; ++n) { const f32x4 v = acc[ai][0][m][n]; st4bf(CQ + (unsigned)row * 384 + 256 + 32 * wc + 16 * n + 4 * fq, v); ss += (v[0] * v[0] + v[1] * v[1]) + (v[2] * v[2] + v[3] * v[3]); }
                ss += __shfl_xor(ss, 16); ss += __shfl_xor(ss, 32); if (fq == 0) PARTQ[(unsigned)row * 8 + 4 + wc] = ss;
                if (wc < 2) { f32x4 c, s; rope_cs(row, wc, fq, c, s); const f32x4 x1 = acc[ai][1][m][0], x2 = acc[ai][1][m][1]; const f32x4 y1 = x1 * c - x2 * s, y2 = x1 * s + x2 * c;
#pragma unroll
                    for (int h = 0; h < 4; ++h) { bf16_t* kp = KMLA + (unsigned)row * 768 + h * 192 + 128 + 16 * (wc & 1) + 4 * fq; st4bf(kp, y1); st4bf(kp + 32, y2); } }  EPI_ROWS_END
        } else if (pn == 12) {
            EPI_ROWS_BEGIN  float ss = 0.f;
#pragma unroll
                for (int bj = 0; bj < 2; ++bj)
#pragma unroll
                    for (int n = 0; n < 2; ++n) { const f32x4 v = acc[ai][bj][m][n]; st4bf(CKV + (unsigned)row * 256 + 128 * bj + 32 * wc + 16 * n + 4 * fq, v); ss += (v[0] * v[0] + v[1] * v[1]) + (v[2] * v[2] + v[3] * v[3]); }
                ss += __shfl_xor(ss, 16); ss += __shfl_xor(ss, 32); if (fq == 0) PARTKV[(unsigned)row * 4 + wc] = ss;  EPI_ROWS_END
        } else {
            const int g = pn - 13;
            if (u.pm == 0) {
                EPI_ROWS_BEGIN
#pragma unroll
                    for (int bj = 0; bj < 2; ++bj)
#pragma unroll
                        for (int n = 0; n < 2; ++n) *(f32x4*)(CTXW + (unsigned)row * 1024 + g * 256 + 128 * bj + 32 * wc + 16 * n + 4 * fq) = acc[ai][bj][m][n];  EPI_ROWS_END
            } else {
                EPI_ROWS_BEGIN  const int nl = row - NCTX, n1 = nl >> 7, n2 = nl & 127;
#pragma unroll
                    for (int bj = 0; bj < 2; ++bj)
#pragma unroll
                        for (int n = 0; n < 2; ++n)
#pragma unroll
                            for (int j = 0; j < 4; ++j) FX[((unsigned)((n2 * 4 + g) * 128 + 32 * wc + 16 * n + 4 * fq + j)) * 256 + bj * 128 + n1] = f2bf(acc[ai][bj][m][n][j]);  EPI_ROWS_END
            }
        }
    }
};

struct EpiUpq {
    static constexpr bool PERM = false, AFTER_DRAIN = false;
    bf16_t* QMLA; const float* PARTQ; const float* ROPE;
    __device__ __forceinline__ void operator()(const f32x4 (&acc)[2][2][4][2], const pg8::Unit& u, int wr, int wc, int fr, int fq) const {
        asm volatile("" : "+v"(fr), "+v"(fq));
        const int pn = u.pn;
        EPI_ROWS_BEGIN  const f32x4 pa = *(const f32x4*)(PARTQ + (unsigned)row * 8), pb = *(const f32x4*)(PARTQ + (unsigned)row * 8 + 4);
            const float f = rsqrtf(((pa[0] + pa[1]) + (pa[2] + pa[3]) + (pb[0] + pb[1]) + (pb[2] + pb[3])) * (1.f / 384.f) + 1e-6f) * QS_MLA;
            if (pn < 2) {
#pragma unroll
                for (int bj = 0; bj < 2; ++bj)
#pragma unroll
                    for (int n = 0; n < 2; ++n) st4bf(QMLA + (unsigned)row * 768 + (2 * pn + bj) * 192 + 32 * wc + 16 * n + 4 * fq, acc[ai][bj][m][n] * f);
            } else {
                f32x4 c, s;
                if (row < NCTX) { c = (f32x4){1.f, 1.f, 1.f, 1.f}; s = (f32x4){0.f, 0.f, 0.f, 0.f}; }
                else { const int nl = row - NCTX, pos = (wc & 1) ? (nl & 63) : (nl >> 6);
                    const f32x4 a = *(const f32x4*)(ROPE + (pos * 16 + 4 * fq) * 2), b = *(const f32x4*)(ROPE + (pos * 16 + 4 * fq) * 2 + 4);
                    c = (f32x4){a[0], a[2], b[0], b[2]}; s = (f32x4){a[1], a[3], b[1], b[3]}; }
#pragma unroll
                for (int bj = 0; bj < 2; ++bj) { const f32x4 x1 = acc[ai][bj][m][0] * f, x2 = acc[ai][bj][m][1] * f; bf16_t* qp = QMLA + (unsigned)row * 768 + (2 * bj + (wc >> 1)) * 192 + 128 + 16 * (wc & 1) + 4 * fq;
                    st4bf(qp, x1 * c - x2 * s); st4bf(qp + 32, x1 * s + x2 * c); }
            }  EPI_ROWS_END
    }
};
struct EpiUpkv {
    static constexpr bool PERM = false, AFTER_DRAIN = false;
    bf16_t *KMLA, *VTMLA; const float* PARTKV;
    __device__ __forceinline__ void operator()(const f32x4 (&acc)[2][2][4][2], const pg8::Unit& u, int wr, int wc, int fr, int fq) const {
        asm volatile("" : "+v"(fr), "+v"(fq));
        const int pn = u.pn;
        EPI_ROWS_BEGIN  const f32x4 pa = *(const f32x4*)(PARTKV + (unsigned)row * 4);
            const float f = rsqrtf(((pa[0] + pa[1]) + (pa[2] + pa[3])) * (1.f / 256.f) + 1e-6f);
            if (pn < 2) {
#pragma unroll
                for (int bj = 0; bj < 2; ++bj)
#pragma unroll
                    for (int n = 0; n < 2; ++n) st4bf(KMLA + (unsigned)row * 768 + (2 * pn + bj) * 192 + 32 * wc + 16 * n + 4 * fq, acc[ai][bj][m][n] * f);
            } else {
#pragma unroll
                for (int bj = 0; bj < 2; ++bj)
#pragma unroll
                    for (int n = 0; n < 2; ++n)
#pragma unroll
                        for (int j = 0; j < 4; ++j) VTMLA[(unsigned)((pn - 2) * 256 + 128 * bj + 32 * wc + 16 * n + 4 * fq + j) * T + row] = f2bf(acc[ai][bj][m][n][j] * f);
            }  EPI_ROWS_END
    }
};
struct LruOrder {
    int G, c;
    __device__ bool next(int i, pg8::Unit& u) const { const long L = (long)i * G + c; if (L >= 520) return false; const int idx = (int)L, pmr = idx % 65, hd = idx / 65; u.pm = (hd >> 1) * 65 + pmr; u.pn = hd; return true; }
    __device__ __forceinline__ void a_ready(const pg8::Unit&) const {}
    __device__ __forceinline__ void done(const pg8::Unit&) const {}
};
__device__ __forceinline__ float neg_expm1(float x) {
    const float ser = -x * (1.f + x * (0.5f + x * (0.16666667f + x * 0.041666667f)));
    return x > -0.125f ? ser : 1.f - __expf(x);
}
struct EpiLru {
    static constexpr bool PERM = false, AFTER_DRAIN = false;
    unsigned* AU; const bf16_t* XC; const float *br, *bi, *c8;
    __device__ __forceinline__ void operator()(const f32x4 (&acc)[2][2][4][2], const pg8::Unit& u, int wr, int wc, int fr, int fq) const {
        asm volatile("" : "+v"(fr), "+v"(fq));
        const int h = u.pn >> 1, d = u.pn & 1, pmr = u.pm - h * 65;
#pragma unroll
        for (int bj = 0; bj < 2; ++bj) { const int chl = 64 * bj + 16 * wc + 4 * fq, ch = d * 512 + h * 128 + chl; const f32x4 vbr = *(const f32x4*)(br + ch), vbi = *(const f32x4*)(bi + ch), vc8 = *(const f32x4*)(c8 + ch);
#pragma unroll
            for (int ai = 0; ai < 2; ++ai)
#pragma unroll
                for (int m = 0; m < 4; ++m) { const int row = pmr * 256 + ai * 128 + wr * 64 + m * 16 + fr; const u32x2 xw = *(const u32x2*)(XC + ((unsigned)h * T + row) * 128 + chl); u32x4 o;
#pragma unroll
                    for (int j = 0; j < 4; ++j) { const float xv = bf2f(j & 1 ? (j < 2 ? xw.x : xw.y) >> 16 : (j < 2 ? xw.x : xw.y) & 0xffffu);
                        const float r = sigmf(acc[ai][bj][m][0][j] + vbr[j]), ig = sigmf(acc[ai][bj][m][1][j] + vbi[j]); const float la = vc8[j] * r;
                        const float uu = sqrtf(neg_expm1(2.f * la)) * (ig * xv); o[j] = pk2(uu, la * LOG2E); }
                    *(u32x4*)(AU + ((unsigned)d * T + row) * 512 + h * 128 + chl) = o; asm volatile("" ::: "memory"); __builtin_amdgcn_sched_barrier(0); } }
    }
};
struct EpiFftA {
    static constexpr bool PERM = false, AFTER_DRAIN = false;
    bf16_t* FT;
    __device__ __forceinline__ void operator()(const f32x4 (&acc)[2][2][4][2], const pg8::Unit& u, int wr, int wc, int fr, int fq) const {
        asm volatile("" : "+v"(fr), "+v"(fq));
        EPI_ROWS_BEGIN const int n2 = row >> 9, gj = row & 511; bf16_t* p0 = FT + ((unsigned)((16 * wc + 4 * fq) * 512 + gj)) * 256 + n2;
#pragma unroll
            for (int bj = 0; bj < 2; ++bj)
#pragma unroll
                for (int j = 0; j < 4; ++j) { bf16_t* p = p0 + (unsigned)(64 * bj + j) * 512 * 256; p[0] = f2bf(acc[ai][bj][m][0][j]); p[128] = f2bf(acc[ai][bj][m][1][j]); } EPI_ROWS_END
    }
};
struct FftCOrder {
    int G, c;
    __device__ bool next(int i, pg8::Unit& u) const { const long L = (long)i * G + c; if (L >= 256) return false; u.pm = (int)L; u.pn = (int)L >> 1; return true; }
    __device__ __forceinline__ void a_ready(const pg8::Unit&) const {}
    __device__ __forceinline__ void done(const pg8::Unit&) const {}
};
struct EpiFftC {
    static constexpr bool PERM = false, AFTER_DRAIN = false;
    bf16_t* MIX;
    __device__ __forceinline__ void operator()(const f32x4 (&acc)[2][2][4][2], const pg8::Unit& u, int wr, int wc, int fr, int fq) const {
        asm volatile("" : "+v"(fr), "+v"(fq));
        EPI_ROWS_BEGIN  const int k1 = row >> 9, gj = row & 511;
#pragma unroll
            for (int n = 0; n < 2; ++n)
#pragma unroll
                for (int j = 0; j < 4; ++j) { const int k2 = 32 * wc + 16 * n + 4 * fq + j; MIX[(unsigned)(NCTX + k1 + 128 * k2) * DM + 1536 + gj] = f2bf(acc[ai][0][m][n][j]); }  EPI_ROWS_END
    }
};
struct EpiRes {
    static constexpr bool PERM = false, AFTER_DRAIN = false;
    const float* xa; const float* xb; float* Y; const float* gate0; const float* gate1; int pm0;
    __device__ __forceinline__ void operator()(const f32x4 (&acc)[2][2][4][2], const pg8::Unit& u_, int wr, int wc, int fr, int fq) const {
        const pg8::Unit u{u_.pm + pm0, u_.pn};
        asm volatile("" : "+v"(fr), "+v"(fq));
        const float* gp = (u.pm == 0 ? gate0 : gate1) + u.pn * 256 + 32 * wc + 4 * fq;
        f32x4 gv[2][2];
#pragma unroll
        for (int bj = 0; bj < 2; ++bj)
#pragma unroll
            for (int n = 0; n < 2; ++n) gv[bj][n] = *(const f32x4*)(gp + 128 * bj + 16 * n);
        EPI_ROWS_BEGIN  const float* xo = (row < NCTX ? xa + (unsigned)row * DM : xb + (unsigned)(row - NCTX) * DM) + u.pn * 256 + 32 * wc + 4 * fq; float* yo = Y + (unsigned)row * DM + u.pn * 256 + 32 * wc + 4 * fq;
#pragma unroll
            for (int bj = 0; bj < 2; ++bj)
#pragma unroll
                for (int n = 0; n < 2; ++n) { const f32x4 xv = *(const f32x4*)(xo + 128 * bj + 16 * n); *(f32x4*)(yo + 128 * bj + 16 * n) = xv * ALPHA + gv[bj][n] * acc[ai][bj][m][n]; }  EPI_ROWS_END
    }
};
struct EpiResAtomic {
    static constexpr bool PERM = false, AFTER_DRAIN = false;
    float* Y; const float* gate;
    __device__ __forceinline__ void operator()(const f32x4 (&acc)[2][2][4][2], const pg8::Unit& u, int wr, int wc, int fr, int fq) const {
        asm volatile("" : "+v"(fr), "+v"(fq));
        const float* gp = gate + u.pn * 256 + 32 * wc + 4 * fq;
        EPI_ROWS_BEGIN float* yo = Y + (unsigned)row * DM + u.pn * 256 + 32 * wc + 4 * fq;
#pragma unroll
            for (int bj = 0; bj < 2; ++bj)
#pragma unroll
                for (int n = 0; n < 2; ++n) { const f32x4 gv = *(const f32x4*)(gp + 128 * bj + 16 * n);
#pragma unroll
                    for (int j = 0; j < 4; ++j) (void)unsafeAtomicAdd(yo + 128 * bj + 16 * n + j, gv[j] * acc[ai][bj][m][n][j]); } EPI_ROWS_END
    }
};
struct EpiGU {
    static constexpr bool PERM = false, AFTER_DRAIN = false;
    bf16_t* H; int pm0;
    __device__ __forceinline__ void operator()(const f32x4 (&acc)[2][2][4][2], const pg8::Unit& u_, int wr, int wc, int fr, int fq) const {
        const pg8::Unit u{u_.pm + pm0, u_.pn};
        asm volatile("" : "+v"(fr), "+v"(fq));
        EPI_ROWS_BEGIN
#pragma unroll
            for (int bj = 0; bj < 2; ++bj) { const f32x4 g = acc[ai][bj][m][0], v = acc[ai][bj][m][1]; f32x4 o;
#pragma unroll
                for (int j = 0; j < 4; ++j) o[j] = siluf(g[j]) * v[j];
                st4bf(H + (unsigned)row * DFF + u.pn * 128 + 64 * bj + 16 * wc + 4 * fq, o); }  EPI_ROWS_END
    }
};

template <int DQK>
__device__ __forceinline__ void attn_unit(const bf16_t* __restrict__ Q, int ldq, const bf16_t* __restrict__ K, int ldk, const bf16_t* __restrict__ Vt, bf16_t* O, int ldo, int q0, int nkeys, LAS unsigned char* lds) {
    constexpr int KS = DQK / 16, KROW = DQK + 8, KCH = DQK / 8, KLD = (64 * KCH) / NTHR, VROW = 72;
    LAS bf16_t* Ks = (LAS bf16_t*)lds; LAS bf16_t* Vs = (LAS bf16_t*)(lds + 2 * 64 * KROW * 2);
    int tid_ = threadIdx.x; asm volatile("" : "+v"(tid_));
    const int tid = tid_, lane = tid & 63, wid = tid >> 6, qi = lane & 31, hi = lane >> 5;
    bf16x8 qf[KS];
    { const bf16_t* qp = Q + (size_t)(q0 + wid * 32 + qi) * ldq + hi * 8;
#pragma unroll
      for (int ks = 0; ks < KS; ++ks) qf[ks] = *(const bf16x8*)(qp + ks * 16); }
    f32x16 o[4];
#pragma unroll
    for (int d0 = 0; d0 < 4; ++d0)
#pragma unroll
        for (int r = 0; r < 16; ++r) o[d0][r] = 0.f;
    float m_run = -1e30f, l_run = 0.f;
    const int NT = nkeys / 64;
    u32x4 kreg[KLD], vreg[2];
#define ATT_LOADK(t) do { _Pragma("unroll") for (int i_ = 0; i_ < KLD; ++i_) { const int c_ = tid + NTHR * i_, r_ = c_ / KCH, cc_ = c_ % KCH; kreg[i_] = *(const u32x4*)(K + (size_t)((t) * 64 + r_) * ldk + cc_ * 8); } } while (0)
#define ATT_LOADV(t) do { _Pragma("unroll") for (int i_ = 0; i_ < 2; ++i_) { const int c_ = tid + NTHR * i_, dv_ = c_ >> 3, k8_ = c_ & 7; vreg[i_] = *(const u32x4*)(Vt + (size_t)dv_ * T + (t) * 64 + k8_ * 8); } } while (0)
#define ATT_STOREK(b) do { _Pragma("unroll") for (int i_ = 0; i_ < KLD; ++i_) { const int c_ = tid + NTHR * i_, r_ = c_ / KCH, cc_ = c_ % KCH; *(LAS u32x4*)(Ks + (b) * 64 * KROW + r_ * KROW + cc_ * 8) = kreg[i_]; } } while (0)
#define ATT_STOREV(b) do { _Pragma("unroll") for (int i_ = 0; i_ < 2; ++i_) { const int c_ = tid + NTHR * i_, dv_ = c_ >> 3, k8_ = c_ & 7; *(LAS u32x4*)(Vs + (b) * 128 * VROW + dv_ * VROW + k8_ * 8) = vreg[i_]; } } while (0)
#define ATT_QK(S0, S1, b) do { const LAS bf16_t* kb_ = Ks + (b) * 64 * KROW + krow * KROW + hi * 8; \
        _Pragma("unroll") for (int r_ = 0; r_ < 16; ++r_) { S0[r_] = 0.f; S1[r_] = 0.f; } \
        _Pragma("unroll") for (int ks_ = 0; ks_ < KS; ++ks_) { const bf16x8 k0_ = *(const LAS bf16x8*)(kb_ + ks_ * 16), k1_ = *(const LAS bf16x8*)(kb_ + 32 * KROW + ks_ * 16); \
            S0 = __builtin_amdgcn_mfma_f32_32x32x16_bf16(k0_, qf[ks_], S0, 0, 0, 0); S1 = __builtin_amdgcn_mfma_f32_32x32x16_bf16(k1_, qf[ks_], S1, 0, 0, 0); } } while (0)
    const int krow = swap23(qi);
    ATT_LOADK(0); ATT_LOADV(0); ATT_STOREK(0); ATT_STOREV(0); ATT_LOADK(1); ATT_STOREK(1); __syncthreads();
    f32x16 s0, s1, n0, n1;
    ATT_QK(s0, s1, 0);
    for (int t = 0; t < NT; ++t) {
        const bool has1 = t + 1 < NT, has2 = t + 2 < NT;
        if (has2) ATT_LOADK(t + 2);
        if (has1) ATT_LOADV(t + 1);
        if (has1) ATT_QK(n0, n1, (t + 1) & 1);
        const LAS bf16_t* vb = Vs + (t & 1) * 128 * VROW + qi * VROW + hi * 8;
        float mx = fmaxf(s0[0], s1[0]);
#pragma unroll
        for (int r = 1; r < 16; ++r) mx = fmaxf(mx, fmaxf(s0[r], s1[r]));
        mx = fmaxf(mx, __shfl_xor(mx, 32));
        if (__any(mx > m_run + 8.f)) {
            const float m_new = fmaxf(m_run, mx), alpha = ex2(m_run - m_new); m_run = m_new; l_run *= alpha;
#pragma unroll
            for (int d0 = 0; d0 < 4; ++d0)
#pragma unroll
                for (int r = 0; r < 16; ++r) o[d0][r] *= alpha;
        }
        float ps = 0.f;
#pragma unroll
        for (int r = 0; r < 16; ++r) { s0[r] = ex2(s0[r] - m_run); s1[r] = ex2(s1[r] - m_run); ps += s0[r] + s1[r]; }
        l_run += ps;
        u32x4 pw[4];
#pragma unroll
        for (int i = 0; i < 4; ++i) { pw[0][i] = pk2(s0[2 * i], s0[2 * i + 1]); pw[1][i] = pk2(s0[8 + 2 * i], s0[8 + 2 * i + 1]); pw[2][i] = pk2(s1[2 * i], s1[2 * i + 1]); pw[3][i] = pk2(s1[8 + 2 * i], s1[8 + 2 * i + 1]); }
#pragma unroll
        for (int sp = 0; sp < 4; ++sp) { const bf16x8 pf = __builtin_bit_cast(bf16x8, pw[sp]);
#pragma unroll
            for (int d0 = 0; d0 < 4; ++d0) { const bf16x8 vf = *(const LAS bf16x8*)(vb + 32 * d0 * VROW + sp * 16); o[d0] = __builtin_amdgcn_mfma_f32_32x32x16_bf16(vf, pf, o[d0], 0, 0, 0); } }
        if (has2) ATT_STOREK(t & 1);
        if (has1) ATT_STOREV((t + 1) & 1);
        __syncthreads();
        s0 = n0; s1 = n1;
    }
#undef ATT_LOADK
#undef ATT_LOADV
#undef ATT_STOREK
#undef ATT_STOREV
#undef ATT_QK
    const float l = l_run + __shfl_xor(l_run, 32), inv = 1.f / l;
    bf16_t* op = O + (size_t)(q0 + wid * 32 + qi) * ldo + 4 * hi;
#pragma unroll
    for (int d0 = 0; d0 < 4; ++d0)
#pragma unroll
        for (int g = 0; g < 4; ++g) { u32x2 w; w.x = pk2(o[d0][4 * g] * inv, o[d0][4 * g + 1] * inv); w.y = pk2(o[d0][4 * g + 2] * inv, o[d0][4 * g + 3] * inv); *(u32x2*)(op + 32 * d0 + 8 * g) = w; }
}

__device__ __forceinline__ void glds16(const void* gsrc, unsigned lds_dst) { unsigned keep;
    asm volatile("s_mov_b32 %0, m0\n\ts_mov_b32 m0, %2\n\ts_nop 0\n\tglobal_load_lds_dwordx4 %1, off\n\ts_mov_b32 m0, %0" : "=&s"(keep) : "v"(gsrc), "s"(lds_dst) : "memory"); }
template <int DQK>
__device__ __forceinline__ void attn_unit_dma(const bf16_t* __restrict__ Q, int ldq, const bf16_t* __restrict__ K, int ldk, const bf16_t* __restrict__ Vt, bf16_t* O, int ldo, int q0, int nkeys, LAS unsigned char* lds) {
    constexpr int KS = DQK / 16, KROW = DQK + 8, KCH = DQK / 8, VROW = 72, KSL = KCH + 1, KCHUNKS = KSL, VCHUNKS = 18, NJ = (KCHUNKS + VCHUNKS + NWV - 1) / NWV;
    constexpr int KBYTES = KCHUNKS * 1024, VBYTES = VCHUNKS * 1024, SLOT = KBYTES + VBYTES, DUMMY = 3 * SLOT;
    static_assert(KROW * 2 == KSL * 16 && 64 * KROW * 2 == KBYTES && 128 * VROW * 2 == VBYTES && DUMMY + 1024 <= LDS_BYTES - 16, "attention LDS image");
    int tid_ = threadIdx.x; asm volatile("" : "+v"(tid_));
    const int tid = tid_, lane = tid & 63, wid = tid >> 6, qi = lane & 31, hi = lane >> 5;
    const int widu = __builtin_amdgcn_readfirstlane(wid);
    const unsigned lds0 = (unsigned)(size_t)lds;
    unsigned goff[NJ];
#pragma unroll
    for (int j = 0; j < NJ; ++j) { const int c = j * NWV + widu;
        if (c < KCHUNKS) { const int sl = c * 64 + lane, r = sl / KSL, cc = sl - r * KSL; goff[j] = (unsigned)(r * ldk + (cc == KCH ? 0 : cc) * 8); }
        else if (c < KCHUNKS + VCHUNKS) { const int sl = (c - KCHUNKS) * 64 + lane, r = sl / 9, cc = sl - r * 9; goff[j] = (unsigned)(r * T + (cc == 8 ? 0 : cc) * 8); }
        else goff[j] = 0u; }
#define AD_DMA(t, slot) do { _Pragma("unroll") for (int j_ = 0; j_ < NJ; ++j_) { const int c_ = j_ * NWV + widu; \
        if (c_ < KCHUNKS) glds16(K + (size_t)(t) * 64 * ldk + goff[j_], lds0 + (slot) * SLOT + c_ * 1024); \
        else if (c_ < KCHUNKS + VCHUNKS) glds16(Vt + (size_t)(t) * 64 + goff[j_], lds0 + (slot) * SLOT + KBYTES + (c_ - KCHUNKS) * 1024); \
        else glds16(K + goff[j_], lds0 + DUMMY); } } while (0)
    bf16x8 qf[KS];
    { const bf16_t* qp = Q + (size_t)(q0 + wid * 32 + qi) * ldq + hi * 8;
#pragma unroll
      for (int ks = 0; ks < KS; ++ks) qf[ks] = *(const bf16x8*)(qp + ks * 16); }
    f32x16 o[4];
#pragma unroll
    for (int d0 = 0; d0 < 4; ++d0)
#pragma unroll
        for (int r = 0; r < 16; ++r) o[d0][r] = 0.f;
    float l_run = 0.f;
    f32x16 negm;
#pragma unroll
    for (int r = 0; r < 16; ++r) negm[r] = 0.f;
    const int NT = nkeys / 64;
    const int krow = swap23(qi);
    AD_DMA(0, 0); AD_DMA(1, 1);
    asm volatile("s_waitcnt vmcnt(0) lgkmcnt(0)" ::: "memory"); __builtin_amdgcn_s_barrier(); asm volatile("" ::: "memory");
    int slot = 0, slot2 = 2;
    for (int t = 0; t < NT; ++t) {
        if (t + 2 < NT) AD_DMA(t + 2, slot2);
        const LAS bf16_t* kb = (const LAS bf16_t*)(lds + slot * SLOT) + krow * KROW + hi * 8; const LAS bf16_t* vb = (const LAS bf16_t*)(lds + slot * SLOT + KBYTES) + qi * VROW + hi * 8;
        f32x16 s0, s1;
        { const bf16x8 k0 = *(const LAS bf16x8*)(kb), k1 = *(const LAS bf16x8*)(kb + 32 * KROW);
          s0 = __builtin_amdgcn_mfma_f32_32x32x16_bf16(k0, qf[0], negm, 0, 0, 0); s1 = __builtin_amdgcn_mfma_f32_32x32x16_bf16(k1, qf[0], negm, 0, 0, 0); }
#pragma unroll
        for (int ks = 1; ks < KS; ++ks) { const bf16x8 k0 = *(const LAS bf16x8*)(kb + ks * 16), k1 = *(const LAS bf16x8*)(kb + 32 * KROW + ks * 16);
            s0 = __builtin_amdgcn_mfma_f32_32x32x16_bf16(k0, qf[ks], s0, 0, 0, 0); s1 = __builtin_amdgcn_mfma_f32_32x32x16_bf16(k1, qf[ks], s1, 0, 0, 0); }
        float mx = fmaxf(s0[0], s1[0]);
#pragma unroll
        for (int r = 1; r < 16; ++r) mx = max3f(mx, s0[r], s1[r]);
        mx = fmaxf(mx, __shfl_xor(mx, 32));
        if (t == 0 || __any(mx > 8.f)) {
            const float delta = t == 0 ? mx : fmaxf(mx, 0.f), alpha = t == 0 ? 1.f : ex2(-delta); l_run *= alpha;
#pragma unroll
            for (int r = 0; r < 16; ++r) { negm[r] -= delta; s0[r] -= delta; s1[r] -= delta; }
#pragma unroll
            for (int d0 = 0; d0 < 4; ++d0)
#pragma unroll
                for (int r = 0; r < 16; ++r) o[d0][r] *= alpha;
        }
        f32x2_t ps2 = {0.f, 0.f};
        u32x4 pw[4];
#pragma unroll
        for (int i = 0; i < 8; ++i) { f32x2_t e = (f32x2_t){s0[2 * i], s0[2 * i + 1]}, f = (f32x2_t){s1[2 * i], s1[2 * i + 1]}; e[0] = ex2(e[0]); e[1] = ex2(e[1]); f[0] = ex2(f[0]); f[1] = ex2(f[1]);
            ps2 = ps2 + e; ps2 = ps2 + f; pw[i >> 2][i & 3] = pk2(e[0], e[1]); pw[2 + (i >> 2)][i & 3] = pk2(f[0], f[1]); }
        l_run += ps2[0] + ps2[1];
#pragma unroll
        for (int sp = 0; sp < 4; ++sp) { const bf16x8 pf = __builtin_bit_cast(bf16x8, pw[sp]);
#pragma unroll
            for (int d0 = 0; d0 < 4; ++d0) { const bf16x8 vf = *(const LAS bf16x8*)(vb + 32 * d0 * VROW + sp * 16); o[d0] = __builtin_amdgcn_mfma_f32_32x32x16_bf16(vf, pf, o[d0], 0, 0, 0); } }
        if (t + 2 < NT) asm volatile("s_waitcnt vmcnt(%0) lgkmcnt(0)" :: "n"(NJ) : "memory"); else asm volatile("s_waitcnt vmcnt(0) lgkmcnt(0)" ::: "memory");
        __builtin_amdgcn_s_barrier(); asm volatile("" ::: "memory");
        slot2 = slot; slot = slot == 2 ? 0 : slot + 1;
    }
#undef AD_DMA
    const float l = l_run + __shfl_xor(l_run, 32), inv = 1.f / l;
    bf16_t* op = O + (size_t)(q0 + wid * 32 + qi) * ldo + 4 * hi;
#pragma unroll
    for (int d0 = 0; d0 < 4; ++d0)
#pragma unroll
        for (int g = 0; g < 4; ++g) { u32x2 w; w.x = pk2(o[d0][4 * g] * inv, o[d0][4 * g + 1] * inv); w.y = pk2(o[d0][4 * g + 2] * inv, o[d0][4 * g + 3] * inv); *(u32x2*)(op + 32 * d0 + 8 * g) = w; }
}

__device__ __forceinline__ void attn_unit_da(const bf16_t* __restrict__ Q, const bf16_t* __restrict__ K, const bf16_t* __restrict__ Vt, bf16_t* O, int q0, int nkeys, LAS unsigned char* lds) {
    constexpr int KROW = 72, VROW = 72, LDQ = 512, LDO = 1024;
    LAS bf16_t* Ks = (LAS bf16_t*)lds; LAS bf16_t* Vs = (LAS bf16_t*)(lds + 2 * 64 * KROW * 2);
    int tid_ = threadIdx.x; asm volatile("" : "+v"(tid_));
    const int tid = tid_, lane = tid & 63, wid = tid >> 6, qi = lane & 31, hi = lane >> 5, qg = wid >> 1, kh = wid & 1;
    bf16x8 qf[2][4];
#pragma unroll
    for (int qs = 0; qs < 2; ++qs) { const bf16_t* qp = Q + (size_t)(q0 + qg * 64 + qs * 32 + qi) * LDQ + hi * 8;
#pragma unroll
        for (int ks = 0; ks < 4; ++ks) qf[qs][ks] = *(const bf16x8*)(qp + ks * 16); }
    f32x16 o[2][4];
#pragma unroll
    for (int qs = 0; qs < 2; ++qs)
#pragma unroll
        for (int d0 = 0; d0 < 4; ++d0)
#pragma unroll
            for (int r = 0; r < 16; ++r) o[qs][d0][r] = 0.f;
    float m_run[2] = {-1e30f, -1e30f}, l_run[2] = {0.f, 0.f};
    const int NT = nkeys / 64;
    u32x4 kreg, vreg[2];
#define DA_LOADG(t) do { { const int r_ = tid >> 3, cc_ = tid & 7; kreg = *(const u32x4*)(K + (size_t)((t) * 64 + r_) * 512 + cc_ * 8); } \
        _Pragma("unroll") for (int i_ = 0; i_ < 2; ++i_) { const int c_ = tid + NTHR * i_, dv_ = c_ >> 3, k8_ = c_ & 7; vreg[i_] = *(const u32x4*)(Vt + (size_t)dv_ * T + (t) * 64 + k8_ * 8); } } while (0)
#define DA_STOREL(b) do { { const int r_ = tid >> 3, cc_ = tid & 7; *(LAS u32x4*)(Ks + (b) * 64 * KROW + r_ * KROW + cc_ * 8) = kreg; } \
        _Pragma("unroll") for (int i_ = 0; i_ < 2; ++i_) { const int c_ = tid + NTHR * i_, dv_ = c_ >> 3, k8_ = c_ & 7; *(LAS u32x4*)(Vs + (b) * 128 * VROW + dv_ * VROW + k8_ * 8) = vreg[i_]; } } while (0)
    DA_LOADG(0); DA_STOREL(0); __syncthreads();
    const int krow = 32 * kh + swap23(qi);
    for (int t = 0; t < NT; ++t) {
        const int buf = t & 1;
        if (t + 1 < NT) DA_LOADG(t + 1);
        const LAS bf16_t* kb = Ks + buf * 64 * KROW + krow * KROW + hi * 8; const LAS bf16_t* vb = Vs + buf * 128 * VROW + qi * VROW + 32 * kh + hi * 8;
        f32x16 sc[2];
#pragma unroll
        for (int r = 0; r < 16; ++r) { sc[0][r] = 0.f; sc[1][r] = 0.f; }
#pragma unroll
        for (int ks = 0; ks < 4; ++ks) { const bf16x8 kf = *(const LAS bf16x8*)(kb + ks * 16);
            sc[0] = __builtin_amdgcn_mfma_f32_32x32x16_bf16(kf, qf[0][ks], sc[0], 0, 0, 0); sc[1] = __builtin_amdgcn_mfma_f32_32x32x16_bf16(kf, qf[1][ks], sc[1], 0, 0, 0); }
        u32x4 pw[2][2];
#pragma unroll
        for (int qs = 0; qs < 2; ++qs) {
            float mx = max3f(sc[qs][0], sc[qs][1], sc[qs][2]);
#pragma unroll
            for (int r = 3; r < 15; r += 2) mx = max3f(mx, sc[qs][r], sc[qs][r + 1]);
            mx = fmaxf(mx, sc[qs][15]);
            mx = fmaxf(mx, __shfl_xor(mx, 32));
            if (__any(mx > m_run[qs] + 8.f)) {
                const float m_new = fmaxf(m_run[qs], mx), alpha = ex2(m_run[qs] - m_new); m_run[qs] = m_new; l_run[qs] *= alpha;
#pragma unroll
                for (int d0 = 0; d0 < 4; ++d0)
#pragma unroll
                    for (int r = 0; r < 16; ++r) o[qs][d0][r] *= alpha;
            }
            float ps = 0.f;
#pragma unroll
            for (int r = 0; r < 16; ++r) { sc[qs][r] = ex2(sc[qs][r] - m_run[qs]); ps += sc[qs][r]; }
            l_run[qs] += ps;
#pragma unroll
            for (int i = 0; i < 4; ++i) { pw[qs][0][i] = pk2(sc[qs][2 * i], sc[qs][2 * i + 1]); pw[qs][1][i] = pk2(sc[qs][8 + 2 * i], sc[qs][8 + 2 * i + 1]); }
        }
#pragma unroll
        for (int sp = 0; sp < 2; ++sp)
#pragma unroll
            for (int d0 = 0; d0 < 4; ++d0) { const bf16x8 vf = *(const LAS bf16x8*)(vb + 32 * d0 * VROW + sp * 16);
                o[0][d0] = __builtin_amdgcn_mfma_f32_32x32x16_bf16(vf, __builtin_bit_cast(bf16x8, pw[0][sp]), o[0][d0], 0, 0, 0);
                o[1][d0] = __builtin_amdgcn_mfma_f32_32x32x16_bf16(vf, __builtin_bit_cast(bf16x8, pw[1][sp]), o[1][d0], 0, 0, 0); }
        if (t + 1 < NT) DA_STOREL(buf ^ 1);
        __syncthreads();
    }
#undef DA_LOADG
#undef DA_STOREL
    LAS float* xp = (LAS float*)lds + (size_t)qg * (130 * 64) + lane;
#pragma unroll
    for (int qs = 0; qs < 2; ++qs) {
        const float lt = l_run[qs] + __shfl_xor(l_run[qs], 32);
        if (kh == 1) { xp[128 * 64] = m_run[qs]; xp[129 * 64] = lt;
#pragma unroll
            for (int d0 = 0; d0 < 4; ++d0)
#pragma unroll
                for (int r = 0; r < 16; ++r) xp[(d0 * 16 + r) * 64] = o[qs][d0][r]; }
        __syncthreads();
        if (kh == 0) { const float mb = xp[128 * 64], lb = xp[129 * 64];
            const float m = fmaxf(m_run[qs], mb), fa = ex2(m_run[qs] - m), fb = ex2(mb - m), inv = 1.f / (lt * fa + lb * fb), ca = fa * inv, cb = fb * inv;
            bf16_t* op = O + (size_t)(q0 + qg * 64 + qs * 32 + qi) * LDO + 4 * hi;
#pragma unroll
            for (int d0 = 0; d0 < 4; ++d0)
#pragma unroll
                for (int g = 0; g < 4; ++g) { float v[4];
#pragma unroll
                    for (int j = 0; j < 4; ++j) v[j] = o[qs][d0][4 * g + j] * ca + xp[(d0 * 16 + 4 * g + j) * 64] * cb;
                    u32x2 w; w.x = pk2(v[0], v[1]); w.y = pk2(v[2], v[3]); *(u32x2*)(op + 32 * d0 + 8 * g) = w; } }
        __syncthreads();
    }
}

#define XB_TMO      128
#define XB_XCNT(j)  (256  + 64 * (j))
#define XB_XSUB(j)  (1280 + 64 * (j))
#define XB_XGEN(j)  (2304 + 64 * (j))
#define XB_TOP      3328
#define XB_TOPGEN   3392
#define XCD_BAR_WORDS 3456
#define XB_SPIN_CAP (1u << 18)

__device__ __forceinline__ unsigned xb_ld(unsigned* p)              { return __hip_atomic_load(p, __ATOMIC_RELAXED, __HIP_MEMORY_SCOPE_AGENT); }
__device__ __forceinline__ unsigned xb_add(unsigned* p, unsigned v) { return __hip_atomic_fetch_add(p, v, __ATOMIC_RELAXED, __HIP_MEMORY_SCOPE_AGENT); }
__device__ __forceinline__ unsigned xb_xcc_id() { return (unsigned)__builtin_amdgcn_s_getreg((3 << 11) | 20) & 0xFu; }
#define XB_SPIN(cond, bar) do { unsigned _sp = 0; while (cond) { __builtin_amdgcn_s_sleep(1); \
    if ((++_sp & 255u) == 0u) { if (xb_ld(&(bar)[XB_TMO])) break; if (_sp > XB_SPIN_CAP) { atomicAdd(&(bar)[XB_TMO], 1u); break; } } } } while (0)

struct XcdBarrier {
    unsigned* bar; unsigned x;
    volatile LAS unsigned* st;
};

__device__ __forceinline__ XcdBarrier xcd_barrier_post(unsigned* bar, volatile LAS unsigned* st) {
    XcdBarrier b; b.bar = bar; b.x = xb_xcc_id(); b.st = st;
    if (threadIdx.x == 0) (void)xb_add(&bar[XB_XCNT(b.x)], 1u);
    return b;
}
__device__ __forceinline__ void xcd_barrier_complete(unsigned* bar, unsigned x, unsigned& nloc, unsigned& nx) {
    const unsigned G = gridDim.x * gridDim.y * gridDim.z;
    unsigned sum, cnt, mine, sp = 0u;
    for (;;) {
        sum = 0u; cnt = 0u; mine = 0u;
#pragma unroll
        for (unsigned j = 0; j < 16; ++j) { const unsigned c = xb_ld(&bar[XB_XCNT(j)]); sum += c; cnt += (c > 0u) ? 1u : 0u; mine = (j == x) ? c : mine; }
        if (sum == G) break;
        __builtin_amdgcn_s_sleep(1);
        if ((++sp & 255u) == 0u) { if (xb_ld(&bar[XB_TMO])) break; if (sp > XB_SPIN_CAP) { atomicAdd(&bar[XB_TMO], 1u); break; } }
    }
    nloc = mine > 0u ? mine : 1u; nx = cnt > 0u ? cnt : 1u;
}

__device__ __forceinline__ void xcd_barrier(const XcdBarrier& b) {
    asm volatile("s_waitcnt vmcnt(0)" ::: "memory");
    __syncthreads();
    if (threadIdx.x == 0) {
        unsigned* bar = b.bar;
        __builtin_amdgcn_s_waitcnt(0);
        unsigned nloc = b.st[0], nx = b.st[1];
        if (nloc == 0u) { xcd_barrier_complete(bar, b.x, nloc, nx); b.st[0] = nloc; b.st[1] = nx; }
        const unsigned old = xb_add(&bar[XB_XSUB(b.x)], 1u);
        const unsigned gen = old / nloc;
        if (old + 1u == (gen + 1u) * nloc) {
            __builtin_amdgcn_fence(__ATOMIC_RELEASE, "agent");
            asm volatile("s_waitcnt vmcnt(0)" ::: "memory");
            const unsigned og = xb_add(&bar[XB_TOP], 1u);
            const unsigned tg = og / nx;
            if (og + 1u == (tg + 1u) * nx) xb_add(&bar[XB_TOPGEN], 1u);
            else XB_SPIN(xb_ld(&bar[XB_TOPGEN]) == tg, bar);
            __builtin_amdgcn_fence(__ATOMIC_ACQUIRE, "agent");
            xb_add(&bar[XB_XGEN(b.x)], 1u);
            asm volatile("s_waitcnt vmcnt(0)" ::: "memory");
        } else {
            XB_SPIN(xb_ld(&bar[XB_XGEN(b.x)]) == gen, bar);
            __builtin_amdgcn_fence(__ATOMIC_ACQUIRE, "agent");
            asm volatile("s_waitcnt vmcnt(0)" ::: "memory");
        }
    }
    __syncthreads();
}

#define GAS __attribute__((address_space(1)))
#define PIN(i) ((const float*)(const GAS float*)pp->in[i])
#define F1T ((bf16_t*)(ws + O_F1T))
#define F2T ((bf16_t*)(ws + O_F2T))
#define ROPE ((float*)(ws + O_ROPE))
#define C8T ((float*)(ws + O_C8))
#define MODS ((float*)(ws + O_MODS))
#define XMOD ((bf16_t*)(ws + O_XMOD))
#define XRES ((float*)(ws + O_XRES))
#define QDA ((bf16_t*)(ws + O_QDA))
#define KDA ((bf16_t*)(ws + O_KDA))
#define VTDA ((bf16_t*)(ws + O_VTDA))
#define LRUX ((bf16_t*)(ws + O_LRUX))
#define LRUG ((bf16_t*)(ws + O_LRUG))
#define CQ ((bf16_t*)(ws + O_CQ))
#define CKV ((bf16_t*)(ws + O_CKV))
#define PARTQ ((float*)(ws + O_PARTQ))
#define PARTKV ((float*)(ws + O_PARTKV))
#define QMLA ((bf16_t*)(ws + O_QMLA))
#define KMLA ((bf16_t*)(ws + O_KMLA))
#define VTMLA ((bf16_t*)(ws + O_VTMLA))
#define FX ((bf16_t*)(ws + O_FX))
#define FT ((bf16_t*)(ws + O_FT))
#define CTXW ((float*)(ws + O_CTXW))
#define XC ((bf16_t*)(ws + O_XC))
#define AU ((unsigned*)(ws + O_AU))
#define SUMM ((float*)(ws + O_SUMM))
#define DAO ((bf16_t*)(ws + O_DAO))
#define HB ((bf16_t*)(ws + O_H))
#define WIN ((bf16_t*)(wl + O_WIN))
#define WOUT ((bf16_t*)(wl + O_WOUT))
#define WGU ((bf16_t*)(wl + O_WGU))
#define WD ((bf16_t*)(wl + O_WD))
#define WUQ ((bf16_t*)(wl + O_WUQ))
#define WUKV ((bf16_t*)(wl + O_WUKV))
#define WLRU ((bf16_t*)(wl + O_WLRU))
#define MIX XMOD
#define mods_c (MODS + (size_t)(l * 2 + 0) * 12288)
#define mods_l (MODS + (size_t)(l * 2 + 1) * 12288)
__device__ __forceinline__ int chunk_start(int c) { if (c <= 4) return 64 * c; const int cl = c - 4; return NCTX + 65 * cl + (cl < 4 ? cl : 4); }
constexpr int N_PHASES = 22;
template <unsigned MASK>
__global__ void __launch_bounds__(NTHR, 2) mega_fwd(Params P) {
    extern __shared__ __attribute__((aligned(16))) unsigned char lds_raw[];
    LAS unsigned char* lds = (LAS unsigned char*)lds_raw;
    const int tid0 = threadIdx.x;
    const int G0 = gridDim.x, bid0 = blockIdx.x;
    cg::grid_group grid = cg::this_grid();
    volatile LAS unsigned* bst = (volatile LAS unsigned*)(lds + LDS_BYTES - 16);
    if (tid0 < 4) bst[tid0] = 0u;
    __syncthreads();
    XcdBarrier xbar = xcd_barrier_post((unsigned*)(P.ws + O_BAR), bst);

    for (int ph = P.ph_lo; ph < P.ph_hi; ++ph) {
        const __attribute__((address_space(4))) Params* pp = (const __attribute__((address_space(4))) Params*)__builtin_amdgcn_kernarg_segment_ptr(); asm volatile("" : "+s"(pp));
        int tid = tid0; asm volatile("" : "+v"(tid));
        int G = G0, bid = bid0; asm volatile("" : "+s"(G), "+s"(bid));
        const int NGW = G * NWV, NT_ALL = G * NTHR;
        const int lane = tid & 63, wid = __builtin_amdgcn_readfirstlane(tid >> 6), gw = bid * NWV + wid, gtid = bid * NTHR + tid;
        GAS unsigned char* ws = (GAS unsigned char*)pp->ws; asm volatile("" : "+s"(ws));
        const int l = ph >= 2 ? (ph - 2) / 10 : 0, sub = ph >= 2 ? (ph - 2) % 10 : -1;
        GAS unsigned char* wl = ws + (size_t)l * SZ_WLAYER;
        if (EN(0) && ph == 0) {
            for (int rp_ = 0; rp_ < DUP_P0; ++rp_) {
            for (int it = bid; it < 256; it += G) {
                const int ll = it >> 7, g = (it >> 5) & 3, kb = it & 31, k0 = 64 * kb;
                LAS float* wt = (LAS float*)lds; LAS float* tab = wt + 128 * 68;
                const float* wsrc = PIN(I_WIN) + (size_t)ll * DM * INW;
                for (int i = 0; i < 16; ++i) { const int e = tid + NTHR * i, kk = e >> 7, c = e & 127; wt[c * 68 + kk] = wsrc[(size_t)(k0 + kk) * INW + 3264 + 128 * g + c]; }
                if (tid < 128) tab[tid] = cospif((float)tid * (1.f / 64.f)) * RSQ128;
                __syncthreads();
                const int col = tid & 255, part = col >> 7, jj = col & 127, kh = tid >> 8; const int ph0 = part ? 96 : 0;
                bf16_t* dst = (bf16_t*)(ws + (size_t)ll * SZ_WLAYER + O_WIN) + (size_t)((13 + g) * 256 + col) * DM + k0 + 32 * kh;
                f32x4 a[8];
#pragma unroll
                for (int q = 0; q < 8; ++q) a[q] = (f32x4){0.f, 0.f, 0.f, 0.f};
                for (int c = 0; c < 128; ++c) { const float tv = tab[(jj * c + ph0) & 127]; const LAS f32x4* wr4 = (const LAS f32x4*)(wt + c * 68 + 32 * kh);
#pragma unroll
                    for (int q = 0; q < 8; ++q) a[q] += wr4[q] * tv; }
                const float sg = part ? -1.f : 1.f;
#pragma unroll
                for (int q = 0; q < 4; ++q) { u32x4 o; o.x = pk2(a[2 * q][0] * sg, a[2 * q][1] * sg); o.y = pk2(a[2 * q][2] * sg, a[2 * q][3] * sg); o.z = pk2(a[2 * q + 1][0] * sg, a[2 * q + 1][1] * sg); o.w = pk2(a[2 * q + 1][2] * sg, a[2 * q + 1][3] * sg);
                    *(u32x4*)(dst + 8 * q) = o; }
                __syncthreads();
            }
            for (int it = bid; it < 192; it += G) {
                const int ll = it / 96, nc = it % 96;
                LAS float* sv = (LAS float*)lds; LAS float* red = sv + 2 * DM;
                for (int i = tid; i < DM; i += NTHR) { sv[i] = siluf(PIN(I_CCTX)[i]); sv[DM + i] = siluf(PIN(I_C)[i]); }
                __syncthreads();
                const float* wp = PIN(I_WADA) + (size_t)ll * DM * 12288 + 128 * nc + 2 * lane;
                float a00 = 0.f, a01 = 0.f, a10 = 0.f, a11 = 0.f;
                for (int k0 = 256 * wid; k0 < 256 * wid + 256; k0 += 16) { f32x2_t w2[16];
#pragma unroll
                    for (int j = 0; j < 16; ++j) w2[j] = *(const f32x2_t*)(wp + (size_t)(k0 + j) * 12288);
#pragma unroll
                    for (int j = 0; j < 16; ++j) { const float s0 = sv[k0 + j], s1 = sv[DM + k0 + j]; a00 += s0 * w2[j][0]; a01 += s0 * w2[j][1]; a10 += s1 * w2[j][0]; a11 += s1 * w2[j][1]; } }
                red[(wid * 2 + 0) * 128 + 2 * lane] = a00; red[(wid * 2 + 0) * 128 + 2 * lane + 1] = a01; red[(wid * 2 + 1) * 128 + 2 * lane] = a10; red[(wid * 2 + 1) * 128 + 2 * lane + 1] = a11;
                __syncthreads();
                if (tid < 256) { const int v = tid >> 7, cc = tid & 127; float s = PIN(I_BADA)[(size_t)ll * 12288 + 128 * nc + cc];
                    for (int w = 0; w < 8; ++w) s += red[(w * 2 + v) * 128 + cc];
                    MODS[(size_t)(ll * 2 + v) * 12288 + 128 * nc + cc] = s; }
                __syncthreads();
            }
            for (int i = gtid; i < 4096; i += NT_ALL) { const int pos = i >> 4, f = i & 15; const float x = ((float)pos * INVF[f]) * 0.3183098861837907f; ROPE[2 * i] = cospif(x); ROPE[2 * i + 1] = sinpif(x); }
            for (int i = gtid; i < 65536; i += NT_ALL) { const int cp = i >> 8, kk = i & 255, part = kk >> 7, nn = kk & 127;
                const int n = (cp >> 4) & 1, k1 = 64 * (cp >> 7) + 16 * ((cp >> 5) & 3) + (cp & 15); const float ang = (float)((k1 * nn) & 127) * (1.f / 64.f); const float cv = cospif(ang) * RSQ128, sv = sinpif(ang) * RSQ128;
                F1T[i] = f2bf(n == 0 ? (part == 0 ? cv : sv) : (part == 0 ? -sv : cv)); }
            for (int i = gtid; i < 128 * 65536; i += NT_ALL) { const int k1 = i >> 16, cp = (i >> 8) & 255, kk = i & 255, part = kk >> 7, nn = kk & 127;
                float v = 0.f; if (cp < 128) { const float ang = (float)((nn * (k1 + 128 * cp)) & 16383) * (1.f / 8192.f); v = (part == 0 ? cospif(ang) : sinpif(ang)) * RSQ128; } F2T[i] = f2bf(v); }
            for (int i = gtid; i < 2048; i += NT_ALL) C8T[i] = -8.f * log1pf(__expf(-PIN(I_LLAM)[i]));
            LAS float* scr = (LAS float*)(lds + wid * 8704);
            for (int ll = 0; ll < 2; ++ll) {
                GAS unsigned char* wd = ws + (size_t)ll * SZ_WLAYER;
                tr_job(MapWin{PIN(I_WIN) + (size_t)ll * DM * INW, INW}, DM, 13 * 256, (bf16_t*)(wd + O_WIN), nullptr, scr, gw, NGW, lane);
                tr_job(MapPlain{PIN(I_WOUT) + (size_t)ll * DM * DM, DM}, DM, DM, (bf16_t*)(wd + O_WOUT), nullptr, scr, gw, NGW, lane);
                tr_job(MapGU{PIN(I_WG) + (size_t)ll * DM * DFF, PIN(I_WU) + (size_t)ll * DM * DFF, DFF}, DM, 2 * DFF, (bf16_t*)(wd + O_WGU), nullptr, scr, gw, NGW, lane);
                tr_job(MapPlain{PIN(I_WD) + (size_t)ll * DFF * DM, DM}, DFF, DM, (bf16_t*)(wd + O_WD), nullptr, scr, gw, NGW, lane);
                tr_job(MapUq{PIN(I_WUQ) + (size_t)ll * 384 * 768, 768}, 384, 768, (bf16_t*)(wd + O_WUQ), PIN(I_QNG) + ll * 384, scr, gw, NGW, lane);
                tr_job(MapUkv{PIN(I_WUKV) + (size_t)ll * 256 * 1024, 1024}, 256, 1024, (bf16_t*)(wd + O_WUKV), PIN(I_KVNG) + ll * 256, scr, gw, NGW, lane);
                for (int hd = 0; hd < 8; ++hd) { const int h = hd >> 1, d = hd & 1; const size_t wo = ((size_t)(ll * 2 + d) * 4 + h) * 16384;
                    tr_job(MapLru{PIN(I_LWR) + wo, PIN(I_LWI) + wo, 128}, 128, 256, (bf16_t*)(wd + O_WLRU) + (size_t)hd * 256 * 128, nullptr, scr, gw, NGW, lane); }
            }
            __syncthreads(); }
        } else if (EN(1) && ph == 1) {
            for (int row = gw; row < T; row += NGW) { const float* xr = row < NCTX ? PIN(I_CTX) + (size_t)row * DM : PIN(I_X) + (size_t)(row - NCTX) * DM; const float* md = MODS + (size_t)(row < NCTX ? 0 : 1) * 12288;
#pragma unroll
                for (int j = 0; j < 8; ++j) { const int c = 4 * lane + 256 * j; const f32x4 xv = *(const f32x4*)(xr + c), sh = *(const f32x4*)(md + c), sc = *(const f32x4*)(md + DM + c); st4bf(XMOD + (size_t)row * DM + c, xv * (sc + 1.f) + sh); if (row < NCTX) *(f32x4*)(XRES + (size_t)row * DM + c) = xv * ALPHA; } }
        } else if (EN(2) && sub == 0) {
            pg8::Gemm g{XMOD, WIN, T, NIN, DM}; pg8::StaticOrder S; S.init(T, NIN, G, bid);
            EpiInproj E{QDA, KDA, VTDA, LRUX, LRUG, CQ, CKV, KMLA, FX, CTXW, PARTQ, PARTKV, ROPE};
            for (int rg_ = 0; rg_ < DUP_GEMM; ++rg_) pg8::gemm_phase<EpiInproj, pg8::StaticOrder, true, true>(lds, g, S, E);
        } else if (EN(3) && sub == 1) {
            for (int rs_ = 0; rs_ < DUP_S1; ++rs_) {
            if (EN(11)) { const float* cw = PIN(I_CONVW) + (size_t)l * 4 * 512; const float* cbv = PIN(I_CONVB) + (size_t)l * 512;
              for (int idx = gtid; idx < T * 64; idx += NT_ALL) { const int row = idx >> 6, ch0 = (idx & 63) * 8; const int lo = row < NCTX ? 0 : NCTX, hi = row < NCTX ? NCTX : T;
                  float a[8];
#pragma unroll
                  for (int q = 0; q < 8; ++q) a[q] = cbv[ch0 + q];
#pragma unroll
                  for (int j = 0; j < 4; ++j) { const int r = row + j - 2; if (r >= lo && r < hi) { const u32x4 xw = *(const u32x4*)(LRUX + (size_t)r * 512 + ch0); const float* wj = cw + j * 512 + ch0;
#pragma unroll
                      for (int q = 0; q < 4; ++q) { a[2 * q] += wj[2 * q] * bf2f(xw[q] & 0xffffu); a[2 * q + 1] += wj[2 * q + 1] * bf2f(xw[q] >> 16); } } }
                  u32x4 o; o.x = pk2(a[0], a[1]); o.y = pk2(a[2], a[3]); o.z = pk2(a[4], a[5]); o.w = pk2(a[6], a[7]);
                  *(u32x4*)(XC + ((size_t)(ch0 >> 7) * T + row) * 128 + (ch0 & 127)) = o; } }
            if (EN(12)) { pg8::Gemm g{CQ, WUQ, T, 768, 384}; pg8::StaticOrder S; S.init(T, 768, G, bid); EpiUpq E{QMLA, PARTQ, ROPE}; pg8::gemm_phase<EpiUpq, pg8::StaticOrder, true, true>(lds, g, S, E); }
            if (EN(13)) { pg8::Gemm g{CKV, WUKV, T, 1024, 256}; pg8::StaticOrder S; S.init(T, 1024, G, (bid + G - 195 % G) % G);     EpiUpkv E{KMLA, VTMLA, PARTKV}; pg8::gemm_phase<EpiUpkv, pg8::StaticOrder, true, true>(lds, g, S, E); }
            if (EN(14)) { pg8::Gemm g{FX, F1T, 65536, 256, 256}; pg8::StaticOrder S; S.init(65536, 256, G, bid); EpiFftA E{FT}; pg8::gemm_phase<EpiFftA, pg8::StaticOrder, true, true>(lds, g, S, E); }
            __syncthreads();
            if (EN(15)) for (int k = bid; k < 256; k += G) {
                LAS float* tab = (LAS float*)lds; LAS float* red = tab + 256; if (tid < 256) tab[tid] = cospif((float)tid * (1.f / 128.f)) * 0.0625f; __syncthreads();
                const float* wp = CTXW + (lane >> 4) * 256 + (lane & 15) * 8; f32x4 a0 = {0.f, 0.f, 0.f, 0.f}, a1 = a0;
                for (int n0 = 32 * wid; n0 < 32 * wid + 32; n0 += 8) { f32x4 xr[8][2], xi[8][2];
#pragma unroll
                    for (int j = 0; j < 8; ++j) { const float* p = wp + (size_t)(n0 + j) * 1024; xr[j][0] = *(const f32x4*)p; xr[j][1] = *(const f32x4*)(p + 4); xi[j][0] = *(const f32x4*)(p + 128); xi[j][1] = *(const f32x4*)(p + 132); }
#pragma unroll
                    for (int j = 0; j < 8; ++j) { const int mm = (k * (n0 + j)) & 255; const float cv = tab[mm], sv = tab[(mm + 192) & 255]; a0 += xr[j][0] * cv + xi[j][0] * sv; a1 += xr[j][1] * cv + xi[j][1] * sv; } }
                *(LAS f32x4*)(red + wid * 512 + lane * 8) = a0; *(LAS f32x4*)(red + wid * 512 + lane * 8 + 4) = a1;
                __syncthreads();
                { float t = 0.f;
#pragma unroll
                  for (int w = 0; w < 8; ++w) t += red[w * 512 + tid];
                  MIX[(size_t)k * DM + 1536 + tid] = f2bf(t); }
                __syncthreads(); }
            }
        } else if (EN(4) && sub == 2) {
            for (int rep_ = 0; rep_ < DUP_ATTN; ++rep_)
            if (EN(16)) for (int un = bid; un < 520; un += G) { const int hh = un < 512 ? (un & 7) : (un - 512), qb = un < 512 ? 1 + (un >> 3) : 0;
                attn_unit_da(QDA + hh * 64, KDA + hh * 64, VTDA + (size_t)(hh >> 1) * 128 * T, DAO + hh * 128, qb * 256, qb == 0 ? NCTX : T, lds); }
            for (int rs_ = 0; rs_ < DUP_S2; ++rs_) {
            if (EN(17)) { pg8::Gemm g{XC, WLRU, 4 * T, 2048, 128}; LruOrder S{G, bid}; EpiLru E{AU, XC, PIN(I_LBR) + (size_t)l * 1024, PIN(I_LBI) + (size_t)l * 1024, C8T + (size_t)l * 1024};
              pg8::gemm_phase<EpiLru, LruOrder, true, true>(lds, g, S, E); }
            if (EN(18)) { pg8::Gemm g{FT, F2T, 65536, 256, 256}; FftCOrder S{G, bid}; EpiFftC E{MIX}; pg8::gemm_phase<EpiFftC, FftCOrder, true, true>(lds, g, S, E); }
            }
        } else if (EN(5) && sub == 3) {
            for (int rep_ = 0; rep_ < DUP_ATTN; ++rep_)
            for (int un = bid; un < 260; un += G) { const int h = un < 256 ? (un & 3) : (un - 256), qb = un < 256 ? 1 + (un >> 2) : 0;
                if (MLA_DMA) attn_unit_dma<192>(QMLA + h * 192, 768, KMLA + h * 192, 768, VTMLA + (size_t)h * 128 * T, MIX + 1024 + h * 128, DM, qb * 256, qb == 0 ? NCTX : T, lds);
                else attn_unit<192>(QMLA + h * 192, 768, KMLA + h * 192, 768, VTMLA + (size_t)h * 128 * T, MIX + 1024 + h * 128, DM, qb * 256, qb == 0 ? NCTX : T, lds); }
            for (int rs_ = 0; rs_ < DUP_S3; ++rs_)
            for (int un = bid; un < 512; un += G) { const int d = un >> 8, c = un & 255; const int cs = chunk_start(c), len = chunk_start(c + 1) - cs;
                const unsigned* au = AU + (size_t)d * T * 512 + tid; float h = 0.f, S = 0.f;
                for (int i0 = 0; i0 < len; i0 += 16) { unsigned w[16];
#pragma unroll
                    for (int j = 0; j < 16; ++j) { const int i = i0 + j < len ? i0 + j : len - 1; const int row = d == 0 ? cs + i : cs + len - 1 - i; w[j] = au[(size_t)row * 512]; }
#pragma unroll
                    for (int j = 0; j < 16; ++j) if (i0 + j < len) { const float l2a = bf2f(w[j] >> 16), uu = bf2f(w[j] & 0xffffu); h = ex2(l2a) * h + uu; S += l2a; } }
                SUMM[((size_t)(d * 256 + c) * 512 + tid) * 2] = S; SUMM[((size_t)(d * 256 + c) * 512 + tid) * 2 + 1] = h; }
        } else if (EN(6) && sub == 4) {
            for (int rs_ = 0; rs_ < DUP_S4; ++rs_) {
            __syncthreads();
            for (int c = bid; c < 256; c += G) { LAS float* hfs = (LAS float*)lds; const f32x2_t* S0 = (const f32x2_t*)SUMM + tid; const f32x2_t* S1 = S0 + (size_t)256 * 512;
                const int cs = chunk_start(c), len = chunk_start(c + 1) - cs;
                float hf = 0.f, hb = 0.f;
                for (int p0 = 0; p0 < c; p0 += 16) { f32x2_t sv[16];
#pragma unroll
                    for (int j = 0; j < 16; ++j) { const int k = p0 + j < c ? p0 + j : c - 1; sv[j] = S0[(size_t)k * 512]; }
#pragma unroll
                    for (int j = 0; j < 16; ++j) if (p0 + j < c) hf = ex2(sv[j][0]) * hf + sv[j][1]; }
                const int np = c < 4 ? 3 - c : 4 + 255 - c;
                for (int p0 = 0; p0 < np; p0 += 16) { f32x2_t sv[16];
#pragma unroll
                    for (int j = 0; j < 16; ++j) { const int p = p0 + j < np ? p0 + j : np - 1; const int k = p < 4 ? 3 - p : 259 - p; sv[j] = S1[(size_t)k * 512]; }
#pragma unroll
                    for (int j = 0; j < 16; ++j) if (p0 + j < np) hb = ex2(sv[j][0]) * hb + sv[j][1]; }
                const unsigned* a0 = AU + tid; const unsigned* a1 = AU + (size_t)T * 512 + tid;
                for (int i0 = 0; i0 < len; i0 += 16) { unsigned w[16];
#pragma unroll
                    for (int j = 0; j < 16; ++j) { const int i = i0 + j < len ? i0 + j : len - 1; w[j] = a0[(size_t)(cs + i) * 512]; }
#pragma unroll
                    for (int j = 0; j < 16; ++j) if (i0 + j < len) { hf = ex2(bf2f(w[j] >> 16)) * hf + bf2f(w[j] & 0xffffu); hfs[(i0 + j) * 512 + tid] = hf; } }
                for (int i0 = 0; i0 < len; i0 += 16) { unsigned w[16]; bf16_t gg[16];
#pragma unroll
                    for (int j = 0; j < 16; ++j) { const int i = i0 + j < len ? i0 + j : len - 1; const int row = cs + len - 1 - i; w[j] = a1[(size_t)row * 512]; gg[j] = LRUG[(size_t)row * 512 + tid]; }
#pragma unroll
                    for (int j = 0; j < 16; ++j) if (i0 + j < len) { const int ii = len - 1 - (i0 + j); hb = ex2(bf2f(w[j] >> 16)) * hb + bf2f(w[j] & 0xffffu);
                        MIX[(size_t)(cs + ii) * DM + 512 + tid] = f2bf((hfs[ii * 512 + tid] + hb) * gelu_tanh(bf2f(gg[j]))); } } }
            { const float linit = l == 0 ? 0.2f : 0.35550906759096926f;
              const float e1 = __expf(wave_sum(PIN(I_LQ1)[l * 64 + lane] * PIN(I_LK1)[l * 64 + lane])), e2 = __expf(wave_sum(PIN(I_LQ2)[l * 64 + lane] * PIN(I_LK2)[l * 64 + lane])); const float lam = e1 - e2 + linit;
              const float g0 = PIN(I_SUBLN)[l * 128 + 2 * lane] * (1.f - linit), g1 = PIN(I_SUBLN)[l * 128 + 2 * lane + 1] * (1.f - linit);
              for (int row = gw; row < T; row += NGW) { unsigned w1[4], w2[4];
#pragma unroll
                  for (int h = 0; h < 4; ++h) { w1[h] = *(const unsigned*)(DAO + (size_t)row * 1024 + h * 256 + 2 * lane); w2[h] = *(const unsigned*)(DAO + (size_t)row * 1024 + h * 256 + 128 + 2 * lane); }
#pragma unroll
                  for (int h = 0; h < 4; ++h) { const float y0 = bf2f(w1[h] & 0xffffu) - lam * bf2f(w2[h] & 0xffffu), y1 = bf2f(w1[h] >> 16) - lam * bf2f(w2[h] >> 16); const float inv = rsqrtf(wave_sum(y0 * y0 + y1 * y1) * (1.f / 128.f) + 1e-6f);
                      *(unsigned*)(MIX + (size_t)row * DM + h * 128 + 2 * lane) = pk2(y0 * inv * g0, y1 * inv * g1); } } }
            }
        } else if (EN(7) && sub == 5) {
            pg8::Gemm g{MIX + (size_t)256 * DM, WOUT, T - 256, DM, DM}; pg8::StaticOrder S; S.init(T - 256, DM, G, bid);
            EpiRes E{l == 0 ? PIN(I_CTX) : XRES, l == 0 ? PIN(I_X) : XRES + (size_t)NCTX * DM, XRES, mods_c + 2 * DM, mods_l + 2 * DM, 1};
            pg8::gemm_phase<EpiRes, pg8::StaticOrder, true, true>(lds, g, S, E);
            if (l == 0) for (int kp = 0; kp < 4; ++kp) {
                pg8::Gemm gc{MIX + kp * 512, WOUT + kp * 512, 256, DM, 512, DM}; pg8::StaticOrder Sc; Sc.init(256, DM, G, (bid + G - 8 * kp) % G); EpiResAtomic Ec{XRES, mods_c + 2 * DM};
                pg8::gemm_phase<EpiResAtomic, pg8::StaticOrder, true, true>(lds, gc, Sc, Ec); }
        } else if (EN(8) && (sub == 6 || sub == 9)) {
            const bool second = sub == 9, fin = second && l == 1;
            const float* gam = PIN(second ? I_LN2G : I_LN1G) + (size_t)l * DM; const float* bet = PIN(second ? I_LN2B : I_LN1B) + (size_t)l * DM;
#define LN_LOAD(V, R) do { _Pragma("unroll") for (int j_ = 0; j_ < 8; ++j_) V[j_] = *(const f32x4*)(XRES + (size_t)(R) * DM + 4 * lane + 256 * j_); } while (0)
#define LN_ROW(V, R) do { const int row_ = (R); float* yr_ = XRES + (size_t)row_ * DM; float s_ = 0.f; \
                _Pragma("unroll") for (int j_ = 0; j_ < 8; ++j_) s_ += (V[j_][0] + V[j_][1]) + (V[j_][2] + V[j_][3]); \
                const float mean_ = wave_sum(s_) * (1.f / DM); float s2_ = 0.f; \
                _Pragma("unroll") for (int j_ = 0; j_ < 8; ++j_) { V[j_] = V[j_] - mean_; s2_ += (V[j_][0] * V[j_][0] + V[j_][1] * V[j_][1]) + (V[j_][2] * V[j_][2] + V[j_][3] * V[j_][3]); } \
                const float rstd_ = rsqrtf(wave_sum(s2_) * (1.f / DM) + 1e-5f); \
                const float* md_ = second ? MODS + (size_t)((l + 1) * 2 + (row_ < NCTX ? 0 : 1)) * 12288 : MODS + (size_t)(l * 2 + (row_ < NCTX ? 0 : 1)) * 12288 + 3 * DM; \
                float* dst_ = fin ? ((float*)(GAS float*)pp->out) + (size_t)(row_ - NCTX) * DM : yr_; \
                const float rs2_ = (!second && row_ < NCTX) ? ALPHA : 1.f; \
                _Pragma("unroll") for (int j_ = 0; j_ < 8; ++j_) { const int c_ = 4 * lane + 256 * j_; const f32x4 xn_ = V[j_] * rstd_ * *(const f32x4*)(gam + c_) + *(const f32x4*)(bet + c_); *(f32x4*)(dst_ + c_) = xn_ * rs2_; \
                    if (!fin) { const f32x4 sh_ = *(const f32x4*)(md_ + c_), sc_ = *(const f32x4*)(md_ + DM + c_); st4bf(XMOD + (size_t)row_ * DM + c_, xn_ * (sc_ + 1.f) + sh_); } } } while (0)
            { f32x4 va[8], vb[8]; int row = gw + l * NCTX;
#pragma unroll
              for (int j = 0; j < 8; ++j) { va[j] = (f32x4){0.f, 0.f, 0.f, 0.f}; vb[j] = va[j]; }
              if (row < T) LN_LOAD(va, row);
              for (; row < T; row += 2 * NGW) {
                  const bool hb = row + NGW < T;
                  if (hb) LN_LOAD(vb, row + NGW);
                  LN_ROW(va, row);
                  if (row + 2 * NGW < T) LN_LOAD(va, row + 2 * NGW);
                  if (hb) LN_ROW(vb, row + NGW);
              } }
#undef LN_LOAD
#undef LN_ROW
        } else if (EN(9) && sub == 7) {
            pg8::Gemm g{XMOD + (size_t)l * 256 * DM, WGU, T - l * 256, 2 * DFF, DM}; pg8::StaticOrder S; S.init(T - l * 256, 2 * DFF, G, bid); EpiGU E{HB, l};
            for (int rg_ = 0; rg_ < DUP_GEMM; ++rg_) pg8::gemm_phase<EpiGU, pg8::StaticOrder, true, true>(lds, g, S, E);
        } else if (EN(10) && sub == 8) {
            pg8::Gemm g{HB + (size_t)256 * DFF, WD, T - 256, DM, DFF}; pg8::StaticOrder S; S.init(T - 256, DM, G, bid);
            EpiRes E{XRES, XRES + (size_t)NCTX * DM, XRES, mods_c + 5 * DM, mods_l + 5 * DM, 1};
            pg8::gemm_phase<EpiRes, pg8::StaticOrder, true, true>(lds, g, S, E);
            if (l == 0) for (int kp = 0; kp < 4; ++kp) {
                pg8::Gemm gc{HB + kp * 1408, WD + kp * 1408, 256, DM, 1408, DFF}; pg8::StaticOrder Sc; Sc.init(256, DM, G, (bid + G - 8 * kp) % G); EpiResAtomic Ec{XRES, mods_c + 5 * DM};
                pg8::gemm_phase<EpiResAtomic, pg8::StaticOrder, true, true>(lds, gc, Sc, Ec); }
        }
        if (ph + 1 < P.ph_hi) { if (ph == 0) grid.sync(); else xcd_barrier(xbar); }
    }
}

template <unsigned MASK> static void launch_one(int grid, Params p, hipStream_t stream, bool coop) {
    static bool attr_set = false;
    if (!attr_set) { (void)hipFuncSetAttribute((const void*)mega_fwd<MASK>, hipFuncAttributeMaxDynamicSharedMemorySize, LDS_BYTES); attr_set = true; }
    if (coop) { void* args[] = {&p}; hipError_t e = hipLaunchCooperativeKernel((const void*)mega_fwd<MASK>, dim3(grid), dim3(NTHR), args, LDS_BYTES, stream);
        if (e != hipSuccess) fprintf(stderr, "cooperative launch failed: %s (grid %d)\n", hipGetErrorString(e), grid); }
    else hipLaunchKernelGGL(mega_fwd<MASK>, dim3(grid), dim3(NTHR), LDS_BYTES, stream, p);
}
extern "C" void kernel_launch(void* const* d_in, const int* in_sizes, int n_in, void* d_out, int out_size, void* d_ws, size_t ws_size, hipStream_t stream) {
    static int grid = 0;
    if (grid == 0) {
        if (n_in != 31 || ws_size < WS_NEED) { fprintf(stderr, "kernel_launch: need 31 inputs and %zu bytes of workspace; got %d, %zu\n", (size_t)WS_NEED, n_in, ws_size); grid = -1; return; }
        int dev = 0, cus = 0;
        (void)hipGetDevice(&dev); (void)hipDeviceGetAttribute(&cus, hipDeviceAttributeMultiprocessorCount, dev);
        grid = cus;
#if !MK_MULTI
        int per_cu = 0;
        (void)hipFuncSetAttribute((const void*)mega_fwd<PH_MASK>, hipFuncAttributeMaxDynamicSharedMemorySize, LDS_BYTES);
        (void)hipOccupancyMaxActiveBlocksPerMultiprocessor(&per_cu, (const void*)mega_fwd<PH_MASK>, NTHR, LDS_BYTES);
        if (per_cu < 1) fprintf(stderr, "kernel_launch: occupancy query returned %d\n", per_cu);
        (void)hipGetLastError();
#endif
    }
    if (grid < 0) return;
    Params p{};
    for (int i = 0; i < 31; ++i) p.in[i] = (const float*)d_in[i];
    p.out = (float*)d_out; p.ws = (unsigned char*)d_ws;
#if MK_MULTI
#define L1(ph, mask) do { p.ph_lo = (ph); p.ph_hi = (ph) + 1; launch_one<(mask)>(grid, p, stream, false); } while (0)
    L1(0, 1u); L1(1, 2u);
    for (int l = 0; l < 2; ++l) { const int b = 2 + 10 * l;
        L1(b + 0, 1u << 2); L1(b + 1, (1u << 3) | (1u << 11) | (1u << 12) | (1u << 13)); L1(b + 1, (1u << 3) | (1u << 14) | (1u << 15));
        L1(b + 2, (1u << 4) | (1u << 16)); L1(b + 2, (1u << 4) | (1u << 17)); L1(b + 2, (1u << 4) | (1u << 18));
        L1(b + 3, 1u << 5); L1(b + 4, 1u << 6); L1(b + 5, 1u << 7); L1(b + 6, 1u << 8); L1(b + 7, 1u << 9); L1(b + 8, 1u << 10); L1(b + 9, 1u << 8); }
#else
    p.ph_lo = 0; p.ph_hi = N_PHASES;
    (void)hipMemsetAsync((unsigned char*)d_ws + O_BAR, 0, 16384, stream);
    launch_one<PH_MASK>(grid, p, stream, true);
#endif
}
```

```cpp
#include <hip/hip_runtime.h>
#include <hip/hip_cooperative_groups.h>
#include <cstdio>
#include <cstdint>
namespace cg = cooperative_groups;
#ifndef PH_MASK
#define PH_MASK 0xfffff
#endif
#define EN(k) (((MASK) >> (k)) & 1u)
#ifndef DUP_ATTN
#define DUP_ATTN 1
#endif
#ifndef DUP_S1
#define DUP_S1 1
#endif
#ifndef DUP_S2
#define DUP_S2 1
#endif
#ifndef DUP_S3
#define DUP_S3 1
#endif
#ifndef DUP_S4
#define DUP_S4 1
#endif
#ifndef DUP_GEMM
#define DUP_GEMM 1
#endif
#ifndef DUP_P0
#define DUP_P0 1
#endif
#ifndef MLA_DMA
#define MLA_DMA 1
#endif
#ifndef MK_MULTI
#define MK_MULTI 0
#endif
namespace pg8 {
#define PG8_LAS __attribute__((address_space(3)))
typedef unsigned short bf16_t;
typedef short bf16x8 __attribute__((ext_vector_type(8)));
typedef float f32x4 __attribute__((ext_vector_type(4)));
typedef unsigned u32x4 __attribute__((ext_vector_type(4)));
constexpr int BM = 256, BK = 64, HALF = 128, HTB = HALF * BK * 2  , STAGE_BYTES = 8 * HTB, NXCD = 8, WGM = 8;

__host__ __device__ __forceinline__ int lds_byte(int r, int c) { const int st = (r >> 4) * 2 + (c >> 5), rr = r & 15, cc = c & 31, ob = rr * 64 + cc * 2; return st * 1024 + (ob ^ (((ob >> 9) & 1) << 5)); }
__host__ __device__ __forceinline__ void stage_rc(int b, int& R, int& C) { const int st = b / 1024, sb = b % 1024, swz = sb ^ (((sb >> 9) & 1) << 5); R = (st >> 1) * 16 + swz / 64; C = (st & 1) * 32 + (swz % 64) / 2; }
__host__ __device__ __forceinline__ int perm32(int rho) { const int n = rho >> 4, i = rho & 15; return 8 * (i >> 2) + 4 * n + (i & 3); }

struct Unit { int pm, pn; };
struct Gemm { const bf16_t* A; const bf16_t* Bt; int M, N, K; int ld; };

struct StaticOrder {
    int nM, nN, nwg, G, c;
    __host__ __device__ void init(int M, int N, int G_, int c_) { nM = M / BM; nN = N / BM; nwg = nM * nN; G = G_; c = c_; }
    __host__ __device__ bool next(int i, Unit& u) const {
        const long L = (long)i * G + c; if (L >= nwg) return false;
        int wgid = (int)L; { const int q = nwg / NXCD, r = nwg % NXCD, xcd = wgid % NXCD, off = wgid / NXCD; wgid = (xcd < r ? xcd * (q + 1) : r * (q + 1) + (xcd - r) * q) + off; }
        const int nig = WGM * nN, gid = wgid / nig, fm = gid * WGM, gsz = (nM - fm) < WGM ? (nM - fm) : WGM;
        u.pm = fm + ((wgid % nig) % gsz); u.pn = (wgid % nig) / gsz; return true;
    }
    __device__ __forceinline__ void a_ready(const Unit&) const {}
    __device__ __forceinline__ void done(const Unit&) const {}
};

template <class Epi, class Sched, bool ALIGN_EPI = false, bool SP2 = false>
__device__ __forceinline__ void gemm_phase(PG8_LAS unsigned char* lds, const Gemm g, const Sched& S, const Epi& E) {
    int tid_ = threadIdx.x; asm volatile("" : "+v"(tid_));
    const int tid = tid_, wid = __builtin_amdgcn_readfirstlane(tid >> 6), lane = tid & 63, wr = wid >> 2, wc = wid & 3, fr = lane & 15, fq = lane >> 4;
    int K_ = g.K; asm volatile("" : "+s"(K_));
    const int K = K_, nt = K / BK; int LD_ = g.ld ? g.ld : g.K; asm volatile("" : "+s"(LD_)); const int LD = LD_;
    unsigned voffA[2], voffB[2];
#pragma unroll
    for (int i = 0; i < 2; ++i) { int R, C; stage_rc(tid * 16 + i * 8192, R, C); const int Rb = Epi::PERM ? ((R & ~31) + perm32(R & 31)) : R;
        voffA[i] = (unsigned)(R * LD + C) * 2u; voffB[i] = (unsigned)(Rb * LD + C) * 2u; }
    const size_t kstep = (size_t)(BK * 2);
    const size_t hstep = (size_t)HALF * LD * 2;
    const size_t tstep = 2 * hstep;
    const unsigned ldsw = (unsigned)wid * 1024u;
    const int aoff = lds_byte(wr * 64 + fr, fq * 8), boff = lds_byte(wc * 32 + fr, fq * 8);
#define PG8_SA(b, h) (((b) * 2 + (h)) * HTB)
#define PG8_SB(b, h) ((4 + (b) * 2 + (h)) * HTB)
#define PG8_STAGE(bufoff, gbase, voff) do { _Pragma("unroll") for (int _i = 0; _i < 2; ++_i) \
        __builtin_amdgcn_global_load_lds((const unsigned*)((const char*)(gbase) + (voff)[_i]), (PG8_LAS unsigned*)(lds + (bufoff) + ldsw + _i * 8192), 16, 0, 0); } while (0)
#define PG8_LDA(dst, b, h) do { _Pragma("unroll") for (int m = 0; m < 4; ++m) _Pragma("unroll") for (int k = 0; k < 2; ++k) dst[m][k] = *(const PG8_LAS bf16x8*)(lds + PG8_SA(b, h) + aoff + m * 2048 + k * 1024); } while (0)
#define PG8_LDB(dst, b, h) do { _Pragma("unroll") for (int n = 0; n < 2; ++n) _Pragma("unroll") for (int k = 0; k < 2; ++k) dst[n][k] = *(const PG8_LAS bf16x8*)(lds + PG8_SB(b, h) + boff + n * 2048 + k * 1024); } while (0)
#define PG8_MMA(ai, bj, At, Bt) do { __builtin_amdgcn_s_setprio(1); _Pragma("unroll") for (int m = 0; m < 4; ++m) _Pragma("unroll") for (int n = 0; n < 2; ++n) _Pragma("unroll") for (int k = 0; k < 2; ++k) \
        acc[ai][bj][m][n] = __builtin_amdgcn_mfma_f32_16x16x32_bf16(Bt[n][k], At[m][k], acc[ai][bj][m][n], 0, 0, 0); __builtin_amdgcn_s_setprio(0); } while (0)
#define PG8_WAIT_V(n) asm volatile("s_waitcnt vmcnt(" #n ")" ::: "memory")
#define PG8_WAIT_L(n) asm volatile("s_waitcnt lgkmcnt(" #n ")" ::: "memory")
#define PG8_BAR __builtin_amdgcn_s_barrier()
#define PG8_SCHED __builtin_amdgcn_sched_barrier(0)
    Unit cur, nxt; int ui = 0;
    if (!S.next(0, cur)) return;
    f32x4 acc[2][2][4][2];
#pragma unroll
    for (int a = 0; a < 2; ++a)
#pragma unroll
        for (int b = 0; b < 2; ++b)
#pragma unroll
            for (int m = 0; m < 4; ++m)
#pragma unroll
                for (int n = 0; n < 2; ++n) acc[a][b][m][n] = (f32x4){0.f, 0.f, 0.f, 0.f};
    bf16x8 At[4][2], B0[2][2], B1[2][2];
    const char* cA = (const char*)g.A + (size_t)cur.pm * tstep; const char* cB = (const char*)g.Bt + (size_t)cur.pn * tstep;
    S.a_ready(cur);
    if constexpr (SP2) {
        PG8_STAGE(PG8_SB(0, 0), cB, voffB); PG8_STAGE(PG8_SB(0, 1), cB + hstep, voffB); PG8_STAGE(PG8_SA(0, 0), cA, voffA); PG8_STAGE(PG8_SA(0, 1), cA + hstep, voffA);
        if (wr == 1) PG8_BAR;
        PG8_WAIT_V(2); PG8_BAR;
        PG8_STAGE(PG8_SB(1, 0), cB + kstep, voffB); PG8_STAGE(PG8_SA(1, 0), cA + kstep, voffA); PG8_STAGE(PG8_SB(1, 1), cB + hstep + kstep, voffB);
        PG8_WAIT_V(6); PG8_BAR;
    } else {
        PG8_STAGE(PG8_SB(0, 0), cB, voffB); PG8_STAGE(PG8_SA(0, 0), cA, voffA); PG8_STAGE(PG8_SB(0, 1), cB + hstep, voffB); PG8_STAGE(PG8_SA(0, 1), cA + hstep, voffA);
        if (wr == 1) PG8_BAR;
        PG8_WAIT_V(4); PG8_BAR;
        PG8_STAGE(PG8_SB(1, 0), cB + kstep, voffB); PG8_STAGE(PG8_SA(1, 0), cA + kstep, voffA); PG8_STAGE(PG8_SB(1, 1), cB + hstep + kstep, voffB);
        PG8_WAIT_V(6); PG8_BAR;
    }
    for (;;) {
        const bool has_next = S.next(ui + 1, nxt);
        const char* nA = has_next ? (const char*)g.A + (size_t)nxt.pm * tstep : cA; const char* nB = has_next ? (const char*)g.Bt + (size_t)nxt.pn * tstep : cB;
        for (int t = 0; t < nt; t += 2) {
            const bool last = (t == nt - 2);
            const char* a1 = cA + (size_t)(t + 1) * kstep;
            const char* a2 = last ? nA : cA + (size_t)(t + 2) * kstep; const char* b2 = last ? nB : cB + (size_t)(t + 2) * kstep;
            const char* a3 = a2 + kstep; const char* b3 = b2 + kstep;
            if (last && has_next) S.a_ready(nxt);
            if constexpr (SP2) {
            PG8_LDB(B0, 0, 0); PG8_LDB(B1, 0, 1); PG8_SCHED; PG8_LDA(At, 0, 0); PG8_STAGE(PG8_SA(1, 1), a1 + hstep, voffA);
            PG8_WAIT_V(8); PG8_WAIT_L(0); PG8_BAR; PG8_MMA(0, 0, At, B0); PG8_MMA(0, 1, At, B1); PG8_BAR; PG8_SCHED;
            PG8_LDA(At, 0, 1); PG8_STAGE(PG8_SB(0, 0), b2, voffB); PG8_STAGE(PG8_SB(0, 1), b2 + hstep, voffB); PG8_STAGE(PG8_SA(0, 0), a2, voffA);
            PG8_WAIT_V(8); PG8_WAIT_L(0); PG8_BAR; PG8_MMA(1, 0, At, B0); PG8_MMA(1, 1, At, B1); PG8_BAR; PG8_SCHED;
            PG8_LDB(B0, 1, 0); PG8_LDB(B1, 1, 1); PG8_SCHED; PG8_LDA(At, 1, 0); PG8_STAGE(PG8_SA(0, 1), a2 + hstep, voffA);
            PG8_WAIT_V(8); PG8_WAIT_L(0); PG8_BAR; PG8_MMA(0, 0, At, B0); PG8_MMA(0, 1, At, B1); PG8_BAR; PG8_SCHED;
            PG8_LDA(At, 1, 1); PG8_STAGE(PG8_SB(1, 0), b3, voffB); PG8_STAGE(PG8_SB(1, 1), b3 + hstep, voffB); PG8_STAGE(PG8_SA(1, 0), a3, voffA);
            PG8_WAIT_V(8); PG8_WAIT_L(0); PG8_BAR; PG8_MMA(1, 0, At, B0); PG8_MMA(1, 1, At, B1); PG8_BAR; PG8_SCHED;
            } else {
            PG8_LDB(B0, 0, 0); PG8_SCHED; PG8_LDA(At, 0, 0); PG8_STAGE(PG8_SA(1, 1), a1 + hstep, voffA);
            PG8_WAIT_L(8); PG8_BAR; PG8_WAIT_L(0); PG8_MMA(0, 0, At, B0); PG8_BAR; PG8_SCHED;
            PG8_LDB(B1, 0, 1); PG8_STAGE(PG8_SB(0, 0), b2, voffB);
            PG8_BAR; PG8_WAIT_L(0); PG8_MMA(0, 1, At, B1); PG8_BAR;
            PG8_LDA(At, 0, 1); PG8_STAGE(PG8_SA(0, 0), a2, voffA);
            PG8_BAR; PG8_WAIT_L(0); PG8_MMA(1, 0, At, B0); PG8_BAR; PG8_SCHED;
            PG8_STAGE(PG8_SB(0, 1), b2 + hstep, voffB);
            PG8_WAIT_V(6); PG8_BAR; PG8_MMA(1, 1, At, B1); PG8_BAR;
            PG8_LDB(B0, 1, 0); PG8_SCHED; PG8_LDA(At, 1, 0); PG8_STAGE(PG8_SA(0, 1), a2 + hstep, voffA);
            PG8_WAIT_L(8); PG8_BAR; PG8_WAIT_L(0); PG8_MMA(0, 0, At, B0); PG8_BAR; PG8_SCHED;
            PG8_LDB(B1, 1, 1); PG8_STAGE(PG8_SB(1, 0), b3, voffB);
            PG8_BAR; PG8_WAIT_L(0); PG8_MMA(0, 1, At, B1); PG8_BAR;
            PG8_LDA(At, 1, 1); PG8_STAGE(PG8_SA(1, 0), a3, voffA);
            PG8_BAR; PG8_WAIT_L(0); PG8_MMA(1, 0, At, B0); PG8_BAR; PG8_SCHED;
            PG8_STAGE(PG8_SB(1, 1), b3 + hstep, voffB);
            PG8_WAIT_V(6); PG8_BAR; PG8_MMA(1, 1, At, B1); PG8_BAR;
            }
        }
        if constexpr (ALIGN_EPI) { if (wr == 0) PG8_BAR; }
        if constexpr (!Epi::AFTER_DRAIN) { E(acc, cur, wr, wc, fr, fq); S.done(cur); }
        if (!has_next) break;
#pragma unroll
        for (int a = 0; a < 2; ++a)
#pragma unroll
            for (int b = 0; b < 2; ++b)
#pragma unroll
                for (int m = 0; m < 4; ++m)
#pragma unroll
                    for (int n = 0; n < 2; ++n) acc[a][b][m][n] = (f32x4){0.f, 0.f, 0.f, 0.f};
        cur = nxt; cA = nA; cB = nB; ++ui;
        if constexpr (ALIGN_EPI) { if (wr == 1) PG8_BAR; }
    }
    PG8_WAIT_V(0);
    if constexpr (!ALIGN_EPI) { if (wr == 0) PG8_BAR; }
    PG8_BAR;
    if constexpr (Epi::AFTER_DRAIN) { E.fused(acc, cur, wr, wc, fr, fq, lds, wid, lane); S.done(cur); }
#undef PG8_SA
#undef PG8_SB
#undef PG8_STAGE
#undef PG8_LDA
#undef PG8_LDB
#undef PG8_MMA
#undef PG8_WAIT_V
#undef PG8_WAIT_L
#undef PG8_BAR
#undef PG8_SCHED
}
}

using pg8::bf16_t; using pg8::bf16x8; using pg8::f32x4; using pg8::u32x4;
typedef float f32x16 __attribute__((ext_vector_type(16)));
typedef unsigned u32x2 __attribute__((ext_vector_type(2)));
typedef float f32x2_t __attribute__((ext_vector_type(2)));
typedef __bf16 bf16x2_t __attribute__((ext_vector_type(2)));
#define LAS __attribute__((address_space(3)))

constexpr int T = 16640, NCTX = 256, DM = 2048, DFF = 5632, NIN = 4352, INW = 3776;
constexpr int NTHR = 512, NWV = 8;
constexpr float ALPHA = 1.4142135623730951f;
constexpr float LOG2E = 1.4426950408889634f;
constexpr float QS_DA = 0.125f * 1.4426950408889634f;
constexpr float QS_MLA = (float)(0.07216878364870323 * 1.4426950408889634);
constexpr float RSQ128 = 0.08838834764831845f;
constexpr int LDS_BYTES = 147456;

__device__ __forceinline__ unsigned pk2(float lo, float hi) { f32x2_t v = {lo, hi}; bf16x2_t b = __builtin_convertvector(v, bf16x2_t); return __builtin_bit_cast(unsigned, b); }
__device__ __forceinline__ bf16_t f2bf(float f) { return (bf16_t)(pk2(f, 0.f) & 0xffffu); }
__device__ __forceinline__ float bf2f(unsigned b) { return __uint_as_float(b << 16); }
__device__ __forceinline__ float ex2(float x) { return __builtin_amdgcn_exp2f(x); }
__device__ __forceinline__ float max3f(float a, float b, float c) { return __builtin_fmaxf(__builtin_fmaxf(a, b), c); }
__device__ __forceinline__ int swap45(int o) { return (o & ~0x30) | ((o & 0x20) >> 1) | ((o & 0x10) << 1); }
__device__ __forceinline__ int swap23(int o) { return (o & ~0xC) | ((o & 0x4) << 1) | ((o & 0x8) >> 1); }
__device__ __forceinline__ float wave_sum(float v) {
#pragma unroll
    for (int o = 1; o < 64; o <<= 1) v += __shfl_xor(v, o);
    return v;
}
__device__ __forceinline__ float siluf(float x) { return x / (1.f + __expf(-x)); }
__device__ __forceinline__ float sigmf(float x) { return 1.f / (1.f + __expf(-x)); }
__device__ __forceinline__ float gelu_tanh(float x) { const float t = tanhf(0.7978845608028654f * (x + 0.044715f * x * x * x)); return 0.5f * x * (1.f + t); }

constexpr size_t al256(size_t x) { return (x + 255) & ~(size_t)255; }
constexpr size_t SZ_WIN = (size_t)NIN * DM * 2, SZ_WOUT = (size_t)DM * DM * 2, SZ_WGU = (size_t)2 * DFF * DM * 2, SZ_WD = (size_t)DM * DFF * 2;
constexpr size_t SZ_WUQ = (size_t)768 * 384 * 2, SZ_WUKV = (size_t)1024 * 256 * 2, SZ_WLRU = (size_t)8 * 256 * 128 * 2;
constexpr size_t O_WIN = 0, O_WOUT = O_WIN + SZ_WIN, O_WGU = O_WOUT + SZ_WOUT, O_WD = O_WGU + SZ_WGU, O_WUQ = O_WD + SZ_WD, O_WUKV = O_WUQ + SZ_WUQ, O_WLRU = O_WUKV + SZ_WUKV;
constexpr size_t SZ_WLAYER = O_WLRU + SZ_WLRU;
constexpr size_t O_F1T = 2 * SZ_WLAYER, O_F2T = O_F1T + 131072, O_ROPE = O_F2T + (size_t)128 * 131072, O_C8 = O_ROPE + 32768, O_MODS = O_C8 + 8192, O_BAR = al256(O_MODS + 2 * 2 * 12288 * 4), O_XMOD = al256(O_BAR + 16384);
constexpr size_t O_XRES = O_XMOD + (size_t)T * DM * 2, O_U = O_XRES + (size_t)T * DM * 4;
constexpr size_t O_QDA = O_U, O_KDA = O_QDA + (size_t)T * 512 * 2, O_VTDA = O_KDA + (size_t)T * 512 * 2, O_LRUX = O_VTDA + (size_t)T * 512 * 2, O_LRUG = O_LRUX + (size_t)T * 512 * 2;
constexpr size_t O_CQ = O_LRUG + (size_t)T * 512 * 2, O_CKV = O_CQ + (size_t)T * 384 * 2, O_PARTQ = O_CKV + (size_t)T * 256 * 2, O_PARTKV = O_PARTQ + (size_t)T * 8 * 4;
constexpr size_t O_QMLA = O_PARTKV + (size_t)T * 4 * 4, O_KMLA = O_QMLA + (size_t)T * 768 * 2, O_VTMLA = O_KMLA + (size_t)T * 768 * 2, O_FX = O_VTMLA + (size_t)T * 512 * 2;
constexpr size_t O_FT = O_FX + (size_t)65536 * 256 * 2, O_CTXW = O_FT + (size_t)65536 * 256 * 2, O_XC = O_CTXW + (size_t)256 * 1024 * 4, O_AU = O_XC + (size_t)4 * T * 128 * 2;
constexpr size_t O_SUMM = O_AU + (size_t)2 * T * 512 * 4, O_DAO = O_SUMM + (size_t)2 * 260 * 512 * 8, O_UEND = O_DAO + (size_t)T * 1024 * 2;
constexpr size_t O_H = O_U;
constexpr size_t WS_NEED = (O_UEND > O_H + (size_t)T * DFF * 2) ? O_UEND : (O_H + (size_t)T * DFF * 2);

struct Params { const float* in[31]; float* out; unsigned char* ws; int ph_lo, ph_hi; };
enum { I_X = 0, I_C, I_CTX, I_CCTX, I_WADA, I_BADA, I_WIN, I_WOUT, I_LN1G, I_LN1B, I_LN2G, I_LN2B, I_LQ1, I_LK1, I_LQ2, I_LK2, I_SUBLN, I_CONVW, I_CONVB, I_LWR, I_LBR, I_LWI, I_LBI, I_LLAM,
       I_QNG, I_WUQ, I_KVNG, I_WUKV, I_WG, I_WU, I_WD };

__device__ const float INVF[16] = {1.0f, 0.5623413324356079f, 0.3162277638912201f, 0.17782793939113617f, 0.10000000149011612f, 0.05623413249850273f, 0.03162277489900589f, 0.017782794311642647f,
                                   0.009999999776482582f, 0.005623413249850273f, 0.003162277629598975f, 0.0017782794311642647f, 0.0010000000474974513f, 0.000562341301701963f, 0.0003162277571391314f, 0.00017782794020604342f};

struct MapWin { const float* W; int stride;
    __device__ __forceinline__ const float* operator()(int d) const { const int tile = d >> 8, c = d & 255; int src;
        if (tile < 4) src = tile * 256 + swap45(c); else if (tile < 10) src = tile * 256 + c; else if (tile == 10) src = 2560 + c;
        else if (tile == 11) { if (c < 128) src = 2816 + c; else if (c < 192) src = 3200 + swap45(c - 128); else return nullptr; }
        else src = 2944 + c;
        return W + src; } };
struct MapPlain { const float* W; int stride; __device__ __forceinline__ const float* operator()(int d) const { return W + d; } };
struct MapGU { const float* Wg; const float* Wu; int stride;
    __device__ __forceinline__ const float* operator()(int d) const { const int tile = d >> 8, c = d & 255, n = (c >> 4) & 1, f = tile * 128 + 64 * (c >> 7) + 16 * ((c >> 5) & 3) + (c & 15); const long long dl = (const char*)Wu - (const char*)Wg; return (const float*)((const char*)Wg + (long long)n * dl) + f; } };
struct MapUq { const float* W; int stride;
    __device__ __forceinline__ const float* operator()(int d) const { if (d < 512) return W + (d >> 7) * 192 + (d & 127); const int c = d - 512; return W + (c >> 6) * 192 + 128 + swap45(c & 63); } };
struct MapUkv { const float* W; int stride;
    __device__ __forceinline__ const float* operator()(int d) const { if (d < 512) return W + (d >> 7) * 256 + (d & 127); const int e = d - 512; return W + (e >> 7) * 256 + 128 + (e & 127); } };
struct MapLru { const float* Wr; const float* Wi; int stride;
    __device__ __forceinline__ const float* operator()(int c) const { const int n = (c >> 4) & 1, j = 64 * (c >> 7) + 16 * ((c >> 5) & 3) + (c & 15); const long long dl = (const char*)Wi - (const char*)Wr; return (const float*)((const char*)Wr + (long long)n * dl) + j; } };

template <class Map>
__device__ __forceinline__ void tr_job(const Map mp, int Kd, int nrows, bf16_t* WT, const float* kscale, LAS float* scr, int gw, int NGW, int lane) {
    const int nblk = nrows / 32, items = (Kd / 64) * nblk, kr = lane >> 3, c4 = lane & 7;
    f32x4 cur[8], nxt[8];
#define TR_LOAD(dst, it_) do { const int kb_ = (it_) / nblk, nb_ = (it_) % nblk; const float* cp_ = mp(32 * nb_ + 4 * c4); const int st_ = mp.stride; \
        _Pragma("unroll") for (int i_ = 0; i_ < 8; ++i_) dst[i_] = cp_ ? *(const f32x4*)(cp_ + (size_t)(64 * kb_ + kr + 8 * i_) * st_) : (f32x4){0.f, 0.f, 0.f, 0.f}; } while (0)
    int it = gw;
    if (it < items) TR_LOAD(cur, it);
    for (; it < items; it += NGW) {
        const int kb = it / nblk, nb = it % nblk, k0 = 64 * kb, d0 = 32 * nb;
        if (it + NGW < items) TR_LOAD(nxt, it + NGW);
#pragma unroll
        for (int i = 0; i < 8; ++i) { const int kk = kr + 8 * i; f32x4 v = cur[i]; if (kscale) v = v * kscale[k0 + kk];
#pragma unroll
            for (int j = 0; j < 4; ++j) scr[kk * 33 + 4 * c4 + j] = v[j]; }
        asm volatile("s_waitcnt lgkmcnt(0)" ::: "memory");
        const int c = lane & 7;
#pragma unroll
        for (int j = 0; j < 4; ++j) { const int n = (lane >> 3) + 8 * j; const LAS float* sp = scr + (8 * c) * 33 + n;
            u32x4 o; o.x = pk2(sp[0 * 33], sp[1 * 33]); o.y = pk2(sp[2 * 33], sp[3 * 33]); o.z = pk2(sp[4 * 33], sp[5 * 33]); o.w = pk2(sp[6 * 33], sp[7 * 33]);
            *(u32x4*)(WT + (size_t)(d0 + n) * Kd + k0 + 8 * c) = o; }
        asm volatile("s_waitcnt lgkmcnt(0)" ::: "memory");
#pragma unroll
        for (int i = 0; i < 8; ++i) cur[i] = nxt[i];
    }
#undef TR_LOAD
}

#define EPI_ROWS_BEGIN _Pragma("unroll") for (int ai = 0; ai < 2; ++ai) _Pragma("unroll") for (int m = 0; m < 4; ++m) { const int row = u.pm * 256 + ai * 128 + wr * 64 + m * 16 + fr;
#define EPI_ROWS_END asm volatile("" ::: "memory"); __builtin_amdgcn_sched_barrier(0); }
__device__ __forceinline__ void st4bf(bf16_t* p, const f32x4 v) { u32x2 w; w.x = pk2(v[0], v[1]); w.y = pk2(v[2], v[3]); *(u32x2*)p = w; }

struct EpiInproj {
    static constexpr bool PERM = false, AFTER_DRAIN = false;
    bf16_t *QDA, *KDA, *VTDA, *LRUX, *LRUG, *CQ, *CKV, *KMLA, *FX; float *CTXW, *PARTQ, *PARTKV; const float* ROPE;
    __device__ __forceinline__ void rope_cs(int row, int wc, int fq, f32x4& c, f32x4& s) const {
        if (row < NCTX) { c = (f32x4){1.f, 1.f, 1.f, 1.f}; s = (f32x4){0.f, 0.f, 0.f, 0.f}; return; }
        const int nl = row - NCTX, pos = (wc & 1) ? (nl & 63) : (nl >> 6);
        const f32x4 a = *(const f32x4*)(ROPE + (pos * 16 + 4 * fq) * 2), b = *(const f32x4*)(ROPE + (pos * 16 + 4 * fq) * 2 + 4);
        c = (f32x4){a[0], a[2], b[0], b[2]}; s = (f32x4){a[1], a[3], b[1], b[3]};
    }
    __device__ __forceinline__ void operator()(const f32x4 (&acc)[2][2][4][2], const pg8::Unit& u, int wr, int wc, int fr, int fq) const {
        asm volatile("" : "+v"(fr), "+v"(fq));
        const int pn = u.pn;
        if (pn < 4) {
            bf16_t* dst = pn < 2 ? QDA : KDA; const float sc = pn < 2 ? QS_DA : 1.f; const int cb = (pn & 1) * 256 + 64 * (wc >> 1) + 16 * (wc & 1) + 4 * fq;
            EPI_ROWS_BEGIN  f32x4 c, s; rope_cs(row, wc, fq, c, s);
#pragma unroll
                for (int bj = 0; bj < 2; ++bj) { const f32x4 x1 = acc[ai][bj][m][0], x2 = acc[ai][bj][m][1];
                    st4bf(dst + (unsigned)row * 512 + cb + 128 * bj, (x1 * c - x2 * s) * sc); st4bf(dst + (unsigned)row * 512 + cb + 128 * bj + 32, (x1 * s + x2 * c) * sc); }  EPI_ROWS_END
        } else if (pn < 6) {
            EPI_ROWS_BEGIN
#pragma unroll
                for (int bj = 0; bj < 2; ++bj)
#pragma unroll
                    for (int n = 0; n < 2; ++n)
#pragma unroll
                        for (int j = 0; j < 4; ++j) VTDA[(unsigned)((pn - 4) * 256 + 128 * bj + 32 * wc + 16 * n + 4 * fq + j) * T + row] = f2bf(acc[ai][bj][m][n][j]);  EPI_ROWS_END
        } else if (pn < 10) {
            bf16_t* dst = pn < 8 ? LRUX : LRUG; const int cb = (pn & 1) * 256 + 32 * wc + 4 * fq;
            EPI_ROWS_BEGIN
#pragma unroll
                for (int bj = 0; bj < 2; ++bj)
#pragma unroll
                    for (int n = 0; n < 2; ++n) st4bf(dst + (unsigned)row * 512 + cb + 128 * bj + 16 * n, acc[ai][bj][m][n]);  EPI_ROWS_END
        } else if (pn == 10) {
            EPI_ROWS_BEGIN  float ss = 0.f;
#pragma unroll
                for (int bj = 0; bj < 2; ++bj)
#pragma unroll
                    for (int n = 0; n < 2; ++n) { const f32x4 v = acc[ai][bj][m][n]; st4bf(CQ + (unsigned)row * 384 + 128 * bj + 32 * wc + 16 * n + 4 * fq, v); ss += (v[0] * v[0] + v[1] * v[1]) + (v[2] * v[2] + v[3] * v[3]); }
                ss += __shfl_xor(ss, 16); ss += __shfl_xor(ss, 32); if (fq == 0) PARTQ[(unsigned)row * 8 + wc] = ss;  EPI_ROWS_END
        } else if (pn == 11) {
            EPI_ROWS_BEGIN  float ss = 0.f;
#pragma unroll
                for (int n = 0; n < 2; ++n) { const f32x4 v = acc[ai][0][m][n]; st4bf(CQ + (unsigned)row * 384 + 256 + 32 * wc + 16 * n + 4 * fq, v); ss += (v[0] * v[0] + v[1] * v[1]) + (v[2] * v[2] + v[3] * v[3]); }
                ss += __shfl_xor(ss, 16); ss += __shfl_xor(ss, 32); if (fq == 0) PARTQ[(unsigned)row * 8 + 4 + wc] = ss;
                if (wc < 2) { f32x4 c, s; rope_cs(row, wc, fq, c, s); const f32x4 x1 = acc[ai][1][m][0], x2 = acc[ai][1][m][1]; const f32x4 y1 = x1 * c - x2 * s, y2 = x1 * s + x2 * c;
#pragma unroll
                    for (int h = 0; h < 4; ++h) { bf16_t* kp = KMLA + (unsigned)row * 768 + h * 192 + 128 + 16 * (wc & 1) + 4 * fq; st4bf(kp, y1); st4bf(kp + 32, y2); } }  EPI_ROWS_END
        } else if (pn == 12) {
            EPI_ROWS_BEGIN  float ss = 0.f;
#pragma unroll
                for (int bj = 0; bj < 2; ++bj)
#pragma unroll
                    for (int n = 0; n < 2; ++n) { const f32x4 v = acc[ai][bj][m][n]; st4bf(CKV + (unsigned)row * 256 + 128 * bj + 32 * wc + 16 * n + 4 * fq, v); ss += (v[0] * v[0] + v[1] * v[1]) + (v[2] * v[2] + v[3] * v[3]); }
                ss += __shfl_xor(ss, 16); ss += __shfl_xor(ss, 32); if (fq == 0) PARTKV[(unsigned)row * 4 + wc] = ss;  EPI_ROWS_END
        } else {
            const int g = pn - 13;
            if (u.pm == 0) {
                EPI_ROWS_BEGIN
#pragma unroll
                    for (int bj = 0; bj < 2; ++bj)
#pragma unroll
                        for (int n = 0; n < 2; ++n) *(f32x4*)(CTXW + (unsigned)row * 1024 + g * 256 + 128 * bj + 32 * wc + 16 * n + 4 * fq) = acc[ai][bj][m][n];  EPI_ROWS_END
            } else {
                EPI_ROWS_BEGIN  const int nl = row - NCTX, n1 = nl >> 7, n2 = nl & 127;
#pragma unroll
                    for (int bj = 0; bj < 2; ++bj)
#pragma unroll
                        for (int n = 0; n < 2; ++n)
#pragma unroll
                            for (int j = 0; j < 4; ++j) FX[((unsigned)((n2 * 4 + g) * 128 + 32 * wc + 16 * n + 4 * fq + j)) * 256 + bj * 128 + n1] = f2bf(acc[ai][bj][m][n][j]);  EPI_ROWS_END
            }
        }
    }
};

struct EpiUpq {
    static constexpr bool PERM = false, AFTER_DRAIN = false;
    bf16_t* QMLA; const float* PARTQ; const float* ROPE;
    __device__ __forceinline__ void operator()(const f32x4 (&acc)[2][2][4][2], const pg8::Unit& u, int wr, int wc, int fr, int fq) const {
        asm volatile("" : "+v"(fr), "+v"(fq));
        const int pn = u.pn;
        EPI_ROWS_BEGIN  const f32x4 pa = *(const f32x4*)(PARTQ + (unsigned)row * 8), pb = *(const f32x4*)(PARTQ + (unsigned)row * 8 + 4);
            const float f = rsqrtf(((pa[0] + pa[1]) + (pa[2] + pa[3]) + (pb[0] + pb[1]) + (pb[2] + pb[3])) * (1.f / 384.f) + 1e-6f) * QS_MLA;
            if (pn < 2) {
#pragma unroll
                for (int bj = 0; bj < 2; ++bj)
#pragma unroll
                    for (int n = 0; n < 2; ++n) st4bf(QMLA + (unsigned)row * 768 + (2 * pn + bj) * 192 + 32 * wc + 16 * n + 4 * fq, acc[ai][bj][m][n] * f);
            } else {
                f32x4 c, s;
                if (row < NCTX) { c = (f32x4){1.f, 1.f, 1.f, 1.f}; s = (f32x4){0.f, 0.f, 0.f, 0.f}; }
                else { const int nl = row - NCTX, pos = (wc & 1) ? (nl & 63) : (nl >> 6);
                    const f32x4 a = *(const f32x4*)(ROPE + (pos * 16 + 4 * fq) * 2), b = *(const f32x4*)(ROPE + (pos * 16 + 4 * fq) * 2 + 4);
                    c = (f32x4){a[0], a[2], b[0], b[2]}; s = (f32x4){a[1], a[3], b[1], b[3]}; }
#pragma unroll
                for (int bj = 0; bj < 2; ++bj) { const f32x4 x1 = acc[ai][bj][m][0] * f, x2 = acc[ai][bj][m][1] * f; bf16_t* qp = QMLA + (unsigned)row * 768 + (2 * bj + (wc >> 1)) * 192 + 128 + 16 * (wc & 1) + 4 * fq;
                    st4bf(qp, x1 * c - x2 * s); st4bf(qp + 32, x1 * s + x2 * c); }
            }  EPI_ROWS_END
    }
};
struct EpiUpkv {
    static constexpr bool PERM = false, AFTER_DRAIN = false;
    bf16_t *KMLA, *VTMLA; const float* PARTKV;
    __device__ __forceinline__ void operator()(const f32x4 (&acc)[2][2][4][2], const pg8::Unit& u, int wr, int wc, int fr, int fq) const {
        asm volatile("" : "+v"(fr), "+v"(fq));
        const int pn = u.pn;
        EPI_ROWS_BEGIN  const f32x4 pa = *(const f32x4*)(PARTKV + (unsigned)row * 4);
            const float f = rsqrtf(((pa[0] + pa[1]) + (pa[2] + pa[3])) * (1.f / 256.f) + 1e-6f);
            if (pn < 2) {
#pragma unroll
                for (int bj = 0; bj < 2; ++bj)
#pragma unroll
                    for (int n = 0; n < 2; ++n) st4bf(KMLA + (unsigned)row * 768 + (2 * pn + bj) * 192 + 32 * wc + 16 * n + 4 * fq, acc[ai][bj][m][n] * f);
            } else {
#pragma unroll
                for (int bj = 0; bj < 2; ++bj)
#pragma unroll
                    for (int n = 0; n < 2; ++n)
#pragma unroll
                        for (int j = 0; j < 4; ++j) VTMLA[(unsigned)((pn - 2) * 256 + 128 * bj + 32 * wc + 16 * n + 4 * fq + j) * T + row] = f2bf(acc[ai][bj][m][n][j] * f);
            }  EPI_ROWS_END
    }
};
struct LruOrder {
    int G, c;
    __device__ bool next(int i, pg8::Unit& u) const { const long L = (long)i * G + c; if (L >= 520) return false; const int idx = (int)L, pmr = idx % 65, hd = idx / 65; u.pm = (hd >> 1) * 65 + pmr; u.pn = hd; return true; }
    __device__ __forceinline__ void a_ready(const pg8::Unit&) const {}
    __device__ __forceinline__ void done(const pg8::Unit&) const {}
};
__device__ __forceinline__ float neg_expm1(float x) {
    const float ser = -x * (1.f + x * (0.5f + x * (0.16666667f + x * 0.041666667f)));
    return x > -0.125f ? ser : 1.f - __expf(x);
}
struct EpiLru {
    static constexpr bool PERM = false, AFTER_DRAIN = false;
    unsigned* AU; const bf16_t* XC; const float *br, *bi, *c8;
    __device__ __forceinline__ void operator()(const f32x4 (&acc)[2][2][4][2], const pg8::Unit& u, int wr, int wc, int fr, int fq) const {
        asm volatile("" : "+v"(fr), "+v"(fq));
        const int h = u.pn >> 1, d = u.pn & 1, pmr = u.pm - h * 65;
#pragma unroll
        for (int bj = 0; bj < 2; ++bj) { const int chl = 64 * bj + 16 * wc + 4 * fq, ch = d * 512 + h * 128 + chl; const f32x4 vbr = *(const f32x4*)(br + ch), vbi = *(const f32x4*)(bi + ch), vc8 = *(const f32x4*)(c8 + ch);
#pragma unroll
            for (int ai = 0; ai < 2; ++ai)
#pragma unroll
                for (int m = 0; m < 4; ++m) { const int row = pmr * 256 + ai * 128 + wr * 64 + m * 16 + fr; const u32x2 xw = *(const u32x2*)(XC + ((unsigned)h * T + row) * 128 + chl); u32x4 o;
#pragma unroll
                    for (int j = 0; j < 4; ++j) { const float xv = bf2f(j & 1 ? (j < 2 ? xw.x : xw.y) >> 16 : (j < 2 ? xw.x : xw.y) & 0xffffu);
                        const float r = sigmf(acc[ai][bj][m][0][j] + vbr[j]), ig = sigmf(acc[ai][bj][m][1][j] + vbi[j]); const float la = vc8[j] * r;
                        const float uu = sqrtf(neg_expm1(2.f * la)) * (ig * xv); o[j] = pk2(uu, la * LOG2E); }
                    *(u32x4*)(AU + ((unsigned)d * T + row) * 512 + h * 128 + chl) = o; asm volatile("" ::: "memory"); __builtin_amdgcn_sched_barrier(0); } }
    }
};
struct EpiFftA {
    static constexpr bool PERM = false, AFTER_DRAIN = false;
    bf16_t* FT;
    __device__ __forceinline__ void operator()(const f32x4 (&acc)[2][2][4][2], const pg8::Unit& u, int wr, int wc, int fr, int fq) const {
        asm volatile("" : "+v"(fr), "+v"(fq));
        EPI_ROWS_BEGIN const int n2 = row >> 9, gj = row & 511; bf16_t* p0 = FT + ((unsigned)((16 * wc + 4 * fq) * 512 + gj)) * 256 + n2;
#pragma unroll
            for (int bj = 0; bj < 2; ++bj)
#pragma unroll
                for (int j = 0; j < 4; ++j) { bf16_t* p = p0 + (unsigned)(64 * bj + j) * 512 * 256; p[0] = f2bf(acc[ai][bj][m][0][j]); p[128] = f2bf(acc[ai][bj][m][1][j]); } EPI_ROWS_END
    }
};
struct FftCOrder {
    int G, c;
    __device__ bool next(int i, pg8::Unit& u) const { const long L = (long)i * G + c; if (L >= 256) return false; u.pm = (int)L; u.pn = (int)L >> 1; return true; }
    __device__ __forceinline__ void a_ready(const pg8::Unit&) const {}
    __device__ __forceinline__ void done(const pg8::Unit&) const {}
};
struct EpiFftC {
    static constexpr bool PERM = false, AFTER_DRAIN = false;
    bf16_t* MIX;
    __device__ __forceinline__ void operator()(const f32x4 (&acc)[2][2][4][2], const pg8::Unit& u, int wr, int wc, int fr, int fq) const {
        asm volatile("" : "+v"(fr), "+v"(fq));
        EPI_ROWS_BEGIN  const int k1 = row >> 9, gj = row & 511;
#pragma unroll
            for (int n = 0; n < 2; ++n)
#pragma unroll
                for (int j = 0; j < 4; ++j) { const int k2 = 32 * wc + 16 * n + 4 * fq + j; MIX[(unsigned)(NCTX + k1 + 128 * k2) * DM + 1536 + gj] = f2bf(acc[ai][0][m][n][j]); }  EPI_ROWS_END
    }
};
struct EpiRes {
    static constexpr bool PERM = false, AFTER_DRAIN = false;
    const float* xa; const float* xb; float* Y; const float* gate0; const float* gate1; int pm0;
    __device__ __forceinline__ void operator()(const f32x4 (&acc)[2][2][4][2], const pg8::Unit& u_, int wr, int wc, int fr, int fq) const {
        const pg8::Unit u{u_.pm + pm0, u_.pn};
        asm volatile("" : "+v"(fr), "+v"(fq));
        const float* gp = (u.pm == 0 ? gate0 : gate1) + u.pn * 256 + 32 * wc + 4 * fq;
        f32x4 gv[2][2];
#pragma unroll
        for (int bj = 0; bj < 2; ++bj)
#pragma unroll
            for (int n = 0; n < 2; ++n) gv[bj][n] = *(const f32x4*)(gp + 128 * bj + 16 * n);
        EPI_ROWS_BEGIN  const float* xo = (row < NCTX ? xa + (unsigned)row * DM : xb + (unsigned)(row - NCTX) * DM) + u.pn * 256 + 32 * wc + 4 * fq; float* yo = Y + (unsigned)row * DM + u.pn * 256 + 32 * wc + 4 * fq;
#pragma unroll
            for (int bj = 0; bj < 2; ++bj)
#pragma unroll
                for (int n = 0; n < 2; ++n) { const f32x4 xv = *(const f32x4*)(xo + 128 * bj + 16 * n); *(f32x4*)(yo + 128 * bj + 16 * n) = xv * ALPHA + gv[bj][n] * acc[ai][bj][m][n]; }  EPI_ROWS_END
    }
};
struct EpiResAtomic {
    static constexpr bool PERM = false, AFTER_DRAIN = false;
    float* Y; const float* gate;
    __device__ __forceinline__ void operator()(const f32x4 (&acc)[2][2][4][2], const pg8::Unit& u, int wr, int wc, int fr, int fq) const {
        asm volatile("" : "+v"(fr), "+v"(fq));
        const float* gp = gate + u.pn * 256 + 32 * wc + 4 * fq;
        EPI_ROWS_BEGIN float* yo = Y + (unsigned)row * DM + u.pn * 256 + 32 * wc + 4 * fq;
#pragma unroll
            for (int bj = 0; bj < 2; ++bj)
#pragma unroll
                for (int n = 0; n < 2; ++n) { const f32x4 gv = *(const f32x4*)(gp + 128 * bj + 16 * n);
#pragma unroll
                    for (int j = 0; j < 4; ++j) (void)unsafeAtomicAdd(yo + 128 * bj + 16 * n + j, gv[j] * acc[ai][bj][m][n][j]); } EPI_ROWS_END
    }
};
struct EpiGU {
    static constexpr bool PERM = false, AFTER_DRAIN = false;
    bf16_t* H; int pm0;
    __device__ __forceinline__ void operator()(const f32x4 (&acc)[2][2][4][2], const pg8::Unit& u_, int wr, int wc, int fr, int fq) const {
        const pg8::Unit u{u_.pm + pm0, u_.pn};
        asm volatile("" : "+v"(fr), "+v"(fq));
        EPI_ROWS_BEGIN
#pragma unroll
            for (int bj = 0; bj < 2; ++bj) { const f32x4 g = acc[ai][bj][m][0], v = acc[ai][bj][m][1]; f32x4 o;
#pragma unroll
                for (int j = 0; j < 4; ++j) o[j] = siluf(g[j]) * v[j];
                st4bf(H + (unsigned)row * DFF + u.pn * 128 + 64 * bj + 16 * wc + 4 * fq, o); }  EPI_ROWS_END
    }
};

template <int DQK>
__device__ __forceinline__ void attn_unit(const bf16_t* __restrict__ Q, int ldq, const bf16_t* __restrict__ K, int ldk, const bf16_t* __restrict__ Vt, bf16_t* O, int ldo, int q0, int nkeys, LAS unsigned char* lds) {
    constexpr int KS = DQK / 16, KROW = DQK + 8, KCH = DQK / 8, KLD = (64 * KCH) / NTHR, VROW = 72;
    LAS bf16_t* Ks = (LAS bf16_t*)lds; LAS bf16_t* Vs = (LAS bf16_t*)(lds + 2 * 64 * KROW * 2);
    int tid_ = threadIdx.x; asm volatile("" : "+v"(tid_));
    const int tid = tid_, lane = tid & 63, wid = tid >> 6, qi = lane & 31, hi = lane >> 5;
    bf16x8 qf[KS];
    { const bf16_t* qp = Q + (size_t)(q0 + wid * 32 + qi) * ldq + hi * 8;
#pragma unroll
      for (int ks = 0; ks < KS; ++ks) qf[ks] = *(const bf16x8*)(qp + ks * 16); }
    f32x16 o[4];
#pragma unroll
    for (int d0 = 0; d0 < 4; ++d0)
#pragma unroll
        for (int r = 0; r < 16; ++r) o[d0][r] = 0.f;
    float m_run = -1e30f, l_run = 0.f;
    const int NT = nkeys / 64;
    u32x4 kreg[KLD], vreg[2];
#define ATT_LOADK(t) do { _Pragma("unroll") for (int i_ = 0; i_ < KLD; ++i_) { const int c_ = tid + NTHR * i_, r_ = c_ / KCH, cc_ = c_ % KCH; kreg[i_] = *(const u32x4*)(K + (size_t)((t) * 64 + r_) * ldk + cc_ * 8); } } while (0)
#define ATT_LOADV(t) do { _Pragma("unroll") for (int i_ = 0; i_ < 2; ++i_) { const int c_ = tid + NTHR * i_, dv_ = c_ >> 3, k8_ = c_ & 7; vreg[i_] = *(const u32x4*)(Vt + (size_t)dv_ * T + (t) * 64 + k8_ * 8); } } while (0)
#define ATT_STOREK(b) do { _Pragma("unroll") for (int i_ = 0; i_ < KLD; ++i_) { const int c_ = tid + NTHR * i_, r_ = c_ / KCH, cc_ = c_ % KCH; *(LAS u32x4*)(Ks + (b) * 64 * KROW + r_ * KROW + cc_ * 8) = kreg[i_]; } } while (0)
#define ATT_STOREV(b) do { _Pragma("unroll") for (int i_ = 0; i_ < 2; ++i_) { const int c_ = tid + NTHR * i_, dv_ = c_ >> 3, k8_ = c_ & 7; *(LAS u32x4*)(Vs + (b) * 128 * VROW + dv_ * VROW + k8_ * 8) = vreg[i_]; } } while (0)
#define ATT_QK(S0, S1, b) do { const LAS bf16_t* kb_ = Ks + (b) * 64 * KROW + krow * KROW + hi * 8; \
        _Pragma("unroll") for (int r_ = 0; r_ < 16; ++r_) { S0[r_] = 0.f; S1[r_] = 0.f; } \
        _Pragma("unroll") for (int ks_ = 0; ks_ < KS; ++ks_) { const bf16x8 k0_ = *(const LAS bf16x8*)(kb_ + ks_ * 16), k1_ = *(const LAS bf16x8*)(kb_ + 32 * KROW + ks_ * 16); \
            S0 = __builtin_amdgcn_mfma_f32_32x32x16_bf16(k0_, qf[ks_], S0, 0, 0, 0); S1 = __builtin_amdgcn_mfma_f32_32x32x16_bf16(k1_, qf[ks_], S1, 0, 0, 0); } } while (0)
    const int krow = swap23(qi);
    ATT_LOADK(0); ATT_LOADV(0); ATT_STOREK(0); ATT_STOREV(0); ATT_LOADK(1); ATT_STOREK(1); __syncthreads();
    f32x16 s0, s1, n0, n1;
    ATT_QK(s0, s1, 0);
    for (int t = 0; t < NT; ++t) {
        const bool has1 = t + 1 < NT, has2 = t + 2 < NT;
        if (has2) ATT_LOADK(t + 2);
        if (has1) ATT_LOADV(t + 1);
        if (has1) ATT_QK(n0, n1, (t + 1) & 1);
        const LAS bf16_t* vb = Vs + (t & 1) * 128 * VROW + qi * VROW + hi * 8;
        float mx = fmaxf(s0[0], s1[0]);
#pragma unroll
        for (int r = 1; r < 16; ++r) mx = fmaxf(mx, fmaxf(s0[r], s1[r]));
        mx = fmaxf(mx, __shfl_xor(mx, 32));
        if (__any(mx > m_run + 8.f)) {
            const float m_new = fmaxf(m_run, mx), alpha = ex2(m_run - m_new); m_run = m_new; l_run *= alpha;
#pragma unroll
            for (int d0 = 0; d0 < 4; ++d0)
#pragma unroll
                for (int r = 0; r < 16; ++r) o[d0][r] *= alpha;
        }
        float ps = 0.f;
#pragma unroll
        for (int r = 0; r < 16; ++r) { s0[r] = ex2(s0[r] - m_run); s1[r] = ex2(s1[r] - m_run); ps += s0[r] + s1[r]; }
        l_run += ps;
        u32x4 pw[4];
#pragma unroll
        for (int i = 0; i < 4; ++i) { pw[0][i] = pk2(s0[2 * i], s0[2 * i + 1]); pw[1][i] = pk2(s0[8 + 2 * i], s0[8 + 2 * i + 1]); pw[2][i] = pk2(s1[2 * i], s1[2 * i + 1]); pw[3][i] = pk2(s1[8 + 2 * i], s1[8 + 2 * i + 1]); }
#pragma unroll
        for (int sp = 0; sp < 4; ++sp) { const bf16x8 pf = __builtin_bit_cast(bf16x8, pw[sp]);
#pragma unroll
            for (int d0 = 0; d0 < 4; ++d0) { const bf16x8 vf = *(const LAS bf16x8*)(vb + 32 * d0 * VROW + sp * 16); o[d0] = __builtin_amdgcn_mfma_f32_32x32x16_bf16(vf, pf, o[d0], 0, 0, 0); } }
        if (has2) ATT_STOREK(t & 1);
        if (has1) ATT_STOREV((t + 1) & 1);
        __syncthreads();
        s0 = n0; s1 = n1;
    }
#undef ATT_LOADK
#undef ATT_LOADV
#undef ATT_STOREK
#undef ATT_STOREV
#undef ATT_QK
    const float l = l_run + __shfl_xor(l_run, 32), inv = 1.f / l;
    bf16_t* op = O + (size_t)(q0 + wid * 32 + qi) * ldo + 4 * hi;
#pragma unroll
    for (int d0 = 0; d0 < 4; ++d0)
#pragma unroll
        for (int g = 0; g < 4; ++g) { u32x2 w; w.x = pk2(o[d0][4 * g] * inv, o[d0][4 * g + 1] * inv); w.y = pk2(o[d0][4 * g + 2] * inv, o[d0][4 * g + 3] * inv); *(u32x2*)(op + 32 * d0 + 8 * g) = w; }
}

__device__ __forceinline__ void glds16(const void* gsrc, unsigned lds_dst) { unsigned keep;
    asm volatile("s_mov_b32 %0, m0\n\ts_mov_b32 m0, %2\n\ts_nop 0\n\tglobal_load_lds_dwordx4 %1, off\n\ts_mov_b32 m0, %0" : "=&s"(keep) : "v"(gsrc), "s"(lds_dst) : "memory"); }
template <int DQK>
__device__ __forceinline__ void attn_unit_dma(const bf16_t* __restrict__ Q, int ldq, const bf16_t* __restrict__ K, int ldk, const bf16_t* __restrict__ Vt, bf16_t* O, int ldo, int q0, int nkeys, LAS unsigned char* lds) {
    constexpr int KS = DQK / 16, KROW = DQK + 8, KCH = DQK / 8, VROW = 72, KSL = KCH + 1, KCHUNKS = KSL, VCHUNKS = 18, NJ = (KCHUNKS + VCHUNKS + NWV - 1) / NWV;
    constexpr int KBYTES = KCHUNKS * 1024, VBYTES = VCHUNKS * 1024, SLOT = KBYTES + VBYTES, DUMMY = 3 * SLOT;
    static_assert(KROW * 2 == KSL * 16 && 64 * KROW * 2 == KBYTES && 128 * VROW * 2 == VBYTES && DUMMY + 1024 <= LDS_BYTES - 16, "attention LDS image");
    int tid_ = threadIdx.x; asm volatile("" : "+v"(tid_));
    const int tid = tid_, lane = tid & 63, wid = tid >> 6, qi = lane & 31, hi = lane >> 5;
    const int widu = __builtin_amdgcn_readfirstlane(wid);
    const unsigned lds0 = (unsigned)(size_t)lds;
    const bf16_t* gsrc[NJ]; int tstep[NJ]; unsigned loff[NJ], lmul[NJ];
#pragma unroll
    for (int j = 0; j < NJ; ++j) { const int c = j * NWV + widu;
        if (c < KCHUNKS) { const int sl = c * 64 + lane, r = sl / KSL, cc = sl - r * KSL; gsrc[j] = K + (size_t)r * ldk + (cc == KCH ? 0 : cc) * 8; tstep[j] = 64 * ldk; loff[j] = c * 1024; lmul[j] = SLOT; }
        else if (c < KCHUNKS + VCHUNKS) { const int sl = (c - KCHUNKS) * 64 + lane, r = sl / 9, cc = sl - r * 9; gsrc[j] = Vt + (size_t)r * T + (cc == 8 ? 0 : cc) * 8; tstep[j] = 64; loff[j] = KBYTES + (c - KCHUNKS) * 1024; lmul[j] = SLOT; }
        else { gsrc[j] = K; tstep[j] = 0; loff[j] = DUMMY; lmul[j] = 0; } }
#define AD_DMA(t, slot) do { _Pragma("unroll") for (int j_ = 0; j_ < NJ; ++j_) glds16(gsrc[j_] + (size_t)(t) * tstep[j_], lds0 + (unsigned)(slot) * lmul[j_] + loff[j_]); } while (0)
    bf16x8 qf[KS];
    { const bf16_t* qp = Q + (size_t)(q0 + wid * 32 + qi) * ldq + hi * 8;
#pragma unroll
      for (int ks = 0; ks < KS; ++ks) qf[ks] = *(const bf16x8*)(qp + ks * 16); }
    f32x16 o[4];
#pragma unroll
    for (int d0 = 0; d0 < 4; ++d0)
#pragma unroll
        for (int r = 0; r < 16; ++r) o[d0][r] = 0.f;
    float l_run = 0.f;
    f32x16 negm;
#pragma unroll
    for (int r = 0; r < 16; ++r) negm[r] = 0.f;
    const int NT = nkeys / 64;
    const int krow = swap23(qi);
    AD_DMA(0, 0); AD_DMA(1, 1);
    asm volatile("s_waitcnt vmcnt(0) lgkmcnt(0)" ::: "memory"); __builtin_amdgcn_s_barrier(); asm volatile("" ::: "memory");
    int slot = 0, slot2 = 2;
    for (int t = 0; t < NT; ++t) {
        if (t + 2 < NT) AD_DMA(t + 2, slot2);
        const LAS bf16_t* kb = (const LAS bf16_t*)(lds + slot * SLOT) + krow * KROW + hi * 8; const LAS bf16_t* vb = (const LAS bf16_t*)(lds + slot * SLOT + KBYTES) + qi * VROW + hi * 8;
        f32x16 s0, s1;
        { const bf16x8 k0 = *(const LAS bf16x8*)(kb), k1 = *(const LAS bf16x8*)(kb + 32 * KROW);
          s0 = __builtin_amdgcn_mfma_f32_32x32x16_bf16(k0, qf[0], negm, 0, 0, 0); s1 = __builtin_amdgcn_mfma_f32_32x32x16_bf16(k1, qf[0], negm, 0, 0, 0); }
#pragma unroll
        for (int ks = 1; ks < KS; ++ks) { const bf16x8 k0 = *(const LAS bf16x8*)(kb + ks * 16), k1 = *(const LAS bf16x8*)(kb + 32 * KROW + ks * 16);
            s0 = __builtin_amdgcn_mfma_f32_32x32x16_bf16(k0, qf[ks], s0, 0, 0, 0); s1 = __builtin_amdgcn_mfma_f32_32x32x16_bf16(k1, qf[ks], s1, 0, 0, 0); }
        float mx = fmaxf(s0[0], s1[0]);
#pragma unroll
        for (int r = 1; r < 16; ++r) mx = max3f(mx, s0[r], s1[r]);
        mx = fmaxf(mx, __shfl_xor(mx, 32));
        if (t == 0 || __any(mx > 8.f)) {
            const float delta = t == 0 ? mx : fmaxf(mx, 0.f), alpha = t == 0 ? 1.f : ex2(-delta); l_run *= alpha;
#pragma unroll
            for (int r = 0; r < 16; ++r) { negm[r] -= delta; s0[r] -= delta; s1[r] -= delta; }
#pragma unroll
            for (int d0 = 0; d0 < 4; ++d0)
#pragma unroll
                for (int r = 0; r < 16; ++r) o[d0][r] *= alpha;
        }
        f32x2_t ps2 = {0.f, 0.f};
        u32x4 pw[4];
#pragma unroll
        for (int i = 0; i < 8; ++i) { f32x2_t e = (f32x2_t){s0[2 * i], s0[2 * i + 1]}, f = (f32x2_t){s1[2 * i], s1[2 * i + 1]}; e[0] = ex2(e[0]); e[1] = ex2(e[1]); f[0] = ex2(f[0]); f[1] = ex2(f[1]);
            ps2 = ps2 + e; ps2 = ps2 + f; pw[i >> 2][i & 3] = pk2(e[0], e[1]); pw[2 + (i >> 2)][i & 3] = pk2(f[0], f[1]); }
        l_run += ps2[0] + ps2[1];
#pragma unroll
        for (int sp = 0; sp < 4; ++sp) { const bf16x8 pf = __builtin_bit_cast(bf16x8, pw[sp]);
#pragma unroll
            for (int d0 = 0; d0 < 4; ++d0) { const bf16x8 vf = *(const LAS bf16x8*)(vb + 32 * d0 * VROW + sp * 16); o[d0] = __builtin_amdgcn_mfma_f32_32x32x16_bf16(vf, pf, o[d0], 0, 0, 0); } }
        if (t + 2 < NT) asm volatile("s_waitcnt vmcnt(%0) lgkmcnt(0)" :: "n"(NJ) : "memory"); else asm volatile("s_waitcnt vmcnt(0) lgkmcnt(0)" ::: "memory");
        __builtin_amdgcn_s_barrier(); asm volatile("" ::: "memory");
        slot2 = slot; slot = slot == 2 ? 0 : slot + 1;
    }
#undef AD_DMA
    const float l = l_run + __shfl_xor(l_run, 32), inv = 1.f / l;
    bf16_t* op = O + (size_t)(q0 + wid * 32 + qi) * ldo + 4 * hi;
#pragma unroll
    for (int d0 = 0; d0 < 4; ++d0)
#pragma unroll
        for (int g = 0; g < 4; ++g) { u32x2 w; w.x = pk2(o[d0][4 * g] * inv, o[d0][4 * g + 1] * inv); w.y = pk2(o[d0][4 * g + 2] * inv, o[d0][4 * g + 3] * inv); *(u32x2*)(op + 32 * d0 + 8 * g) = w; }
}

__device__ __forceinline__ void attn_unit_da(const bf16_t* __restrict__ Q, const bf16_t* __restrict__ K, const bf16_t* __restrict__ Vt, bf16_t* O, int q0, int nkeys, LAS unsigned char* lds) {
    constexpr int KROW = 72, VROW = 72, LDQ = 512, LDO = 1024;
    LAS bf16_t* Ks = (LAS bf16_t*)lds; LAS bf16_t* Vs = (LAS bf16_t*)(lds + 2 * 64 * KROW * 2);
    int tid_ = threadIdx.x; asm volatile("" : "+v"(tid_));
    const int tid = tid_, lane = tid & 63, wid = tid >> 6, qi = lane & 31, hi = lane >> 5, qg = wid >> 1, kh = wid & 1;
    bf16x8 qf[2][4];
#pragma unroll
    for (int qs = 0; qs < 2; ++qs) { const bf16_t* qp = Q + (size_t)(q0 + qg * 64 + qs * 32 + qi) * LDQ + hi * 8;
#pragma unroll
        for (int ks = 0; ks < 4; ++ks) qf[qs][ks] = *(const bf16x8*)(qp + ks * 16); }
    f32x16 o[2][4];
#pragma unroll
    for (int qs = 0; qs < 2; ++qs)
#pragma unroll
        for (int d0 = 0; d0 < 4; ++d0)
#pragma unroll
            for (int r = 0; r < 16; ++r) o[qs][d0][r] = 0.f;
    float m_run[2] = {-1e30f, -1e30f}, l_run[2] = {0.f, 0.f};
    const int NT = nkeys / 64;
    u32x4 kreg, vreg[2];
#define DA_LOADG(t) do { { const int r_ = tid >> 3, cc_ = tid & 7; kreg = *(const u32x4*)(K + (size_t)((t) * 64 + r_) * 512 + cc_ * 8); } \
        _Pragma("unroll") for (int i_ = 0; i_ < 2; ++i_) { const int c_ = tid + NTHR * i_, dv_ = c_ >> 3, k8_ = c_ & 7; vreg[i_] = *(const u32x4*)(Vt + (size_t)dv_ * T + (t) * 64 + k8_ * 8); } } while (0)
#define DA_STOREL(b) do { { const int r_ = tid >> 3, cc_ = tid & 7; *(LAS u32x4*)(Ks + (b) * 64 * KROW + r_ * KROW + cc_ * 8) = kreg; } \
        _Pragma("unroll") for (int i_ = 0; i_ < 2; ++i_) { const int c_ = tid + NTHR * i_, dv_ = c_ >> 3, k8_ = c_ & 7; *(LAS u32x4*)(Vs + (b) * 128 * VROW + dv_ * VROW + k8_ * 8) = vreg[i_]; } } while (0)
    DA_LOADG(0); DA_STOREL(0); __syncthreads();
    const int krow = 32 * kh + swap23(qi);
    for (int t = 0; t < NT; ++t) {
        const int buf = t & 1;
        if (t + 1 < NT) DA_LOADG(t + 1);
        const LAS bf16_t* kb = Ks + buf * 64 * KROW + krow * KROW + hi * 8; const LAS bf16_t* vb = Vs + buf * 128 * VROW + qi * VROW + 32 * kh + hi * 8;
        f32x16 sc[2];
#pragma unroll
        for (int r = 0; r < 16; ++r) { sc[0][r] = 0.f; sc[1][r] = 0.f; }
#pragma unroll
        for (int ks = 0; ks < 4; ++ks) { const bf16x8 kf = *(const LAS bf16x8*)(kb + ks * 16);
            sc[0] = __builtin_amdgcn_mfma_f32_32x32x16_bf16(kf, qf[0][ks], sc[0], 0, 0, 0); sc[1] = __builtin_amdgcn_mfma_f32_32x32x16_bf16(kf, qf[1][ks], sc[1], 0, 0, 0); }
        u32x4 pw[2][2];
#pragma unroll
        for (int qs = 0; qs < 2; ++qs) {
            float mx = max3f(sc[qs][0], sc[qs][1], sc[qs][2]);
#pragma unroll
            for (int r = 3; r < 15; r += 2) mx = max3f(mx, sc[qs][r], sc[qs][r + 1]);
            mx = fmaxf(mx, sc[qs][15]);
            mx = fmaxf(mx, __shfl_xor(mx, 32));
            if (__any(mx > m_run[qs] + 8.f)) {
                const float m_new = fmaxf(m_run[qs], mx), alpha = ex2(m_run[qs] - m_new); m_run[qs] = m_new; l_run[qs] *= alpha;
#pragma unroll
                for (int d0 = 0; d0 < 4; ++d0)
#pragma unroll
                    for (int r = 0; r < 16; ++r) o[qs][d0][r] *= alpha;
            }
            float ps = 0.f;
#pragma unroll
            for (int r = 0; r < 16; ++r) { sc[qs][r] = ex2(sc[qs][r] - m_run[qs]); ps += sc[qs][r]; }
            l_run[qs] += ps;
#pragma unroll
            for (int i = 0; i < 4; ++i) { pw[qs][0][i] = pk2(sc[qs][2 * i], sc[qs][2 * i + 1]); pw[qs][1][i] = pk2(sc[qs][8 + 2 * i], sc[qs][8 + 2 * i + 1]); }
        }
#pragma unroll
        for (int sp = 0; sp < 2; ++sp)
#pragma unroll
            for (int d0 = 0; d0 < 4; ++d0) { const bf16x8 vf = *(const LAS bf16x8*)(vb + 32 * d0 * VROW + sp * 16);
                o[0][d0] = __builtin_amdgcn_mfma_f32_32x32x16_bf16(vf, __builtin_bit_cast(bf16x8, pw[0][sp]), o[0][d0], 0, 0, 0);
                o[1][d0] = __builtin_amdgcn_mfma_f32_32x32x16_bf16(vf, __builtin_bit_cast(bf16x8, pw[1][sp]), o[1][d0], 0, 0, 0); }
        if (t + 1 < NT) DA_STOREL(buf ^ 1);
        __syncthreads();
    }
#undef DA_LOADG
#undef DA_STOREL
    LAS float* xp = (LAS float*)lds + (size_t)qg * (130 * 64) + lane;
#pragma unroll
    for (int qs = 0; qs < 2; ++qs) {
        const float lt = l_run[qs] + __shfl_xor(l_run[qs], 32);
        if (kh == 1) { xp[128 * 64] = m_run[qs]; xp[129 * 64] = lt;
#pragma unroll
            for (int d0 = 0; d0 < 4; ++d0)
#pragma unroll
                for (int r = 0; r < 16; ++r) xp[(d0 * 16 + r) * 64] = o[qs][d0][r]; }
        __syncthreads();
        if (kh == 0) { const float mb = xp[128 * 64], lb = xp[129 * 64];
            const float m = fmaxf(m_run[qs], mb), fa = ex2(m_run[qs] - m), fb = ex2(mb - m), inv = 1.f / (lt * fa + lb * fb), ca = fa * inv, cb = fb * inv;
            bf16_t* op = O + (size_t)(q0 + qg * 64 + qs * 32 + qi) * LDO + 4 * hi;
#pragma unroll
            for (int d0 = 0; d0 < 4; ++d0)
#pragma unroll
                for (int g = 0; g < 4; ++g) { float v[4];
#pragma unroll
                    for (int j = 0; j < 4; ++j) v[j] = o[qs][d0][4 * g + j] * ca + xp[(d0 * 16 + 4 * g + j) * 64] * cb;
                    u32x2 w; w.x = pk2(v[0], v[1]); w.y = pk2(v[2], v[3]); *(u32x2*)(op + 32 * d0 + 8 * g) = w; } }
        __syncthreads();
    }
}

#define XB_TMO      128
#define XB_XCNT(j)  (256  + 64 * (j))
#define XB_XSUB(j)  (1280 + 64 * (j))
#define XB_XGEN(j)  (2304 + 64 * (j))
#define XB_TOP      3328
#define XB_TOPGEN   3392
#define XCD_BAR_WORDS 3456
#define XB_SPIN_CAP (1u << 18)

__device__ __forceinline__ unsigned xb_ld(unsigned* p)              { return __hip_atomic_load(p, __ATOMIC_RELAXED, __HIP_MEMORY_SCOPE_AGENT); }
__device__ __forceinline__ unsigned xb_add(unsigned* p, unsigned v) { return __hip_atomic_fetch_add(p, v, __ATOMIC_RELAXED, __HIP_MEMORY_SCOPE_AGENT); }
__device__ __forceinline__ unsigned xb_xcc_id() { return (unsigned)__builtin_amdgcn_s_getreg((3 << 11) | 20) & 0xFu; }
#define XB_SPIN(cond, bar) do { unsigned _sp = 0; while (cond) { __builtin_amdgcn_s_sleep(1); \
    if ((++_sp & 255u) == 0u) { if (xb_ld(&(bar)[XB_TMO])) break; if (_sp > XB_SPIN_CAP) { atomicAdd(&(bar)[XB_TMO], 1u); break; } } } } while (0)

struct XcdBarrier {
    unsigned* bar; unsigned x;
    volatile LAS unsigned* st;
};

__device__ __forceinline__ XcdBarrier xcd_barrier_post(unsigned* bar, volatile LAS unsigned* st) {
    XcdBarrier b; b.bar = bar; b.x = xb_xcc_id(); b.st = st;
    if (threadIdx.x == 0) (void)xb_add(&bar[XB_XCNT(b.x)], 1u);
    return b;
}
__device__ __forceinline__ void xcd_barrier_complete(unsigned* bar, unsigned x, unsigned& nloc, unsigned& nx) {
    const unsigned G = gridDim.x * gridDim.y * gridDim.z;
    unsigned sum, cnt, mine, sp = 0u;
    for (;;) {
        sum = 0u; cnt = 0u; mine = 0u;
#pragma unroll
        for (unsigned j = 0; j < 16; ++j) { const unsigned c = xb_ld(&bar[XB_XCNT(j)]); sum += c; cnt += (c > 0u) ? 1u : 0u; mine = (j == x) ? c : mine; }
        if (sum == G) break;
        __builtin_amdgcn_s_sleep(1);
        if ((++sp & 255u) == 0u) { if (xb_ld(&bar[XB_TMO])) break; if (sp > XB_SPIN_CAP) { atomicAdd(&bar[XB_TMO], 1u); break; } }
    }
    nloc = mine > 0u ? mine : 1u; nx = cnt > 0u ? cnt : 1u;
}

__device__ __forceinline__ void xcd_barrier(const XcdBarrier& b) {
    asm volatile("s_waitcnt vmcnt(0)" ::: "memory");
    __syncthreads();
    if (threadIdx.x == 0) {
        unsigned* bar = b.bar;
        __builtin_amdgcn_s_waitcnt(0);
        unsigned nloc = b.st[0], nx = b.st[1];
        if (nloc == 0u) { xcd_barrier_complete(bar, b.x, nloc, nx); b.st[0] = nloc; b.st[1] = nx; }
        const unsigned old = xb_add(&bar[XB_XSUB(b.x)], 1u);
        const unsigned gen = old / nloc;
        if (old + 1u == (gen + 1u) * nloc) {
            __builtin_amdgcn_fence(__ATOMIC_RELEASE, "agent");
            asm volatile("s_waitcnt vmcnt(0)" ::: "memory");
            const unsigned og = xb_add(&bar[XB_TOP], 1u);
            const unsigned tg = og / nx;
            if (og + 1u == (tg + 1u) * nx) xb_add(&bar[XB_TOPGEN], 1u);
            else XB_SPIN(xb_ld(&bar[XB_TOPGEN]) == tg, bar);
            __builtin_amdgcn_fence(__ATOMIC_ACQUIRE, "agent");
            xb_add(&bar[XB_XGEN(b.x)], 1u);
            asm volatile("s_waitcnt vmcnt(0)" ::: "memory");
        } else {
            XB_SPIN(xb_ld(&bar[XB_XGEN(b.x)]) == gen, bar);
            __builtin_amdgcn_fence(__ATOMIC_ACQUIRE, "agent");
            asm volatile("s_waitcnt vmcnt(0)" ::: "memory");
        }
    }
    __syncthreads();
}

#define GAS __attribute__((address_space(1)))
#define PIN(i) ((const float*)(const GAS float*)pp->in[i])
#define F1T ((bf16_t*)(ws + O_F1T))
#define F2T ((bf16_t*)(ws + O_F2T))
#define ROPE ((float*)(ws + O_ROPE))
#define C8T ((float*)(ws + O_C8))
#define MODS ((float*)(ws + O_MODS))
#define XMOD ((bf16_t*)(ws + O_XMOD))
#define XRES ((float*)(ws + O_XRES))
#define QDA ((bf16_t*)(ws + O_QDA))
#define KDA ((bf16_t*)(ws + O_KDA))
#define VTDA ((bf16_t*)(ws + O_VTDA))
#define LRUX ((bf16_t*)(ws + O_LRUX))
#define LRUG ((bf16_t*)(ws + O_LRUG))
#define CQ ((bf16_t*)(ws + O_CQ))
#define CKV ((bf16_t*)(ws + O_CKV))
#define PARTQ ((float*)(ws + O_PARTQ))
#define PARTKV ((float*)(ws + O_PARTKV))
#define QMLA ((bf16_t*)(ws + O_QMLA))
#define KMLA ((bf16_t*)(ws + O_KMLA))
#define VTMLA ((bf16_t*)(ws + O_VTMLA))
#define FX ((bf16_t*)(ws + O_FX))
#define FT ((bf16_t*)(ws + O_FT))
#define CTXW ((float*)(ws + O_CTXW))
#define XC ((bf16_t*)(ws + O_XC))
#define AU ((unsigned*)(ws + O_AU))
#define SUMM ((float*)(ws + O_SUMM))
#define DAO ((bf16_t*)(ws + O_DAO))
#define HB ((bf16_t*)(ws + O_H))
#define WIN ((bf16_t*)(wl + O_WIN))
#define WOUT ((bf16_t*)(wl + O_WOUT))
#define WGU ((bf16_t*)(wl + O_WGU))
#define WD ((bf16_t*)(wl + O_WD))
#define WUQ ((bf16_t*)(wl + O_WUQ))
#define WUKV ((bf16_t*)(wl + O_WUKV))
#define WLRU ((bf16_t*)(wl + O_WLRU))
#define MIX XMOD
#define mods_c (MODS + (size_t)(l * 2 + 0) * 12288)
#define mods_l (MODS + (size_t)(l * 2 + 1) * 12288)
__device__ __forceinline__ int chunk_start(int c) { if (c <= 4) return 64 * c; const int cl = c - 4; return NCTX + 65 * cl + (cl < 4 ? cl : 4); }
constexpr int N_PHASES = 22;
template <unsigned MASK>
__global__ void __launch_bounds__(NTHR, 2) mega_fwd(Params P) {
    extern __shared__ __attribute__((aligned(16))) unsigned char lds_raw[];
    LAS unsigned char* lds = (LAS unsigned char*)lds_raw;
    const int tid0 = threadIdx.x;
    const int G0 = gridDim.x, bid0 = blockIdx.x;
    cg::grid_group grid = cg::this_grid();
    volatile LAS unsigned* bst = (volatile LAS unsigned*)(lds + LDS_BYTES - 16);
    if (tid0 < 4) bst[tid0] = 0u;
    __syncthreads();
    XcdBarrier xbar = xcd_barrier_post((unsigned*)(P.ws + O_BAR), bst);

    for (int ph = P.ph_lo; ph < P.ph_hi; ++ph) {
        const __attribute__((address_space(4))) Params* pp = (const __attribute__((address_space(4))) Params*)__builtin_amdgcn_kernarg_segment_ptr(); asm volatile("" : "+s"(pp));
        int tid = tid0; asm volatile("" : "+v"(tid));
        int G = G0, bid = bid0; asm volatile("" : "+s"(G), "+s"(bid));
        const int NGW = G * NWV, NT_ALL = G * NTHR;
        const int lane = tid & 63, wid = __builtin_amdgcn_readfirstlane(tid >> 6), gw = bid * NWV + wid, gtid = bid * NTHR + tid;
        GAS unsigned char* ws = (GAS unsigned char*)pp->ws; asm volatile("" : "+s"(ws));
        const int l = ph >= 2 ? (ph - 2) / 10 : 0, sub = ph >= 2 ? (ph - 2) % 10 : -1;
        GAS unsigned char* wl = ws + (size_t)l * SZ_WLAYER;
        if (EN(0) && ph == 0) {
            for (int rp_ = 0; rp_ < DUP_P0; ++rp_) {
            for (int it = bid; it < 256; it += G) {
                const int ll = it >> 7, g = (it >> 5) & 3, kb = it & 31, k0 = 64 * kb;
                LAS float* wt = (LAS float*)lds; LAS float* tab = wt + 128 * 68;
                const float* wsrc = PIN(I_WIN) + (size_t)ll * DM * INW;
                for (int i = 0; i < 16; ++i) { const int e = tid + NTHR * i, kk = e >> 7, c = e & 127; wt[c * 68 + kk] = wsrc[(size_t)(k0 + kk) * INW + 3264 + 128 * g + c]; }
                if (tid < 128) tab[tid] = cospif((float)tid * (1.f / 64.f)) * RSQ128;
                __syncthreads();
                const int col = tid & 255, part = col >> 7, jj = col & 127, kh = tid >> 8; const int ph0 = part ? 96 : 0;
                bf16_t* dst = (bf16_t*)(ws + (size_t)ll * SZ_WLAYER + O_WIN) + (size_t)((13 + g) * 256 + col) * DM + k0 + 32 * kh;
                f32x4 a[8];
#pragma unroll
                for (int q = 0; q < 8; ++q) a[q] = (f32x4){0.f, 0.f, 0.f, 0.f};
                for (int c = 0; c < 128; ++c) { const float tv = tab[(jj * c + ph0) & 127]; const LAS f32x4* wr4 = (const LAS f32x4*)(wt + c * 68 + 32 * kh);
#pragma unroll
                    for (int q = 0; q < 8; ++q) a[q] += wr4[q] * tv; }
                const float sg = part ? -1.f : 1.f;
#pragma unroll
                for (int q = 0; q < 4; ++q) { u32x4 o; o.x = pk2(a[2 * q][0] * sg, a[2 * q][1] * sg); o.y = pk2(a[2 * q][2] * sg, a[2 * q][3] * sg); o.z = pk2(a[2 * q + 1][0] * sg, a[2 * q + 1][1] * sg); o.w = pk2(a[2 * q + 1][2] * sg, a[2 * q + 1][3] * sg);
                    *(u32x4*)(dst + 8 * q) = o; }
                __syncthreads();
            }
            for (int it = bid; it < 192; it += G) {
                const int ll = it / 96, nc = it % 96;
                LAS float* sv = (LAS float*)lds; LAS float* red = sv + 2 * DM;
                for (int i = tid; i < DM; i += NTHR) { sv[i] = siluf(PIN(I_CCTX)[i]); sv[DM + i] = siluf(PIN(I_C)[i]); }
                __syncthreads();
                const float* wp = PIN(I_WADA) + (size_t)ll * DM * 12288 + 128 * nc + 2 * lane;
                float a00 = 0.f, a01 = 0.f, a10 = 0.f, a11 = 0.f;
                for (int k0 = 256 * wid; k0 < 256 * wid + 256; k0 += 16) { f32x2_t w2[16];
#pragma unroll
                    for (int j = 0; j < 16; ++j) w2[j] = *(const f32x2_t*)(wp + (size_t)(k0 + j) * 12288);
#pragma unroll
                    for (int j = 0; j < 16; ++j) { const float s0 = sv[k0 + j], s1 = sv[DM + k0 + j]; a00 += s0 * w2[j][0]; a01 += s0 * w2[j][1]; a10 += s1 * w2[j][0]; a11 += s1 * w2[j][1]; } }
                red[(wid * 2 + 0) * 128 + 2 * lane] = a00; red[(wid * 2 + 0) * 128 + 2 * lane + 1] = a01; red[(wid * 2 + 1) * 128 + 2 * lane] = a10; red[(wid * 2 + 1) * 128 + 2 * lane + 1] = a11;
                __syncthreads();
                if (tid < 256) { const int v = tid >> 7, cc = tid & 127; float s = PIN(I_BADA)[(size_t)ll * 12288 + 128 * nc + cc];
                    for (int w = 0; w < 8; ++w) s += red[(w * 2 + v) * 128 + cc];
                    MODS[(size_t)(ll * 2 + v) * 12288 + 128 * nc + cc] = s; }
                __syncthreads();
            }
            for (int i = gtid; i < 4096; i += NT_ALL) { const int pos = i >> 4, f = i & 15; const float x = ((float)pos * INVF[f]) * 0.3183098861837907f; ROPE[2 * i] = cospif(x); ROPE[2 * i + 1] = sinpif(x); }
            for (int i = gtid; i < 65536; i += NT_ALL) { const int cp = i >> 8, kk = i & 255, part = kk >> 7, nn = kk & 127;
                const int n = (cp >> 4) & 1, k1 = 64 * (cp >> 7) + 16 * ((cp >> 5) & 3) + (cp & 15); const float ang = (float)((k1 * nn) & 127) * (1.f / 64.f); const float cv = cospif(ang) * RSQ128, sv = sinpif(ang) * RSQ128;
                F1T[i] = f2bf(n == 0 ? (part == 0 ? cv : sv) : (part == 0 ? -sv : cv)); }
            for (int i = gtid; i < 128 * 65536; i += NT_ALL) { const int k1 = i >> 16, cp = (i >> 8) & 255, kk = i & 255, part = kk >> 7, nn = kk & 127;
                float v = 0.f; if (cp < 128) { const float ang = (float)((nn * (k1 + 128 * cp)) & 16383) * (1.f / 8192.f); v = (part == 0 ? cospif(ang) : sinpif(ang)) * RSQ128; } F2T[i] = f2bf(v); }
            for (int i = gtid; i < 2048; i += NT_ALL) C8T[i] = -8.f * log1pf(__expf(-PIN(I_LLAM)[i]));
            LAS float* scr = (LAS float*)(lds + wid * 8704);
            for (int ll = 0; ll < 2; ++ll) {
                GAS unsigned char* wd = ws + (size_t)ll * SZ_WLAYER;
                tr_job(MapWin{PIN(I_WIN) + (size_t)ll * DM * INW, INW}, DM, 13 * 256, (bf16_t*)(wd + O_WIN), nullptr, scr, gw, NGW, lane);
                tr_job(MapPlain{PIN(I_WOUT) + (size_t)ll * DM * DM, DM}, DM, DM, (bf16_t*)(wd + O_WOUT), nullptr, scr, gw, NGW, lane);
                tr_job(MapGU{PIN(I_WG) + (size_t)ll * DM * DFF, PIN(I_WU) + (size_t)ll * DM * DFF, DFF}, DM, 2 * DFF, (bf16_t*)(wd + O_WGU), nullptr, scr, gw, NGW, lane);
                tr_job(MapPlain{PIN(I_WD) + (size_t)ll * DFF * DM, DM}, DFF, DM, (bf16_t*)(wd + O_WD), nullptr, scr, gw, NGW, lane);
                tr_job(MapUq{PIN(I_WUQ) + (size_t)ll * 384 * 768, 768}, 384, 768, (bf16_t*)(wd + O_WUQ), PIN(I_QNG) + ll * 384, scr, gw, NGW, lane);
                tr_job(MapUkv{PIN(I_WUKV) + (size_t)ll * 256 * 1024, 1024}, 256, 1024, (bf16_t*)(wd + O_WUKV), PIN(I_KVNG) + ll * 256, scr, gw, NGW, lane);
                for (int hd = 0; hd < 8; ++hd) { const int h = hd >> 1, d = hd & 1; const size_t wo = ((size_t)(ll * 2 + d) * 4 + h) * 16384;
                    tr_job(MapLru{PIN(I_LWR) + wo, PIN(I_LWI) + wo, 128}, 128, 256, (bf16_t*)(wd + O_WLRU) + (size_t)hd * 256 * 128, nullptr, scr, gw, NGW, lane); }
            }
            __syncthreads(); }
        } else if (EN(1) && ph == 1) {
            for (int row = gw; row < T; row += NGW) { const float* xr = row < NCTX ? PIN(I_CTX) + (size_t)row * DM : PIN(I_X) + (size_t)(row - NCTX) * DM; const float* md = MODS + (size_t)(row < NCTX ? 0 : 1) * 12288;
#pragma unroll
                for (int j = 0; j < 8; ++j) { const int c = 4 * lane + 256 * j; const f32x4 xv = *(const f32x4*)(xr + c), sh = *(const f32x4*)(md + c), sc = *(const f32x4*)(md + DM + c); st4bf(XMOD + (size_t)row * DM + c, xv * (sc + 1.f) + sh); if (row < NCTX) *(f32x4*)(XRES + (size_t)row * DM + c) = xv * ALPHA; } }
        } else if (EN(2) && sub == 0) {
            pg8::Gemm g{XMOD, WIN, T, NIN, DM}; pg8::StaticOrder S; S.init(T, NIN, G, bid);
            EpiInproj E{QDA, KDA, VTDA, LRUX, LRUG, CQ, CKV, KMLA, FX, CTXW, PARTQ, PARTKV, ROPE};
            for (int rg_ = 0; rg_ < DUP_GEMM; ++rg_) pg8::gemm_phase<EpiInproj, pg8::StaticOrder, true, true>(lds, g, S, E);
        } else if (EN(3) && sub == 1) {
            for (int rs_ = 0; rs_ < DUP_S1; ++rs_) {
            if (EN(11)) { const float* cw = PIN(I_CONVW) + (size_t)l * 4 * 512; const float* cbv = PIN(I_CONVB) + (size_t)l * 512;
              for (int idx = gtid; idx < T * 64; idx += NT_ALL) { const int row = idx >> 6, ch0 = (idx & 63) * 8; const int lo = row < NCTX ? 0 : NCTX, hi = row < NCTX ? NCTX : T;
                  float a[8];
#pragma unroll
                  for (int q = 0; q < 8; ++q) a[q] = cbv[ch0 + q];
#pragma unroll
                  for (int j = 0; j < 4; ++j) { const int r = row + j - 2; if (r >= lo && r < hi) { const u32x4 xw = *(const u32x4*)(LRUX + (size_t)r * 512 + ch0); const float* wj = cw + j * 512 + ch0;
#pragma unroll
                      for (int q = 0; q < 4; ++q) { a[2 * q] += wj[2 * q] * bf2f(xw[q] & 0xffffu); a[2 * q + 1] += wj[2 * q + 1] * bf2f(xw[q] >> 16); } } }
                  u32x4 o; o.x = pk2(a[0], a[1]); o.y = pk2(a[2], a[3]); o.z = pk2(a[4], a[5]); o.w = pk2(a[6], a[7]);
                  *(u32x4*)(XC + ((size_t)(ch0 >> 7) * T + row) * 128 + (ch0 & 127)) = o; } }
            if (EN(12)) { pg8::Gemm g{CQ, WUQ, T, 768, 384}; pg8::StaticOrder S; S.init(T, 768, G, bid); EpiUpq E{QMLA, PARTQ, ROPE}; pg8::gemm_phase<EpiUpq, pg8::StaticOrder, true, true>(lds, g, S, E); }
            if (EN(13)) { pg8::Gemm g{CKV, WUKV, T, 1024, 256}; pg8::StaticOrder S; S.init(T, 1024, G, (bid + G - 195 % G) % G);     EpiUpkv E{KMLA, VTMLA, PARTKV}; pg8::gemm_phase<EpiUpkv, pg8::StaticOrder, true, true>(lds, g, S, E); }
            if (EN(14)) { pg8::Gemm g{FX, F1T, 65536, 256, 256}; pg8::StaticOrder S; S.init(65536, 256, G, bid); EpiFftA E{FT}; pg8::gemm_phase<EpiFftA, pg8::StaticOrder, true, true>(lds, g, S, E); }
            __syncthreads();
            if (EN(15)) for (int k = bid; k < 256; k += G) {
                LAS float* tab = (LAS float*)lds; LAS float* red = tab + 256; if (tid < 256) tab[tid] = cospif((float)tid * (1.f / 128.f)) * 0.0625f; __syncthreads();
                const float* wp = CTXW + (lane >> 4) * 256 + (lane & 15) * 8; f32x4 a0 = {0.f, 0.f, 0.f, 0.f}, a1 = a0;
                for (int n0 = 32 * wid; n0 < 32 * wid + 32; n0 += 8) { f32x4 xr[8][2], xi[8][2];
#pragma unroll
                    for (int j = 0; j < 8; ++j) { const float* p = wp + (size_t)(n0 + j) * 1024; xr[j][0] = *(const f32x4*)p; xr[j][1] = *(const f32x4*)(p + 4); xi[j][0] = *(const f32x4*)(p + 128); xi[j][1] = *(const f32x4*)(p + 132); }
#pragma unroll
                    for (int j = 0; j < 8; ++j) { const int mm = (k * (n0 + j)) & 255; const float cv = tab[mm], sv = tab[(mm + 192) & 255]; a0 += xr[j][0] * cv + xi[j][0] * sv; a1 += xr[j][1] * cv + xi[j][1] * sv; } }
                *(LAS f32x4*)(red + wid * 512 + lane * 8) = a0; *(LAS f32x4*)(red + wid * 512 + lane * 8 + 4) = a1;
                __syncthreads();
                { float t = 0.f;
#pragma unroll
                  for (int w = 0; w < 8; ++w) t += red[w * 512 + tid];
                  MIX[(size_t)k * DM + 1536 + tid] = f2bf(t); }
                __syncthreads(); }
            }
        } else if (EN(4) && sub == 2) {
            for (int rep_ = 0; rep_ < DUP_ATTN; ++rep_)
            if (EN(16)) for (int un = bid; un < 520; un += G) { const int hh = un < 512 ? (un & 7) : (un - 512), qb = un < 512 ? 1 + (un >> 3) : 0;
                attn_unit_da(QDA + hh * 64, KDA + hh * 64, VTDA + (size_t)(hh >> 1) * 128 * T, DAO + hh * 128, qb * 256, qb == 0 ? NCTX : T, lds); }
            for (int rs_ = 0; rs_ < DUP_S2; ++rs_) {
            if (EN(17)) { pg8::Gemm g{XC, WLRU, 4 * T, 2048, 128}; LruOrder S{G, bid}; EpiLru E{AU, XC, PIN(I_LBR) + (size_t)l * 1024, PIN(I_LBI) + (size_t)l * 1024, C8T + (size_t)l * 1024};
              pg8::gemm_phase<EpiLru, LruOrder, true, true>(lds, g, S, E); }
            if (EN(18)) { pg8::Gemm g{FT, F2T, 65536, 256, 256}; FftCOrder S{G, bid}; EpiFftC E{MIX}; pg8::gemm_phase<EpiFftC, FftCOrder, true, true>(lds, g, S, E); }
            }
        } else if (EN(5) && sub == 3) {
            for (int rep_ = 0; rep_ < DUP_ATTN; ++rep_)
            for (int un = bid; un < 260; un += G) { const int h = un < 256 ? (un & 3) : (un - 256), qb = un < 256 ? 1 + (un >> 2) : 0;
                if (MLA_DMA) attn_unit_dma<192>(QMLA + h * 192, 768, KMLA + h * 192, 768, VTMLA + (size_t)h * 128 * T, MIX + 1024 + h * 128, DM, qb * 256, qb == 0 ? NCTX : T, lds);
                else attn_unit<192>(QMLA + h * 192, 768, KMLA + h * 192, 768, VTMLA + (size_t)h * 128 * T, MIX + 1024 + h * 128, DM, qb * 256, qb == 0 ? NCTX : T, lds); }
            for (int rs_ = 0; rs_ < DUP_S3; ++rs_)
            for (int un = bid; un < 512; un += G) { const int d = un >> 8, c = un & 255; const int cs = chunk_start(c), len = chunk_start(c + 1) - cs;
                const unsigned* au = AU + (size_t)d * T * 512 + tid; float h = 0.f, S = 0.f;
                for (int i0 = 0; i0 < len; i0 += 16) { unsigned w[16];
#pragma unroll
                    for (int j = 0; j < 16; ++j) { const int i = i0 + j < len ? i0 + j : len - 1; const int row = d == 0 ? cs + i : cs + len - 1 - i; w[j] = au[(size_t)row * 512]; }
#pragma unroll
                    for (int j = 0; j < 16; ++j) if (i0 + j < len) { const float l2a = bf2f(w[j] >> 16), uu = bf2f(w[j] & 0xffffu); h = ex2(l2a) * h + uu; S += l2a; } }
                SUMM[((size_t)(d * 256 + c) * 512 + tid) * 2] = S; SUMM[((size_t)(d * 256 + c) * 512 + tid) * 2 + 1] = h; }
        } else if (EN(6) && sub == 4) {
            for (int rs_ = 0; rs_ < DUP_S4; ++rs_) {
            __syncthreads();
            for (int c = bid; c < 256; c += G) { LAS float* hfs = (LAS float*)lds; const f32x2_t* S0 = (const f32x2_t*)SUMM + tid; const f32x2_t* S1 = S0 + (size_t)256 * 512;
                const int cs = chunk_start(c), len = chunk_start(c + 1) - cs;
                float hf = 0.f, hb = 0.f;
                for (int p0 = 0; p0 < c; p0 += 16) { f32x2_t sv[16];
#pragma unroll
                    for (int j = 0; j < 16; ++j) { const int k = p0 + j < c ? p0 + j : c - 1; sv[j] = S0[(size_t)k * 512]; }
#pragma unroll
                    for (int j = 0; j < 16; ++j) if (p0 + j < c) hf = ex2(sv[j][0]) * hf + sv[j][1]; }
                const int np = c < 4 ? 3 - c : 4 + 255 - c;
                for (int p0 = 0; p0 < np; p0 += 16) { f32x2_t sv[16];
#pragma unroll
                    for (int j = 0; j < 16; ++j) { const int p = p0 + j < np ? p0 + j : np - 1; const int k = p < 4 ? 3 - p : 259 - p; sv[j] = S1[(size_t)k * 512]; }
#pragma unroll
                    for (int j = 0; j < 16; ++j) if (p0 + j < np) hb = ex2(sv[j][0]) * hb + sv[j][1]; }
                const unsigned* a0 = AU + tid; const unsigned* a1 = AU + (size_t)T * 512 + tid;
                for (int i0 = 0; i0 < len; i0 += 16) { unsigned w[16];
#pragma unroll
                    for (int j = 0; j < 16; ++j) { const int i = i0 + j < len ? i0 + j : len - 1; w[j] = a0[(size_t)(cs + i) * 512]; }
#pragma unroll
                    for (int j = 0; j < 16; ++j) if (i0 + j < len) { hf = ex2(bf2f(w[j] >> 16)) * hf + bf2f(w[j] & 0xffffu); hfs[(i0 + j) * 512 + tid] = hf; } }
                for (int i0 = 0; i0 < len; i0 += 16) { unsigned w[16]; bf16_t gg[16];
#pragma unroll
                    for (int j = 0; j < 16; ++j) { const int i = i0 + j < len ? i0 + j : len - 1; const int row = cs + len - 1 - i; w[j] = a1[(size_t)row * 512]; gg[j] = LRUG[(size_t)row * 512 + tid]; }
#pragma unroll
                    for (int j = 0; j < 16; ++j) if (i0 + j < len) { const int ii = len - 1 - (i0 + j); hb = ex2(bf2f(w[j] >> 16)) * hb + bf2f(w[j] & 0xffffu);
                        MIX[(size_t)(cs + ii) * DM + 512 + tid] = f2bf((hfs[ii * 512 + tid] + hb) * gelu_tanh(bf2f(gg[j]))); } } }
            { const float linit = l == 0 ? 0.2f : 0.35550906759096926f;
              const float e1 = __expf(wave_sum(PIN(I_LQ1)[l * 64 + lane] * PIN(I_LK1)[l * 64 + lane])), e2 = __expf(wave_sum(PIN(I_LQ2)[l * 64 + lane] * PIN(I_LK2)[l * 64 + lane])); const float lam = e1 - e2 + linit;
              const float g0 = PIN(I_SUBLN)[l * 128 + 2 * lane] * (1.f - linit), g1 = PIN(I_SUBLN)[l * 128 + 2 * lane + 1] * (1.f - linit);
              for (int row = gw; row < T; row += NGW) { unsigned w1[4], w2[4];
#pragma unroll
                  for (int h = 0; h < 4; ++h) { w1[h] = *(const unsigned*)(DAO + (size_t)row * 1024 + h * 256 + 2 * lane); w2[h] = *(const unsigned*)(DAO + (size_t)row * 1024 + h * 256 + 128 + 2 * lane); }
#pragma unroll
                  for (int h = 0; h < 4; ++h) { const float y0 = bf2f(w1[h] & 0xffffu) - lam * bf2f(w2[h] & 0xffffu), y1 = bf2f(w1[h] >> 16) - lam * bf2f(w2[h] >> 16); const float inv = rsqrtf(wave_sum(y0 * y0 + y1 * y1) * (1.f / 128.f) + 1e-6f);
                      *(unsigned*)(MIX + (size_t)row * DM + h * 128 + 2 * lane) = pk2(y0 * inv * g0, y1 * inv * g1); } } }
            }
        } else if (EN(7) && sub == 5) {
            pg8::Gemm g{MIX + (size_t)256 * DM, WOUT, T - 256, DM, DM}; pg8::StaticOrder S; S.init(T - 256, DM, G, bid);
            EpiRes E{l == 0 ? PIN(I_CTX) : XRES, l == 0 ? PIN(I_X) : XRES + (size_t)NCTX * DM, XRES, mods_c + 2 * DM, mods_l + 2 * DM, 1};
            pg8::gemm_phase<EpiRes, pg8::StaticOrder, true, true>(lds, g, S, E);
            if (l == 0) for (int kp = 0; kp < 4; ++kp) {
                pg8::Gemm gc{MIX + kp * 512, WOUT + kp * 512, 256, DM, 512, DM}; pg8::StaticOrder Sc; Sc.init(256, DM, G, (bid + G - 8 * kp) % G); EpiResAtomic Ec{XRES, mods_c + 2 * DM};
                pg8::gemm_phase<EpiResAtomic, pg8::StaticOrder, true, true>(lds, gc, Sc, Ec); }
        } else if (EN(8) && (sub == 6 || sub == 9)) {
            const bool second = sub == 9, fin = second && l == 1;
            const float* gam = PIN(second ? I_LN2G : I_LN1G) + (size_t)l * DM; const float* bet = PIN(second ? I_LN2B : I_LN1B) + (size_t)l * DM;
#define LN_LOAD(V, R) do { _Pragma("unroll") for (int j_ = 0; j_ < 8; ++j_) V[j_] = *(const f32x4*)(XRES + (size_t)(R) * DM + 4 * lane + 256 * j_); } while (0)
#define LN_ROW(V, R) do { const int row_ = (R); float* yr_ = XRES + (size_t)row_ * DM; float s_ = 0.f; \
                _Pragma("unroll") for (int j_ = 0; j_ < 8; ++j_) s_ += (V[j_][0] + V[j_][1]) + (V[j_][2] + V[j_][3]); \
                const float mean_ = wave_sum(s_) * (1.f / DM); float s2_ = 0.f; \
                _Pragma("unroll") for (int j_ = 0; j_ < 8; ++j_) { V[j_] = V[j_] - mean_; s2_ += (V[j_][0] * V[j_][0] + V[j_][1] * V[j_][1]) + (V[j_][2] * V[j_][2] + V[j_][3] * V[j_][3]); } \
                const float rstd_ = rsqrtf(wave_sum(s2_) * (1.f / DM) + 1e-5f); \
                const float* md_ = second ? MODS + (size_t)((l + 1) * 2 + (row_ < NCTX ? 0 : 1)) * 12288 : MODS + (size_t)(l * 2 + (row_ < NCTX ? 0 : 1)) * 12288 + 3 * DM; \
                float* dst_ = fin ? ((float*)(GAS float*)pp->out) + (size_t)(row_ - NCTX) * DM : yr_; \
                const float rs2_ = (!second && row_ < NCTX) ? ALPHA : 1.f; \
                _Pragma("unroll") for (int j_ = 0; j_ < 8; ++j_) { const int c_ = 4 * lane + 256 * j_; const f32x4 xn_ = V[j_] * rstd_ * *(const f32x4*)(gam + c_) + *(const f32x4*)(bet + c_); *(f32x4*)(dst_ + c_) = xn_ * rs2_; \
                    if (!fin) { const f32x4 sh_ = *(const f32x4*)(md_ + c_), sc_ = *(const f32x4*)(md_ + DM + c_); st4bf(XMOD + (size_t)row_ * DM + c_, xn_ * (sc_ + 1.f) + sh_); } } } while (0)
            { f32x4 va[8], vb[8]; int row = gw + l * NCTX;
#pragma unroll
              for (int j = 0; j < 8; ++j) { va[j] = (f32x4){0.f, 0.f, 0.f, 0.f}; vb[j] = va[j]; }
              if (row < T) LN_LOAD(va, row);
              for (; row < T; row += 2 * NGW) {
                  const bool hb = row + NGW < T;
                  if (hb) LN_LOAD(vb, row + NGW);
                  LN_ROW(va, row);
                  if (row + 2 * NGW < T) LN_LOAD(va, row + 2 * NGW);
                  if (hb) LN_ROW(vb, row + NGW);
              } }
#undef LN_LOAD
#undef LN_ROW
        } else if (EN(9) && sub == 7) {
            pg8::Gemm g{XMOD + (size_t)l * 256 * DM, WGU, T - l * 256, 2 * DFF, DM}; pg8::StaticOrder S; S.init(T - l * 256, 2 * DFF, G, bid); EpiGU E{HB, l};
            for (int rg_ = 0; rg_ < DUP_GEMM; ++rg_) pg8::gemm_phase<EpiGU, pg8::StaticOrder, true, true>(lds, g, S, E);
        } else if (EN(10) && sub == 8) {
            pg8::Gemm g{HB + (size_t)256 * DFF, WD, T - 256, DM, DFF}; pg8::StaticOrder S; S.init(T - 256, DM, G, bid);
            EpiRes E{XRES, XRES + (size_t)NCTX * DM, XRES, mods_c + 5 * DM, mods_l + 5 * DM, 1};
            pg8::gemm_phase<EpiRes, pg8::StaticOrder, true, true>(lds, g, S, E);
            if (l == 0) for (int kp = 0; kp < 4; ++kp) {
                pg8::Gemm gc{HB + kp * 1408, WD + kp * 1408, 256, DM, 1408, DFF}; pg8::StaticOrder Sc; Sc.init(256, DM, G, (bid + G - 8 * kp) % G); EpiResAtomic Ec{XRES, mods_c + 5 * DM};
                pg8::gemm_phase<EpiResAtomic, pg8::StaticOrder, true, true>(lds, gc, Sc, Ec); }
        }
        if (ph + 1 < P.ph_hi) { if (ph == 0) grid.sync(); else xcd_barrier(xbar); }
    }
}

template <unsigned MASK> static void launch_one(int grid, Params p, hipStream_t stream, bool coop) {
    static bool attr_set = false;
    if (!attr_set) { (void)hipFuncSetAttribute((const void*)mega_fwd<MASK>, hipFuncAttributeMaxDynamicSharedMemorySize, LDS_BYTES); attr_set = true; }
    if (coop) { void* args[] = {&p}; hipError_t e = hipLaunchCooperativeKernel((const void*)mega_fwd<MASK>, dim3(grid), dim3(NTHR), args, LDS_BYTES, stream);
        if (e != hipSuccess) fprintf(stderr, "cooperative launch failed: %s (grid %d)\n", hipGetErrorString(e), grid); }
    else hipLaunchKernelGGL(mega_fwd<MASK>, dim3(grid), dim3(NTHR), LDS_BYTES, stream, p);
}
extern "C" void kernel_launch(void* const* d_in, const int* in_sizes, int n_in, void* d_out, int out_size, void* d_ws, size_t ws_size, hipStream_t stream) {
    static int grid = 0;
    if (grid == 0) {
        if (n_in != 31 || ws_size < WS_NEED) { fprintf(stderr, "kernel_launch: need 31 inputs and %zu bytes of workspace; got %d, %zu\n", (size_t)WS_NEED, n_in, ws_size); grid = -1; return; }
        int dev = 0, cus = 0;
        (void)hipGetDevice(&dev); (void)hipDeviceGetAttribute(&cus, hipDeviceAttributeMultiprocessorCount, dev);
        grid = cus;
#if !MK_MULTI
        int per_cu = 0;
        (void)hipFuncSetAttribute((const void*)mega_fwd<PH_MASK>, hipFuncAttributeMaxDynamicSharedMemorySize, LDS_BYTES);
        (void)hipOccupancyMaxActiveBlocksPerMultiprocessor(&per_cu, (const void*)mega_fwd<PH_MASK>, NTHR, LDS_BYTES);
        if (per_cu < 1) fprintf(stderr, "kernel_launch: occupancy query returned %d\n", per_cu);
        (void)hipGetLastError();
#endif
    }
    if (grid < 0) return;
    Params p{};
    for (int i = 0; i < 31; ++i) p.in[i] = (const float*)d_in[i];
    p.out = (float*)d_out; p.ws = (unsigned char*)d_ws;
#if MK_MULTI
#define L1(ph, mask) do { p.ph_lo = (ph); p.ph_hi = (ph) + 1; launch_one<(mask)>(grid, p, stream, false); } while (0)
    L1(0, 1u); L1(1, 2u);
    for (int l = 0; l < 2; ++l) { const int b = 2 + 10 * l;
        L1(b + 0, 1u << 2); L1(b + 1, (1u << 3) | (1u << 11) | (1u << 12) | (1u << 13)); L1(b + 1, (1u << 3) | (1u << 14) | (1u << 15));
        L1(b + 2, (1u << 4) | (1u << 16)); L1(b + 2, (1u << 4) | (1u << 17)); L1(b + 2, (1u << 4) | (1u << 18));
        L1(b + 3, 1u << 5); L1(b + 4, 1u << 6); L1(b + 5, 1u << 7); L1(b + 6, 1u << 8); L1(b + 7, 1u << 9); L1(b + 8, 1u << 10); L1(b + 9, 1u << 8); }
#else
    p.ph_lo = 0; p.ph_hi = N_PHASES;
    (void)hipMemsetAsync((unsigned char*)d_ws + O_BAR, 0, 16384, stream);
    launch_one<PH_MASK>(grid, p, stream, true);
#endif
}
```

```cpp
#include <hip/hip_runtime.h>
#include <hip/hip_cooperative_groups.h>
#include <cstdio>
#include <cstdint>
namespace cg = cooperative_groups;
#ifndef PH_MASK
#define PH_MASK 0xfffff
#endif
#define EN(k) (((MASK) >> (k)) & 1u)
#ifndef DUP_ATTN
#define DUP_ATTN 1
#endif
#ifndef DUP_S1
#define DUP_S1 1
#endif
#ifndef DUP_S2
#define DUP_S2 1
#endif
#ifndef DUP_S3
#define DUP_S3 1
#endif
#ifndef DUP_S4
#define DUP_S4 1
#endif
#ifndef DUP_GEMM
#define DUP_GEMM 1
#endif
#ifndef DUP_P0
#define DUP_P0 1
#endif
#ifndef MLA_DMA
#define MLA_DMA 1
#endif
#ifndef MK_MULTI
#define MK_MULTI 0
#endif
namespace pg8 {
#define PG8_LAS __attribute__((address_space(3)))
typedef unsigned short bf16_t;
typedef short bf16x8 __attribute__((ext_vector_type(8)));
typedef float f32x4 __attribute__((ext_vector_type(4)));
typedef unsigned u32x4 __attribute__((ext_vector_type(4)));
constexpr int BM = 256, BK = 64, HALF = 128, HTB = HALF * BK * 2  , STAGE_BYTES = 8 * HTB, NXCD = 8, WGM = 8;

__host__ __device__ __forceinline__ int lds_byte(int r, int c) { const int st = (r >> 4) * 2 + (c >> 5), rr = r & 15, cc = c & 31, ob = rr * 64 + cc * 2; return st * 1024 + (ob ^ (((ob >> 9) & 1) << 5)); }
__host__ __device__ __forceinline__ void stage_rc(int b, int& R, int& C) { const int st = b / 1024, sb = b % 1024, swz = sb ^ (((sb >> 9) & 1) << 5); R = (st >> 1) * 16 + swz / 64; C = (st & 1) * 32 + (swz % 64) / 2; }
__host__ __device__ __forceinline__ int perm32(int rho) { const int n = rho >> 4, i = rho & 15; return 8 * (i >> 2) + 4 * n + (i & 3); }

struct Unit { int pm, pn; };
struct Gemm { const bf16_t* A; const bf16_t* Bt; int M, N, K; int ld; };

struct StaticOrder {
    int nM, nN, nwg, G, c;
    __host__ __device__ void init(int M, int N, int G_, int c_) { nM = M / BM; nN = N / BM; nwg = nM * nN; G = G_; c = c_; }
    __host__ __device__ bool next(int i, Unit& u) const {
        const long L = (long)i * G + c; if (L >= nwg) return false;
        int wgid = (int)L; { const int q = nwg / NXCD, r = nwg % NXCD, xcd = wgid % NXCD, off = wgid / NXCD; wgid = (xcd < r ? xcd * (q + 1) : r * (q + 1) + (xcd - r) * q) + off; }
        const int nig = WGM * nN, gid = wgid / nig, fm = gid * WGM, gsz = (nM - fm) < WGM ? (nM - fm) : WGM;
        u.pm = fm + ((wgid % nig) % gsz); u.pn = (wgid % nig) / gsz; return true;
    }
    __device__ __forceinline__ void a_ready(const Unit&) const {}
    __device__ __forceinline__ void done(const Unit&) const {}
};

template <class Epi, class Sched, bool ALIGN_EPI = false, bool SP2 = false>
__device__ __forceinline__ void gemm_phase(PG8_LAS unsigned char* lds, const Gemm g, const Sched& S, const Epi& E) {
    int tid_ = threadIdx.x; asm volatile("" : "+v"(tid_));
    const int tid = tid_, wid = __builtin_amdgcn_readfirstlane(tid >> 6), lane = tid & 63, wr = wid >> 2, wc = wid & 3, fr = lane & 15, fq = lane >> 4;
    int K_ = g.K; asm volatile("" : "+s"(K_));
    const int K = K_, nt = K / BK; int LD_ = g.ld ? g.ld : g.K; asm volatile("" : "+s"(LD_)); const int LD = LD_;
    unsigned voffA[2], voffB[2];
#pragma unroll
    for (int i = 0; i < 2; ++i) { int R, C; stage_rc(tid * 16 + i * 8192, R, C); const int Rb = Epi::PERM ? ((R & ~31) + perm32(R & 31)) : R;
        voffA[i] = (unsigned)(R * LD + C) * 2u; voffB[i] = (unsigned)(Rb * LD + C) * 2u; }
    const size_t kstep = (size_t)(BK * 2);
    const size_t hstep = (size_t)HALF * LD * 2;
    const size_t tstep = 2 * hstep;
    const unsigned ldsw = (unsigned)wid * 1024u;
    const int aoff = lds_byte(wr * 64 + fr, fq * 8), boff = lds_byte(wc * 32 + fr, fq * 8);
#define PG8_SA(b, h) (((b) * 2 + (h)) * HTB)
#define PG8_SB(b, h) ((4 + (b) * 2 + (h)) * HTB)
#define PG8_STAGE(bufoff, gbase, voff) do { _Pragma("unroll") for (int _i = 0; _i < 2; ++_i) \
        __builtin_amdgcn_global_load_lds((const unsigned*)((const char*)(gbase) + (voff)[_i]), (PG8_LAS unsigned*)(lds + (bufoff) + ldsw + _i * 8192), 16, 0, 0); } while (0)
#define PG8_LDA(dst, b, h) do { _Pragma("unroll") for (int m = 0; m < 4; ++m) _Pragma("unroll") for (int k = 0; k < 2; ++k) dst[m][k] = *(const PG8_LAS bf16x8*)(lds + PG8_SA(b, h) + aoff + m * 2048 + k * 1024); } while (0)
#define PG8_LDB(dst, b, h) do { _Pragma("unroll") for (int n = 0; n < 2; ++n) _Pragma("unroll") for (int k = 0; k < 2; ++k) dst[n][k] = *(const PG8_LAS bf16x8*)(lds + PG8_SB(b, h) + boff + n * 2048 + k * 1024); } while (0)
#define PG8_MMA(ai, bj, At, Bt) do { __builtin_amdgcn_s_setprio(1); _Pragma("unroll") for (int m = 0; m < 4; ++m) _Pragma("unroll") for (int n = 0; n < 2; ++n) _Pragma("unroll") for (int k = 0; k < 2; ++k) \
        acc[ai][bj][m][n] = __builtin_amdgcn_mfma_f32_16x16x32_bf16(Bt[n][k], At[m][k], acc[ai][bj][m][n], 0, 0, 0); __builtin_amdgcn_s_setprio(0); } while (0)
#define PG8_WAIT_V(n) asm volatile("s_waitcnt vmcnt(" #n ")" ::: "memory")
#define PG8_WAIT_L(n) asm volatile("s_waitcnt lgkmcnt(" #n ")" ::: "memory")
#define PG8_BAR __builtin_amdgcn_s_barrier()
#define PG8_SCHED __builtin_amdgcn_sched_barrier(0)
    Unit cur, nxt; int ui = 0;
    if (!S.next(0, cur)) return;
    f32x4 acc[2][2][4][2];
#pragma unroll
    for (int a = 0; a < 2; ++a)
#pragma unroll
        for (int b = 0; b < 2; ++b)
#pragma unroll
            for (int m = 0; m < 4; ++m)
#pragma unroll
                for (int n = 0; n < 2; ++n) acc[a][b][m][n] = (f32x4){0.f, 0.f, 0.f, 0.f};
    bf16x8 At[4][2], B0[2][2], B1[2][2];
    const char* cA = (const char*)g.A + (size_t)cur.pm * tstep; const char* cB = (const char*)g.Bt + (size_t)cur.pn * tstep;
    S.a_ready(cur);
    if constexpr (SP2) {
        PG8_STAGE(PG8_SB(0, 0), cB, voffB); PG8_STAGE(PG8_SB(0, 1), cB + hstep, voffB); PG8_STAGE(PG8_SA(0, 0), cA, voffA); PG8_STAGE(PG8_SA(0, 1), cA + hstep, voffA);
        if (wr == 1) PG8_BAR;
        PG8_WAIT_V(2); PG8_BAR;
        PG8_STAGE(PG8_SB(1, 0), cB + kstep, voffB); PG8_STAGE(PG8_SA(1, 0), cA + kstep, voffA); PG8_STAGE(PG8_SB(1, 1), cB + hstep + kstep, voffB);
        PG8_WAIT_V(6); PG8_BAR;
    } else {
        PG8_STAGE(PG8_SB(0, 0), cB, voffB); PG8_STAGE(PG8_SA(0, 0), cA, voffA); PG8_STAGE(PG8_SB(0, 1), cB + hstep, voffB); PG8_STAGE(PG8_SA(0, 1), cA + hstep, voffA);
        if (wr == 1) PG8_BAR;
        PG8_WAIT_V(4); PG8_BAR;
        PG8_STAGE(PG8_SB(1, 0), cB + kstep, voffB); PG8_STAGE(PG8_SA(1, 0), cA + kstep, voffA); PG8_STAGE(PG8_SB(1, 1), cB + hstep + kstep, voffB);
        PG8_WAIT_V(6); PG8_BAR;
    }
    for (;;) {
        const bool has_next = S.next(ui + 1, nxt);
        const char* nA = has_next ? (const char*)g.A + (size_t)nxt.pm * tstep : cA; const char* nB = has_next ? (const char*)g.Bt + (size_t)nxt.pn * tstep : cB;
        for (int t = 0; t < nt; t += 2) {
            const bool last = (t == nt - 2);
            const char* a1 = cA + (size_t)(t + 1) * kstep;
            const char* a2 = last ? nA : cA + (size_t)(t + 2) * kstep; const char* b2 = last ? nB : cB + (size_t)(t + 2) * kstep;
            const char* a3 = a2 + kstep; const char* b3 = b2 + kstep;
            if (last && has_next) S.a_ready(nxt);
            if constexpr (SP2) {
            PG8_LDB(B0, 0, 0); PG8_LDB(B1, 0, 1); PG8_SCHED; PG8_LDA(At, 0, 0); PG8_STAGE(PG8_SA(1, 1), a1 + hstep, voffA);
            PG8_WAIT_V(8); PG8_WAIT_L(0); PG8_BAR; PG8_MMA(0, 0, At, B0); PG8_MMA(0, 1, At, B1); PG8_BAR; PG8_SCHED;
            PG8_LDA(At, 0, 1); PG8_STAGE(PG8_SB(0, 0), b2, voffB); PG8_STAGE(PG8_SB(0, 1), b2 + hstep, voffB); PG8_STAGE(PG8_SA(0, 0), a2, voffA);
            PG8_WAIT_V(8); PG8_WAIT_L(0); PG8_BAR; PG8_MMA(1, 0, At, B0); PG8_MMA(1, 1, At, B1); PG8_BAR; PG8_SCHED;
            PG8_LDB(B0, 1, 0); PG8_LDB(B1, 1, 1); PG8_SCHED; PG8_LDA(At, 1, 0); PG8_STAGE(PG8_SA(0, 1), a2 + hstep, voffA);
            PG8_WAIT_V(8); PG8_WAIT_L(0); PG8_BAR; PG8_MMA(0, 0, At, B0); PG8_MMA(0, 1, At, B1); PG8_BAR; PG8_SCHED;
            PG8_LDA(At, 1, 1); PG8_STAGE(PG8_SB(1, 0), b3, voffB); PG8_STAGE(PG8_SB(1, 1), b3 + hstep, voffB); PG8_STAGE(PG8_SA(1, 0), a3, voffA);
            PG8_WAIT_V(8); PG8_WAIT_L(0); PG8_BAR; PG8_MMA(1, 0, At, B0); PG8_MMA(1, 1, At, B1); PG8_BAR; PG8_SCHED;
            } else {
            PG8_LDB(B0, 0, 0); PG8_SCHED; PG8_LDA(At, 0, 0); PG8_STAGE(PG8_SA(1, 1), a1 + hstep, voffA);
            PG8_WAIT_L(8); PG8_BAR; PG8_WAIT_L(0); PG8_MMA(0, 0, At, B0); PG8_BAR; PG8_SCHED;
            PG8_LDB(B1, 0, 1); PG8_STAGE(PG8_SB(0, 0), b2, voffB);
            PG8_BAR; PG8_WAIT_L(0); PG8_MMA(0, 1, At, B1); PG8_BAR;
            PG8_LDA(At, 0, 1); PG8_STAGE(PG8_SA(0, 0), a2, voffA);
            PG8_BAR; PG8_WAIT_L(0); PG8_MMA(1, 0, At, B0); PG8_BAR; PG8_SCHED;
            PG8_STAGE(PG8_SB(0, 1), b2 + hstep, voffB);
            PG8_WAIT_V(6); PG8_BAR; PG8_MMA(1, 1, At, B1); PG8_BAR;
            PG8_LDB(B0, 1, 0); PG8_SCHED; PG8_LDA(At, 1, 0); PG8_STAGE(PG8_SA(0, 1), a2 + hstep, voffA);
            PG8_WAIT_L(8); PG8_BAR; PG8_WAIT_L(0); PG8_MMA(0, 0, At, B0); PG8_BAR; PG8_SCHED;
            PG8_LDB(B1, 1, 1); PG8_STAGE(PG8_SB(1, 0), b3, voffB);
            PG8_BAR; PG8_WAIT_L(0); PG8_MMA(0, 1, At, B1); PG8_BAR;
            PG8_LDA(At, 1, 1); PG8_STAGE(PG8_SA(1, 0), a3, voffA);
            PG8_BAR; PG8_WAIT_L(0); PG8_MMA(1, 0, At, B0); PG8_BAR; PG8_SCHED;
            PG8_STAGE(PG8_SB(1, 1), b3 + hstep, voffB);
            PG8_WAIT_V(6); PG8_BAR; PG8_MMA(1, 1, At, B1); PG8_BAR;
            }
        }
        if constexpr (ALIGN_EPI) { if (wr == 0) PG8_BAR; }
        if constexpr (!Epi::AFTER_DRAIN) { E(acc, cur, wr, wc, fr, fq); S.done(cur); }
        if (!has_next) break;
#pragma unroll
        for (int a = 0; a < 2; ++a)
#pragma unroll
            for (int b = 0; b < 2; ++b)
#pragma unroll
                for (int m = 0; m < 4; ++m)
#pragma unroll
                    for (int n = 0; n < 2; ++n) acc[a][b][m][n] = (f32x4){0.f, 0.f, 0.f, 0.f};
        cur = nxt; cA = nA; cB = nB; ++ui;
        if constexpr (ALIGN_EPI) { if (wr == 1) PG8_BAR; }
    }
    PG8_WAIT_V(0);
    if constexpr (!ALIGN_EPI) { if (wr == 0) PG8_BAR; }
    PG8_BAR;
    if constexpr (Epi::AFTER_DRAIN) { E.fused(acc, cur, wr, wc, fr, fq, lds, wid, lane); S.done(cur); }
#undef PG8_SA
#undef PG8_SB
#undef PG8_STAGE
#undef PG8_LDA
#undef PG8_LDB
#undef PG8_MMA
#undef PG8_WAIT_V
#undef PG8_WAIT_L
#undef PG8_BAR
#undef PG8_SCHED
}
}

using pg8::bf16_t; using pg8::bf16x8; using pg8::f32x4; using pg8::u32x4;
typedef float f32x16 __attribute__((ext_vector_type(16)));
typedef unsigned u32x2 __attribute__((ext_vector_type(2)));
typedef float f32x2_t __attribute__((ext_vector_type(2)));
typedef __bf16 bf16x2_t __attribute__((ext_vector_type(2)));
#define LAS __attribute__((address_space(3)))

constexpr int T = 16640, NCTX = 256, DM = 2048, DFF = 5632, NIN = 4352, INW = 3776;
constexpr int NTHR = 512, NWV = 8;
constexpr float ALPHA = 1.4142135623730951f;
constexpr float LOG2E = 1.4426950408889634f;
constexpr float QS_DA = 0.125f * 1.4426950408889634f;
constexpr float QS_MLA = (float)(0.07216878364870323 * 1.4426950408889634);
constexpr float RSQ128 = 0.08838834764831845f;
constexpr int LDS_BYTES = 147456;

__device__ __forceinline__ unsigned pk2(float lo, float hi) { f32x2_t v = {lo, hi}; bf16x2_t b = __builtin_convertvector(v, bf16x2_t); return __builtin_bit_cast(unsigned, b); }
__device__ __forceinline__ bf16_t f2bf(float f) { return (bf16_t)(pk2(f, 0.f) & 0xffffu); }
__device__ __forceinline__ float bf2f(unsigned b) { return __uint_as_float(b << 16); }
__device__ __forceinline__ float ex2(float x) { return __builtin_amdgcn_exp2f(x); }
__device__ __forceinline__ float max3f(float a, float b, float c) { return __builtin_fmaxf(__builtin_fmaxf(a, b), c); }
__device__ __forceinline__ int swap45(int o) { return (o & ~0x30) | ((o & 0x20) >> 1) | ((o & 0x10) << 1); }
__device__ __forceinline__ int swap23(int o) { return (o & ~0xC) | ((o & 0x4) << 1) | ((o & 0x8) >> 1); }
__device__ __forceinline__ float wave_sum(float v) {
#pragma unroll
    for (int o = 1; o < 64; o <<= 1) v += __shfl_xor(v, o);
    return v;
}
__device__ __forceinline__ float siluf(float x) { return x / (1.f + __expf(-x)); }
__device__ __forceinline__ float sigmf(float x) { return 1.f / (1.f + __expf(-x)); }
__device__ __forceinline__ float gelu_tanh(float x) { const float t = tanhf(0.7978845608028654f * (x + 0.044715f * x * x * x)); return 0.5f * x * (1.f + t); }

constexpr size_t al256(size_t x) { return (x + 255) & ~(size_t)255; }
constexpr size_t SZ_WIN = (size_t)NIN * DM * 2, SZ_WOUT = (size_t)DM * DM * 2, SZ_WGU = (size_t)2 * DFF * DM * 2, SZ_WD = (size_t)DM * DFF * 2;
constexpr size_t SZ_WUQ = (size_t)768 * 384 * 2, SZ_WUKV = (size_t)1024 * 256 * 2, SZ_WLRU = (size_t)8 * 256 * 128 * 2;
constexpr size_t O_WIN = 0, O_WOUT = O_WIN + SZ_WIN, O_WGU = O_WOUT + SZ_WOUT, O_WD = O_WGU + SZ_WGU, O_WUQ = O_WD + SZ_WD, O_WUKV = O_WUQ + SZ_WUQ, O_WLRU = O_WUKV + SZ_WUKV;
constexpr size_t SZ_WLAYER = O_WLRU + SZ_WLRU;
constexpr size_t O_F1T = 2 * SZ_WLAYER, O_F2T = O_F1T + 131072, O_ROPE = O_F2T + (size_t)128 * 131072, O_C8 = O_ROPE + 32768, O_MODS = O_C8 + 8192, O_BAR = al256(O_MODS + 2 * 2 * 12288 * 4), O_XMOD = al256(O_BAR + 16384);
constexpr size_t O_XRES = O_XMOD + (size_t)T * DM * 2, O_U = O_XRES + (size_t)T * DM * 4;
constexpr size_t O_QDA = O_U, O_KDA = O_QDA + (size_t)T * 512 * 2, O_VTDA = O_KDA + (size_t)T * 512 * 2, O_LRUX = O_VTDA + (size_t)T * 512 * 2, O_LRUG = O_LRUX + (size_t)T * 512 * 2;
constexpr size_t O_CQ = O_LRUG + (size_t)T * 512 * 2, O_CKV = O_CQ + (size_t)T * 384 * 2, O_PARTQ = O_CKV + (size_t)T * 256 * 2, O_PARTKV = O_PARTQ + (size_t)T * 8 * 4;
constexpr size_t O_QMLA = O_PARTKV + (size_t)T * 4 * 4, O_KMLA = O_QMLA + (size_t)T * 768 * 2, O_VTMLA = O_KMLA + (size_t)T * 768 * 2, O_FX = O_VTMLA + (size_t)T * 512 * 2;
constexpr size_t O_FT = O_FX + (size_t)65536 * 256 * 2, O_CTXW = O_FT + (size_t)65536 * 256 * 2, O_XC = O_CTXW + (size_t)256 * 1024 * 4, O_AU = O_XC + (size_t)4 * T * 128 * 2;
constexpr size_t O_SUMM = O_AU + (size_t)2 * T * 512 * 4, O_DAO = O_SUMM + (size_t)2 * 260 * 512 * 8, O_UEND = O_DAO + (size_t)T * 1024 * 2;
constexpr size_t O_H = O_U;
constexpr size_t WS_NEED = (O_UEND > O_H + (size_t)T * DFF * 2) ? O_UEND : (O_H + (size_t)T * DFF * 2);

struct Params { const float* in[31]; float* out; unsigned char* ws; int ph_lo, ph_hi; };
enum { I_X = 0, I_C, I_CTX, I_CCTX, I_WADA, I_BADA, I_WIN, I_WOUT, I_LN1G, I_LN1B, I_LN2G, I_LN2B, I_LQ1, I_LK1, I_LQ2, I_LK2, I_SUBLN, I_CONVW, I_CONVB, I_LWR, I_LBR, I_LWI, I_LBI, I_LLAM,
       I_QNG, I_WUQ, I_KVNG, I_WUKV, I_WG, I_WU, I_WD };

__device__ const float INVF[16] = {1.0f, 0.5623413324356079f, 0.3162277638912201f, 0.17782793939113617f, 0.10000000149011612f, 0.05623413249850273f, 0.03162277489900589f, 0.017782794311642647f,
                                   0.009999999776482582f, 0.005623413249850273f, 0.003162277629598975f, 0.0017782794311642647f, 0.0010000000474974513f, 0.000562341301701963f, 0.0003162277571391314f, 0.00017782794020604342f};

struct MapWin { const float* W; int stride;
    __device__ __forceinline__ const float* operator()(int d) const { const int tile = d >> 8, c = d & 255; int src;
        if (tile < 4) src = tile * 256 + swap45(c); else if (tile < 10) src = tile * 256 + c; else if (tile == 10) src = 2560 + c;
        else if (tile == 11) { if (c < 128) src = 2816 + c; else if (c < 192) src = 3200 + swap45(c - 128); else return nullptr; }
        else src = 2944 + c;
        return W + src; } };
struct MapPlain { const float* W; int stride; __device__ __forceinline__ const float* operator()(int d) const { return W + d; } };
struct MapGU { const float* Wg; const float* Wu; int stride;
    __device__ __forceinline__ const float* operator()(int d) const { const int tile = d >> 8, c = d & 255, n = (c >> 4) & 1, f = tile * 128 + 64 * (c >> 7) + 16 * ((c >> 5) & 3) + (c & 15); const long long dl = (const char*)Wu - (const char*)Wg; return (const float*)((const char*)Wg + (long long)n * dl) + f; } };
struct MapUq { const float* W; int stride;
    __device__ __forceinline__ const float* operator()(int d) const { if (d < 512) return W + (d >> 7) * 192 + (d & 127); const int c = d - 512; return W + (c >> 6) * 192 + 128 + swap45(c & 63); } };
struct MapUkv { const float* W; int stride;
    __device__ __forceinline__ const float* operator()(int d) const { if (d < 512) return W + (d >> 7) * 256 + (d & 127); const int e = d - 512; return W + (e >> 7) * 256 + 128 + (e & 127); } };
struct MapLru { const float* Wr; const float* Wi; int stride;
    __device__ __forceinline__ const float* operator()(int c) const { const int n = (c >> 4) & 1, j = 64 * (c >> 7) + 16 * ((c >> 5) & 3) + (c & 15); const long long dl = (const char*)Wi - (const char*)Wr; return (const float*)((const char*)Wr + (long long)n * dl) + j; } };

template <class Map>
__device__ __forceinline__ void tr_job(const Map mp, int Kd, int nrows, bf16_t* WT, const float* kscale, LAS float* scr, int gw, int NGW, int lane) {
    const int nblk = nrows / 32, items = (Kd / 64) * nblk, kr = lane >> 3, c4 = lane & 7;
    f32x4 cur[8], nxt[8];
#define TR_LOAD(dst, it_) do { const int kb_ = (it_) / nblk, nb_ = (it_) % nblk; const float* cp_ = mp(32 * nb_ + 4 * c4); const int st_ = mp.stride; \
        _Pragma("unroll") for (int i_ = 0; i_ < 8; ++i_) dst[i_] = cp_ ? *(const f32x4*)(cp_ + (size_t)(64 * kb_ + kr + 8 * i_) * st_) : (f32x4){0.f, 0.f, 0.f, 0.f}; } while (0)
    int it = gw;
    if (it < items) TR_LOAD(cur, it);
    for (; it < items; it += NGW) {
        const int kb = it / nblk, nb = it % nblk, k0 = 64 * kb, d0 = 32 * nb;
        if (it + NGW < items) TR_LOAD(nxt, it + NGW);
#pragma unroll
        for (int i = 0; i < 8; ++i) { const int kk = kr + 8 * i; f32x4 v = cur[i]; if (kscale) v = v * kscale[k0 + kk];
#pragma unroll
            for (int j = 0; j < 4; ++j) scr[kk * 33 + 4 * c4 + j] = v[j]; }
        asm volatile("s_waitcnt lgkmcnt(0)" ::: "memory");
        const int c = lane & 7;
#pragma unroll
        for (int j = 0; j < 4; ++j) { const int n = (lane >> 3) + 8 * j; const LAS float* sp = scr + (8 * c) * 33 + n;
            u32x4 o; o.x = pk2(sp[0 * 33], sp[1 * 33]); o.y = pk2(sp[2 * 33], sp[3 * 33]); o.z = pk2(sp[4 * 33], sp[5 * 33]); o.w = pk2(sp[6 * 33], sp[7 * 33]);
            *(u32x4*)(WT + (size_t)(d0 + n) * Kd + k0 + 8 * c) = o; }
        asm volatile("s_waitcnt lgkmcnt(0)" ::: "memory");
#pragma unroll
        for (int i = 0; i < 8; ++i) cur[i] = nxt[i];
    }
#undef TR_LOAD
}

#define EPI_ROWS_BEGIN _Pragma("unroll") for (int ai = 0; ai < 2; ++ai) _Pragma("unroll") for (int m = 0; m < 4; ++m) { const int row = u.pm * 256 + ai * 128 + wr * 64 + m * 16 + fr;
#define EPI_ROWS_END asm volatile("" ::: "memory"); __builtin_amdgcn_sched_barrier(0); }
__device__ __forceinline__ void st4bf(bf16_t* p, const f32x4 v) { u32x2 w; w.x = pk2(v[0], v[1]); w.y = pk2(v[2], v[3]); *(u32x2*)p = w; }

struct EpiInproj {
    static constexpr bool PERM = false, AFTER_DRAIN = false;
    bf16_t *QDA, *KDA, *VTDA, *LRUX, *LRUG, *CQ, *CKV, *KMLA, *FX; float *CTXW, *PARTQ, *PARTKV; const float* ROPE;
    __device__ __forceinline__ void rope_cs(int row, int wc, int fq, f32x4& c, f32x4& s) const {
        if (row < NCTX) { c = (f32x4){1.f, 1.f, 1.f, 1.f}; s = (f32x4){0.f, 0.f, 0.f, 0.f}; return; }
        const int nl = row - NCTX, pos = (wc & 1) ? (nl & 63) : (nl >> 6);
        const f32x4 a = *(const f32x4*)(ROPE + (pos * 16 + 4 * fq) * 2), b = *(const f32x4*)(ROPE + (pos * 16 + 4 * fq) * 2 + 4);
        c = (f32x4){a[0], a[2], b[0], b[2]}; s = (f32x4){a[1], a[3], b[1], b[3]};
    }
    __device__ __forceinline__ void operator()(const f32x4 (&acc)[2][2][4][2], const pg8::Unit& u, int wr, int wc, int fr, int fq) const {
        asm volatile("" : "+v"(fr), "+v"(fq));
        const int pn = u.pn;
        if (pn < 4) {
            bf16_t* dst = pn < 2 ? QDA : KDA; const float sc = pn < 2 ? QS_DA : 1.f; const int cb = (pn & 1) * 256 + 64 * (wc >> 1) + 16 * (wc & 1) + 4 * fq;
            EPI_ROWS_BEGIN  f32x4 c, s; rope_cs(row, wc, fq, c, s);
#pragma unroll
                for (int bj = 0; bj < 2; ++bj) { const f32x4 x1 = acc[ai][bj][m][0], x2 = acc[ai][bj][m][1];
                    st4bf(dst + (unsigned)row * 512 + cb + 128 * bj, (x1 * c - x2 * s) * sc); st4bf(dst + (unsigned)row * 512 + cb + 128 * bj + 32, (x1 * s + x2 * c) * sc); }  EPI_ROWS_END
        } else if (pn < 6) {
            EPI_ROWS_BEGIN
#pragma unroll
                for (int bj = 0; bj < 2; ++bj)
#pragma unroll
                    for (int n = 0; n < 2; ++n)
#pragma unroll
                        for (int j = 0; j < 4; ++j) VTDA[(unsigned)((pn - 4) * 256 + 128 * bj + 32 * wc + 16 * n + 4 * fq + j) * T + row] = f2bf(acc[ai][bj][m][n][j]);  EPI_ROWS_END
        } else if (pn < 10) {
            bf16_t* dst = pn < 8 ? LRUX : LRUG; const int cb = (pn & 1) * 256 + 32 * wc + 4 * fq;
            EPI_ROWS_BEGIN
#pragma unroll
                for (int bj = 0; bj < 2; ++bj)
#pragma unroll
                    for (int n = 0; n < 2; ++n) st4bf(dst + (unsigned)row * 512 + cb + 128 * bj + 16 * n, acc[ai][bj][m][n]);  EPI_ROWS_END
        } else if (pn == 10) {
            EPI_ROWS_BEGIN  float ss = 0.f;
#pragma unroll
                for (int bj = 0; bj < 2; ++bj)
#pragma unroll
                    for (int n = 0; n < 2; ++n) { const f32x4 v = acc[ai][bj][m][n]; st4bf(CQ + (unsigned)row * 384 + 128 * bj + 32 * wc + 16 * n + 4 * fq, v); ss += (v[0] * v[0] + v[1] * v[1]) + (v[2] * v[2] + v[3] * v[3]); }
                ss += __shfl_xor(ss, 16); ss += __shfl_xor(ss, 32); if (fq == 0) PARTQ[(unsigned)row * 8 + wc] = ss;  EPI_ROWS_END
        } else if (pn == 11) {
            EPI_ROWS_BEGIN  float ss = 0.f;
#pragma unroll
                for (int n = 0; n < 2; ++n) { const f32x4 v = acc[ai][0][m][n]; st4bf(CQ + (unsigned)row * 384 + 256 + 32 * wc + 16 * n + 4 * fq, v); ss += (v[0] * v[0] + v[1] * v[1]) + (v[2] * v[2] + v[3] * v[3]); }
                ss += __shfl_xor(ss, 16); ss += __shfl_xor(ss, 32); if (fq == 0) PARTQ[(unsigned)row * 8 + 4 + wc] = ss;
                if (wc < 2) { f32x4 c, s; rope_cs(row, wc, fq, c, s); const f32x4 x1 = acc[ai][1][m][0], x2 = acc[ai][1][m][1]; const f32x4 y1 = x1 * c - x2 * s, y2 = x1 * s + x2 * c;
#pragma unroll
                    for (int h = 0; h < 4; ++h) { bf16_t* kp = KMLA + (unsigned)row * 768 + h * 192 + 128 + 16 * (wc & 1) + 4 * fq; st4bf(kp, y1); st4bf(kp + 32, y2); } }  EPI_ROWS_END
        } else if (pn == 12) {
            EPI_ROWS_BEGIN  float ss = 0.f;
#pragma unroll
                for (int bj = 0; bj < 2; ++bj)
#pragma unroll
                    for (int n = 0; n < 2; ++n) { const f32x4 v = acc[ai][bj][m][n]; st4bf(CKV + (unsigned)row * 256 + 128 * bj + 32 * wc + 16 * n + 4 * fq, v); ss += (v[0] * v[0] + v[1] * v[1]) + (v[2] * v[2] + v[3] * v[3]); }
                ss += __shfl_xor(ss, 16); ss += __shfl_xor(ss, 32); if (fq == 0) PARTKV[(unsigned)row * 4 + wc] = ss;  EPI_ROWS_END
        } else {
            const int g = pn - 13;
            if (u.pm == 0) {
                EPI_ROWS_BEGIN
#pragma unroll
                    for (int bj = 0; bj < 2; ++bj)
#pragma unroll
                        for (int n = 0; n < 2; ++n) *(f32x4*)(CTXW + (unsigned)row * 1024 + g * 256 + 128 * bj + 32 * wc + 16 * n + 4 * fq) = acc[ai][bj][m][n];  EPI_ROWS_END
            } else {
                EPI_ROWS_BEGIN  const int nl = row - NCTX, n1 = nl >> 7, n2 = nl & 127;
#pragma unroll
                    for (int bj = 0; bj < 2; ++bj)
#pragma unroll
                        for (int n = 0; n < 2; ++n)
#pragma unroll
                            for (int j = 0; j < 4; ++j) FX[((unsigned)((n2 * 4 + g) * 128 + 32 * wc + 16 * n + 4 * fq + j)) * 256 + bj * 128 + n1] = f2bf(acc[ai][bj][m][n][j]);  EPI_ROWS_END
            }
        }
    }
};

struct EpiUpq {
    static constexpr bool PERM = false, AFTER_DRAIN = false;
    bf16_t* QMLA; const float* PARTQ; const float* ROPE;
    __device__ __forceinline__ void operator()(const f32x4 (&acc)[2][2][4][2], const pg8::Unit& u, int wr, int wc, int fr, int fq) const {
        asm volatile("" : "+v"(fr), "+v"(fq));
        const int pn = u.pn;
        EPI_ROWS_BEGIN  const f32x4 pa = *(const f32x4*)(PARTQ + (unsigned)row * 8), pb = *(const f32x4*)(PARTQ + (unsigned)row * 8 + 4);
            const float f = rsqrtf(((pa[0] + pa[1]) + (pa[2] + pa[3]) + (pb[0] + pb[1]) + (pb[2] + pb[3])) * (1.f / 384.f) + 1e-6f) * QS_MLA;
            if (pn < 2) {
#pragma unroll
                for (int bj = 0; bj < 2; ++bj)
#pragma unroll
                    for (int n = 0; n < 2; ++n) st4bf(QMLA + (unsigned)row * 768 + (2 * pn + bj) * 192 + 32 * wc + 16 * n + 4 * fq, acc[ai][bj][m][n] * f);
            } else {
                f32x4 c, s;
                if (row < NCTX) { c = (f32x4){1.f, 1.f, 1.f, 1.f}; s = (f32x4){0.f, 0.f, 0.f, 0.f}; }
                else { const int nl = row - NCTX, pos = (wc & 1) ? (nl & 63) : (nl >> 6);
                    const f32x4 a = *(const f32x4*)(ROPE + (pos * 16 + 4 * fq) * 2), b = *(const f32x4*)(ROPE + (pos * 16 + 4 * fq) * 2 + 4);
                    c = (f32x4){a[0], a[2], b[0], b[2]}; s = (f32x4){a[1], a[3], b[1], b[3]}; }
#pragma unroll
                for (int bj = 0; bj < 2; ++bj) { const f32x4 x1 = acc[ai][bj][m][0] * f, x2 = acc[ai][bj][m][1] * f; bf16_t* qp = QMLA + (unsigned)row * 768 + (2 * bj + (wc >> 1)) * 192 + 128 + 16 * (wc & 1) + 4 * fq;
                    st4bf(qp, x1 * c - x2 * s); st4bf(qp + 32, x1 * s + x2 * c); }
            }  EPI_ROWS_END
    }
};
struct EpiUpkv {
    static constexpr bool PERM = false, AFTER_DRAIN = false;
    bf16_t *KMLA, *VTMLA; const float* PARTKV;
    __device__ __forceinline__ void operator()(const f32x4 (&acc)[2][2][4][2], const pg8::Unit& u, int wr, int wc, int fr, int fq) const {
        asm volatile("" : "+v"(fr), "+v"(fq));
        const int pn = u.pn;
        EPI_ROWS_BEGIN  const f32x4 pa = *(const f32x4*)(PARTKV + (unsigned)row * 4);
            const float f = rsqrtf(((pa[0] + pa[1]) + (pa[2] + pa[3])) * (1.f / 256.f) + 1e-6f);
            if (pn < 2) {
#pragma unroll
                for (int bj = 0; bj < 2; ++bj)
#pragma unroll
                    for (int n = 0; n < 2; ++n) st4bf(KMLA + (unsigned)row * 768 + (2 * pn + bj) * 192 + 32 * wc + 16 * n + 4 * fq, acc[ai][bj][m][n] * f);
            } else {
#pragma unroll
                for (int bj = 0; bj < 2; ++bj)
#pragma unroll
                    for (int n = 0; n < 2; ++n)
#pragma unroll
                        for (int j = 0; j < 4; ++j) VTMLA[(unsigned)((pn - 2) * 256 + 128 * bj + 32 * wc + 16 * n + 4 * fq + j) * T + row] = f2bf(acc[ai][bj][m][n][j] * f);
            }  EPI_ROWS_END
    }
};
struct LruOrder {
    int G, c;
    __device__ bool next(int i, pg8::Unit& u) const { const long L = (long)i * G + c; if (L >= 520) return false; const int idx = (int)L, pmr = idx % 65, hd = idx / 65; u.pm = (hd >> 1) * 65 + pmr; u.pn = hd; return true; }
    __device__ __forceinline__ void a_ready(const pg8::Unit&) const {}
    __device__ __forceinline__ void done(const pg8::Unit&) const {}
};
__device__ __forceinline__ float neg_expm1(float x) {
    const float ser = -x * (1.f + x * (0.5f + x * (0.16666667f + x * 0.041666667f)));
    return x > -0.125f ? ser : 1.f - __expf(x);
}
struct EpiLru {
    static constexpr bool PERM = false, AFTER_DRAIN = false;
    unsigned* AU; const bf16_t* XC; const float *br, *bi, *c8;
    __device__ __forceinline__ void operator()(const f32x4 (&acc)[2][2][4][2], const pg8::Unit& u, int wr, int wc, int fr, int fq) const {
        asm volatile("" : "+v"(fr), "+v"(fq));
        const int h = u.pn >> 1, d = u.pn & 1, pmr = u.pm - h * 65;
#pragma unroll
        for (int bj = 0; bj < 2; ++bj) { const int chl = 64 * bj + 16 * wc + 4 * fq, ch = d * 512 + h * 128 + chl; const f32x4 vbr = *(const f32x4*)(br + ch), vbi = *(const f32x4*)(bi + ch), vc8 = *(const f32x4*)(c8 + ch);
#pragma unroll
            for (int ai = 0; ai < 2; ++ai)
#pragma unroll
                for (int m = 0; m < 4; ++m) { const int row = pmr * 256 + ai * 128 + wr * 64 + m * 16 + fr; const u32x2 xw = *(const u32x2*)(XC + ((unsigned)h * T + row) * 128 + chl); u32x4 o;
#pragma unroll
                    for (int j = 0; j < 4; ++j) { const float xv = bf2f(j & 1 ? (j < 2 ? xw.x : xw.y) >> 16 : (j < 2 ? xw.x : xw.y) & 0xffffu);
                        const float r = sigmf(acc[ai][bj][m][0][j] + vbr[j]), ig = sigmf(acc[ai][bj][m][1][j] + vbi[j]); const float la = vc8[j] * r;
                        const float uu = sqrtf(neg_expm1(2.f * la)) * (ig * xv); o[j] = pk2(uu, la * LOG2E); }
                    *(u32x4*)(AU + ((unsigned)d * T + row) * 512 + h * 128 + chl) = o; asm volatile("" ::: "memory"); __builtin_amdgcn_sched_barrier(0); } }
    }
};
struct EpiFftA {
    static constexpr bool PERM = false, AFTER_DRAIN = false;
    bf16_t* FT;
    __device__ __forceinline__ void operator()(const f32x4 (&acc)[2][2][4][2], const pg8::Unit& u, int wr, int wc, int fr, int fq) const {
        asm volatile("" : "+v"(fr), "+v"(fq));
        EPI_ROWS_BEGIN const int n2 = row >> 9, gj = row & 511; bf16_t* p0 = FT + ((unsigned)((16 * wc + 4 * fq) * 512 + gj)) * 256 + n2;
#pragma unroll
            for (int bj = 0; bj < 2; ++bj)
#pragma unroll
                for (int j = 0; j < 4; ++j) { bf16_t* p = p0 + (unsigned)(64 * bj + j) * 512 * 256; p[0] = f2bf(acc[ai][bj][m][0][j]); p[128] = f2bf(acc[ai][bj][m][1][j]); } EPI_ROWS_END
    }
};
struct FftCOrder {
    int G, c;
    __device__ bool next(int i, pg8::Unit& u) const { const long L = (long)i * G + c; if (L >= 256) return false; u.pm = (int)L; u.pn = (int)L >> 1; return true; }
    __device__ __forceinline__ void a_ready(const pg8::Unit&) const {}
    __device__ __forceinline__ void done(const pg8::Unit&) const {}
};
struct EpiFftC {
    static constexpr bool PERM = false, AFTER_DRAIN = false;
    bf16_t* MIX;
    __device__ __forceinline__ void operator()(const f32x4 (&acc)[2][2][4][2], const pg8::Unit& u, int wr, int wc, int fr, int fq) const {
        asm volatile("" : "+v"(fr), "+v"(fq));
        EPI_ROWS_BEGIN  const int k1 = row >> 9, gj = row & 511;
#pragma unroll
            for (int n = 0; n < 2; ++n)
#pragma unroll
                for (int j = 0; j < 4; ++j) { const int k2 = 32 * wc + 16 * n + 4 * fq + j; MIX[(unsigned)(NCTX + k1 + 128 * k2) * DM + 1536 + gj] = f2bf(acc[ai][0][m][n][j]); }  EPI_ROWS_END
    }
};
struct EpiRes {
    static constexpr bool PERM = false, AFTER_DRAIN = false;
    const float* xa; const float* xb; float* Y; const float* gate0; const float* gate1; int pm0;
    __device__ __forceinline__ void operator()(const f32x4 (&acc)[2][2][4][2], const pg8::Unit& u_, int wr, int wc, int fr, int fq) const {
        const pg8::Unit u{u_.pm + pm0, u_.pn};
        asm volatile("" : "+v"(fr), "+v"(fq));
        const float* gp = (u.pm == 0 ? gate0 : gate1) + u.pn * 256 + 32 * wc + 4 * fq;
        f32x4 gv[2][2];
#pragma unroll
        for (int bj = 0; bj < 2; ++bj)
#pragma unroll
            for (int n = 0; n < 2; ++n) gv[bj][n] = *(const f32x4*)(gp + 128 * bj + 16 * n);
        EPI_ROWS_BEGIN  const float* xo = (row < NCTX ? xa + (unsigned)row * DM : xb + (unsigned)(row - NCTX) * DM) + u.pn * 256 + 32 * wc + 4 * fq; float* yo = Y + (unsigned)row * DM + u.pn * 256 + 32 * wc + 4 * fq;
#pragma unroll
            for (int bj = 0; bj < 2; ++bj)
#pragma unroll
                for (int n = 0; n < 2; ++n) { const f32x4 xv = *(const f32x4*)(xo + 128 * bj + 16 * n); *(f32x4*)(yo + 128 * bj + 16 * n) = xv * ALPHA + gv[bj][n] * acc[ai][bj][m][n]; }  EPI_ROWS_END
    }
};
struct EpiResAtomic {
    static constexpr bool PERM = false, AFTER_DRAIN = false;
    float* Y; const float* gate;
    __device__ __forceinline__ void operator()(const f32x4 (&acc)[2][2][4][2], const pg8::Unit& u, int wr, int wc, int fr, int fq) const {
        asm volatile("" : "+v"(fr), "+v"(fq));
        const float* gp = gate + u.pn * 256 + 32 * wc + 4 * fq;
        EPI_ROWS_BEGIN float* yo = Y + (unsigned)row * DM + u.pn * 256 + 32 * wc + 4 * fq;
#pragma unroll
            for (int bj = 0; bj < 2; ++bj)
#pragma unroll
                for (int n = 0; n < 2; ++n) { const f32x4 gv = *(const f32x4*)(gp + 128 * bj + 16 * n);
#pragma unroll
                    for (int j = 0; j < 4; ++j) (void)unsafeAtomicAdd(yo + 128 * bj + 16 * n + j, gv[j] * acc[ai][bj][m][n][j]); } EPI_ROWS_END
    }
};
struct EpiGU {
    static constexpr bool PERM = false, AFTER_DRAIN = false;
    bf16_t* H; int pm0;
    __device__ __forceinline__ void operator()(const f32x4 (&acc)[2][2][4][2], const pg8::Unit& u_, int wr, int wc, int fr, int fq) const {
        const pg8::Unit u{u_.pm + pm0, u_.pn};
        asm volatile("" : "+v"(fr), "+v"(fq));
        EPI_ROWS_BEGIN
#pragma unroll
            for (int bj = 0; bj < 2; ++bj) { const f32x4 g = acc[ai][bj][m][0], v = acc[ai][bj][m][1]; f32x4 o;
#pragma unroll
                for (int j = 0; j < 4; ++j) o[j] = siluf(g[j]) * v[j];
                st4bf(H + (unsigned)row * DFF + u.pn * 128 + 64 * bj + 16 * wc + 4 * fq, o); }  EPI_ROWS_END
    }
};

template <int DQK>
__device__ __forceinline__ void attn_unit(const bf16_t* __restrict__ Q, int ldq, const bf16_t* __restrict__ K, int ldk, const bf16_t* __restrict__ Vt, bf16_t* O, int ldo, int q0, int nkeys, LAS unsigned char* lds) {
    constexpr int KS = DQK / 16, KROW = DQK + 8, KCH = DQK / 8, KLD = (64 * KCH) / NTHR, VROW = 72;
    LAS bf16_t* Ks = (LAS bf16_t*)lds; LAS bf16_t* Vs = (LAS bf16_t*)(lds + 2 * 64 * KROW * 2);
    int tid_ = threadIdx.x; asm volatile("" : "+v"(tid_));
    const int tid = tid_, lane = tid & 63, wid = tid >> 6, qi = lane & 31, hi = lane >> 5;
    bf16x8 qf[KS];
    { const bf16_t* qp = Q + (size_t)(q0 + wid * 32 + qi) * ldq + hi * 8;
#pragma unroll
      for (int ks = 0; ks < KS; ++ks) qf[ks] = *(const bf16x8*)(qp + ks * 16); }
    f32x16 o[4];
#pragma unroll
    for (int d0 = 0; d0 < 4; ++d0)
#pragma unroll
        for (int r = 0; r < 16; ++r) o[d0][r] = 0.f;
    float m_run = -1e30f, l_run = 0.f;
    const int NT = nkeys / 64;
    u32x4 kreg[KLD], vreg[2];
#define ATT_LOADK(t) do { _Pragma("unroll") for (int i_ = 0; i_ < KLD; ++i_) { const int c_ = tid + NTHR * i_, r_ = c_ / KCH, cc_ = c_ % KCH; kreg[i_] = *(const u32x4*)(K + (size_t)((t) * 64 + r_) * ldk + cc_ * 8); } } while (0)
#define ATT_LOADV(t) do { _Pragma("unroll") for (int i_ = 0; i_ < 2; ++i_) { const int c_ = tid + NTHR * i_, dv_ = c_ >> 3, k8_ = c_ & 7; vreg[i_] = *(const u32x4*)(Vt + (size_t)dv_ * T + (t) * 64 + k8_ * 8); } } while (0)
#define ATT_STOREK(b) do { _Pragma("unroll") for (int i_ = 0; i_ < KLD; ++i_) { const int c_ = tid + NTHR * i_, r_ = c_ / KCH, cc_ = c_ % KCH; *(LAS u32x4*)(Ks + (b) * 64 * KROW + r_ * KROW + cc_ * 8) = kreg[i_]; } } while (0)
#define ATT_STOREV(b) do { _Pragma("unroll") for (int i_ = 0; i_ < 2; ++i_) { const int c_ = tid + NTHR * i_, dv_ = c_ >> 3, k8_ = c_ & 7; *(LAS u32x4*)(Vs + (b) * 128 * VROW + dv_ * VROW + k8_ * 8) = vreg[i_]; } } while (0)
#define ATT_QK(S0, S1, b) do { const LAS bf16_t* kb_ = Ks + (b) * 64 * KROW + krow * KROW + hi * 8; \
        _Pragma("unroll") for (int r_ = 0; r_ < 16; ++r_) { S0[r_] = 0.f; S1[r_] = 0.f; } \
        _Pragma("unroll") for (int ks_ = 0; ks_ < KS; ++ks_) { const bf16x8 k0_ = *(const LAS bf16x8*)(kb_ + ks_ * 16), k1_ = *(const LAS bf16x8*)(kb_ + 32 * KROW + ks_ * 16); \
            S0 = __builtin_amdgcn_mfma_f32_32x32x16_bf16(k0_, qf[ks_], S0, 0, 0, 0); S1 = __builtin_amdgcn_mfma_f32_32x32x16_bf16(k1_, qf[ks_], S1, 0, 0, 0); } } while (0)
    const int krow = swap23(qi);
    ATT_LOADK(0); ATT_LOADV(0); ATT_STOREK(0); ATT_STOREV(0); ATT_LOADK(1); ATT_STOREK(1); __syncthreads();
    f32x16 s0, s1, n0, n1;
    ATT_QK(s0, s1, 0);
    for (int t = 0; t < NT; ++t) {
        const bool has1 = t + 1 < NT, has2 = t + 2 < NT;
        if (has2) ATT_LOADK(t + 2);
        if (has1) ATT_LOADV(t + 1);
        if (has1) ATT_QK(n0, n1, (t + 1) & 1);
        const LAS bf16_t* vb = Vs + (t & 1) * 128 * VROW + qi * VROW + hi * 8;
        float mx = fmaxf(s0[0], s1[0]);
#pragma unroll
        for (int r = 1; r < 16; ++r) mx = fmaxf(mx, fmaxf(s0[r], s1[r]));
        mx = fmaxf(mx, __shfl_xor(mx, 32));
        if (__any(mx > m_run + 8.f)) {
            const float m_new = fmaxf(m_run, mx), alpha = ex2(m_run - m_new); m_run = m_new; l_run *= alpha;
#pragma unroll
            for (int d0 = 0; d0 < 4; ++d0)
#pragma unroll
                for (int r = 0; r < 16; ++r) o[d0][r] *= alpha;
        }
        float ps = 0.f;
#pragma unroll
        for (int r = 0; r < 16; ++r) { s0[r] = ex2(s0[r] - m_run); s1[r] = ex2(s1[r] - m_run); ps += s0[r] + s1[r]; }
        l_run += ps;
        u32x4 pw[4];
#pragma unroll
        for (int i = 0; i < 4; ++i) { pw[0][i] = pk2(s0[2 * i], s0[2 * i + 1]); pw[1][i] = pk2(s0[8 + 2 * i], s0[8 + 2 * i + 1]); pw[2][i] = pk2(s1[2 * i], s1[2 * i + 1]); pw[3][i] = pk2(s1[8 + 2 * i], s1[8 + 2 * i + 1]); }
#pragma unroll
        for (int sp = 0; sp < 4; ++sp) { const bf16x8 pf = __builtin_bit_cast(bf16x8, pw[sp]);
#pragma unroll
            for (int d0 = 0; d0 < 4; ++d0) { const bf16x8 vf = *(const LAS bf16x8*)(vb + 32 * d0 * VROW + sp * 16); o[d0] = __builtin_amdgcn_mfma_f32_32x32x16_bf16(vf, pf, o[d0], 0, 0, 0); } }
        if (has2) ATT_STOREK(t & 1);
        if (has1) ATT_STOREV((t + 1) & 1);
        __syncthreads();
        s0 = n0; s1 = n1;
    }
#undef ATT_LOADK
#undef ATT_LOADV
#undef ATT_STOREK
#undef ATT_STOREV
#undef ATT_QK
    const float l = l_run + __shfl_xor(l_run, 32), inv = 1.f / l;
    bf16_t* op = O + (size_t)(q0 + wid * 32 + qi) * ldo + 4 * hi;
#pragma unroll
    for (int d0 = 0; d0 < 4; ++d0)
#pragma unroll
        for (int g = 0; g < 4; ++g) { u32x2 w; w.x = pk2(o[d0][4 * g] * inv, o[d0][4 * g + 1] * inv); w.y = pk2(o[d0][4 * g + 2] * inv, o[d0][4 * g + 3] * inv); *(u32x2*)(op + 32 * d0 + 8 * g) = w; }
}

__device__ __forceinline__ void glds16(const void* gsrc, unsigned lds_dst) { unsigned keep;
    asm volatile("s_mov_b32 %0, m0\n\ts_mov_b32 m0, %2\n\ts_nop 0\n\tglobal_load_lds_dwordx4 %1, off\n\ts_mov_b32 m0, %0" : "=&s"(keep) : "v"(gsrc), "s"(lds_dst) : "memory"); }
template <int DQK>
__device__ __forceinline__ void attn_unit_dma(const bf16_t* __restrict__ Q, int ldq, const bf16_t* __restrict__ K, int ldk, const bf16_t* __restrict__ Vt, bf16_t* O, int ldo, int q0, int nkeys, LAS unsigned char* lds) {
    constexpr int KS = DQK / 16, KROW = DQK + 8, KCH = DQK / 8, VROW = 72, KSL = KCH + 1, KCHUNKS = KSL, VCHUNKS = 18, NJ = (KCHUNKS + VCHUNKS + NWV - 1) / NWV;
    constexpr int KBYTES = KCHUNKS * 1024, VBYTES = VCHUNKS * 1024, SLOT = KBYTES + VBYTES, DUMMY = 3 * SLOT;
    static_assert(KROW * 2 == KSL * 16 && 64 * KROW * 2 == KBYTES && 128 * VROW * 2 == VBYTES && DUMMY + 1024 <= LDS_BYTES - 16, "attention LDS image");
    int tid_ = threadIdx.x; asm volatile("" : "+v"(tid_));
    const int tid = tid_, lane = tid & 63, wid = tid >> 6, qi = lane & 31, hi = lane >> 5;
    const int widu = __builtin_amdgcn_readfirstlane(wid);
    const unsigned lds0 = (unsigned)(size_t)lds;
    const bf16_t* gsrc[NJ]; int tstep[NJ]; unsigned loff[NJ], lmul[NJ];
#pragma unroll
    for (int j = 0; j < NJ; ++j) { const int c = j * NWV + widu;
        if (c < KCHUNKS) { const int sl = c * 64 + lane, r = sl / KSL, cc = sl - r * KSL; gsrc[j] = K + (size_t)r * ldk + (cc == KCH ? 0 : cc) * 8; tstep[j] = 64 * ldk; loff[j] = c * 1024; lmul[j] = SLOT; }
        else if (c < KCHUNKS + VCHUNKS) { const int sl = (c - KCHUNKS) * 64 + lane, r = sl / 9, cc = sl - r * 9; gsrc[j] = Vt + (size_t)r * T + (cc == 8 ? 0 : cc) * 8; tstep[j] = 64; loff[j] = KBYTES + (c - KCHUNKS) * 1024; lmul[j] = SLOT; }
        else { gsrc[j] = K; tstep[j] = 0; loff[j] = DUMMY; lmul[j] = 0; } }
    constexpr int NLAST = KCHUNKS + VCHUNKS - (NJ - 1) * NWV;
    const bool has_last = widu < NLAST;
#define AD_DMA(t, slot) do { _Pragma("unroll") for (int j_ = 0; j_ < NJ; ++j_) if (j_ < NJ - 1 || has_last) glds16(gsrc[j_] + (size_t)(t) * tstep[j_], lds0 + (unsigned)(slot) * lmul[j_] + loff[j_]); } while (0)
    bf16x8 qf[KS];
    { const bf16_t* qp = Q + (size_t)(q0 + wid * 32 + qi) * ldq + hi * 8;
#pragma unroll
      for (int ks = 0; ks < KS; ++ks) qf[ks] = *(const bf16x8*)(qp + ks * 16); }
    f32x16 o[4];
#pragma unroll
    for (int d0 = 0; d0 < 4; ++d0)
#pragma unroll
        for (int r = 0; r < 16; ++r) o[d0][r] = 0.f;
    float l_run = 0.f;
    f32x16 negm;
#pragma unroll
    for (int r = 0; r < 16; ++r) negm[r] = 0.f;
    const int NT = nkeys / 64;
    const int krow = swap23(qi);
    AD_DMA(0, 0); AD_DMA(1, 1);
    asm volatile("s_waitcnt vmcnt(0) lgkmcnt(0)" ::: "memory"); __builtin_amdgcn_s_barrier(); asm volatile("" ::: "memory");
    int slot = 0, slot2 = 2;
    for (int t = 0; t < NT; ++t) {
        if (t + 2 < NT) AD_DMA(t + 2, slot2);
        const LAS bf16_t* kb = (const LAS bf16_t*)(lds + slot * SLOT) + krow * KROW + hi * 8; const LAS bf16_t* vb = (const LAS bf16_t*)(lds + slot * SLOT + KBYTES) + qi * VROW + hi * 8;
        f32x16 s0, s1;
        { const bf16x8 k0 = *(const LAS bf16x8*)(kb), k1 = *(const LAS bf16x8*)(kb + 32 * KROW);
          s0 = __builtin_amdgcn_mfma_f32_32x32x16_bf16(k0, qf[0], negm, 0, 0, 0); s1 = __builtin_amdgcn_mfma_f32_32x32x16_bf16(k1, qf[0], negm, 0, 0, 0); }
#pragma unroll
        for (int ks = 1; ks < KS; ++ks) { const bf16x8 k0 = *(const LAS bf16x8*)(kb + ks * 16), k1 = *(const LAS bf16x8*)(kb + 32 * KROW + ks * 16);
            s0 = __builtin_amdgcn_mfma_f32_32x32x16_bf16(k0, qf[ks], s0, 0, 0, 0); s1 = __builtin_amdgcn_mfma_f32_32x32x16_bf16(k1, qf[ks], s1, 0, 0, 0); }
        float mx = fmaxf(s0[0], s1[0]);
#pragma unroll
        for (int r = 1; r < 16; ++r) mx = max3f(mx, s0[r], s1[r]);
        mx = fmaxf(mx, __shfl_xor(mx, 32));
        if (t == 0 || __any(mx > 8.f)) {
            const float delta = t == 0 ? mx : fmaxf(mx, 0.f), alpha = t == 0 ? 1.f : ex2(-delta); l_run *= alpha;
#pragma unroll
            for (int r = 0; r < 16; ++r) { negm[r] -= delta; s0[r] -= delta; s1[r] -= delta; }
#pragma unroll
            for (int d0 = 0; d0 < 4; ++d0)
#pragma unroll
                for (int r = 0; r < 16; ++r) o[d0][r] *= alpha;
        }
        f32x2_t ps2 = {0.f, 0.f};
        u32x4 pw[4];
#pragma unroll
        for (int i = 0; i < 8; ++i) { f32x2_t e = (f32x2_t){s0[2 * i], s0[2 * i + 1]}, f = (f32x2_t){s1[2 * i], s1[2 * i + 1]}; e[0] = ex2(e[0]); e[1] = ex2(e[1]); f[0] = ex2(f[0]); f[1] = ex2(f[1]);
            ps2 = ps2 + e; ps2 = ps2 + f; pw[i >> 2][i & 3] = pk2(e[0], e[1]); pw[2 + (i >> 2)][i & 3] = pk2(f[0], f[1]); }
        l_run += ps2[0] + ps2[1];
#pragma unroll
        for (int sp = 0; sp < 4; ++sp) { const bf16x8 pf = __builtin_bit_cast(bf16x8, pw[sp]);
#pragma unroll
            for (int d0 = 0; d0 < 4; ++d0) { const bf16x8 vf = *(const LAS bf16x8*)(vb + 32 * d0 * VROW + sp * 16); o[d0] = __builtin_amdgcn_mfma_f32_32x32x16_bf16(vf, pf, o[d0], 0, 0, 0); } }
        if (t + 2 >= NT) asm volatile("s_waitcnt vmcnt(0) lgkmcnt(0)" ::: "memory"); else if (has_last) asm volatile("s_waitcnt vmcnt(%0) lgkmcnt(0)" :: "n"(NJ) : "memory"); else asm volatile("s_waitcnt vmcnt(%0) lgkmcnt(0)" :: "n"(NJ - 1) : "memory");
        __builtin_amdgcn_s_barrier(); asm volatile("" ::: "memory");
        slot2 = slot; slot = slot == 2 ? 0 : slot + 1;
    }
#undef AD_DMA
    const float l = l_run + __shfl_xor(l_run, 32), inv = 1.f / l;
    bf16_t* op = O + (size_t)(q0 + wid * 32 + qi) * ldo + 4 * hi;
#pragma unroll
    for (int d0 = 0; d0 < 4; ++d0)
#pragma unroll
        for (int g = 0; g < 4; ++g) { u32x2 w; w.x = pk2(o[d0][4 * g] * inv, o[d0][4 * g + 1] * inv); w.y = pk2(o[d0][4 * g + 2] * inv, o[d0][4 * g + 3] * inv); *(u32x2*)(op + 32 * d0 + 8 * g) = w; }
}

__device__ __forceinline__ void attn_unit_da(const bf16_t* __restrict__ Q, const bf16_t* __restrict__ K, const bf16_t* __restrict__ Vt, bf16_t* O, int q0, int nkeys, LAS unsigned char* lds) {
    constexpr int KROW = 72, VROW = 72, LDQ = 512, LDO = 1024;
    LAS bf16_t* Ks = (LAS bf16_t*)lds; LAS bf16_t* Vs = (LAS bf16_t*)(lds + 2 * 64 * KROW * 2);
    int tid_ = threadIdx.x; asm volatile("" : "+v"(tid_));
    const int tid = tid_, lane = tid & 63, wid = tid >> 6, qi = lane & 31, hi = lane >> 5, qg = wid >> 1, kh = wid & 1;
    bf16x8 qf[2][4];
#pragma unroll
    for (int qs = 0; qs < 2; ++qs) { const bf16_t* qp = Q + (size_t)(q0 + qg * 64 + qs * 32 + qi) * LDQ + hi * 8;
#pragma unroll
        for (int ks = 0; ks < 4; ++ks) qf[qs][ks] = *(const bf16x8*)(qp + ks * 16); }
    f32x16 o[2][4];
#pragma unroll
    for (int qs = 0; qs < 2; ++qs)
#pragma unroll
        for (int d0 = 0; d0 < 4; ++d0)
#pragma unroll
            for (int r = 0; r < 16; ++r) o[qs][d0][r] = 0.f;
    float m_run[2] = {-1e30f, -1e30f}, l_run[2] = {0.f, 0.f};
    const int NT = nkeys / 64;
    u32x4 kreg, vreg[2];
#define DA_LOADG(t) do { { const int r_ = tid >> 3, cc_ = tid & 7; kreg = *(const u32x4*)(K + (size_t)((t) * 64 + r_) * 512 + cc_ * 8); } \
        _Pragma("unroll") for (int i_ = 0; i_ < 2; ++i_) { const int c_ = tid + NTHR * i_, dv_ = c_ >> 3, k8_ = c_ & 7; vreg[i_] = *(const u32x4*)(Vt + (size_t)dv_ * T + (t) * 64 + k8_ * 8); } } while (0)
#define DA_STOREL(b) do { { const int r_ = tid >> 3, cc_ = tid & 7; *(LAS u32x4*)(Ks + (b) * 64 * KROW + r_ * KROW + cc_ * 8) = kreg; } \
        _Pragma("unroll") for (int i_ = 0; i_ < 2; ++i_) { const int c_ = tid + NTHR * i_, dv_ = c_ >> 3, k8_ = c_ & 7; *(LAS u32x4*)(Vs + (b) * 128 * VROW + dv_ * VROW + k8_ * 8) = vreg[i_]; } } while (0)
    DA_LOADG(0); DA_STOREL(0); __syncthreads();
    const int krow = 32 * kh + swap23(qi);
    for (int t = 0; t < NT; ++t) {
        const int buf = t & 1;
        if (t + 1 < NT) DA_LOADG(t + 1);
        const LAS bf16_t* kb = Ks + buf * 64 * KROW + krow * KROW + hi * 8; const LAS bf16_t* vb = Vs + buf * 128 * VROW + qi * VROW + 32 * kh + hi * 8;
        f32x16 sc[2];
#pragma unroll
        for (int r = 0; r < 16; ++r) { sc[0][r] = 0.f; sc[1][r] = 0.f; }
#pragma unroll
        for (int ks = 0; ks < 4; ++ks) { const bf16x8 kf = *(const LAS bf16x8*)(kb + ks * 16);
            sc[0] = __builtin_amdgcn_mfma_f32_32x32x16_bf16(kf, qf[0][ks], sc[0], 0, 0, 0); sc[1] = __builtin_amdgcn_mfma_f32_32x32x16_bf16(kf, qf[1][ks], sc[1], 0, 0, 0); }
        u32x4 pw[2][2];
#pragma unroll
        for (int qs = 0; qs < 2; ++qs) {
            float mx = max3f(sc[qs][0], sc[qs][1], sc[qs][2]);
#pragma unroll
            for (int r = 3; r < 15; r += 2) mx = max3f(mx, sc[qs][r], sc[qs][r + 1]);
            mx = fmaxf(mx, sc[qs][15]);
            mx = fmaxf(mx, __shfl_xor(mx, 32));
            if (__any(mx > m_run[qs] + 8.f)) {
                const float m_new = fmaxf(m_run[qs], mx), alpha = ex2(m_run[qs] - m_new); m_run[qs] = m_new; l_run[qs] *= alpha;
#pragma unroll
                for (int d0 = 0; d0 < 4; ++d0)
#pragma unroll
                    for (int r = 0; r < 16; ++r) o[qs][d0][r] *= alpha;
            }
            float ps = 0.f;
#pragma unroll
            for (int r = 0; r < 16; ++r) { sc[qs][r] = ex2(sc[qs][r] - m_run[qs]); ps += sc[qs][r]; }
            l_run[qs] += ps;
#pragma unroll
            for (int i = 0; i < 4; ++i) { pw[qs][0][i] = pk2(sc[qs][2 * i], sc[qs][2 * i + 1]); pw[qs][1][i] = pk2(sc[qs][8 + 2 * i], sc[qs][8 + 2 * i + 1]); }
        }
#pragma unroll
        for (int sp = 0; sp < 2; ++sp)
#pragma unroll
            for (int d0 = 0; d0 < 4; ++d0) { const bf16x8 vf = *(const LAS bf16x8*)(vb + 32 * d0 * VROW + sp * 16);
                o[0][d0] = __builtin_amdgcn_mfma_f32_32x32x16_bf16(vf, __builtin_bit_cast(bf16x8, pw[0][sp]), o[0][d0], 0, 0, 0);
                o[1][d0] = __builtin_amdgcn_mfma_f32_32x32x16_bf16(vf, __builtin_bit_cast(bf16x8, pw[1][sp]), o[1][d0], 0, 0, 0); }
        if (t + 1 < NT) DA_STOREL(buf ^ 1);
        __syncthreads();
    }
#undef DA_LOADG
#undef DA_STOREL
    LAS float* xp = (LAS float*)lds + (size_t)qg * (130 * 64) + lane;
#pragma unroll
    for (int qs = 0; qs < 2; ++qs) {
        const float lt = l_run[qs] + __shfl_xor(l_run[qs], 32);
        if (kh == 1) { xp[128 * 64] = m_run[qs]; xp[129 * 64] = lt;
#pragma unroll
            for (int d0 = 0; d0 < 4; ++d0)
#pragma unroll
                for (int r = 0; r < 16; ++r) xp[(d0 * 16 + r) * 64] = o[qs][d0][r]; }
        __syncthreads();
        if (kh == 0) { const float mb = xp[128 * 64], lb = xp[129 * 64];
            const float m = fmaxf(m_run[qs], mb), fa = ex2(m_run[qs] - m), fb = ex2(mb - m), inv = 1.f / (lt * fa + lb * fb), ca = fa * inv, cb = fb * inv;
            bf16_t* op = O + (size_t)(q0 + qg * 64 + qs * 32 + qi) * LDO + 4 * hi;
#pragma unroll
            for (int d0 = 0; d0 < 4; ++d0)
#pragma unroll
                for (int g = 0; g < 4; ++g) { float v[4];
#pragma unroll
                    for (int j = 0; j < 4; ++j) v[j] = o[qs][d0][4 * g + j] * ca + xp[(d0 * 16 + 4 * g + j) * 64] * cb;
                    u32x2 w; w.x = pk2(v[0], v[1]); w.y = pk2(v[2], v[3]); *(u32x2*)(op + 32 * d0 + 8 * g) = w; } }
        __syncthreads();
    }
}

#define XB_TMO      128
#define XB_XCNT(j)  (256  + 64 * (j))
#define XB_XSUB(j)  (1280 + 64 * (j))
#define XB_XGEN(j)  (2304 + 64 * (j))
#define XB_TOP      3328
#define XB_TOPGEN   3392
#define XCD_BAR_WORDS 3456
#define XB_SPIN_CAP (1u << 18)

__device__ __forceinline__ unsigned xb_ld(unsigned* p)              { return __hip_atomic_load(p, __ATOMIC_RELAXED, __HIP_MEMORY_SCOPE_AGENT); }
__device__ __forceinline__ unsigned xb_add(unsigned* p, unsigned v) { return __hip_atomic_fetch_add(p, v, __ATOMIC_RELAXED, __HIP_MEMORY_SCOPE_AGENT); }
__device__ __forceinline__ unsigned xb_xcc_id() { return (unsigned)__builtin_amdgcn_s_getreg((3 << 11) | 20) & 0xFu; }
#define XB_SPIN(cond, bar) do { unsigned _sp = 0; while (cond) { __builtin_amdgcn_s_sleep(1); \
    if ((++_sp & 255u) == 0u) { if (xb_ld(&(bar)[XB_TMO])) break; if (_sp > XB_SPIN_CAP) { atomicAdd(&(bar)[XB_TMO], 1u); break; } } } } while (0)

struct XcdBarrier {
    unsigned* bar; unsigned x;
    volatile LAS unsigned* st;
};

__device__ __forceinline__ XcdBarrier xcd_barrier_post(unsigned* bar, volatile LAS unsigned* st) {
    XcdBarrier b; b.bar = bar; b.x = xb_xcc_id(); b.st = st;
    if (threadIdx.x == 0) (void)xb_add(&bar[XB_XCNT(b.x)], 1u);
    return b;
}
__device__ __forceinline__ void xcd_barrier_complete(unsigned* bar, unsigned x, unsigned& nloc, unsigned& nx) {
    const unsigned G = gridDim.x * gridDim.y * gridDim.z;
    unsigned sum, cnt, mine, sp = 0u;
    for (;;) {
        sum = 0u; cnt = 0u; mine = 0u;
#pragma unroll
        for (unsigned j = 0; j < 16; ++j) { const unsigned c = xb_ld(&bar[XB_XCNT(j)]); sum += c; cnt += (c > 0u) ? 1u : 0u; mine = (j == x) ? c : mine; }
        if (sum == G) break;
        __builtin_amdgcn_s_sleep(1);
        if ((++sp & 255u) == 0u) { if (xb_ld(&bar[XB_TMO])) break; if (sp > XB_SPIN_CAP) { atomicAdd(&bar[XB_TMO], 1u); break; } }
    }
    nloc = mine > 0u ? mine : 1u; nx = cnt > 0u ? cnt : 1u;
}

__device__ __forceinline__ void xcd_barrier(const XcdBarrier& b) {
    asm volatile("s_waitcnt vmcnt(0)" ::: "memory");
    __syncthreads();
    if (threadIdx.x == 0) {
        unsigned* bar = b.bar;
        __builtin_amdgcn_s_waitcnt(0);
        unsigned nloc = b.st[0], nx = b.st[1];
        if (nloc == 0u) { xcd_barrier_complete(bar, b.x, nloc, nx); b.st[0] = nloc; b.st[1] = nx; }
        const unsigned old = xb_add(&bar[XB_XSUB(b.x)], 1u);
        const unsigned gen = old / nloc;
        if (old + 1u == (gen + 1u) * nloc) {
            __builtin_amdgcn_fence(__ATOMIC_RELEASE, "agent");
            asm volatile("s_waitcnt vmcnt(0)" ::: "memory");
            const unsigned og = xb_add(&bar[XB_TOP], 1u);
            const unsigned tg = og / nx;
            if (og + 1u == (tg + 1u) * nx) xb_add(&bar[XB_TOPGEN], 1u);
            else XB_SPIN(xb_ld(&bar[XB_TOPGEN]) == tg, bar);
            __builtin_amdgcn_fence(__ATOMIC_ACQUIRE, "agent");
            xb_add(&bar[XB_XGEN(b.x)], 1u);
            asm volatile("s_waitcnt vmcnt(0)" ::: "memory");
        } else {
            XB_SPIN(xb_ld(&bar[XB_XGEN(b.x)]) == gen, bar);
            __builtin_amdgcn_fence(__ATOMIC_ACQUIRE, "agent");
            asm volatile("s_waitcnt vmcnt(0)" ::: "memory");
        }
    }
    __syncthreads();
}

#define GAS __attribute__((address_space(1)))
#define PIN(i) ((const float*)(const GAS float*)pp->in[i])
#define F1T ((bf16_t*)(ws + O_F1T))
#define F2T ((bf16_t*)(ws + O_F2T))
#define ROPE ((float*)(ws + O_ROPE))
#define C8T ((float*)(ws + O_C8))
#define MODS ((float*)(ws + O_MODS))
#define XMOD ((bf16_t*)(ws + O_XMOD))
#define XRES ((float*)(ws + O_XRES))
#define QDA ((bf16_t*)(ws + O_QDA))
#define KDA ((bf16_t*)(ws + O_KDA))
#define VTDA ((bf16_t*)(ws + O_VTDA))
#define LRUX ((bf16_t*)(ws + O_LRUX))
#define LRUG ((bf16_t*)(ws + O_LRUG))
#define CQ ((bf16_t*)(ws + O_CQ))
#define CKV ((bf16_t*)(ws + O_CKV))
#define PARTQ ((float*)(ws + O_PARTQ))
#define PARTKV ((float*)(ws + O_PARTKV))
#define QMLA ((bf16_t*)(ws + O_QMLA))
#define KMLA ((bf16_t*)(ws + O_KMLA))
#define VTMLA ((bf16_t*)(ws + O_VTMLA))
#define FX ((bf16_t*)(ws + O_FX))
#define FT ((bf16_t*)(ws + O_FT))
#define CTXW ((float*)(ws + O_CTXW))
#define XC ((bf16_t*)(ws + O_XC))
#define AU ((unsigned*)(ws + O_AU))
#define SUMM ((float*)(ws + O_SUMM))
#define DAO ((bf16_t*)(ws + O_DAO))
#define HB ((bf16_t*)(ws + O_H))
#define WIN ((bf16_t*)(wl + O_WIN))
#define WOUT ((bf16_t*)(wl + O_WOUT))
#define WGU ((bf16_t*)(wl + O_WGU))
#define WD ((bf16_t*)(wl + O_WD))
#define WUQ ((bf16_t*)(wl + O_WUQ))
#define WUKV ((bf16_t*)(wl + O_WUKV))
#define WLRU ((bf16_t*)(wl + O_WLRU))
#define MIX XMOD
#define mods_c (MODS + (size_t)(l * 2 + 0) * 12288)
#define mods_l (MODS + (size_t)(l * 2 + 1) * 12288)
__device__ __forceinline__ int chunk_start(int c) { if (c <= 4) return 64 * c; const int cl = c - 4; return NCTX + 65 * cl + (cl < 4 ? cl : 4); }
constexpr int N_PHASES = 22;
template <unsigned MASK>
__global__ void __launch_bounds__(NTHR, 2) mega_fwd(Params P) {
    extern __shared__ __attribute__((aligned(16))) unsigned char lds_raw[];
    LAS unsigned char* lds = (LAS unsigned char*)lds_raw;
    const int tid0 = threadIdx.x;
    const int G0 = gridDim.x, bid0 = blockIdx.x;
    cg::grid_group grid = cg::this_grid();
    volatile LAS unsigned* bst = (volatile LAS unsigned*)(lds + LDS_BYTES - 16);
    if (tid0 < 4) bst[tid0] = 0u;
    __syncthreads();
    XcdBarrier xbar = xcd_barrier_post((unsigned*)(P.ws + O_BAR), bst);

    for (int ph = P.ph_lo; ph < P.ph_hi; ++ph) {
        const __attribute__((address_space(4))) Params* pp = (const __attribute__((address_space(4))) Params*)__builtin_amdgcn_kernarg_segment_ptr(); asm volatile("" : "+s"(pp));
        int tid = tid0; asm volatile("" : "+v"(tid));
        int G = G0, bid = bid0; asm volatile("" : "+s"(G), "+s"(bid));
        const int NGW = G * NWV, NT_ALL = G * NTHR;
        const int lane = tid & 63, wid = __builtin_amdgcn_readfirstlane(tid >> 6), gw = bid * NWV + wid, gtid = bid * NTHR + tid;
        GAS unsigned char* ws = (GAS unsigned char*)pp->ws; asm volatile("" : "+s"(ws));
        const int l = ph >= 2 ? (ph - 2) / 10 : 0, sub = ph >= 2 ? (ph - 2) % 10 : -1;
        GAS unsigned char* wl = ws + (size_t)l * SZ_WLAYER;
        if (EN(0) && ph == 0) {
            for (int rp_ = 0; rp_ < DUP_P0; ++rp_) {
            for (int it = bid; it < 256; it += G) {
                const int ll = it >> 7, g = (it >> 5) & 3, kb = it & 31, k0 = 64 * kb;
                LAS float* wt = (LAS float*)lds; LAS float* tab = wt + 128 * 68;
                const float* wsrc = PIN(I_WIN) + (size_t)ll * DM * INW;
                for (int i = 0; i < 16; ++i) { const int e = tid + NTHR * i, kk = e >> 7, c = e & 127; wt[c * 68 + kk] = wsrc[(size_t)(k0 + kk) * INW + 3264 + 128 * g + c]; }
                if (tid < 128) tab[tid] = cospif((float)tid * (1.f / 64.f)) * RSQ128;
                __syncthreads();
                const int col = tid & 255, part = col >> 7, jj = col & 127, kh = tid >> 8; const int ph0 = part ? 96 : 0;
                bf16_t* dst = (bf16_t*)(ws + (size_t)ll * SZ_WLAYER + O_WIN) + (size_t)((13 + g) * 256 + col) * DM + k0 + 32 * kh;
                f32x4 a[8];
#pragma unroll
                for (int q = 0; q < 8; ++q) a[q] = (f32x4){0.f, 0.f, 0.f, 0.f};
                for (int c = 0; c < 128; ++c) { const float tv = tab[(jj * c + ph0) & 127]; const LAS f32x4* wr4 = (const LAS f32x4*)(wt + c * 68 + 32 * kh);
#pragma unroll
                    for (int q = 0; q < 8; ++q) a[q] += wr4[q] * tv; }
                const float sg = part ? -1.f : 1.f;
#pragma unroll
                for (int q = 0; q < 4; ++q) { u32x4 o; o.x = pk2(a[2 * q][0] * sg, a[2 * q][1] * sg); o.y = pk2(a[2 * q][2] * sg, a[2 * q][3] * sg); o.z = pk2(a[2 * q + 1][0] * sg, a[2 * q + 1][1] * sg); o.w = pk2(a[2 * q + 1][2] * sg, a[2 * q + 1][3] * sg);
                    *(u32x4*)(dst + 8 * q) = o; }
                __syncthreads();
            }
            for (int it = bid; it < 192; it += G) {
                const int ll = it / 96, nc = it % 96;
                LAS float* sv = (LAS float*)lds; LAS float* red = sv + 2 * DM;
                for (int i = tid; i < DM; i += NTHR) { sv[i] = siluf(PIN(I_CCTX)[i]); sv[DM + i] = siluf(PIN(I_C)[i]); }
                __syncthreads();
                const float* wp = PIN(I_WADA) + (size_t)ll * DM * 12288 + 128 * nc + 2 * lane;
                float a00 = 0.f, a01 = 0.f, a10 = 0.f, a11 = 0.f;
                for (int k0 = 256 * wid; k0 < 256 * wid + 256; k0 += 16) { f32x2_t w2[16];
#pragma unroll
                    for (int j = 0; j < 16; ++j) w2[j] = *(const f32x2_t*)(wp + (size_t)(k0 + j) * 12288);
#pragma unroll
                    for (int j = 0; j < 16; ++j) { const float s0 = sv[k0 + j], s1 = sv[DM + k0 + j]; a00 += s0 * w2[j][0]; a01 += s0 * w2[j][1]; a10 += s1 * w2[j][0]; a11 += s1 * w2[j][1]; } }
                red[(wid * 2 + 0) * 128 + 2 * lane] = a00; red[(wid * 2 + 0) * 128 + 2 * lane + 1] = a01; red[(wid * 2 + 1) * 128 + 2 * lane] = a10; red[(wid * 2 + 1) * 128 + 2 * lane + 1] = a11;
                __syncthreads();
                if (tid < 256) { const int v = tid >> 7, cc = tid & 127; float s = PIN(I_BADA)[(size_t)ll * 12288 + 128 * nc + cc];
                    for (int w = 0; w < 8; ++w) s += red[(w * 2 + v) * 128 + cc];
                    MODS[(size_t)(ll * 2 + v) * 12288 + 128 * nc + cc] = s; }
                __syncthreads();
            }
            for (int i = gtid; i < 4096; i += NT_ALL) { const int pos = i >> 4, f = i & 15; const float x = ((float)pos * INVF[f]) * 0.3183098861837907f; ROPE[2 * i] = cospif(x); ROPE[2 * i + 1] = sinpif(x); }
            for (int i = gtid; i < 65536; i += NT_ALL) { const int cp = i >> 8, kk = i & 255, part = kk >> 7, nn = kk & 127;
                const int n = (cp >> 4) & 1, k1 = 64 * (cp >> 7) + 16 * ((cp >> 5) & 3) + (cp & 15); const float ang = (float)((k1 * nn) & 127) * (1.f / 64.f); const float cv = cospif(ang) * RSQ128, sv = sinpif(ang) * RSQ128;
                F1T[i] = f2bf(n == 0 ? (part == 0 ? cv : sv) : (part == 0 ? -sv : cv)); }
            for (int i = gtid; i < 128 * 65536; i += NT_ALL) { const int k1 = i >> 16, cp = (i >> 8) & 255, kk = i & 255, part = kk >> 7, nn = kk & 127;
                float v = 0.f; if (cp < 128) { const float ang = (float)((nn * (k1 + 128 * cp)) & 16383) * (1.f / 8192.f); v = (part == 0 ? cospif(ang) : sinpif(ang)) * RSQ128; } F2T[i] = f2bf(v); }
            for (int i = gtid; i < 2048; i += NT_ALL) C8T[i] = -8.f * log1pf(__expf(-PIN(I_LLAM)[i]));
            LAS float* scr = (LAS float*)(lds + wid * 8704);
            for (int ll = 0; ll < 2; ++ll) {
                GAS unsigned char* wd = ws + (size_t)ll * SZ_WLAYER;
                tr_job(MapWin{PIN(I_WIN) + (size_t)ll * DM * INW, INW}, DM, 13 * 256, (bf16_t*)(wd + O_WIN), nullptr, scr, gw, NGW, lane);
                tr_job(MapPlain{PIN(I_WOUT) + (size_t)ll * DM * DM, DM}, DM, DM, (bf16_t*)(wd + O_WOUT), nullptr, scr, gw, NGW, lane);
                tr_job(MapGU{PIN(I_WG) + (size_t)ll * DM * DFF, PIN(I_WU) + (size_t)ll * DM * DFF, DFF}, DM, 2 * DFF, (bf16_t*)(wd + O_WGU), nullptr, scr, gw, NGW, lane);
                tr_job(MapPlain{PIN(I_WD) + (size_t)ll * DFF * DM, DM}, DFF, DM, (bf16_t*)(wd + O_WD), nullptr, scr, gw, NGW, lane);
                tr_job(MapUq{PIN(I_WUQ) + (size_t)ll * 384 * 768, 768}, 384, 768, (bf16_t*)(wd + O_WUQ), PIN(I_QNG) + ll * 384, scr, gw, NGW, lane);
                tr_job(MapUkv{PIN(I_WUKV) + (size_t)ll * 256 * 1024, 1024}, 256, 1024, (bf16_t*)(wd + O_WUKV), PIN(I_KVNG) + ll * 256, scr, gw, NGW, lane);
                for (int hd = 0; hd < 8; ++hd) { const int h = hd >> 1, d = hd & 1; const size_t wo = ((size_t)(ll * 2 + d) * 4 + h) * 16384;
                    tr_job(MapLru{PIN(I_LWR) + wo, PIN(I_LWI) + wo, 128}, 128, 256, (bf16_t*)(wd + O_WLRU) + (size_t)hd * 256 * 128, nullptr, scr, gw, NGW, lane); }
            }
            __syncthreads(); }
        } else if (EN(1) && ph == 1) {
            for (int row = gw; row < T; row += NGW) { const float* xr = row < NCTX ? PIN(I_CTX) + (size_t)row * DM : PIN(I_X) + (size_t)(row - NCTX) * DM; const float* md = MODS + (size_t)(row < NCTX ? 0 : 1) * 12288;
#pragma unroll
                for (int j = 0; j < 8; ++j) { const int c = 4 * lane + 256 * j; const f32x4 xv = *(const f32x4*)(xr + c), sh = *(const f32x4*)(md + c), sc = *(const f32x4*)(md + DM + c); st4bf(XMOD + (size_t)row * DM + c, xv * (sc + 1.f) + sh); if (row < NCTX) *(f32x4*)(XRES + (size_t)row * DM + c) = xv * ALPHA; } }
        } else if (EN(2) && sub == 0) {
            pg8::Gemm g{XMOD, WIN, T, NIN, DM}; pg8::StaticOrder S; S.init(T, NIN, G, bid);
            EpiInproj E{QDA, KDA, VTDA, LRUX, LRUG, CQ, CKV, KMLA, FX, CTXW, PARTQ, PARTKV, ROPE};
            for (int rg_ = 0; rg_ < DUP_GEMM; ++rg_) pg8::gemm_phase<EpiInproj, pg8::StaticOrder, true, true>(lds, g, S, E);
        } else if (EN(3) && sub == 1) {
            for (int rs_ = 0; rs_ < DUP_S1; ++rs_) {
            if (EN(11)) { const float* cw = PIN(I_CONVW) + (size_t)l * 4 * 512; const float* cbv = PIN(I_CONVB) + (size_t)l * 512;
              for (int idx = gtid; idx < T * 64; idx += NT_ALL) { const int row = idx >> 6, ch0 = (idx & 63) * 8; const int lo = row < NCTX ? 0 : NCTX, hi = row < NCTX ? NCTX : T;
                  float a[8];
#pragma unroll
                  for (int q = 0; q < 8; ++q) a[q] = cbv[ch0 + q];
#pragma unroll
                  for (int j = 0; j < 4; ++j) { const int r = row + j - 2; if (r >= lo && r < hi) { const u32x4 xw = *(const u32x4*)(LRUX + (size_t)r * 512 + ch0); const float* wj = cw + j * 512 + ch0;
#pragma unroll
                      for (int q = 0; q < 4; ++q) { a[2 * q] += wj[2 * q] * bf2f(xw[q] & 0xffffu); a[2 * q + 1] += wj[2 * q + 1] * bf2f(xw[q] >> 16); } } }
                  u32x4 o; o.x = pk2(a[0], a[1]); o.y = pk2(a[2], a[3]); o.z = pk2(a[4], a[5]); o.w = pk2(a[6], a[7]);
                  *(u32x4*)(XC + ((size_t)(ch0 >> 7) * T + row) * 128 + (ch0 & 127)) = o; } }
            if (EN(12)) { pg8::Gemm g{CQ, WUQ, T, 768, 384}; pg8::StaticOrder S; S.init(T, 768, G, bid); EpiUpq E{QMLA, PARTQ, ROPE}; pg8::gemm_phase<EpiUpq, pg8::StaticOrder, true, true>(lds, g, S, E); }
            if (EN(13)) { pg8::Gemm g{CKV, WUKV, T, 1024, 256}; pg8::StaticOrder S; S.init(T, 1024, G, (bid + G - 195 % G) % G);     EpiUpkv E{KMLA, VTMLA, PARTKV}; pg8::gemm_phase<EpiUpkv, pg8::StaticOrder, true, true>(lds, g, S, E); }
            if (EN(14)) { pg8::Gemm g{FX, F1T, 65536, 256, 256}; pg8::StaticOrder S; S.init(65536, 256, G, bid); EpiFftA E{FT}; pg8::gemm_phase<EpiFftA, pg8::StaticOrder, true, true>(lds, g, S, E); }
            __syncthreads();
            if (EN(15)) for (int k = bid; k < 256; k += G) {
                LAS float* tab = (LAS float*)lds; LAS float* red = tab + 256; if (tid < 256) tab[tid] = cospif((float)tid * (1.f / 128.f)) * 0.0625f; __syncthreads();
                const float* wp = CTXW + (lane >> 4) * 256 + (lane & 15) * 8; f32x4 a0 = {0.f, 0.f, 0.f, 0.f}, a1 = a0;
                for (int n0 = 32 * wid; n0 < 32 * wid + 32; n0 += 8) { f32x4 xr[8][2], xi[8][2];
#pragma unroll
                    for (int j = 0; j < 8; ++j) { const float* p = wp + (size_t)(n0 + j) * 1024; xr[j][0] = *(const f32x4*)p; xr[j][1] = *(const f32x4*)(p + 4); xi[j][0] = *(const f32x4*)(p + 128); xi[j][1] = *(const f32x4*)(p + 132); }
#pragma unroll
                    for (int j = 0; j < 8; ++j) { const int mm = (k * (n0 + j)) & 255; const float cv = tab[mm], sv = tab[(mm + 192) & 255]; a0 += xr[j][0] * cv + xi[j][0] * sv; a1 += xr[j][1] * cv + xi[j][1] * sv; } }
                *(LAS f32x4*)(red + wid * 512 + lane * 8) = a0; *(LAS f32x4*)(red + wid * 512 + lane * 8 + 4) = a1;
                __syncthreads();
                { float t = 0.f;
#pragma unroll
                  for (int w = 0; w < 8; ++w) t += red[w * 512 + tid];
                  MIX[(size_t)k * DM + 1536 + tid] = f2bf(t); }
                __syncthreads(); }
            }
        } else if (EN(4) && sub == 2) {
            for (int rep_ = 0; rep_ < DUP_ATTN; ++rep_)
            if (EN(16)) for (int un = bid; un < 520; un += G) { const int hh = un < 512 ? (un & 7) : (un - 512), qb = un < 512 ? 1 + (un >> 3) : 0;
                attn_unit_da(QDA + hh * 64, KDA + hh * 64, VTDA + (size_t)(hh >> 1) * 128 * T, DAO + hh * 128, qb * 256, qb == 0 ? NCTX : T, lds); }
            for (int rs_ = 0; rs_ < DUP_S2; ++rs_) {
            if (EN(17)) { pg8::Gemm g{XC, WLRU, 4 * T, 2048, 128}; LruOrder S{G, bid}; EpiLru E{AU, XC, PIN(I_LBR) + (size_t)l * 1024, PIN(I_LBI) + (size_t)l * 1024, C8T + (size_t)l * 1024};
              pg8::gemm_phase<EpiLru, LruOrder, true, true>(lds, g, S, E); }
            if (EN(18)) { pg8::Gemm g{FT, F2T, 65536, 256, 256}; FftCOrder S{G, bid}; EpiFftC E{MIX}; pg8::gemm_phase<EpiFftC, FftCOrder, true, true>(lds, g, S, E); }
            }
        } else if (EN(5) && sub == 3) {
            for (int rep_ = 0; rep_ < DUP_ATTN; ++rep_)
            for (int un = bid; un < 260; un += G) { const int h = un < 256 ? (un & 3) : (un - 256), qb = un < 256 ? 1 + (un >> 2) : 0;
                if (MLA_DMA) attn_unit_dma<192>(QMLA + h * 192, 768, KMLA + h * 192, 768, VTMLA + (size_t)h * 128 * T, MIX + 1024 + h * 128, DM, qb * 256, qb == 0 ? NCTX : T, lds);
                else attn_unit<192>(QMLA + h * 192, 768, KMLA + h * 192, 768, VTMLA + (size_t)h * 128 * T, MIX + 1024 + h * 128, DM, qb * 256, qb == 0 ? NCTX : T, lds); }
            for (int rs_ = 0; rs_ < DUP_S3; ++rs_)
            for (int un = bid; un < 512; un += G) { const int d = un >> 8, c = un & 255; const int cs = chunk_start(c), len = chunk_start(c + 1) - cs;
                const unsigned* au = AU + (size_t)d * T * 512 + tid; float h = 0.f, S = 0.f;
                for (int i0 = 0; i0 < len; i0 += 16) { unsigned w[16];
#pragma unroll
                    for (int j = 0; j < 16; ++j) { const int i = i0 + j < len ? i0 + j : len - 1; const int row = d == 0 ? cs + i : cs + len - 1 - i; w[j] = au[(size_t)row * 512]; }
#pragma unroll
                    for (int j = 0; j < 16; ++j) if (i0 + j < len) { const float l2a = bf2f(w[j] >> 16), uu = bf2f(w[j] & 0xffffu); h = ex2(l2a) * h + uu; S += l2a; } }
                SUMM[((size_t)(d * 256 + c) * 512 + tid) * 2] = S; SUMM[((size_t)(d * 256 + c) * 512 + tid) * 2 + 1] = h; }
        } else if (EN(6) && sub == 4) {
            for (int rs_ = 0; rs_ < DUP_S4; ++rs_) {
            __syncthreads();
            for (int c = bid; c < 256; c += G) { LAS float* hfs = (LAS float*)lds; const f32x2_t* S0 = (const f32x2_t*)SUMM + tid; const f32x2_t* S1 = S0 + (size_t)256 * 512;
                const int cs = chunk_start(c), len = chunk_start(c + 1) - cs;
                float hf = 0.f, hb = 0.f;
                for (int p0 = 0; p0 < c; p0 += 16) { f32x2_t sv[16];
#pragma unroll
                    for (int j = 0; j < 16; ++j) { const int k = p0 + j < c ? p0 + j : c - 1; sv[j] = S0[(size_t)k * 512]; }
#pragma unroll
                    for (int j = 0; j < 16; ++j) if (p0 + j < c) hf = ex2(sv[j][0]) * hf + sv[j][1]; }
                const int np = c < 4 ? 3 - c : 4 + 255 - c;
                for (int p0 = 0; p0 < np; p0 += 16) { f32x2_t sv[16];
#pragma unroll
                    for (int j = 0; j < 16; ++j) { const int p = p0 + j < np ? p0 + j : np - 1; const int k = p < 4 ? 3 - p : 259 - p; sv[j] = S1[(size_t)k * 512]; }
#pragma unroll
                    for (int j = 0; j < 16; ++j) if (p0 + j < np) hb = ex2(sv[j][0]) * hb + sv[j][1]; }
                const unsigned* a0 = AU + tid; const unsigned* a1 = AU + (size_t)T * 512 + tid;
                for (int i0 = 0; i0 < len; i0 += 16) { unsigned w[16];
#pragma unroll
                    for (int j = 0; j < 16; ++j) { const int i = i0 + j < len ? i0 + j : len - 1; w[j] = a0[(size_t)(cs + i) * 512]; }
#pragma unroll
                    for (int j = 0; j < 16; ++j) if (i0 + j < len) { hf = ex2(bf2f(w[j] >> 16)) * hf + bf2f(w[j] & 0xffffu); hfs[(i0 + j) * 512 + tid] = hf; } }
                for (int i0 = 0; i0 < len; i0 += 16) { unsigned w[16]; bf16_t gg[16];
#pragma unroll
                    for (int j = 0; j < 16; ++j) { const int i = i0 + j < len ? i0 + j : len - 1; const int row = cs + len - 1 - i; w[j] = a1[(size_t)row * 512]; gg[j] = LRUG[(size_t)row * 512 + tid]; }
#pragma unroll
                    for (int j = 0; j < 16; ++j) if (i0 + j < len) { const int ii = len - 1 - (i0 + j); hb = ex2(bf2f(w[j] >> 16)) * hb + bf2f(w[j] & 0xffffu);
                        MIX[(size_t)(cs + ii) * DM + 512 + tid] = f2bf((hfs[ii * 512 + tid] + hb) * gelu_tanh(bf2f(gg[j]))); } } }
            { const float linit = l == 0 ? 0.2f : 0.35550906759096926f;
              const float e1 = __expf(wave_sum(PIN(I_LQ1)[l * 64 + lane] * PIN(I_LK1)[l * 64 + lane])), e2 = __expf(wave_sum(PIN(I_LQ2)[l * 64 + lane] * PIN(I_LK2)[l * 64 + lane])); const float lam = e1 - e2 + linit;
              const float g0 = PIN(I_SUBLN)[l * 128 + 2 * lane] * (1.f - linit), g1 = PIN(I_SUBLN)[l * 128 + 2 * lane + 1] * (1.f - linit);
              for (int row = gw; row < T; row += NGW) { unsigned w1[4], w2[4];
#pragma unroll
                  for (int h = 0; h < 4; ++h) { w1[h] = *(const unsigned*)(DAO + (size_t)row * 1024 + h * 256 + 2 * lane); w2[h] = *(const unsigned*)(DAO + (size_t)row * 1024 + h * 256 + 128 + 2 * lane); }
#pragma unroll
                  for (int h = 0; h < 4; ++h) { const float y0 = bf2f(w1[h] & 0xffffu) - lam * bf2f(w2[h] & 0xffffu), y1 = bf2f(w1[h] >> 16) - lam * bf2f(w2[h] >> 16); const float inv = rsqrtf(wave_sum(y0 * y0 + y1 * y1) * (1.f / 128.f) + 1e-6f);
                      *(unsigned*)(MIX + (size_t)row * DM + h * 128 + 2 * lane) = pk2(y0 * inv * g0, y1 * inv * g1); } } }
            }
        } else if (EN(7) && sub == 5) {
            pg8::Gemm g{MIX + (size_t)256 * DM, WOUT, T - 256, DM, DM}; pg8::StaticOrder S; S.init(T - 256, DM, G, bid);
            EpiRes E{l == 0 ? PIN(I_CTX) : XRES, l == 0 ? PIN(I_X) : XRES + (size_t)NCTX * DM, XRES, mods_c + 2 * DM, mods_l + 2 * DM, 1};
            pg8::gemm_phase<EpiRes, pg8::StaticOrder, true, true>(lds, g, S, E);
            if (l == 0) for (int kp = 0; kp < 4; ++kp) {
                pg8::Gemm gc{MIX + kp * 512, WOUT + kp * 512, 256, DM, 512, DM}; pg8::StaticOrder Sc; Sc.init(256, DM, G, (bid + G - 8 * kp) % G); EpiResAtomic Ec{XRES, mods_c + 2 * DM};
                pg8::gemm_phase<EpiResAtomic, pg8::StaticOrder, true, true>(lds, gc, Sc, Ec); }
        } else if (EN(8) && (sub == 6 || sub == 9)) {
            const bool second = sub == 9, fin = second && l == 1;
            const float* gam = PIN(second ? I_LN2G : I_LN1G) + (size_t)l * DM; const float* bet = PIN(second ? I_LN2B : I_LN1B) + (size_t)l * DM;
#define LN_LOAD(V, R) do { _Pragma("unroll") for (int j_ = 0; j_ < 8; ++j_) V[j_] = *(const f32x4*)(XRES + (size_t)(R) * DM + 4 * lane + 256 * j_); } while (0)
#define LN_ROW(V, R) do { const int row_ = (R); float* yr_ = XRES + (size_t)row_ * DM; float s_ = 0.f; \
                _Pragma("unroll") for (int j_ = 0; j_ < 8; ++j_) s_ += (V[j_][0] + V[j_][1]) + (V[j_][2] + V[j_][3]); \
                const float mean_ = wave_sum(s_) * (1.f / DM); float s2_ = 0.f; \
                _Pragma("unroll") for (int j_ = 0; j_ < 8; ++j_) { V[j_] = V[j_] - mean_; s2_ += (V[j_][0] * V[j_][0] + V[j_][1] * V[j_][1]) + (V[j_][2] * V[j_][2] + V[j_][3] * V[j_][3]); } \
                const float rstd_ = rsqrtf(wave_sum(s2_) * (1.f / DM) + 1e-5f); \
                const float* md_ = second ? MODS + (size_t)((l + 1) * 2 + (row_ < NCTX ? 0 : 1)) * 12288 : MODS + (size_t)(l * 2 + (row_ < NCTX ? 0 : 1)) * 12288 + 3 * DM; \
                float* dst_ = fin ? ((float*)(GAS float*)pp->out) + (size_t)(row_ - NCTX) * DM : yr_; \
                const float rs2_ = (!second && row_ < NCTX) ? ALPHA : 1.f; \
                _Pragma("unroll") for (int j_ = 0; j_ < 8; ++j_) { const int c_ = 4 * lane + 256 * j_; const f32x4 xn_ = V[j_] * rstd_ * *(const f32x4*)(gam + c_) + *(const f32x4*)(bet + c_); *(f32x4*)(dst_ + c_) = xn_ * rs2_; \
                    if (!fin) { const f32x4 sh_ = *(const f32x4*)(md_ + c_), sc_ = *(const f32x4*)(md_ + DM + c_); st4bf(XMOD + (size_t)row_ * DM + c_, xn_ * (sc_ + 1.f) + sh_); } } } while (0)
            { f32x4 va[8], vb[8]; int row = gw + l * NCTX;
#pragma unroll
              for (int j = 0; j < 8; ++j) { va[j] = (f32x4){0.f, 0.f, 0.f, 0.f}; vb[j] = va[j]; }
              if (row < T) LN_LOAD(va, row);
              for (; row < T; row += 2 * NGW) {
                  const bool hb = row + NGW < T;
                  if (hb) LN_LOAD(vb, row + NGW);
                  LN_ROW(va, row);
                  if (row + 2 * NGW < T) LN_LOAD(va, row + 2 * NGW);
                  if (hb) LN_ROW(vb, row + NGW);
              } }
#undef LN_LOAD
#undef LN_ROW
        } else if (EN(9) && sub == 7) {
            pg8::Gemm g{XMOD + (size_t)l * 256 * DM, WGU, T - l * 256, 2 * DFF, DM}; pg8::StaticOrder S; S.init(T - l * 256, 2 * DFF, G, bid); EpiGU E{HB, l};
            for (int rg_ = 0; rg_ < DUP_GEMM; ++rg_) pg8::gemm_phase<EpiGU, pg8::StaticOrder, true, true>(lds, g, S, E);
        } else if (EN(10) && sub == 8) {
            pg8::Gemm g{HB + (size_t)256 * DFF, WD, T - 256, DM, DFF}; pg8::StaticOrder S; S.init(T - 256, DM, G, bid);
            EpiRes E{XRES, XRES + (size_t)NCTX * DM, XRES, mods_c + 5 * DM, mods_l + 5 * DM, 1};
            pg8::gemm_phase<EpiRes, pg8::StaticOrder, true, true>(lds, g, S, E);
            if (l == 0) for (int kp = 0; kp < 4; ++kp) {
                pg8::Gemm gc{HB + kp * 1408, WD + kp * 1408, 256, DM, 1408, DFF}; pg8::StaticOrder Sc; Sc.init(256, DM, G, (bid + G - 8 * kp) % G); EpiResAtomic Ec{XRES, mods_c + 5 * DM};
                pg8::gemm_phase<EpiResAtomic, pg8::StaticOrder, true, true>(lds, gc, Sc, Ec); }
        }
        if (ph + 1 < P.ph_hi) { if (ph == 0) grid.sync(); else xcd_barrier(xbar); }
    }
}

template <unsigned MASK> static void launch_one(int grid, Params p, hipStream_t stream, bool coop) {
    static bool attr_set = false;
    if (!attr_set) { (void)hipFuncSetAttribute((const void*)mega_fwd<MASK>, hipFuncAttributeMaxDynamicSharedMemorySize, LDS_BYTES); attr_set = true; }
    if (coop) { void* args[] = {&p}; hipError_t e = hipLaunchCooperativeKernel((const void*)mega_fwd<MASK>, dim3(grid), dim3(NTHR), args, LDS_BYTES, stream);
        if (e != hipSuccess) fprintf(stderr, "cooperative launch failed: %s (grid %d)\n", hipGetErrorString(e), grid); }
    else hipLaunchKernelGGL(mega_fwd<MASK>, dim3(grid), dim3(NTHR), LDS_BYTES, stream, p);
}
extern "C" void kernel_launch(void* const* d_in, const int* in_sizes, int n_in, void* d_out, int out_size, void* d_ws, size_t ws_size, hipStream_t stream) {
    static int grid = 0;
    if (grid == 0) {
        if (n_in != 31 || ws_size < WS_NEED) { fprintf(stderr, "kernel_launch: need 31 inputs and %zu bytes of workspace; got %d, %zu\n", (size_t)WS_NEED, n_in, ws_size); grid = -1; return; }
        int dev = 0, cus = 0;
        (void)hipGetDevice(&dev); (void)hipDeviceGetAttribute(&cus, hipDeviceAttributeMultiprocessorCount, dev);
        grid = cus;
#if !MK_MULTI
        int per_cu = 0;
        (void)hipFuncSetAttribute((const void*)mega_fwd<PH_MASK>, hipFuncAttributeMaxDynamicSharedMemorySize, LDS_BYTES);
        (void)hipOccupancyMaxActiveBlocksPerMultiprocessor(&per_cu, (const void*)mega_fwd<PH_MASK>, NTHR, LDS_BYTES);
        if (per_cu < 1) fprintf(stderr, "kernel_launch: occupancy query returned %d\n", per_cu);
        (void)hipGetLastError();
#endif
    }
    if (grid < 0) return;
    Params p{};
    for (int i = 0; i < 31; ++i) p.in[i] = (const float*)d_in[i];
    p.out = (float*)d_out; p.ws = (unsigned char*)d_ws;
#if MK_MULTI
#define L1(ph, mask) do { p.ph_lo = (ph); p.ph_hi = (ph) + 1; launch_one<(mask)>(grid, p, stream, false); } while (0)
    L1(0, 1u); L1(1, 2u);
    for (int l = 0; l < 2; ++l) { const int b = 2 + 10 * l;
        L1(b + 0, 1u << 2); L1(b + 1, (1u << 3) | (1u << 11) | (1u << 12) | (1u << 13)); L1(b + 1, (1u << 3) | (1u << 14) | (1u << 15));
        L1(b + 2, (1u << 4) | (1u << 16)); L1(b + 2, (1u << 4) | (1u << 17)); L1(b + 2, (1u << 4) | (1u << 18));
        L1(b + 3, 1u << 5); L1(b + 4, 1u << 6); L1(b + 5, 1u << 7); L1(b + 6, 1u << 8); L1(b + 7, 1u << 9); L1(b + 8, 1u << 10); L1(b + 9, 1u << 8); }
#else
    p.ph_lo = 0; p.ph_hi = N_PHASES;
    (void)hipMemsetAsync((unsigned char*)d_ws + O_BAR, 0, 16384, stream);
    launch_one<PH_MASK>(grid, p, stream, true);
#endif
}
```
